# Optimizing an MI355X kernel written in HIP

```python
import jax, jax.numpy as jnp
from jax import lax
import numpy as np

D_MODEL = 1024
BATCH = 32
SEQ = 2048
DEPTH = 4
DEC_BATCH = 32
DEC_SEQ = 32
PAST_LEN = 1024

CHUNK = 64
GMLP_CHUNK = 128
GMLP_GROUPS = 8
WIDTH_A = D_MODEL
GMLP_HEAD = WIDTH_A // GMLP_GROUPS
WIDTH_B = D_MODEL
CONV_WIDTH = 3
D_FF = ((8 * D_MODEL // 3 + 255) // 256) * 256
EPS = 1e-6
SPLITS = (WIDTH_A, WIDTH_A, WIDTH_B, WIDTH_B, WIDTH_B, D_MODEL, D_MODEL)
IN_COLS = sum(SPLITS)
SPLIT_IDX = tuple(int(i) for i in np.cumsum(SPLITS)[:-1])

kernel_name = "hybrid_gmlp_shortconv_streaming_step"


def rmsnorm(x, g):
    xf = x.astype(jnp.float32)
    r = lax.rsqrt(jnp.mean(xf * xf, axis=-1, keepdims=True) + EPS)
    return (xf * r).astype(x.dtype) * g


def layernorm(x, g, b):
    xf = x.astype(jnp.float32)
    mu = jnp.mean(xf, axis=-1, keepdims=True)
    var = jnp.mean(jnp.square(xf - mu), axis=-1, keepdims=True)
    return ((xf - mu) * lax.rsqrt(var + EPS)).astype(x.dtype) * g + b


def spatial_gate(v, w_s, b_s):
    bsz, L, _ = v.shape
    n_chunks = -(-L // GMLP_CHUNK)
    pad = n_chunks * GMLP_CHUNK - L
    vp = jnp.pad(v, ((0, 0), (0, pad), (0, 0)))
    vr = vp.reshape(bsz, n_chunks, GMLP_CHUNK, GMLP_GROUPS, GMLP_HEAD)
    mask = jnp.tril(jnp.ones((GMLP_CHUNK, GMLP_CHUNK), dtype=bool))
    ws = jnp.where(mask[None], w_s, jnp.zeros_like(w_s))
    out = jnp.einsum('gij,bcjgd->bcigd', ws, vr) + b_s.T[None, None, :, :, None]
    return out.reshape(bsz, n_chunks * GMLP_CHUNK, WIDTH_A)[:, :L]


def mixer(xn, conv_prev, w_in, ln_g, ln_b, w_s, b_s, conv_w, w_pa, w_pb, w_o):
    z = xn @ w_in
    u_a, v_a, bg, cg, hh, ga, gb = jnp.split(z, SPLIT_IDX, axis=-1)
    u = jax.nn.gelu(u_a, approximate=False)
    v = layernorm(jax.nn.gelu(v_a, approximate=False), ln_g, ln_b)
    a = u * spatial_gate(v, w_s, b_s)
    L = xn.shape[1]
    xc = jnp.concatenate([conv_prev, cg * hh], axis=1)
    conv = conv_w[0] * xc[:, :L] + conv_w[1] * xc[:, 1:L + 1] + conv_w[2] * xc[:, 2:]
    bconv = bg * conv
    m = jax.nn.sigmoid(ga) * (a @ w_pa) + jax.nn.sigmoid(gb) * (bconv @ w_pb)
    return m @ w_o, xc[:, -(CONV_WIDTH - 1):], v


def swiglu(x, w_gate, w_up, w_down):
    return (jax.nn.silu(x @ w_gate) * (x @ w_up)) @ w_down


def trunk(x, conv_states, norm_mix, w_in, ln_g, ln_b, w_s, b_s, conv_w,
          w_pa, w_pb, w_o, norm_ffn, w_gate, w_up, w_down, norm_final):
    new_conv, new_v = [], []
    for l in range(DEPTH):
        mo, c_new, v_rows = mixer(rmsnorm(x, norm_mix[l]), conv_states[l], w_in[l], ln_g[l], ln_b[l],
                                  w_s[l], b_s[l], conv_w[l], w_pa[l], w_pb[l], w_o[l])
        x = x + mo
        x = x + swiglu(rmsnorm(x, norm_ffn[l]), w_gate[l], w_up[l], w_down[l])
        new_conv.append(c_new)
        new_v.append(v_rows)
    return rmsnorm(x, norm_final), jnp.stack(new_conv), jnp.stack(new_v)


def setup_inputs(seed: int = 0) -> dict:
    key = jax.random.key(seed)
    ks = jax.random.split(key, 20)
    f32 = jnp.float32
    def nrm(k, shape, scale):
        return jax.random.normal(k, shape, f32) * scale
    return {
        "x_prompt": nrm(ks[0], (BATCH, SEQ, D_MODEL), 1.0),
        "x_sample": nrm(ks[1], (DEC_BATCH, DEC_SEQ, D_MODEL), 1.0),
        "state_conv": nrm(ks[2], (DEPTH, DEC_BATCH, CONV_WIDTH - 1, WIDTH_B), 1.0),
        "norm_mix": 1.0 + nrm(ks[3], (DEPTH, D_MODEL), 0.02),
        "w_in": nrm(ks[4], (DEPTH, D_MODEL, IN_COLS), D_MODEL ** -0.5),
        "gmlp_ln_g": 1.0 + nrm(ks[5], (DEPTH, WIDTH_A), 0.02),
        "gmlp_ln_b": nrm(ks[6], (DEPTH, WIDTH_A), 0.02),
        "w_s": nrm(ks[7], (DEPTH, GMLP_GROUPS, GMLP_CHUNK, GMLP_CHUNK), GMLP_CHUNK ** -0.5),
        "b_s": 1.0 + nrm(ks[8], (DEPTH, GMLP_GROUPS, GMLP_CHUNK), 0.02),
        "conv_w": nrm(ks[9], (DEPTH, CONV_WIDTH, WIDTH_B), CONV_WIDTH ** -0.5),
        "w_pa": nrm(ks[10], (DEPTH, WIDTH_A, D_MODEL), WIDTH_A ** -0.5),
        "w_pb": nrm(ks[11], (DEPTH, WIDTH_B, D_MODEL), WIDTH_B ** -0.5),
        "w_o": nrm(ks[12], (DEPTH, D_MODEL, D_MODEL), 0.5 * D_MODEL ** -0.5),
        "norm_ffn": 1.0 + nrm(ks[13], (DEPTH, D_MODEL), 0.02),
        "w_gate": nrm(ks[14], (DEPTH, D_MODEL, D_FF), D_MODEL ** -0.5),
        "w_up": nrm(ks[15], (DEPTH, D_MODEL, D_FF), D_MODEL ** -0.5),
        "w_down": nrm(ks[16], (DEPTH, D_FF, D_MODEL), 0.5 * D_FF ** -0.5),
        "norm_final": 1.0 + nrm(ks[17], (D_MODEL,), 0.02),
    }


def reference(x_prompt, x_sample, state_conv, norm_mix, w_in, gmlp_ln_g, gmlp_ln_b, w_s, b_s,
              conv_w, w_pa, w_pb, w_o, norm_ffn, w_gate, w_up, w_down, norm_final):
    params = (norm_mix, w_in, gmlp_ln_g, gmlp_ln_b, w_s, b_s, conv_w,
              w_pa, w_pb, w_o, norm_ffn, w_gate, w_up, w_down, norm_final)
    zero_conv = jnp.zeros((DEPTH, x_prompt.shape[0], CONV_WIDTH - 1, WIDTH_B), dtype=x_prompt.dtype)
    y_prompt, new_conv_prompt, _ = trunk(x_prompt, zero_conv, *params)
    y_sample, new_conv_sample, new_gmlp_v_sample = trunk(x_sample, state_conv, *params)
    return (y_prompt, y_sample, new_conv_prompt, new_conv_sample, new_gmlp_v_sample)
```

```cpp
#include <hip/hip_runtime.h>
#include <hip/hip_cooperative_groups.h>
#include <cstdio>
#include <cstdint>
namespace cg = cooperative_groups;

#ifndef PHASE_MASK
#define PHASE_MASK 511
#endif
#ifndef MK_MULTI
#define MK_MULTI 0
#endif

constexpr int MP = 65536, MS = 1024, MT = MP + MS, DM = 1024, NL = 4, DFF = 2816, NIN = 7168;
constexpr float EPS = 1e-6f;
constexpr size_t OUT_YS = (size_t)MP * DM, OUT_NCP = OUT_YS + (size_t)MS * DM, OUT_NCS = OUT_NCP + (size_t)NL * 32 * 2 * DM, OUT_V = OUT_NCS + (size_t)NL * 32 * 2 * DM;
constexpr size_t OUT_TOTAL = OUT_V + (size_t)NL * 32 * 32 * DM;

constexpr size_t MiB = (size_t)1 << 20;
constexpr size_t WS_SSQM = 0, WS_SSQF = 5 * MiB, WS_LNS = 10 * MiB;
constexpr size_t WS_W = 24 * MiB;
constexpr size_t LW_WIN = 0, LW_WPAB = LW_WIN + (size_t)NIN * DM * 2, LW_WO = LW_WPAB + (size_t)2048 * DM * 2, LW_WGU = LW_WO + (size_t)DM * DM * 2,
                 LW_WD = LW_WGU + (size_t)2 * DFF * DM * 2, LW_WSP = LW_WD + (size_t)DM * DFF * 2, LW_WSS = LW_WSP + (size_t)8 * 128 * 128 * 2, LW_BYTES = LW_WSS + (size_t)8 * 128 * 128 * 2;
constexpr size_t WS_XB = 176 * MiB;
constexpr size_t WS_AB = 306 * MiB;
constexpr size_t WS_GV = 566 * MiB;
constexpr size_t WS_CH = 696 * MiB;
constexpr size_t WS_END = 826 * MiB;
static_assert(WS_W + NL * LW_BYTES <= WS_XB, "weights overflow");

namespace pg8 {
#define PG8_LAS __attribute__((address_space(3)))
typedef unsigned short bf16_t;
typedef short bf16x8 __attribute__((ext_vector_type(8)));
typedef float f32x4 __attribute__((ext_vector_type(4)));
typedef float f32x2 __attribute__((ext_vector_type(2)));
typedef unsigned u32x4 __attribute__((ext_vector_type(4)));
typedef unsigned u32x2 __attribute__((ext_vector_type(2)));
constexpr int BM = 256, BK = 64, HALF = 128, HTB = HALF * BK * 2, STAGE_BYTES = 8 * HTB, NXCD = 8, WGM = 8;

__host__ __device__ __forceinline__ int lds_byte(int r, int c) { const int st = (r >> 4) * 2 + (c >> 5), rr = r & 15, cc = c & 31, ob = rr * 64 + cc * 2; return st * 1024 + (ob ^ (((ob >> 9) & 1) << 5)); }
__host__ __device__ __forceinline__ void stage_rc(int b, int& R, int& C) { const int st = b / 1024, sb = b % 1024, swz = sb ^ (((sb >> 9) & 1) << 5); R = (st >> 1) * 16 + swz / 64; C = (st & 1) * 32 + (swz % 64) / 2; }
__host__ __device__ __forceinline__ int perm32(int rho) { const int n = rho >> 4, i = rho & 15; return 8 * (i >> 2) + 4 * n + (i & 3); }

struct Unit { int pm, pn; };
struct Gemm { const bf16_t* A; const bf16_t* Bt; int M, N, K, lda, asplit_pn, asplit_off; };

struct StaticOrder {
    int nM, nN, nwg, G, c;
    __host__ __device__ void init(int M, int N, int G_, int c_) { nM = M / BM; nN = N / BM; nwg = nM * nN; G = G_; c = c_; }
    __host__ __device__ bool next(int i, Unit& u) const {
        const long L = (long)i * G + c; if (L >= nwg) return false;
        int wgid = (int)L; { const int q = nwg / NXCD, r = nwg % NXCD, xcd = wgid % NXCD, off = wgid / NXCD; wgid = (xcd < r ? xcd * (q + 1) : r * (q + 1) + (xcd - r) * q) + off; }
        const int nig = WGM * nN, gid = wgid / nig, fm = gid * WGM, gsz = (nM - fm) < WGM ? (nM - fm) : WGM;
        u.pm = fm + ((wgid % nig) % gsz); u.pn = (wgid % nig) / gsz; return true;
    }
    __device__ __forceinline__ void a_ready(const Unit&) const {}
    __device__ __forceinline__ void done(const Unit&) const {}
};

__device__ __forceinline__ unsigned cvt_pk_bf16(float lo, float hi) { unsigned r; asm volatile("v_cvt_pk_bf16_f32 %0, %1, %2" : "=v"(r) : "v"(lo), "v"(hi)); return r; }
__device__ __forceinline__ float bf_lo(unsigned w) { return __uint_as_float(w << 16); }
__device__ __forceinline__ float bf_hi(unsigned w) { return __uint_as_float(w & 0xffff0000u); }
__device__ __forceinline__ f32x2 gelu_pk(f32x2 v) {
    const f32x2 av = __builtin_elementwise_abs(v), d = av * 0.2316418882f + 1.0f;
    f32x2 t; t.x = __builtin_amdgcn_rcpf(d.x); t.y = __builtin_amdgcn_rcpf(d.y);
    f32x2 q = t * 0.5307027145f + (-0.7265760135f); q = q * t + 0.7107068705f; q = q * t + (-0.142248368f); q = q * t + 0.127414796f; q = q * t;
    const f32x2 s = (v * v) * (-0.72134752044f);
    f32x2 e; e.x = __builtin_amdgcn_exp2f(s.x); e.y = __builtin_amdgcn_exp2f(s.y);
    const f32x2 m = v * (q * e), r = v - m;
    f32x2 o; o.x = v.x < 0.f ? m.x : r.x; o.y = v.y < 0.f ? m.y : r.y; return o;
}
__device__ __forceinline__ f32x4 gelu4(f32x4 v) { const f32x2 a = gelu_pk((f32x2){v[0], v[1]}), b = gelu_pk((f32x2){v[2], v[3]}); return (f32x4){a.x, a.y, b.x, b.y}; }
__device__ __forceinline__ float sigmoidf_(float x) { return __builtin_amdgcn_rcpf(1.0f + __builtin_amdgcn_exp2f(x * -1.44269504f)); }
__device__ __forceinline__ f32x4 sigmoid4(f32x4 v) { return (f32x4){sigmoidf_(v[0]), sigmoidf_(v[1]), sigmoidf_(v[2]), sigmoidf_(v[3])}; }
__device__ __forceinline__ u32x4 pack8(f32x4 v0, f32x4 v1) { u32x4 w; w.x = cvt_pk_bf16(v0[0], v0[1]); w.y = cvt_pk_bf16(v0[2], v0[3]); w.z = cvt_pk_bf16(v1[0], v1[1]); w.w = cvt_pk_bf16(v1[2], v1[3]); return w; }
__device__ __forceinline__ float rstd_of(const float* slots, int row) { const f32x4* s = (const f32x4*)(slots + (size_t)row * 16); const f32x4 t = (s[0] + s[1]) + (s[2] + s[3]);
    return __builtin_amdgcn_rsqf(((t[0] + t[1]) + (t[2] + t[3])) * (1.0f / 1024.0f) + EPS); }


struct EpiA {
    static constexpr bool PERM = true, AFTER_DRAIN = false;
    bf16_t* AB; bf16_t* GV; bf16_t* CH; const float* ssq; float* lns;
    __device__ __forceinline__ void operator()(const f32x4 (&acc)[2][2][4][2], const Unit& u, int wr, int wc, int fr, int fq) const {
        const int row0 = u.pm * BM + wr * 64 + fr, cw = wc * 32 + 8 * fq, pn = u.pn;
        if (pn < 4) {
#pragma unroll
            for (int ai = 0; ai < 2; ++ai)
#pragma unroll
                for (int m = 0; m < 4; ++m) { const int row = row0 + ai * HALF + m * 16; const float rs = rstd_of(ssq, row); bf16_t* rowp = AB + (size_t)row * 2048 + pn * 256 + cw;
#pragma unroll
                    for (int bj = 0; bj < 2; ++bj) *(u32x4*)(rowp + bj * HALF) = pack8(gelu4(acc[ai][bj][m][0] * rs), gelu4(acc[ai][bj][m][1] * rs)); }
        } else if (pn < 8) {
#pragma unroll
            for (int ai = 0; ai < 2; ++ai)
#pragma unroll
                for (int m = 0; m < 4; ++m) { const int row = row0 + ai * HALF + m * 16; const float rs = rstd_of(ssq, row); bf16_t* rowp = GV + (size_t)row * 1024 + (pn - 4) * 256 + cw;
                    float s = 0.f, q = 0.f;
#pragma unroll
                    for (int bj = 0; bj < 2; ++bj) { const u32x4 w = pack8(gelu4(acc[ai][bj][m][0] * rs), gelu4(acc[ai][bj][m][1] * rs)); *(u32x4*)(rowp + bj * HALF) = w;
#pragma unroll
                        for (int e = 0; e < 4; ++e) { const float a = bf_lo(w[e]), b = bf_hi(w[e]); s += a + b; q += a * a + b * b; } }
                    s += __shfl_xor(s, 16); s += __shfl_xor(s, 32); q += __shfl_xor(q, 16); q += __shfl_xor(q, 32);
                    if (fq == 0) *(f32x2*)(lns + ((size_t)row * 16 + (pn - 4) * 4 + wc) * 2) = (f32x2){s, q}; }
        } else if (pn < 12) {
#pragma unroll
            for (int ai = 0; ai < 2; ++ai)
#pragma unroll
                for (int m = 0; m < 4; ++m) { const int row = row0 + ai * HALF + m * 16; const float rs = rstd_of(ssq, row); bf16_t* rowp = AB + (size_t)row * 2048 + 1024 + (pn - 8) * 256 + cw;
#pragma unroll
                    for (int bj = 0; bj < 2; ++bj) *(u32x4*)(rowp + bj * HALF) = pack8(acc[ai][bj][m][0] * rs, acc[ai][bj][m][1] * rs); }
        } else {
#pragma unroll
            for (int ai = 0; ai < 2; ++ai)
#pragma unroll
                for (int m = 0; m < 4; ++m) { const int row = row0 + ai * HALF + m * 16; const float rs = rstd_of(ssq, row); const float rs2 = rs * rs;
                    *(u32x4*)(CH + (size_t)row * 1024 + (pn - 12) * 128 + cw) = pack8(acc[ai][0][m][0] * acc[ai][1][m][0] * rs2, acc[ai][0][m][1] * acc[ai][1][m][1] * rs2); }
        }
    }
};
struct EpiC {
    static constexpr bool PERM = true, AFTER_DRAIN = false;
    bf16_t* T;
    __device__ __forceinline__ void operator()(const f32x4 (&acc)[2][2][4][2], const Unit& u, int wr, int wc, int fr, int fq) const {
        const int row0 = u.pm * BM + wr * 64 + fr, cw = u.pn * 256 + wc * 32 + 8 * fq;
#pragma unroll
        for (int ai = 0; ai < 2; ++ai)
#pragma unroll
            for (int m = 0; m < 4; ++m) { bf16_t* rowp = T + (size_t)(row0 + ai * HALF + m * 16) * 2048 + cw;
#pragma unroll
                for (int bj = 0; bj < 2; ++bj) *(u32x4*)(rowp + bj * HALF) = pack8(acc[ai][bj][m][0], acc[ai][bj][m][1]); }
    }
};
struct EpiD {
    static constexpr bool PERM = true, AFTER_DRAIN = false;
    const bf16_t* T; bf16_t* MM; const float* ssq;
    __device__ __forceinline__ void operator()(const f32x4 (&acc)[2][2][4][2], const Unit& u, int wr, int wc, int fr, int fq) const {
        const int row0 = u.pm * BM + wr * 64 + fr, cw = u.pn * 128 + wc * 32 + 8 * fq;
#pragma unroll
        for (int ai = 0; ai < 2; ++ai)
#pragma unroll
            for (int m = 0; m < 4; ++m) { const int row = row0 + ai * HALF + m * 16; const float rs = rstd_of(ssq, row);
                const u32x4 t1 = *(const u32x4*)(T + (size_t)row * 2048 + cw), t2 = *(const u32x4*)(T + (size_t)row * 2048 + 1024 + cw);
                const f32x4 a0 = sigmoid4(acc[ai][0][m][0] * rs), a1 = sigmoid4(acc[ai][0][m][1] * rs), b0 = sigmoid4(acc[ai][1][m][0] * rs), b1 = sigmoid4(acc[ai][1][m][1] * rs);
                const f32x4 p0 = {bf_lo(t1[0]), bf_hi(t1[0]), bf_lo(t1[1]), bf_hi(t1[1])}, p1 = {bf_lo(t1[2]), bf_hi(t1[2]), bf_lo(t1[3]), bf_hi(t1[3])};
                const f32x4 q0 = {bf_lo(t2[0]), bf_hi(t2[0]), bf_lo(t2[1]), bf_hi(t2[1])}, q1 = {bf_lo(t2[2]), bf_hi(t2[2]), bf_lo(t2[3]), bf_hi(t2[3])};
                *(u32x4*)(MM + (size_t)row * 1024 + cw) = pack8(a0 * p0 + b0 * q0, a1 * p1 + b1 * q1); }
    }
};
struct EpiRes {
    static constexpr bool PERM = false, AFTER_DRAIN = false;
    const float* xold_p; const float* xold_s; float* xout; bf16_t* xb; float* ssq;
    __device__ __forceinline__ void operator()(const f32x4 (&acc)[2][2][4][2], const Unit& u, int wr, int wc, int fr, int fq) const {
        const int row0 = u.pm * BM + wr * 64 + fr, col0 = u.pn * BM + wc * 32 + 4 * fq;
        const float* xo = (u.pm < MP / BM) ? xold_p : xold_s - (size_t)MP * DM;
#pragma unroll
        for (int ai = 0; ai < 2; ++ai)
#pragma unroll
            for (int m = 0; m < 4; ++m) { const int row = row0 + ai * HALF + m * 16; const size_t off = (size_t)row * DM + col0; float q = 0.f;
#pragma unroll
                for (int bj = 0; bj < 2; ++bj)
#pragma unroll
                    for (int n = 0; n < 2; ++n) { const f32x4 xv = *(const f32x4*)(xo + off + bj * HALF + n * 16) + acc[ai][bj][m][n];
                        *(f32x4*)(xout + off + bj * HALF + n * 16) = xv; q += (xv[0] * xv[0] + xv[1] * xv[1]) + (xv[2] * xv[2] + xv[3] * xv[3]);
                        u32x2 w; w.x = cvt_pk_bf16(xv[0], xv[1]); w.y = cvt_pk_bf16(xv[2], xv[3]); *(u32x2*)(xb + off + bj * HALF + n * 16) = w; }
                q += __shfl_xor(q, 16); q += __shfl_xor(q, 32);
                if (fq == 0) ssq[(size_t)row * 16 + u.pn * 4 + wc] = q;
                asm volatile("" ::: "memory"); }
    }
};
struct EpiF {
    static constexpr bool PERM = true, AFTER_DRAIN = false;
    bf16_t* H; const float* ssq;
    __device__ __forceinline__ void operator()(const f32x4 (&acc)[2][2][4][2], const Unit& u, int wr, int wc, int fr, int fq) const {
        const int row0 = u.pm * BM + wr * 64 + fr, cw = u.pn * 128 + wc * 32 + 8 * fq;
#pragma unroll
        for (int ai = 0; ai < 2; ++ai)
#pragma unroll
            for (int m = 0; m < 4; ++m) { const int row = row0 + ai * HALF + m * 16; const float rs = rstd_of(ssq, row);
                const f32x4 g0 = acc[ai][0][m][0] * rs, g1 = acc[ai][0][m][1] * rs, u0 = acc[ai][1][m][0] * rs, u1 = acc[ai][1][m][1] * rs;
                *(u32x4*)(H + (size_t)row * DFF + cw) = pack8(g0 * sigmoid4(g0) * u0, g1 * sigmoid4(g1) * u1); }
    }
};

template <class Epi, class Sched>
__device__ __forceinline__ void gemm_phase(PG8_LAS unsigned char* lds, const Gemm g, const Sched& S, const Epi& E) {
    int tid = threadIdx.x; asm volatile("" : "+v"(tid));
    const int wid = __builtin_amdgcn_readfirstlane(tid >> 6), lane = tid & 63, wr = wid >> 2, wc = wid & 3, fr = lane & 15, fq = lane >> 4;
    const int K = g.K, nt = K / BK, lda = g.lda;
    unsigned voffA[2], voffB[2];
#pragma unroll
    for (int i = 0; i < 2; ++i) { int R, C; stage_rc(tid * 16 + i * 8192, R, C); const int Rb = Epi::PERM ? ((R & ~31) + perm32(R & 31)) : R;
        voffA[i] = (unsigned)(R * lda + C) * 2u; voffB[i] = (unsigned)(Rb * K + C) * 2u; }
    const size_t kstep = (size_t)(BK * 2);
    const size_t hstepA = (size_t)HALF * lda * 2, hstepB = (size_t)HALF * K * 2;
    const size_t tstepA = 2 * hstepA, tstepB = 2 * hstepB;
    const unsigned ldsw = (unsigned)wid * 1024u;
    const int aoff = lds_byte(wr * 64 + fr, fq * 8), boff = lds_byte(wc * 32 + fr, fq * 8);
#define PG8_SA(b, h) (((b) * 2 + (h)) * HTB)
#define PG8_SB(b, h) ((4 + (b) * 2 + (h)) * HTB)
#define PG8_STAGE(bufoff, gbase, voff) do { _Pragma("unroll") for (int _i = 0; _i < 2; ++_i) \
        __builtin_amdgcn_global_load_lds((const unsigned*)((const char*)(gbase) + (voff)[_i]), (PG8_LAS unsigned*)(lds + (bufoff) + ldsw + _i * 8192), 16, 0, 0); } while (0)
#define PG8_LDA(dst, b, h) do { _Pragma("unroll") for (int m = 0; m < 4; ++m) _Pragma("unroll") for (int k = 0; k < 2; ++k) dst[m][k] = *(const PG8_LAS bf16x8*)(lds + PG8_SA(b, h) + aoff + m * 2048 + k * 1024); } while (0)
#define PG8_LDB(dst, b, h) do { _Pragma("unroll") for (int n = 0; n < 2; ++n) _Pragma("unroll") for (int k = 0; k < 2; ++k) dst[n][k] = *(const PG8_LAS bf16x8*)(lds + PG8_SB(b, h) + boff + n * 2048 + k * 1024); } while (0)
#define PG8_MMA(ai, bj, At, Bt) do { __builtin_amdgcn_s_setprio(1); _Pragma("unroll") for (int m = 0; m < 4; ++m) _Pragma("unroll") for (int n = 0; n < 2; ++n) _Pragma("unroll") for (int k = 0; k < 2; ++k) \
        acc[ai][bj][m][n] = __builtin_amdgcn_mfma_f32_16x16x32_bf16(Bt[n][k], At[m][k], acc[ai][bj][m][n], 0, 0, 0); __builtin_amdgcn_s_setprio(0); } while (0)
#define PG8_WAIT_V(n) asm volatile("s_waitcnt vmcnt(" #n ")" ::: "memory")
#define PG8_WAIT_L(n) asm volatile("s_waitcnt lgkmcnt(" #n ")" ::: "memory")
#define PG8_BAR __builtin_amdgcn_s_barrier()
#define PG8_SCHED __builtin_amdgcn_sched_barrier(0)
#define PG8_APTR(u) ((const char*)g.A + (size_t)(u).pm * tstepA + (((u).pn >= g.asplit_pn) ? (size_t)g.asplit_off * 2 : (size_t)0))
    Unit cur, nxt; int ui = 0;
    if (!S.next(0, cur)) return;
    f32x4 acc[2][2][4][2];
#pragma unroll
    for (int a = 0; a < 2; ++a)
#pragma unroll
        for (int b = 0; b < 2; ++b)
#pragma unroll
            for (int m = 0; m < 4; ++m)
#pragma unroll
                for (int n = 0; n < 2; ++n) acc[a][b][m][n] = (f32x4){0.f, 0.f, 0.f, 0.f};
    bf16x8 At[4][2], B0[2][2], B1[2][2];
    const char* cA = PG8_APTR(cur); const char* cB = (const char*)g.Bt + (size_t)cur.pn * tstepB;
    S.a_ready(cur);
    PG8_STAGE(PG8_SB(0, 0), cB, voffB); PG8_STAGE(PG8_SA(0, 0), cA, voffA); PG8_STAGE(PG8_SB(0, 1), cB + hstepB, voffB); PG8_STAGE(PG8_SA(0, 1), cA + hstepA, voffA);
    if (wr == 1) PG8_BAR;
    PG8_WAIT_V(4); PG8_BAR;
    PG8_STAGE(PG8_SB(1, 0), cB + kstep, voffB); PG8_STAGE(PG8_SA(1, 0), cA + kstep, voffA); PG8_STAGE(PG8_SB(1, 1), cB + hstepB + kstep, voffB);
    PG8_WAIT_V(6); PG8_BAR;
    for (;;) {
        const bool has_next = S.next(ui + 1, nxt);
        const char* nA = has_next ? PG8_APTR(nxt) : cA; const char* nB = has_next ? (const char*)g.Bt + (size_t)nxt.pn * tstepB : cB;
        for (int t = 0; t < nt; t += 2) {
            const bool last = (t == nt - 2);
            const char* a1 = cA + (size_t)(t + 1) * kstep;
            const char* a2 = last ? nA : cA + (size_t)(t + 2) * kstep; const char* b2 = last ? nB : cB + (size_t)(t + 2) * kstep;
            const char* a3 = a2 + kstep; const char* b3 = b2 + kstep;
            if (last && has_next) S.a_ready(nxt);
            PG8_LDB(B0, 0, 0); PG8_SCHED; PG8_LDA(At, 0, 0); PG8_STAGE(PG8_SA(1, 1), a1 + hstepA, voffA);
            PG8_WAIT_L(8); PG8_BAR; PG8_WAIT_L(0); PG8_MMA(0, 0, At, B0); PG8_BAR; PG8_SCHED;
            PG8_LDB(B1, 0, 1); PG8_STAGE(PG8_SB(0, 0), b2, voffB);
            PG8_BAR; PG8_WAIT_L(0); PG8_MMA(0, 1, At, B1); PG8_BAR;
            PG8_LDA(At, 0, 1); PG8_STAGE(PG8_SA(0, 0), a2, voffA);
            PG8_BAR; PG8_WAIT_L(0); PG8_MMA(1, 0, At, B0); PG8_BAR; PG8_SCHED;
            PG8_STAGE(PG8_SB(0, 1), b2 + hstepB, voffB);
            PG8_WAIT_V(6); PG8_BAR; PG8_MMA(1, 1, At, B1); PG8_BAR;
            PG8_LDB(B0, 1, 0); PG8_SCHED; PG8_LDA(At, 1, 0); PG8_STAGE(PG8_SA(0, 1), a2 + hstepA, voffA);
            PG8_WAIT_L(8); PG8_BAR; PG8_WAIT_L(0); PG8_MMA(0, 0, At, B0); PG8_BAR; PG8_SCHED;
            PG8_LDB(B1, 1, 1); PG8_STAGE(PG8_SB(1, 0), b3, voffB);
            PG8_BAR; PG8_WAIT_L(0); PG8_MMA(0, 1, At, B1); PG8_BAR;
            PG8_LDA(At, 1, 1); PG8_STAGE(PG8_SA(1, 0), a3, voffA);
            PG8_BAR; PG8_WAIT_L(0); PG8_MMA(1, 0, At, B0); PG8_BAR; PG8_SCHED;
            PG8_STAGE(PG8_SB(1, 1), b3 + hstepB, voffB);
            PG8_WAIT_V(6); PG8_BAR; PG8_MMA(1, 1, At, B1); PG8_BAR;
        }
        E(acc, cur, wr, wc, fr, fq); S.done(cur);
        if (!has_next) break;
#pragma unroll
        for (int a = 0; a < 2; ++a)
#pragma unroll
            for (int b = 0; b < 2; ++b)
#pragma unroll
                for (int m = 0; m < 4; ++m)
#pragma unroll
                    for (int n = 0; n < 2; ++n) acc[a][b][m][n] = (f32x4){0.f, 0.f, 0.f, 0.f};
        cur = nxt; cA = nA; cB = nB; ++ui;
    }
    PG8_WAIT_V(0);
    if (wr == 0) PG8_BAR;
    PG8_BAR;
#undef PG8_APTR
#undef PG8_SA
#undef PG8_SB
#undef PG8_STAGE
#undef PG8_LDA
#undef PG8_LDB
#undef PG8_MMA
#undef PG8_WAIT_V
#undef PG8_WAIT_L
#undef PG8_BAR
#undef PG8_SCHED
}
}

using pg8::bf16_t; using pg8::f32x4; using pg8::u32x4; using pg8::u32x2; using pg8::bf16x8;
using pg8::cvt_pk_bf16; using pg8::bf_lo; using pg8::bf_hi;

struct Params {
    const float* x_prompt; const float* x_sample; const float* state_conv; const float* norm_mix; const float* w_in; const float* ln_g; const float* ln_b;
    const float* w_s; const float* b_s; const float* conv_w; const float* w_pa; const float* w_pb; const float* w_o; const float* norm_ffn;
    const float* w_gate; const float* w_up; const float* w_down; const float* norm_final;
    float* out; unsigned char* ws; int ph_lo, ph_hi;
};
constexpr int LDS_BYTES = pg8::STAGE_BYTES;
constexpr int NPHASE = 2 + 7 * NL;

__device__ __forceinline__ void transpose_tile(const float* __restrict__ src, int ld, int k0, int col0, const float* __restrict__ scale, bf16_t* __restrict__ dst, int K, float* t, int tid) {
    const int r = tid >> 4, c4 = tid & 15;
#pragma unroll
    for (int pass = 0; pass < 2; ++pass) { const int k = r + 32 * pass; const f32x4 v = *(const f32x4*)(src + (size_t)(k0 + k) * ld + col0 + 4 * c4); const float s = scale ? scale[k0 + k] : 1.0f;
        t[k * 65 + 4 * c4 + 0] = v[0] * s; t[k * 65 + 4 * c4 + 1] = v[1] * s; t[k * 65 + 4 * c4 + 2] = v[2] * s; t[k * 65 + 4 * c4 + 3] = v[3] * s; }
    __syncthreads();
    const int n = tid >> 3, kc = tid & 7; u32x4 w;
    w.x = cvt_pk_bf16(t[(8 * kc + 0) * 65 + n], t[(8 * kc + 1) * 65 + n]); w.y = cvt_pk_bf16(t[(8 * kc + 2) * 65 + n], t[(8 * kc + 3) * 65 + n]);
    w.z = cvt_pk_bf16(t[(8 * kc + 4) * 65 + n], t[(8 * kc + 5) * 65 + n]); w.w = cvt_pk_bf16(t[(8 * kc + 6) * 65 + n], t[(8 * kc + 7) * 65 + n]);
    *(u32x4*)(dst + (size_t)n * K + k0 + 8 * kc) = w;
    __syncthreads();
}
constexpr int IT_WIN = (NIN / 64) * 16, IT_WPAB = 32 * 16, IT_WO = 16 * 16, IT_WGU = (2 * DFF / 64) * 16, IT_WD = 16 * (DFF / 64), IT_LAYER = IT_WIN + IT_WPAB + IT_WO + IT_WGU + IT_WD;

__device__ __forceinline__ void p0_prologue(const Params& p, float* ldsf) {
    unsigned char* ws = p.ws;
    float* ssqm = (float*)(ws + WS_SSQM);
    int tid = threadIdx.x; asm volatile("" : "+v"(tid));
    const int G = gridDim.x, b = blockIdx.x;
    for (int it = b; it < NL * IT_LAYER; it += G) {
        const int l = it / IT_LAYER; int r = it % IT_LAYER; unsigned char* lw = ws + WS_W + (size_t)l * LW_BYTES;
        if (r < IT_WIN) { const int ntile = r >> 4, kt = r & 15, n0 = ntile * 64; int col;
            if (n0 < 3072) col = n0; else if (n0 < 5120) { const int t = n0 - 3072; col = ((t & 128) ? 4096 : 3072) + (t >> 8) * 128 + (t & 127); } else { const int t = n0 - 5120; col = ((t & 128) ? 6144 : 5120) + (t >> 8) * 128 + (t & 127); }
            transpose_tile(p.w_in + (size_t)l * DM * NIN, NIN, kt * 64, col, p.norm_mix + l * DM, (bf16_t*)(lw + LW_WIN) + (size_t)n0 * DM, DM, ldsf, tid); continue; }
        r -= IT_WIN;
        if (r < IT_WPAB) { const int ntile = r >> 4, kt = r & 15, n0 = ntile * 64;
            const float* src = (n0 < 1024) ? p.w_pa + (size_t)l * DM * DM : p.w_pb + (size_t)l * DM * DM;
            transpose_tile(src, DM, kt * 64, n0 & 1023, nullptr, (bf16_t*)(lw + LW_WPAB) + (size_t)n0 * DM, DM, ldsf, tid); continue; }
        r -= IT_WPAB;
        if (r < IT_WO) { const int ntile = r >> 4, kt = r & 15, n0 = ntile * 64;
            transpose_tile(p.w_o + (size_t)l * DM * DM, DM, kt * 64, n0, nullptr, (bf16_t*)(lw + LW_WO) + (size_t)n0 * DM, DM, ldsf, tid); continue; }
        r -= IT_WO;
        if (r < IT_WGU) { const int ntile = r >> 4, kt = r & 15, n0 = ntile * 64;
            const float* src = ((n0 & 128) ? p.w_up : p.w_gate) + (size_t)l * DM * DFF; const int col = (n0 >> 8) * 128 + (n0 & 127);
            transpose_tile(src, DFF, kt * 64, col, p.norm_ffn + l * DM, (bf16_t*)(lw + LW_WGU) + (size_t)n0 * DM, DM, ldsf, tid); continue; }
        r -= IT_WGU;
        { const int ntile = r / (DFF / 64), kt = r % (DFF / 64), n0 = ntile * 64;
            transpose_tile(p.w_down + (size_t)l * DFF * DM, DM, kt * 64, n0, nullptr, (bf16_t*)(lw + LW_WD) + (size_t)n0 * DFF, DFF, ldsf, tid); }
    }
    for (int i = b * 512 + tid; i < NL * 8 * 128 * 128; i += G * 512) {
        const int l = i >> 17, rem = i & 131071, ii = (rem >> 7) & 127, jj = rem & 127;
        const float* wsrc = p.w_s + (size_t)(i - rem);
        const int grp = rem >> 14;
        unsigned char* lw = ws + WS_W + (size_t)l * LW_BYTES;
        const float vp = (jj <= ii) ? p.w_s[i] : 0.f;
        const float vs = ((ii >> 5) == (jj >> 5) && (jj & 31) <= (ii & 31)) ? wsrc[grp * 16384 + (ii & 31) * 128 + (jj & 31)] : 0.f;
        ((bf16_t*)(lw + LW_WSP))[rem] = (bf16_t)(cvt_pk_bf16(vp, 0.f) & 0xffffu);
        ((bf16_t*)(lw + LW_WSS))[rem] = (bf16_t)(cvt_pk_bf16(vs, 0.f) & 0xffffu);
    }
    { const int wave = tid >> 6, lane = tid & 63; bf16_t* xb = (bf16_t*)(ws + WS_XB);
      for (int row = b * 8 + wave; row < MT; row += G * 8) {
          const float* xr = (row < MP) ? p.x_prompt + (size_t)row * DM : p.x_sample + (size_t)(row - MP) * DM; float q = 0.f;
#pragma unroll
          for (int j = 0; j < 4; ++j) { const f32x4 v = *(const f32x4*)(xr + 4 * (lane + 64 * j)); q += (v[0] * v[0] + v[1] * v[1]) + (v[2] * v[2] + v[3] * v[3]);
              u32x2 w; w.x = cvt_pk_bf16(v[0], v[1]); w.y = cvt_pk_bf16(v[2], v[3]); *(u32x2*)(xb + (size_t)row * DM + 4 * (lane + 64 * j)) = w; }
#pragma unroll
          for (int o = 32; o >= 1; o >>= 1) q += __shfl_xor(q, o);
          if (lane < 4) ((f32x4*)(ssqm + (size_t)row * 16))[lane] = (f32x4){lane == 0 ? q : 0.f, 0.f, 0.f, 0.f};
      } }
}

constexpr int VT_PITCH = 136;
__device__ __forceinline__ void gate_conv_phase(const Params& p, int l, unsigned char* lds) {
    unsigned char* ws = p.ws;
    const float* lns = (const float*)(ws + WS_LNS);
    bf16_t* AB = (bf16_t*)(ws + WS_AB); const bf16_t* GV = (const bf16_t*)(ws + WS_GV); const bf16_t* CH = (const bf16_t*)(ws + WS_CH);
    const unsigned char* lw = ws + WS_W + (size_t)l * LW_BYTES;
    bf16_t* vT = (bf16_t*)lds;
    float* mr = (float*)(lds + 128 * VT_PITCH * 2);
    int tid = threadIdx.x; asm volatile("" : "+v"(tid));
    const int lane = tid & 63, w = tid >> 6, fr = lane & 15, fq = lane >> 4;
    for (int item = blockIdx.x; item < (MT / 128) * 8; item += gridDim.x) {
        const int ct = item >> 3, g = item & 7, row0 = ct * 128, c0 = g * 128; const bool smp = ct >= MP / 128;
        if (tid < 128) { const f32x4* s = (const f32x4*)(lns + (size_t)(row0 + tid) * 32); float sm = 0.f, sq = 0.f;
#pragma unroll
            for (int k = 0; k < 8; ++k) { const f32x4 t = s[k]; sm += t[0] + t[2]; sq += t[1] + t[3]; }
            const float mean = sm * (1.0f / 1024.0f), var = sq * (1.0f / 1024.0f) - mean * mean; mr[2 * tid] = mean; mr[2 * tid + 1] = __builtin_amdgcn_rsqf(fmaxf(var, 0.f) + EPS); }
        __syncthreads();
        { const int jg = tid >> 5, cq = tid & 31, c = c0 + 4 * cq;
          const f32x4 lg = *(const f32x4*)(p.ln_g + l * DM + c), lb = *(const f32x4*)(p.ln_b + l * DM + c);
          float v[8][4];
#pragma unroll
          for (int jj = 0; jj < 8; ++jj) { const int row = row0 + 8 * jg + jj; const float mean = mr[2 * (8 * jg + jj)], rstd = mr[2 * (8 * jg + jj) + 1];
              const u32x2 gv = *(const u32x2*)(GV + (size_t)row * DM + c);
              v[jj][0] = (bf_lo(gv.x) - mean) * rstd * lg[0] + lb[0]; v[jj][1] = (bf_hi(gv.x) - mean) * rstd * lg[1] + lb[1];
              v[jj][2] = (bf_lo(gv.y) - mean) * rstd * lg[2] + lb[2]; v[jj][3] = (bf_hi(gv.y) - mean) * rstd * lg[3] + lb[3];
              if (smp) *(f32x4*)(p.out + OUT_V + ((size_t)l * MS + (row - MP)) * DM + c) = (f32x4){v[jj][0], v[jj][1], v[jj][2], v[jj][3]}; }
#pragma unroll
          for (int e = 0; e < 4; ++e) { u32x4 wv; wv.x = cvt_pk_bf16(v[0][e], v[1][e]); wv.y = cvt_pk_bf16(v[2][e], v[3][e]); wv.z = cvt_pk_bf16(v[4][e], v[5][e]); wv.w = cvt_pk_bf16(v[6][e], v[7][e]);
              *(u32x4*)(vT + (4 * cq + e) * VT_PITCH + 8 * jg) = wv; } }
        __syncthreads();
        { const bf16_t* Wsrc = (const bf16_t*)(lw + (smp ? LW_WSS : LW_WSP)) + g * 16384;
          f32x4 acc[8];
#pragma unroll
          for (int dt = 0; dt < 8; ++dt) acc[dt] = (f32x4){0.f, 0.f, 0.f, 0.f};
          const int nks = (w >> 1) + 1;
          for (int ks = 0; ks < nks; ++ks) {
              const bf16x8 wf = *(const bf16x8*)(Wsrc + (16 * w + fr) * 128 + 32 * ks + 8 * fq);
#pragma unroll
              for (int dt = 0; dt < 8; ++dt) { const int d = 32 * (dt >> 1) + 8 * (fr >> 2) + 4 * (dt & 1) + (fr & 3);
                  const bf16x8 vf = *(const bf16x8*)(vT + d * VT_PITCH + 32 * ks + 8 * fq);
                  acc[dt] = __builtin_amdgcn_mfma_f32_16x16x32_bf16(vf, wf, acc[dt], 0, 0, 0); } }
          const int i = 16 * w + fr; const float bs = p.b_s[(l * 8 + g) * 128 + (smp ? (i & 31) : i)];
          bf16_t* rowp = AB + (size_t)(row0 + i) * 2048 + c0 + 8 * fq;
#pragma unroll
          for (int pp = 0; pp < 4; ++pp) { const u32x4 uu = *(const u32x4*)(rowp + 32 * pp); const f32x4 s0 = acc[2 * pp] + bs, s1 = acc[2 * pp + 1] + bs;
              const f32x4 u0 = {bf_lo(uu[0]), bf_hi(uu[0]), bf_lo(uu[1]), bf_hi(uu[1])}, u1 = {bf_lo(uu[2]), bf_hi(uu[2]), bf_lo(uu[3]), bf_hi(uu[3])};
              *(u32x4*)(rowp + 32 * pp) = pg8::pack8(u0 * s0, u1 * s1); } }
#pragma unroll
        for (int vv = 0; vv < 4; ++vv) { const int idx = tid + 512 * vv, i = idx >> 4, c = c0 + 8 * (idx & 15), row = row0 + i;
            const int pos = smp ? ((row - MP) & 31) : (row & 2047);
            const u32x4 z4 = {0u, 0u, 0u, 0u};
            const u32x4 ch0 = *(const u32x4*)(CH + (size_t)row * DM + c);
            u32x4 ch1 = z4, ch2 = z4; float f1[8], f2[8]; bool st1 = false, st2 = false;
            if (pos >= 1) ch1 = *(const u32x4*)(CH + (size_t)(row - 1) * DM + c); else if (smp) st1 = true;
            if (pos >= 2) ch2 = *(const u32x4*)(CH + (size_t)(row - 2) * DM + c); else if (smp) st2 = true;
#pragma unroll
            for (int e = 0; e < 4; ++e) { f1[2 * e] = bf_lo(ch1[e]); f1[2 * e + 1] = bf_hi(ch1[e]); f2[2 * e] = bf_lo(ch2[e]); f2[2 * e + 1] = bf_hi(ch2[e]); }
            if (smp) { const int sq = (row - MP) >> 5; const float* stp = p.state_conv + ((size_t)(l * 32 + sq) * 2) * DM + c;
                if (st1) { const f32x4 a = *(const f32x4*)(stp + DM), bq = *(const f32x4*)(stp + DM + 4); f1[0] = a[0]; f1[1] = a[1]; f1[2] = a[2]; f1[3] = a[3]; f1[4] = bq[0]; f1[5] = bq[1]; f1[6] = bq[2]; f1[7] = bq[3]; }
                if (st2) { const float* s2 = stp + (pos == 0 ? 0 : DM); const f32x4 a = *(const f32x4*)(s2), bq = *(const f32x4*)(s2 + 4); f2[0] = a[0]; f2[1] = a[1]; f2[2] = a[2]; f2[3] = a[3]; f2[4] = bq[0]; f2[5] = bq[1]; f2[6] = bq[2]; f2[7] = bq[3]; } }
            const float* cw = p.conv_w + (size_t)l * 3 * DM + c;
            const f32x4 w0a = *(const f32x4*)(cw), w0b = *(const f32x4*)(cw + 4), w1a = *(const f32x4*)(cw + DM), w1b = *(const f32x4*)(cw + DM + 4), w2a = *(const f32x4*)(cw + 2 * DM), w2b = *(const f32x4*)(cw + 2 * DM + 4);
            bf16_t* bp = AB + (size_t)row * 2048 + 1024 + c; const u32x4 bg = *(const u32x4*)bp;
            float f0[8], o[8];
#pragma unroll
            for (int e = 0; e < 4; ++e) { f0[2 * e] = bf_lo(ch0[e]); f0[2 * e + 1] = bf_hi(ch0[e]); }
#pragma unroll
            for (int e = 0; e < 4; ++e) { o[e] = w0a[e] * f2[e] + w1a[e] * f1[e] + w2a[e] * f0[e]; o[4 + e] = w0b[e] * f2[4 + e] + w1b[e] * f1[4 + e] + w2b[e] * f0[4 + e]; }
            u32x4 ov;
#pragma unroll
            for (int e = 0; e < 4; ++e) ov[e] = cvt_pk_bf16(o[2 * e] * bf_lo(bg[e]), o[2 * e + 1] * bf_hi(bg[e]));
            *(u32x4*)bp = ov;
            const int lastpos = smp ? 31 : 2047;
            if (pos >= lastpos - 1) { float* op = smp ? p.out + OUT_NCS + (((size_t)l * 32 + ((row - MP) >> 5)) * 2 + (pos - (lastpos - 1))) * DM + c
                                                      : p.out + OUT_NCP + (((size_t)l * 32 + (row >> 11)) * 2 + (pos - (lastpos - 1))) * DM + c;
                *(f32x4*)op = (f32x4){f0[0], f0[1], f0[2], f0[3]}; *(f32x4*)(op + 4) = (f32x4){f0[4], f0[5], f0[6], f0[7]}; } }
        __syncthreads();
    }
}

__device__ __forceinline__ void final_norm_phase(const Params& p) {
    const float* ssq = (const float*)(p.ws + WS_SSQM);
    const size_t n4 = (size_t)MT * DM / 4;
    for (size_t i = (size_t)blockIdx.x * 512 + threadIdx.x; i < n4; i += (size_t)gridDim.x * 512) {
        const int row = (int)(i >> 8), c = (int)(i & 255) * 4; const float rs = pg8::rstd_of(ssq, row);
        const f32x4 g = *(const f32x4*)(p.norm_final + c); f32x4 v = ((f32x4*)p.out)[i]; v = v * rs * g; ((f32x4*)p.out)[i] = v; }
}

__global__ void __launch_bounds__(512, 2) mk_fwd(Params p) {
    extern __shared__ __attribute__((aligned(16))) unsigned char lds[];
    unsigned char* ws = p.ws;
    float* ssq_mix = (float*)(ws + WS_SSQM); float* ssq_ffn = (float*)(ws + WS_SSQF); float* lns = (float*)(ws + WS_LNS);
    bf16_t* XB = (bf16_t*)(ws + WS_XB); bf16_t* AB = (bf16_t*)(ws + WS_AB); bf16_t* GV = (bf16_t*)(ws + WS_GV); bf16_t* CH = (bf16_t*)(ws + WS_CH);
    bf16_t* T12 = GV; bf16_t* MMb = AB; bf16_t* Hb = AB;
    const int G = gridDim.x, c = blockIdx.x;
    PG8_LAS unsigned char* ring = (PG8_LAS unsigned char*)lds;
#if MK_MULTI
#define GRID_SYNC() do { } while (0)
#else
    cg::grid_group grid = cg::this_grid();
#define GRID_SYNC() grid.sync()
#endif
    for (int ph = p.ph_lo; ph < p.ph_hi; ++ph) {
        if (ph == 0) { if (PHASE_MASK & 1) p0_prologue(p, (float*)lds); }
        else if (ph == NPHASE - 1) { if (PHASE_MASK & 2) final_norm_phase(p); }
        else {
            const int l = (ph - 1) / 7, s = (ph - 1) % 7;
            const unsigned char* lw = ws + WS_W + (size_t)l * LW_BYTES;
            if (s == 0) { if (PHASE_MASK & 4) {
                pg8::Gemm g{XB, (const bf16_t*)(lw + LW_WIN), MT, 5120, DM, DM, 1 << 30, 0}; pg8::StaticOrder S; S.init(MT, 5120, G, c);
                pg8::EpiA E{AB, GV, CH, ssq_mix, lns};
                pg8::gemm_phase<pg8::EpiA, pg8::StaticOrder>(ring, g, S, E); }
            } else if (s == 1) {
                if (PHASE_MASK & 8) gate_conv_phase(p, l, lds);
            } else if (s == 2) { if (PHASE_MASK & 16) {
                pg8::Gemm g{AB, (const bf16_t*)(lw + LW_WPAB), MT, 2048, DM, 2048, 4, 1024}; pg8::StaticOrder S; S.init(MT, 2048, G, c);
                pg8::EpiC E{T12};
                pg8::gemm_phase<pg8::EpiC, pg8::StaticOrder>(ring, g, S, E); }
            } else if (s == 3) { if (PHASE_MASK & 32) {
                pg8::Gemm g{XB, (const bf16_t*)(lw + LW_WIN) + (size_t)5120 * DM, MT, 2048, DM, DM, 1 << 30, 0}; pg8::StaticOrder S; S.init(MT, 2048, G, c);
                pg8::EpiD E{T12, MMb, ssq_mix};
                pg8::gemm_phase<pg8::EpiD, pg8::StaticOrder>(ring, g, S, E); }
            } else if (s == 4) { if (PHASE_MASK & 64) {
                pg8::Gemm g{MMb, (const bf16_t*)(lw + LW_WO), MT, DM, DM, DM, 1 << 30, 0}; pg8::StaticOrder S; S.init(MT, DM, G, c);
                pg8::EpiRes E{l == 0 ? p.x_prompt : p.out, l == 0 ? p.x_sample : p.out + OUT_YS, p.out, XB, ssq_ffn};
                pg8::gemm_phase<pg8::EpiRes, pg8::StaticOrder>(ring, g, S, E); }
            } else if (s == 5) { if (PHASE_MASK & 128) {
                pg8::Gemm g{XB, (const bf16_t*)(lw + LW_WGU), MT, 2 * DFF, DM, DM, 1 << 30, 0}; pg8::StaticOrder S; S.init(MT, 2 * DFF, G, c);
                pg8::EpiF E{Hb, ssq_ffn};
                pg8::gemm_phase<pg8::EpiF, pg8::StaticOrder>(ring, g, S, E); }
            } else { if (PHASE_MASK & 256) {
                pg8::Gemm g{Hb, (const bf16_t*)(lw + LW_WD), MT, DM, DFF, DFF, 1 << 30, 0}; pg8::StaticOrder S; S.init(MT, DM, G, c);
                pg8::EpiRes E{p.out, p.out + OUT_YS, p.out, XB, ssq_mix};
                pg8::gemm_phase<pg8::EpiRes, pg8::StaticOrder>(ring, g, S, E); }
            }
        }
        if (ph + 1 < p.ph_hi) { GRID_SYNC(); }
    }
}

extern "C" void kernel_launch(void* const* d_in, const int* in_sizes, int n_in, void* d_out, int out_size, void* d_ws, size_t ws_size, hipStream_t stream) {
    static int grid = 0;
    if (grid == 0) {
        if (n_in != 18 || in_sizes[0] != MP * DM || (size_t)out_size != OUT_TOTAL || ws_size < WS_END) {
            fprintf(stderr, "kernel_launch: unexpected shapes: n_in %d in0 %d out %d ws %zu (need %zu)\n", n_in, n_in > 0 ? in_sizes[0] : -1, out_size, ws_size, (size_t)WS_END); grid = -1; return; }
        int dev = 0, cus = 0, per_cu = 0;
        (void)hipGetDevice(&dev); (void)hipDeviceGetAttribute(&cus, hipDeviceAttributeMultiprocessorCount, dev);
        if (hipFuncSetAttribute((const void*)mk_fwd, hipFuncAttributeMaxDynamicSharedMemorySize, LDS_BYTES) != hipSuccess) { fprintf(stderr, "kernel_launch: hipFuncSetAttribute failed\n"); grid = -1; return; }
        if (hipOccupancyMaxActiveBlocksPerMultiprocessor(&per_cu, (const void*)mk_fwd, 512, LDS_BYTES) != hipSuccess || per_cu < 1) { fprintf(stderr, "kernel_launch: occupancy query says %d\n", per_cu); per_cu = 1; }
        (void)hipGetLastError();
        grid = cus * 1;
        fprintf(stderr, "kernel_launch: cus %d per_cu %d grid %d\n", cus, per_cu, grid);
    }
    if (grid < 0) return;
    Params p{};
    const float** pp = (const float**)&p;
    for (int i = 0; i < 18; ++i) pp[i] = (const float*)d_in[i];
    p.out = (float*)d_out; p.ws = (unsigned char*)d_ws;
#if MK_MULTI
    for (int ph = 0; ph < NPHASE; ++ph) { p.ph_lo = ph; p.ph_hi = ph + 1; hipLaunchKernelGGL(mk_fwd, dim3(grid), dim3(512), LDS_BYTES, stream, p); }
#else
    p.ph_lo = 0; p.ph_hi = NPHASE;
    void* args[] = {&p};
    hipError_t e = hipLaunchCooperativeKernel((const void*)mk_fwd, dim3(grid), dim3(512), args, LDS_BYTES, stream);
    if (e != hipSuccess) fprintf(stderr, "kernel_launch: cooperative launch failed: %s (grid %d)\n", hipGetErrorString(e), grid);
#endif
}
```

```cpp
#include <hip/hip_runtime.h>
#include <hip/hip_cooperative_groups.h>
#include <cstdio>
#include <cstdint>
namespace cg = cooperative_groups;

#ifndef PHASE_MASK
#define PHASE_MASK 511
#endif
#ifndef PROBE_DUP
#define PROBE_DUP 0
#endif
#ifndef MK_MULTI
#define MK_MULTI 0
#endif

constexpr int MP = 65536, MS = 1024, MT = MP + MS, DM = 1024, NL = 4, DFF = 2816, NIN = 7168;
constexpr float EPS = 1e-6f;
constexpr size_t OUT_YS = (size_t)MP * DM, OUT_NCP = OUT_YS + (size_t)MS * DM, OUT_NCS = OUT_NCP + (size_t)NL * 32 * 2 * DM, OUT_V = OUT_NCS + (size_t)NL * 32 * 2 * DM;
constexpr size_t OUT_TOTAL = OUT_V + (size_t)NL * 32 * 32 * DM;

constexpr size_t MiB = (size_t)1 << 20;
constexpr size_t WS_SSQM = 0, WS_SSQF = 5 * MiB, WS_LNS = 10 * MiB;
constexpr size_t WS_CTL = 20 * MiB, CTL_BYTES = 16384;
constexpr size_t WS_W = 24 * MiB;
constexpr size_t LW_WIN = 0, LW_WPAB = LW_WIN + (size_t)NIN * DM * 2, LW_WO = LW_WPAB + (size_t)2048 * DM * 2, LW_WGU = LW_WO + (size_t)DM * DM * 2,
                 LW_WD = LW_WGU + (size_t)2 * DFF * DM * 2, LW_WSP = LW_WD + (size_t)DM * DFF * 2, LW_WSS = LW_WSP + (size_t)8 * 128 * 128 * 2, LW_BYTES = LW_WSS + (size_t)8 * 128 * 128 * 2;
constexpr size_t WS_XB = 176 * MiB;
constexpr size_t WS_AB = 306 * MiB;
constexpr size_t WS_GV = 566 * MiB;
constexpr size_t WS_CH = 696 * MiB;
constexpr size_t WS_END = 826 * MiB;
static_assert(WS_W + NL * LW_BYTES <= WS_XB, "weights overflow");

namespace pg8 {
#define PG8_LAS __attribute__((address_space(3)))
typedef unsigned short bf16_t;
typedef short bf16x8 __attribute__((ext_vector_type(8)));
typedef float f32x4 __attribute__((ext_vector_type(4)));
typedef float f32x2 __attribute__((ext_vector_type(2)));
typedef unsigned u32x4 __attribute__((ext_vector_type(4)));
typedef unsigned u32x2 __attribute__((ext_vector_type(2)));
constexpr int BM = 256, BK = 64, HALF = 128, HTB = HALF * BK * 2, STAGE_BYTES = 8 * HTB, NXCD = 8, WGM = 8;

__host__ __device__ __forceinline__ int lds_byte(int r, int c) { const int st = (r >> 4) * 2 + (c >> 5), rr = r & 15, cc = c & 31, ob = rr * 64 + cc * 2; return st * 1024 + (ob ^ (((ob >> 9) & 1) << 5)); }
__host__ __device__ __forceinline__ void stage_rc(int b, int& R, int& C) { const int st = b / 1024, sb = b % 1024, swz = sb ^ (((sb >> 9) & 1) << 5); R = (st >> 1) * 16 + swz / 64; C = (st & 1) * 32 + (swz % 64) / 2; }
__host__ __device__ __forceinline__ int perm32(int rho) { const int n = rho >> 4, i = rho & 15; return 8 * (i >> 2) + 4 * n + (i & 3); }

struct Unit { int pm, pn; };
struct Gemm { const bf16_t* A; const bf16_t* Bt; int M, N, K, lda, asplit_pn, asplit_off; };

struct StaticOrder {
    int nM, nN, nwg, G, c;
    __host__ __device__ void init(int M, int N, int G_, int c_) { nM = M / BM; nN = N / BM; nwg = nM * nN; G = G_; c = c_; }
    __host__ __device__ bool next(int i, Unit& u) const {
        const long L = (long)i * G + c; if (L >= nwg) return false;
        int wgid = (int)L; { const int q = nwg / NXCD, r = nwg % NXCD, xcd = wgid % NXCD, off = wgid / NXCD; wgid = (xcd < r ? xcd * (q + 1) : r * (q + 1) + (xcd - r) * q) + off; }
        const int nig = WGM * nN, gid = wgid / nig, fm = gid * WGM, gsz = (nM - fm) < WGM ? (nM - fm) : WGM;
        u.pm = fm + ((wgid % nig) % gsz); u.pn = (wgid % nig) / gsz; return true;
    }
    __device__ __forceinline__ void a_ready(const Unit&) const {}
    __device__ __forceinline__ void done(const Unit&) const {}
};

__device__ __forceinline__ unsigned cvt_pk_bf16(float lo, float hi) { unsigned r; asm volatile("v_cvt_pk_bf16_f32 %0, %1, %2" : "=v"(r) : "v"(lo), "v"(hi)); return r; }
__device__ __forceinline__ float bf_lo(unsigned w) { return __uint_as_float(w << 16); }
__device__ __forceinline__ float bf_hi(unsigned w) { return __uint_as_float(w & 0xffff0000u); }
__device__ __forceinline__ f32x2 gelu_pk(f32x2 v) {
    const f32x2 av = __builtin_elementwise_abs(v), d = av * 0.2316418882f + 1.0f;
    f32x2 t; t.x = __builtin_amdgcn_rcpf(d.x); t.y = __builtin_amdgcn_rcpf(d.y);
    f32x2 q = t * 0.5307027145f + (-0.7265760135f); q = q * t + 0.7107068705f; q = q * t + (-0.142248368f); q = q * t + 0.127414796f; q = q * t;
    const f32x2 s = (v * v) * (-0.72134752044f);
    f32x2 e; e.x = __builtin_amdgcn_exp2f(s.x); e.y = __builtin_amdgcn_exp2f(s.y);
    const f32x2 m = v * (q * e), r = v - m;
    f32x2 o; o.x = v.x < 0.f ? m.x : r.x; o.y = v.y < 0.f ? m.y : r.y; return o;
}
__device__ __forceinline__ f32x4 gelu4(f32x4 v) { const f32x2 a = gelu_pk((f32x2){v[0], v[1]}), b = gelu_pk((f32x2){v[2], v[3]}); return (f32x4){a.x, a.y, b.x, b.y}; }
__device__ __forceinline__ float sigmoidf_(float x) { return __builtin_amdgcn_rcpf(1.0f + __builtin_amdgcn_exp2f(x * -1.44269504f)); }
__device__ __forceinline__ f32x4 sigmoid4(f32x4 v) { return (f32x4){sigmoidf_(v[0]), sigmoidf_(v[1]), sigmoidf_(v[2]), sigmoidf_(v[3])}; }
__device__ __forceinline__ u32x4 pack8(f32x4 v0, f32x4 v1) { u32x4 w; w.x = cvt_pk_bf16(v0[0], v0[1]); w.y = cvt_pk_bf16(v0[2], v0[3]); w.z = cvt_pk_bf16(v1[0], v1[1]); w.w = cvt_pk_bf16(v1[2], v1[3]); return w; }
__device__ __forceinline__ float rstd_of(const float* slots, int row) { const f32x4* s = (const f32x4*)(slots + (size_t)row * 16); const f32x4 t = (s[0] + s[1]) + (s[2] + s[3]);
    return __builtin_amdgcn_rsqf(((t[0] + t[1]) + (t[2] + t[3])) * (1.0f / 1024.0f) + EPS); }


struct EpiA {
    static constexpr bool PERM = true, AFTER_DRAIN = false;
    bf16_t* AB; bf16_t* GV; bf16_t* CH; const float* ssq; float* lns;
    __device__ __forceinline__ void operator()(const f32x4 (&acc)[2][2][4][2], const Unit& u, int wr, int wc, int fr, int fq) const {
        const int row0 = u.pm * BM + wr * 64 + fr, cw = wc * 32 + 8 * fq, pn = u.pn;
        if (pn < 4) {
#pragma unroll
            for (int ai = 0; ai < 2; ++ai)
#pragma unroll
                for (int m = 0; m < 4; ++m) { const int row = row0 + ai * HALF + m * 16; const float rs = rstd_of(ssq, row); bf16_t* rowp = AB + (size_t)row * 2048 + pn * 256 + cw;
#pragma unroll
                    for (int bj = 0; bj < 2; ++bj) *(u32x4*)(rowp + bj * HALF) = pack8(gelu4(acc[ai][bj][m][0] * rs), gelu4(acc[ai][bj][m][1] * rs)); }
        } else if (pn < 8) {
#pragma unroll
            for (int ai = 0; ai < 2; ++ai)
#pragma unroll
                for (int m = 0; m < 4; ++m) { const int row = row0 + ai * HALF + m * 16; const float rs = rstd_of(ssq, row); bf16_t* rowp = GV + (size_t)row * 1024 + (pn - 4) * 256 + cw;
                    float s = 0.f, q = 0.f;
#pragma unroll
                    for (int bj = 0; bj < 2; ++bj) { const u32x4 w = pack8(gelu4(acc[ai][bj][m][0] * rs), gelu4(acc[ai][bj][m][1] * rs)); *(u32x4*)(rowp + bj * HALF) = w;
#pragma unroll
                        for (int e = 0; e < 4; ++e) { const float a = bf_lo(w[e]), b = bf_hi(w[e]); s += a + b; q += a * a + b * b; } }
                    s += __shfl_xor(s, 16); s += __shfl_xor(s, 32); q += __shfl_xor(q, 16); q += __shfl_xor(q, 32);
                    if (fq == 0) *(f32x2*)(lns + ((size_t)row * 16 + (pn - 4) * 4 + wc) * 2) = (f32x2){s, q}; }
        } else if (pn < 12) {
#pragma unroll
            for (int ai = 0; ai < 2; ++ai)
#pragma unroll
                for (int m = 0; m < 4; ++m) { const int row = row0 + ai * HALF + m * 16; const float rs = rstd_of(ssq, row); bf16_t* rowp = AB + (size_t)row * 2048 + 1024 + (pn - 8) * 256 + cw;
#pragma unroll
                    for (int bj = 0; bj < 2; ++bj) *(u32x4*)(rowp + bj * HALF) = pack8(acc[ai][bj][m][0] * rs, acc[ai][bj][m][1] * rs); }
        } else {
#pragma unroll
            for (int ai = 0; ai < 2; ++ai)
#pragma unroll
                for (int m = 0; m < 4; ++m) { const int row = row0 + ai * HALF + m * 16; const float rs = rstd_of(ssq, row); const float rs2 = rs * rs;
                    *(u32x4*)(CH + (size_t)row * 1024 + (pn - 12) * 128 + cw) = pack8(acc[ai][0][m][0] * acc[ai][1][m][0] * rs2, acc[ai][0][m][1] * acc[ai][1][m][1] * rs2); }
        }
    }
};
struct EpiC {
    static constexpr bool PERM = true, AFTER_DRAIN = false;
    bf16_t* T;
    __device__ __forceinline__ void operator()(const f32x4 (&acc)[2][2][4][2], const Unit& u, int wr, int wc, int fr, int fq) const {
        const int row0 = u.pm * BM + wr * 64 + fr, cw = u.pn * 256 + wc * 32 + 8 * fq;
#pragma unroll
        for (int ai = 0; ai < 2; ++ai)
#pragma unroll
            for (int m = 0; m < 4; ++m) { bf16_t* rowp = T + (size_t)(row0 + ai * HALF + m * 16) * 2048 + cw;
#pragma unroll
                for (int bj = 0; bj < 2; ++bj) *(u32x4*)(rowp + bj * HALF) = pack8(acc[ai][bj][m][0], acc[ai][bj][m][1]); }
    }
};
struct EpiD {
    static constexpr bool PERM = true, AFTER_DRAIN = false;
    const bf16_t* T; bf16_t* MM; const float* ssq;
    __device__ __forceinline__ void operator()(const f32x4 (&acc)[2][2][4][2], const Unit& u, int wr, int wc, int fr, int fq) const {
        const int row0 = u.pm * BM + wr * 64 + fr, cw = u.pn * 128 + wc * 32 + 8 * fq;
#pragma unroll
        for (int ai = 0; ai < 2; ++ai)
#pragma unroll
            for (int m = 0; m < 4; ++m) { const int row = row0 + ai * HALF + m * 16; const float rs = rstd_of(ssq, row);
                const u32x4 t1 = *(const u32x4*)(T + (size_t)row * 2048 + cw), t2 = *(const u32x4*)(T + (size_t)row * 2048 + 1024 + cw);
                const f32x4 a0 = sigmoid4(acc[ai][0][m][0] * rs), a1 = sigmoid4(acc[ai][0][m][1] * rs), b0 = sigmoid4(acc[ai][1][m][0] * rs), b1 = sigmoid4(acc[ai][1][m][1] * rs);
                const f32x4 p0 = {bf_lo(t1[0]), bf_hi(t1[0]), bf_lo(t1[1]), bf_hi(t1[1])}, p1 = {bf_lo(t1[2]), bf_hi(t1[2]), bf_lo(t1[3]), bf_hi(t1[3])};
                const f32x4 q0 = {bf_lo(t2[0]), bf_hi(t2[0]), bf_lo(t2[1]), bf_hi(t2[1])}, q1 = {bf_lo(t2[2]), bf_hi(t2[2]), bf_lo(t2[3]), bf_hi(t2[3])};
                *(u32x4*)(MM + (size_t)row * 1024 + cw) = pack8(a0 * p0 + b0 * q0, a1 * p1 + b1 * q1); }
    }
};
struct EpiRes {
    static constexpr bool PERM = false, AFTER_DRAIN = false;
    const float* xold_p; const float* xold_s; float* xout; bf16_t* xb; float* ssq;
    __device__ __forceinline__ void operator()(const f32x4 (&acc)[2][2][4][2], const Unit& u, int wr, int wc, int fr, int fq) const {
        const int row0 = u.pm * BM + wr * 64 + fr, col0 = u.pn * BM + wc * 32 + 4 * fq;
        const float* xo = (u.pm < MP / BM) ? xold_p : xold_s - (size_t)MP * DM;
#pragma unroll
        for (int ai = 0; ai < 2; ++ai)
#pragma unroll
            for (int m = 0; m < 4; ++m) { const int row = row0 + ai * HALF + m * 16; const size_t off = (size_t)row * DM + col0; float q = 0.f;
#pragma unroll
                for (int bj = 0; bj < 2; ++bj)
#pragma unroll
                    for (int n = 0; n < 2; ++n) { const f32x4 xv = *(const f32x4*)(xo + off + bj * HALF + n * 16) + acc[ai][bj][m][n];
                        *(f32x4*)(xout + off + bj * HALF + n * 16) = xv; q += (xv[0] * xv[0] + xv[1] * xv[1]) + (xv[2] * xv[2] + xv[3] * xv[3]);
                        u32x2 w; w.x = cvt_pk_bf16(xv[0], xv[1]); w.y = cvt_pk_bf16(xv[2], xv[3]); *(u32x2*)(xb + off + bj * HALF + n * 16) = w; }
                q += __shfl_xor(q, 16); q += __shfl_xor(q, 32);
                if (fq == 0) ssq[(size_t)row * 16 + u.pn * 4 + wc] = q;
                asm volatile("" ::: "memory"); }
    }
};
struct EpiF {
    static constexpr bool PERM = true, AFTER_DRAIN = false;
    bf16_t* H; const float* ssq;
    __device__ __forceinline__ void operator()(const f32x4 (&acc)[2][2][4][2], const Unit& u, int wr, int wc, int fr, int fq) const {
        const int row0 = u.pm * BM + wr * 64 + fr, cw = u.pn * 128 + wc * 32 + 8 * fq;
#pragma unroll
        for (int ai = 0; ai < 2; ++ai)
#pragma unroll
            for (int m = 0; m < 4; ++m) { const int row = row0 + ai * HALF + m * 16; const float rs = rstd_of(ssq, row);
                const f32x4 g0 = acc[ai][0][m][0] * rs, g1 = acc[ai][0][m][1] * rs, u0 = acc[ai][1][m][0] * rs, u1 = acc[ai][1][m][1] * rs;
                *(u32x4*)(H + (size_t)row * DFF + cw) = pack8(g0 * sigmoid4(g0) * u0, g1 * sigmoid4(g1) * u1); }
    }
};

template <class Epi, class Sched>
__device__ __forceinline__ void gemm_phase(PG8_LAS unsigned char* lds, const Gemm g, const Sched& S, const Epi& E) {
    int tid = threadIdx.x; asm volatile("" : "+v"(tid));
    const int wid = __builtin_amdgcn_readfirstlane(tid >> 6), lane = tid & 63, wr = wid >> 2, wc = wid & 3, fr = lane & 15, fq = lane >> 4;
    const int K = g.K, nt = K / BK, lda = g.lda;
    unsigned voffA[2], voffB[2];
#pragma unroll
    for (int i = 0; i < 2; ++i) { int R, C; stage_rc(tid * 16 + i * 8192, R, C); const int Rb = Epi::PERM ? ((R & ~31) + perm32(R & 31)) : R;
        voffA[i] = (unsigned)(R * lda + C) * 2u; voffB[i] = (unsigned)(Rb * K + C) * 2u; }
    const size_t kstep = (size_t)(BK * 2);
    const size_t hstepA = (size_t)HALF * lda * 2, hstepB = (size_t)HALF * K * 2;
    const size_t tstepA = 2 * hstepA, tstepB = 2 * hstepB;
    const unsigned ldsw = (unsigned)wid * 1024u;
    const int aoff = lds_byte(wr * 64 + fr, fq * 8), boff = lds_byte(wc * 32 + fr, fq * 8);
#define PG8_SA(b, h) (((b) * 2 + (h)) * HTB)
#define PG8_SB(b, h) ((4 + (b) * 2 + (h)) * HTB)
#define PG8_STAGE(bufoff, gbase, voff) do { _Pragma("unroll") for (int _i = 0; _i < 2; ++_i) \
        __builtin_amdgcn_global_load_lds((const unsigned*)((const char*)(gbase) + (voff)[_i]), (PG8_LAS unsigned*)(lds + (bufoff) + ldsw + _i * 8192), 16, 0, 0); } while (0)
#define PG8_LDA(dst, b, h) do { _Pragma("unroll") for (int m = 0; m < 4; ++m) _Pragma("unroll") for (int k = 0; k < 2; ++k) dst[m][k] = *(const PG8_LAS bf16x8*)(lds + PG8_SA(b, h) + aoff + m * 2048 + k * 1024); } while (0)
#define PG8_LDB(dst, b, h) do { _Pragma("unroll") for (int n = 0; n < 2; ++n) _Pragma("unroll") for (int k = 0; k < 2; ++k) dst[n][k] = *(const PG8_LAS bf16x8*)(lds + PG8_SB(b, h) + boff + n * 2048 + k * 1024); } while (0)
#define PG8_MMA(ai, bj, At, Bt) do { __builtin_amdgcn_s_setprio(1); _Pragma("unroll") for (int m = 0; m < 4; ++m) _Pragma("unroll") for (int n = 0; n < 2; ++n) _Pragma("unroll") for (int k = 0; k < 2; ++k) \
        acc[ai][bj][m][n] = __builtin_amdgcn_mfma_f32_16x16x32_bf16(Bt[n][k], At[m][k], acc[ai][bj][m][n], 0, 0, 0); __builtin_amdgcn_s_setprio(0); } while (0)
#define PG8_WAIT_V(n) asm volatile("s_waitcnt vmcnt(" #n ")" ::: "memory")
#define PG8_WAIT_L(n) asm volatile("s_waitcnt lgkmcnt(" #n ")" ::: "memory")
#define PG8_BAR __builtin_amdgcn_s_barrier()
#define PG8_SCHED __builtin_amdgcn_sched_barrier(0)
#define PG8_APTR(u) ((const char*)g.A + (size_t)(u).pm * tstepA + (((u).pn >= g.asplit_pn) ? (size_t)g.asplit_off * 2 : (size_t)0))
    Unit cur, nxt; int ui = 0;
    if (!S.next(0, cur)) return;
    f32x4 acc[2][2][4][2];
#pragma unroll
    for (int a = 0; a < 2; ++a)
#pragma unroll
        for (int b = 0; b < 2; ++b)
#pragma unroll
            for (int m = 0; m < 4; ++m)
#pragma unroll
                for (int n = 0; n < 2; ++n) acc[a][b][m][n] = (f32x4){0.f, 0.f, 0.f, 0.f};
    bf16x8 At[4][2], B0[2][2], B1[2][2];
    const char* cA = PG8_APTR(cur); const char* cB = (const char*)g.Bt + (size_t)cur.pn * tstepB;
    S.a_ready(cur);
    PG8_STAGE(PG8_SB(0, 0), cB, voffB); PG8_STAGE(PG8_SA(0, 0), cA, voffA); PG8_STAGE(PG8_SB(0, 1), cB + hstepB, voffB); PG8_STAGE(PG8_SA(0, 1), cA + hstepA, voffA);
    if (wr == 1) PG8_BAR;
    PG8_WAIT_V(4); PG8_BAR;
    PG8_STAGE(PG8_SB(1, 0), cB + kstep, voffB); PG8_STAGE(PG8_SA(1, 0), cA + kstep, voffA); PG8_STAGE(PG8_SB(1, 1), cB + hstepB + kstep, voffB);
    PG8_WAIT_V(6); PG8_BAR;
    for (;;) {
        const bool has_next = S.next(ui + 1, nxt);
        const char* nA = has_next ? PG8_APTR(nxt) : cA; const char* nB = has_next ? (const char*)g.Bt + (size_t)nxt.pn * tstepB : cB;
        for (int t = 0; t < nt; t += 2) {
            const bool last = (t == nt - 2);
            const char* a1 = cA + (size_t)(t + 1) * kstep;
            const char* a2 = last ? nA : cA + (size_t)(t + 2) * kstep; const char* b2 = last ? nB : cB + (size_t)(t + 2) * kstep;
            const char* a3 = a2 + kstep; const char* b3 = b2 + kstep;
            if (last && has_next) S.a_ready(nxt);
            PG8_LDB(B0, 0, 0); PG8_SCHED; PG8_LDA(At, 0, 0); PG8_STAGE(PG8_SA(1, 1), a1 + hstepA, voffA);
            PG8_WAIT_L(8); PG8_BAR; PG8_WAIT_L(0); PG8_MMA(0, 0, At, B0); PG8_BAR; PG8_SCHED;
            PG8_LDB(B1, 0, 1); PG8_STAGE(PG8_SB(0, 0), b2, voffB);
            PG8_BAR; PG8_WAIT_L(0); PG8_MMA(0, 1, At, B1); PG8_BAR;
            PG8_LDA(At, 0, 1); PG8_STAGE(PG8_SA(0, 0), a2, voffA);
            PG8_BAR; PG8_WAIT_L(0); PG8_MMA(1, 0, At, B0); PG8_BAR; PG8_SCHED;
            PG8_STAGE(PG8_SB(0, 1), b2 + hstepB, voffB);
            PG8_WAIT_V(6); PG8_BAR; PG8_MMA(1, 1, At, B1); PG8_BAR;
            PG8_LDB(B0, 1, 0); PG8_SCHED; PG8_LDA(At, 1, 0); PG8_STAGE(PG8_SA(0, 1), a2 + hstepA, voffA);
            PG8_WAIT_L(8); PG8_BAR; PG8_WAIT_L(0); PG8_MMA(0, 0, At, B0); PG8_BAR; PG8_SCHED;
            PG8_LDB(B1, 1, 1); PG8_STAGE(PG8_SB(1, 0), b3, voffB);
            PG8_BAR; PG8_WAIT_L(0); PG8_MMA(0, 1, At, B1); PG8_BAR;
            PG8_LDA(At, 1, 1); PG8_STAGE(PG8_SA(1, 0), a3, voffA);
            PG8_BAR; PG8_WAIT_L(0); PG8_MMA(1, 0, At, B0); PG8_BAR; PG8_SCHED;
            PG8_STAGE(PG8_SB(1, 1), b3 + hstepB, voffB);
            PG8_WAIT_V(6); PG8_BAR; PG8_MMA(1, 1, At, B1); PG8_BAR;
        }
        E(acc, cur, wr, wc, fr, fq); S.done(cur);
        if (!has_next) break;
#pragma unroll
        for (int a = 0; a < 2; ++a)
#pragma unroll
            for (int b = 0; b < 2; ++b)
#pragma unroll
                for (int m = 0; m < 4; ++m)
#pragma unroll
                    for (int n = 0; n < 2; ++n) acc[a][b][m][n] = (f32x4){0.f, 0.f, 0.f, 0.f};
        cur = nxt; cA = nA; cB = nB; ++ui;
    }
    PG8_WAIT_V(0);
    if (wr == 0) PG8_BAR;
    PG8_BAR;
#undef PG8_APTR
#undef PG8_SA
#undef PG8_SB
#undef PG8_STAGE
#undef PG8_LDA
#undef PG8_LDB
#undef PG8_MMA
#undef PG8_WAIT_V
#undef PG8_WAIT_L
#undef PG8_BAR
#undef PG8_SCHED
}
}

using pg8::bf16_t; using pg8::f32x4; using pg8::u32x4; using pg8::u32x2; using pg8::bf16x8;
using pg8::cvt_pk_bf16; using pg8::bf_lo; using pg8::bf_hi;

struct Params {
    const float* x_prompt; const float* x_sample; const float* state_conv; const float* norm_mix; const float* w_in; const float* ln_g; const float* ln_b;
    const float* w_s; const float* b_s; const float* conv_w; const float* w_pa; const float* w_pb; const float* w_o; const float* norm_ffn;
    const float* w_gate; const float* w_up; const float* w_down; const float* norm_final;
    float* out; unsigned char* ws; int ph_lo, ph_hi;
};
constexpr int LDS_BYTES = pg8::STAGE_BYTES + 256;
constexpr int NPHASE = 2 + 7 * NL;

__device__ __forceinline__ void transpose_tile(const float* __restrict__ src, int ld, int k0, int col0, const float* __restrict__ scale, bf16_t* __restrict__ dst, int K, float* t, int tid) {
    const int r = tid >> 4, c4 = tid & 15;
#pragma unroll
    for (int pass = 0; pass < 2; ++pass) { const int k = r + 32 * pass; const f32x4 v = *(const f32x4*)(src + (size_t)(k0 + k) * ld + col0 + 4 * c4); const float s = scale ? scale[k0 + k] : 1.0f;
        t[k * 65 + 4 * c4 + 0] = v[0] * s; t[k * 65 + 4 * c4 + 1] = v[1] * s; t[k * 65 + 4 * c4 + 2] = v[2] * s; t[k * 65 + 4 * c4 + 3] = v[3] * s; }
    __syncthreads();
    const int n = tid >> 3, kc = tid & 7; u32x4 w;
    w.x = cvt_pk_bf16(t[(8 * kc + 0) * 65 + n], t[(8 * kc + 1) * 65 + n]); w.y = cvt_pk_bf16(t[(8 * kc + 2) * 65 + n], t[(8 * kc + 3) * 65 + n]);
    w.z = cvt_pk_bf16(t[(8 * kc + 4) * 65 + n], t[(8 * kc + 5) * 65 + n]); w.w = cvt_pk_bf16(t[(8 * kc + 6) * 65 + n], t[(8 * kc + 7) * 65 + n]);
    *(u32x4*)(dst + (size_t)n * K + k0 + 8 * kc) = w;
    __syncthreads();
}
constexpr int IT_WIN = (NIN / 64) * 16, IT_WPAB = 32 * 16, IT_WO = 16 * 16, IT_WGU = (2 * DFF / 64) * 16, IT_WD = 16 * (DFF / 64), IT_LAYER = IT_WIN + IT_WPAB + IT_WO + IT_WGU + IT_WD;

__device__ __forceinline__ void p0_prologue(const Params& p, float* ldsf) {
    unsigned char* ws = p.ws;
    float* ssqm = (float*)(ws + WS_SSQM);
    int tid = threadIdx.x; asm volatile("" : "+v"(tid));
    const int G = gridDim.x, b = blockIdx.x;
    for (int it = b; it < NL * IT_LAYER; it += G) {
        const int l = it / IT_LAYER; int r = it % IT_LAYER; unsigned char* lw = ws + WS_W + (size_t)l * LW_BYTES;
        if (r < IT_WIN) { const int ntile = r >> 4, kt = r & 15, n0 = ntile * 64; int col;
            if (n0 < 3072) col = n0; else if (n0 < 5120) { const int t = n0 - 3072; col = ((t & 128) ? 4096 : 3072) + (t >> 8) * 128 + (t & 127); } else { const int t = n0 - 5120; col = ((t & 128) ? 6144 : 5120) + (t >> 8) * 128 + (t & 127); }
            transpose_tile(p.w_in + (size_t)l * DM * NIN, NIN, kt * 64, col, p.norm_mix + l * DM, (bf16_t*)(lw + LW_WIN) + (size_t)n0 * DM, DM, ldsf, tid); continue; }
        r -= IT_WIN;
        if (r < IT_WPAB) { const int ntile = r >> 4, kt = r & 15, n0 = ntile * 64;
            const float* src = (n0 < 1024) ? p.w_pa + (size_t)l * DM * DM : p.w_pb + (size_t)l * DM * DM;
            transpose_tile(src, DM, kt * 64, n0 & 1023, nullptr, (bf16_t*)(lw + LW_WPAB) + (size_t)n0 * DM, DM, ldsf, tid); continue; }
        r -= IT_WPAB;
        if (r < IT_WO) { const int ntile = r >> 4, kt = r & 15, n0 = ntile * 64;
            transpose_tile(p.w_o + (size_t)l * DM * DM, DM, kt * 64, n0, nullptr, (bf16_t*)(lw + LW_WO) + (size_t)n0 * DM, DM, ldsf, tid); continue; }
        r -= IT_WO;
        if (r < IT_WGU) { const int ntile = r >> 4, kt = r & 15, n0 = ntile * 64;
            const float* src = ((n0 & 128) ? p.w_up : p.w_gate) + (size_t)l * DM * DFF; const int col = (n0 >> 8) * 128 + (n0 & 127);
            transpose_tile(src, DFF, kt * 64, col, p.norm_ffn + l * DM, (bf16_t*)(lw + LW_WGU) + (size_t)n0 * DM, DM, ldsf, tid); continue; }
        r -= IT_WGU;
        { const int ntile = r / (DFF / 64), kt = r % (DFF / 64), n0 = ntile * 64;
            transpose_tile(p.w_down + (size_t)l * DFF * DM, DM, kt * 64, n0, nullptr, (bf16_t*)(lw + LW_WD) + (size_t)n0 * DFF, DFF, ldsf, tid); }
    }
    for (int i = b * 512 + tid; i < NL * 8 * 128 * 128; i += G * 512) {
        const int l = i >> 17, rem = i & 131071, ii = (rem >> 7) & 127, jj = rem & 127;
        const float* wsrc = p.w_s + (size_t)(i - rem);
        const int grp = rem >> 14;
        unsigned char* lw = ws + WS_W + (size_t)l * LW_BYTES;
        const float vp = (jj <= ii) ? p.w_s[i] : 0.f;
        const float vs = ((ii >> 5) == (jj >> 5) && (jj & 31) <= (ii & 31)) ? wsrc[grp * 16384 + (ii & 31) * 128 + (jj & 31)] : 0.f;
        ((bf16_t*)(lw + LW_WSP))[rem] = (bf16_t)(cvt_pk_bf16(vp, 0.f) & 0xffffu);
        ((bf16_t*)(lw + LW_WSS))[rem] = (bf16_t)(cvt_pk_bf16(vs, 0.f) & 0xffffu);
    }
    { const int wave = tid >> 6, lane = tid & 63; bf16_t* xb = (bf16_t*)(ws + WS_XB);
      for (int row = b * 8 + wave; row < MT; row += G * 8) {
          const float* xr = (row < MP) ? p.x_prompt + (size_t)row * DM : p.x_sample + (size_t)(row - MP) * DM; float q = 0.f;
#pragma unroll
          for (int j = 0; j < 4; ++j) { const f32x4 v = *(const f32x4*)(xr + 4 * (lane + 64 * j)); q += (v[0] * v[0] + v[1] * v[1]) + (v[2] * v[2] + v[3] * v[3]);
              u32x2 w; w.x = cvt_pk_bf16(v[0], v[1]); w.y = cvt_pk_bf16(v[2], v[3]); *(u32x2*)(xb + (size_t)row * DM + 4 * (lane + 64 * j)) = w; }
#pragma unroll
          for (int o = 32; o >= 1; o >>= 1) q += __shfl_xor(q, o);
          if (lane < 4) ((f32x4*)(ssqm + (size_t)row * 16))[lane] = (f32x4){lane == 0 ? q : 0.f, 0.f, 0.f, 0.f};
      } }
}

constexpr int VT_PITCH = 136;
__device__ __forceinline__ void gate_conv_phase(const Params& p, int l, unsigned char* lds) {
    unsigned char* ws = p.ws;
    const float* lns = (const float*)(ws + WS_LNS);
    bf16_t* AB = (bf16_t*)(ws + WS_AB); const bf16_t* GV = (const bf16_t*)(ws + WS_GV); const bf16_t* CH = (const bf16_t*)(ws + WS_CH);
    const unsigned char* lw = ws + WS_W + (size_t)l * LW_BYTES;
    bf16_t* vT = (bf16_t*)lds;
    float* mr = (float*)(lds + 128 * VT_PITCH * 2);
    int tid = threadIdx.x; asm volatile("" : "+v"(tid));
    const int lane = tid & 63, w = tid >> 6, fr = lane & 15, fq = lane >> 4;
    const int jg = tid >> 5, cq = tid & 31;
    const int ci = tid & 15;
    const int nks = (w >> 1) + 1;
    for (int item = blockIdx.x; item < (MT / 128) * 8; item += gridDim.x) {
        const int ct = item >> 3, g = item & 7, row0 = ct * 128, c0 = g * 128; const bool smp = ct >= MP / 128;
        const f32x4 lg = *(const f32x4*)(p.ln_g + l * DM + c0 + 4 * cq), lb = *(const f32x4*)(p.ln_b + l * DM + c0 + 4 * cq);
        const bf16_t* Wsrc = (const bf16_t*)(lw + (smp ? LW_WSS : LW_WSP)) + g * 16384 + (16 * w + fr) * 128 + 8 * fq;
        bf16x8 wf[4];
#pragma unroll
        for (int ks = 0; ks < 4; ++ks) wf[ks] = *(const bf16x8*)(Wsrc + 32 * ks);
        const int irow = 16 * w + fr; const float bs = p.b_s[(l * 8 + g) * 128 + (smp ? (irow & 31) : irow)];
        const float* cwp = p.conv_w + (size_t)l * 3 * DM + c0 + 8 * ci;
        const f32x4 w0a = *(const f32x4*)(cwp), w0b = *(const f32x4*)(cwp + 4), w1a = *(const f32x4*)(cwp + DM), w1b = *(const f32x4*)(cwp + DM + 4), w2a = *(const f32x4*)(cwp + 2 * DM), w2b = *(const f32x4*)(cwp + 2 * DM + 4);
        const f32x4* sl = (const f32x4*)(lns + (size_t)(row0 + (tid >> 2)) * 32 + (tid & 3) * 8);
        const f32x4 sl0 = sl[0], sl1 = sl[1];
        u32x2 gv[8];
#pragma unroll
        for (int jj = 0; jj < 8; ++jj) gv[jj] = *(const u32x2*)(GV + (size_t)(row0 + 8 * jg + jj) * DM + c0 + 4 * cq);
        bf16_t* rowp = AB + (size_t)(row0 + irow) * 2048 + c0 + 8 * fq;
        u32x4 uu[4];
#pragma unroll
        for (int pp = 0; pp < 4; ++pp) uu[pp] = *(const u32x4*)(rowp + 32 * pp);
        { float sm = (sl0[0] + sl0[2]) + (sl1[0] + sl1[2]), sq = (sl0[1] + sl0[3]) + (sl1[1] + sl1[3]);
          sm += __shfl_xor(sm, 1); sq += __shfl_xor(sq, 1); sm += __shfl_xor(sm, 2); sq += __shfl_xor(sq, 2);
          if ((tid & 3) == 0) { const float mean = sm * (1.0f / 1024.0f), var = sq * (1.0f / 1024.0f) - mean * mean; mr[2 * (tid >> 2)] = mean; mr[2 * (tid >> 2) + 1] = __builtin_amdgcn_rsqf(fmaxf(var, 0.f) + EPS); } }
        __syncthreads();
        { float v[8][4];
#pragma unroll
          for (int jj = 0; jj < 8; ++jj) { const float mean = mr[2 * (8 * jg + jj)], rstd = mr[2 * (8 * jg + jj) + 1];
              v[jj][0] = (bf_lo(gv[jj].x) - mean) * rstd * lg[0] + lb[0]; v[jj][1] = (bf_hi(gv[jj].x) - mean) * rstd * lg[1] + lb[1];
              v[jj][2] = (bf_lo(gv[jj].y) - mean) * rstd * lg[2] + lb[2]; v[jj][3] = (bf_hi(gv[jj].y) - mean) * rstd * lg[3] + lb[3];
              if (smp) *(f32x4*)(p.out + OUT_V + ((size_t)l * MS + (row0 + 8 * jg + jj - MP)) * DM + c0 + 4 * cq) = (f32x4){v[jj][0], v[jj][1], v[jj][2], v[jj][3]}; }
#pragma unroll
          for (int e = 0; e < 4; ++e) { u32x4 wv; wv.x = cvt_pk_bf16(v[0][e], v[1][e]); wv.y = cvt_pk_bf16(v[2][e], v[3][e]); wv.z = cvt_pk_bf16(v[4][e], v[5][e]); wv.w = cvt_pk_bf16(v[6][e], v[7][e]);
              *(u32x4*)(vT + (4 * cq + e) * VT_PITCH + 8 * jg) = wv; } }
        u32x4 ch0[4], ch1[4], ch2[4], bg[4];
#pragma unroll
        for (int vv = 0; vv < 4; ++vv) { const int i = (tid >> 4) + 32 * vv, row = row0 + i, c = c0 + 8 * ci; const int pos = smp ? ((row - MP) & 31) : (row & 2047);
            const u32x4 z4 = {0u, 0u, 0u, 0u};
            ch0[vv] = *(const u32x4*)(CH + (size_t)row * DM + c);
            ch1[vv] = (pos >= 1) ? *(const u32x4*)(CH + (size_t)(row - 1) * DM + c) : z4;
            ch2[vv] = (pos >= 2) ? *(const u32x4*)(CH + (size_t)(row - 2) * DM + c) : z4;
            bg[vv] = *(const u32x4*)(AB + (size_t)row * 2048 + 1024 + c); }
        __syncthreads();
        { f32x4 acc[8];
#pragma unroll
          for (int dt = 0; dt < 8; ++dt) acc[dt] = (f32x4){0.f, 0.f, 0.f, 0.f};
#pragma unroll
          for (int ks = 0; ks < 4; ++ks) if (ks < nks) {
#pragma unroll
              for (int dt = 0; dt < 8; ++dt) { const int d = 32 * (dt >> 1) + 8 * (fr >> 2) + 4 * (dt & 1) + (fr & 3);
                  const bf16x8 vf = *(const bf16x8*)(vT + d * VT_PITCH + 32 * ks + 8 * fq);
                  acc[dt] = __builtin_amdgcn_mfma_f32_16x16x32_bf16(vf, wf[ks], acc[dt], 0, 0, 0); } }
#pragma unroll
          for (int pp = 0; pp < 4; ++pp) { const f32x4 s0 = acc[2 * pp] + bs, s1 = acc[2 * pp + 1] + bs;
              const f32x4 u0 = {bf_lo(uu[pp][0]), bf_hi(uu[pp][0]), bf_lo(uu[pp][1]), bf_hi(uu[pp][1])}, u1 = {bf_lo(uu[pp][2]), bf_hi(uu[pp][2]), bf_lo(uu[pp][3]), bf_hi(uu[pp][3])};
              *(u32x4*)(rowp + 32 * pp) = pg8::pack8(u0 * s0, u1 * s1); } }
#pragma unroll
        for (int vv = 0; vv < 4; ++vv) { const int i = (tid >> 4) + 32 * vv, row = row0 + i, c = c0 + 8 * ci; const int pos = smp ? ((row - MP) & 31) : (row & 2047);
            float f0[8], f1[8], f2[8], o[8];
#pragma unroll
            for (int e = 0; e < 4; ++e) { f0[2 * e] = bf_lo(ch0[vv][e]); f0[2 * e + 1] = bf_hi(ch0[vv][e]); f1[2 * e] = bf_lo(ch1[vv][e]); f1[2 * e + 1] = bf_hi(ch1[vv][e]); f2[2 * e] = bf_lo(ch2[vv][e]); f2[2 * e + 1] = bf_hi(ch2[vv][e]); }
            if (smp && pos < 2) { const int sq = (row - MP) >> 5; const float* stp = p.state_conv + ((size_t)(l * 32 + sq) * 2) * DM + c;
                if (pos == 0) { const f32x4 a = *(const f32x4*)(stp + DM), bq = *(const f32x4*)(stp + DM + 4); f1[0] = a[0]; f1[1] = a[1]; f1[2] = a[2]; f1[3] = a[3]; f1[4] = bq[0]; f1[5] = bq[1]; f1[6] = bq[2]; f1[7] = bq[3]; }
                { const float* s2 = stp + (pos == 0 ? 0 : DM); const f32x4 a = *(const f32x4*)(s2), bq = *(const f32x4*)(s2 + 4); f2[0] = a[0]; f2[1] = a[1]; f2[2] = a[2]; f2[3] = a[3]; f2[4] = bq[0]; f2[5] = bq[1]; f2[6] = bq[2]; f2[7] = bq[3]; } }
#pragma unroll
            for (int e = 0; e < 4; ++e) { o[e] = w0a[e] * f2[e] + w1a[e] * f1[e] + w2a[e] * f0[e]; o[4 + e] = w0b[e] * f2[4 + e] + w1b[e] * f1[4 + e] + w2b[e] * f0[4 + e]; }
            u32x4 ov;
#pragma unroll
            for (int e = 0; e < 4; ++e) ov[e] = cvt_pk_bf16(o[2 * e] * bf_lo(bg[vv][e]), o[2 * e + 1] * bf_hi(bg[vv][e]));
            *(u32x4*)(AB + (size_t)row * 2048 + 1024 + c) = ov;
            const int lastpos = smp ? 31 : 2047;
            if (pos >= lastpos - 1) { float* op = smp ? p.out + OUT_NCS + (((size_t)l * 32 + ((row - MP) >> 5)) * 2 + (pos - (lastpos - 1))) * DM + c
                                                      : p.out + OUT_NCP + (((size_t)l * 32 + (row >> 11)) * 2 + (pos - (lastpos - 1))) * DM + c;
                *(f32x4*)op = (f32x4){f0[0], f0[1], f0[2], f0[3]}; *(f32x4*)(op + 4) = (f32x4){f0[4], f0[5], f0[6], f0[7]}; } }
        __syncthreads();
    }
}

__device__ __forceinline__ void final_norm_phase(const Params& p) {
    const float* ssq = (const float*)(p.ws + WS_SSQM);
    const size_t n4 = (size_t)MT * DM / 4;
    for (size_t i = (size_t)blockIdx.x * 512 + threadIdx.x; i < n4; i += (size_t)gridDim.x * 512) {
        const int row = (int)(i >> 8), c = (int)(i & 255) * 4; const float rs = pg8::rstd_of(ssq, row);
        const f32x4 g = *(const f32x4*)(p.norm_final + c); f32x4 v = ((f32x4*)p.out)[i]; v = v * rs * g; ((f32x4*)p.out)[i] = v; }
}

#define LAS __attribute__((address_space(3)))
#define XB_TMO      128
#define XB_XCNT(j)  (256  + 64 * (j))
#define XB_XSUB(j)  (1280 + 64 * (j))
#define XB_XGEN(j)  (2304 + 64 * (j))
#define XB_TOP      3328
#define XB_TOPGEN   3392
#define XCD_BAR_WORDS 3456
#define XB_SPIN_CAP (1u << 18)

__device__ __forceinline__ unsigned xb_ld(unsigned* p)              { return __hip_atomic_load(p, __ATOMIC_RELAXED, __HIP_MEMORY_SCOPE_AGENT); }
__device__ __forceinline__ unsigned xb_add(unsigned* p, unsigned v) { return __hip_atomic_fetch_add(p, v, __ATOMIC_RELAXED, __HIP_MEMORY_SCOPE_AGENT); }
__device__ __forceinline__ unsigned xb_xcc_id() { return (unsigned)__builtin_amdgcn_s_getreg((3 << 11) | 20) & 0xFu; }
#define XB_SPIN(cond, bar) do { unsigned _sp = 0; while (cond) { __builtin_amdgcn_s_sleep(1); \
    if ((++_sp & 255u) == 0u) { if (xb_ld(&(bar)[XB_TMO])) break; if (_sp > XB_SPIN_CAP) { atomicAdd(&(bar)[XB_TMO], 1u); break; } } } } while (0)

struct XcdBarrier {
    unsigned* bar; unsigned x;
    volatile LAS unsigned* st;
};

__device__ __forceinline__ XcdBarrier xcd_barrier_post(unsigned* bar, volatile LAS unsigned* st) {
    XcdBarrier b; b.bar = bar; b.x = xb_xcc_id(); b.st = st;
    if (threadIdx.x == 0) (void)xb_add(&bar[XB_XCNT(b.x)], 1u);
    return b;
}
__device__ __forceinline__ void xcd_barrier_complete(unsigned* bar, unsigned x, unsigned& nloc, unsigned& nx) {
    const unsigned G = gridDim.x * gridDim.y * gridDim.z;
    unsigned sum, cnt, mine, sp = 0u;
    for (;;) {
        sum = 0u; cnt = 0u; mine = 0u;
#pragma unroll
        for (unsigned j = 0; j < 16; ++j) { const unsigned c = xb_ld(&bar[XB_XCNT(j)]); sum += c; cnt += (c > 0u) ? 1u : 0u; mine = (j == x) ? c : mine; }
        if (sum == G) break;
        __builtin_amdgcn_s_sleep(1);
        if ((++sp & 255u) == 0u) { if (xb_ld(&bar[XB_TMO])) break; if (sp > XB_SPIN_CAP) { atomicAdd(&bar[XB_TMO], 1u); break; } }
    }
    nloc = mine > 0u ? mine : 1u; nx = cnt > 0u ? cnt : 1u;
}

__device__ __forceinline__ void xcd_barrier(const XcdBarrier& b) {
    asm volatile("s_waitcnt vmcnt(0)" ::: "memory");
    __syncthreads();
    if (threadIdx.x == 0) {
        unsigned* bar = b.bar;
        __builtin_amdgcn_s_waitcnt(0);
        unsigned nloc = b.st[0], nx = b.st[1];
        if (nloc == 0u) { xcd_barrier_complete(bar, b.x, nloc, nx); b.st[0] = nloc; b.st[1] = nx; }
        const unsigned old = xb_add(&bar[XB_XSUB(b.x)], 1u);
        const unsigned gen = old / nloc;
        if (old + 1u == (gen + 1u) * nloc) {
            __builtin_amdgcn_fence(__ATOMIC_RELEASE, "agent");
            asm volatile("s_waitcnt vmcnt(0)" ::: "memory");
            const unsigned og = xb_add(&bar[XB_TOP], 1u);
            const unsigned tg = og / nx;
            if (og + 1u == (tg + 1u) * nx) xb_add(&bar[XB_TOPGEN], 1u);
            else XB_SPIN(xb_ld(&bar[XB_TOPGEN]) == tg, bar);
            __builtin_amdgcn_fence(__ATOMIC_ACQUIRE, "agent");
            xb_add(&bar[XB_XGEN(b.x)], 1u);
            asm volatile("s_waitcnt vmcnt(0)" ::: "memory");
        } else {
            XB_SPIN(xb_ld(&bar[XB_XGEN(b.x)]) == gen, bar);
            __builtin_amdgcn_fence(__ATOMIC_ACQUIRE, "agent");
            asm volatile("s_waitcnt vmcnt(0)" ::: "memory");
        }
    }
    __syncthreads();
}

__global__ void __launch_bounds__(512, 2) mk_fwd(Params p) {
    extern __shared__ __attribute__((aligned(16))) unsigned char lds[];
    unsigned char* ws = p.ws;
    float* ssq_mix = (float*)(ws + WS_SSQM); float* ssq_ffn = (float*)(ws + WS_SSQF); float* lns = (float*)(ws + WS_LNS);
    bf16_t* XB = (bf16_t*)(ws + WS_XB); bf16_t* AB = (bf16_t*)(ws + WS_AB); bf16_t* GV = (bf16_t*)(ws + WS_GV); bf16_t* CH = (bf16_t*)(ws + WS_CH);
    bf16_t* T12 = GV; bf16_t* MMb = AB; bf16_t* Hb = AB;
    const int G = gridDim.x, c = blockIdx.x;
    PG8_LAS unsigned char* ring = (PG8_LAS unsigned char*)lds;
#if MK_MULTI
#define GRID_SYNC() do { } while (0)
#else
    cg::grid_group grid = cg::this_grid();
    volatile LAS unsigned* bst = (volatile LAS unsigned*)((LAS unsigned char*)lds + pg8::STAGE_BYTES);
    if (threadIdx.x < 2) bst[threadIdx.x] = 0u;
    __syncthreads();
    XcdBarrier xbar = xcd_barrier_post((unsigned*)(ws + WS_CTL), bst);
#define GRID_SYNC() do { if (ph == 0) grid.sync(); else xcd_barrier(xbar); } while (0)
#endif
    for (int ph = p.ph_lo; ph < p.ph_hi; ++ph) {
        if (ph == 0) { if (PHASE_MASK & 1) { if (PROBE_DUP & 512) p0_prologue(p, (float*)lds); p0_prologue(p, (float*)lds); } }
        else if (ph == NPHASE - 1) { if (PHASE_MASK & 2) final_norm_phase(p); }
        else {
            const int l = (ph - 1) / 7, s = (ph - 1) % 7;
            for (int rep_ = 0; rep_ < (((PROBE_DUP >> s) & 1) ? 2 : 1); ++rep_) {
            const unsigned char* lw = ws + WS_W + (size_t)l * LW_BYTES;
            if (s == 0) { if (PHASE_MASK & 4) {
                pg8::Gemm g{XB, (const bf16_t*)(lw + LW_WIN), MT, 5120, DM, DM, 1 << 30, 0}; pg8::StaticOrder S; S.init(MT, 5120, G, c);
                pg8::EpiA E{AB, GV, CH, ssq_mix, lns};
                pg8::gemm_phase<pg8::EpiA, pg8::StaticOrder>(ring, g, S, E); }
            } else if (s == 1) {
                if (PHASE_MASK & 8) gate_conv_phase(p, l, lds);
            } else if (s == 2) { if (PHASE_MASK & 16) {
                pg8::Gemm g{AB, (const bf16_t*)(lw + LW_WPAB), MT, 2048, DM, 2048, 4, 1024}; pg8::StaticOrder S; S.init(MT, 2048, G, c);
                pg8::EpiC E{T12};
                pg8::gemm_phase<pg8::EpiC, pg8::StaticOrder>(ring, g, S, E); }
            } else if (s == 3) { if (PHASE_MASK & 32) {
                pg8::Gemm g{XB, (const bf16_t*)(lw + LW_WIN) + (size_t)5120 * DM, MT, 2048, DM, DM, 1 << 30, 0}; pg8::StaticOrder S; S.init(MT, 2048, G, c);
                pg8::EpiD E{T12, MMb, ssq_mix};
                pg8::gemm_phase<pg8::EpiD, pg8::StaticOrder>(ring, g, S, E); }
            } else if (s == 4) { if (PHASE_MASK & 64) {
                pg8::Gemm g{MMb, (const bf16_t*)(lw + LW_WO), MT, DM, DM, DM, 1 << 30, 0}; pg8::StaticOrder S; S.init(MT, DM, G, c);
                pg8::EpiRes E{l == 0 ? p.x_prompt : p.out, l == 0 ? p.x_sample : p.out + OUT_YS, p.out, XB, ssq_ffn};
                pg8::gemm_phase<pg8::EpiRes, pg8::StaticOrder>(ring, g, S, E); }
            } else if (s == 5) { if (PHASE_MASK & 128) {
                pg8::Gemm g{XB, (const bf16_t*)(lw + LW_WGU), MT, 2 * DFF, DM, DM, 1 << 30, 0}; pg8::StaticOrder S; S.init(MT, 2 * DFF, G, c);
                pg8::EpiF E{Hb, ssq_ffn};
                pg8::gemm_phase<pg8::EpiF, pg8::StaticOrder>(ring, g, S, E); }
            } else { if (PHASE_MASK & 256) {
                pg8::Gemm g{Hb, (const bf16_t*)(lw + LW_WD), MT, DM, DFF, DFF, 1 << 30, 0}; pg8::StaticOrder S; S.init(MT, DM, G, c);
                pg8::EpiRes E{p.out, p.out + OUT_YS, p.out, XB, ssq_mix};
                pg8::gemm_phase<pg8::EpiRes, pg8::StaticOrder>(ring, g, S, E); }
            }
            }
        }
        if (ph + 1 < p.ph_hi) { GRID_SYNC(); }
    }
}

extern "C" void kernel_launch(void* const* d_in, const int* in_sizes, int n_in, void* d_out, int out_size, void* d_ws, size_t ws_size, hipStream_t stream) {
    static int grid = 0;
    if (grid == 0) {
        if (n_in != 18 || in_sizes[0] != MP * DM || (size_t)out_size != OUT_TOTAL || ws_size < WS_END) {
            fprintf(stderr, "kernel_launch: unexpected shapes: n_in %d in0 %d out %d ws %zu (need %zu)\n", n_in, n_in > 0 ? in_sizes[0] : -1, out_size, ws_size, (size_t)WS_END); grid = -1; return; }
        int dev = 0, cus = 0, per_cu = 0;
        (void)hipGetDevice(&dev); (void)hipDeviceGetAttribute(&cus, hipDeviceAttributeMultiprocessorCount, dev);
        if (hipFuncSetAttribute((const void*)mk_fwd, hipFuncAttributeMaxDynamicSharedMemorySize, LDS_BYTES) != hipSuccess) { fprintf(stderr, "kernel_launch: hipFuncSetAttribute failed\n"); grid = -1; return; }
        if (hipOccupancyMaxActiveBlocksPerMultiprocessor(&per_cu, (const void*)mk_fwd, 512, LDS_BYTES) != hipSuccess || per_cu < 1) { fprintf(stderr, "kernel_launch: occupancy query says %d\n", per_cu); per_cu = 1; }
        (void)hipGetLastError();
        grid = cus * 1;
        fprintf(stderr, "kernel_launch: cus %d per_cu %d grid %d\n", cus, per_cu, grid);
    }
    if (grid < 0) return;
    if (hipMemsetAsync((char*)d_ws + WS_CTL, 0, CTL_BYTES, stream) != hipSuccess) { fprintf(stderr, "kernel_launch: memset failed\n"); return; }
    Params p{};
    const float** pp = (const float**)&p;
    for (int i = 0; i < 18; ++i) pp[i] = (const float*)d_in[i];
    p.out = (float*)d_out; p.ws = (unsigned char*)d_ws;
#if MK_MULTI
    for (int ph = 0; ph < NPHASE; ++ph) { p.ph_lo = ph; p.ph_hi = ph + 1; hipLaunchKernelGGL(mk_fwd, dim3(grid), dim3(512), LDS_BYTES, stream, p); }
#else
    p.ph_lo = 0; p.ph_hi = NPHASE;
    void* args[] = {&p};
    hipError_t e = hipLaunchCooperativeKernel((const void*)mk_fwd, dim3(grid), dim3(512), args, LDS_BYTES, stream);
    if (e != hipSuccess) fprintf(stderr, "kernel_launch: cooperative launch failed: %s (grid %d)\n", hipGetErrorString(e), grid);
#endif
}
```

```cpp
#include <hip/hip_runtime.h>
#include <hip/hip_cooperative_groups.h>
#include <cstdio>
#include <cstdint>
namespace cg = cooperative_groups;

#ifndef PHASE_MASK
#define PHASE_MASK 511
#endif
#ifndef PROBE_DUP
#define PROBE_DUP 0
#endif
#ifndef MK_MULTI
#define MK_MULTI 0
#endif

constexpr int MP = 65536, MS = 1024, MT = MP + MS, DM = 1024, NL = 4, DFF = 2816, NIN = 7168;
constexpr float EPS = 1e-6f;
constexpr size_t OUT_YS = (size_t)MP * DM, OUT_NCP = OUT_YS + (size_t)MS * DM, OUT_NCS = OUT_NCP + (size_t)NL * 32 * 2 * DM, OUT_V = OUT_NCS + (size_t)NL * 32 * 2 * DM;
constexpr size_t OUT_TOTAL = OUT_V + (size_t)NL * 32 * 32 * DM;

constexpr size_t MiB = (size_t)1 << 20;
constexpr size_t WS_SSQM = 0, WS_SSQF = 5 * MiB, WS_LNS = 10 * MiB;
constexpr size_t WS_CTL = 20 * MiB, CTL_BYTES = 16384;
constexpr size_t WS_W = 24 * MiB;
constexpr size_t LW_WIN = 0, LW_WPAB = LW_WIN + (size_t)NIN * DM * 2, LW_WO = LW_WPAB + (size_t)2048 * DM * 2, LW_WGU = LW_WO + (size_t)DM * DM * 2,
                 LW_WD = LW_WGU + (size_t)2 * DFF * DM * 2, LW_WSP = LW_WD + (size_t)DM * DFF * 2, LW_WSS = LW_WSP + (size_t)8 * 128 * 128 * 2, LW_BYTES = LW_WSS + (size_t)8 * 128 * 128 * 2;
constexpr size_t WS_XB = 176 * MiB;
constexpr size_t WS_AB = 306 * MiB;
constexpr size_t WS_GV = 566 * MiB;
constexpr size_t WS_CH = 696 * MiB;
constexpr size_t WS_END = 826 * MiB;
static_assert(WS_W + NL * LW_BYTES <= WS_XB, "weights overflow");

namespace pg8 {
#define PG8_LAS __attribute__((address_space(3)))
typedef unsigned short bf16_t;
typedef short bf16x8 __attribute__((ext_vector_type(8)));
typedef float f32x4 __attribute__((ext_vector_type(4)));
typedef float f32x2 __attribute__((ext_vector_type(2)));
typedef unsigned u32x4 __attribute__((ext_vector_type(4)));
typedef unsigned u32x2 __attribute__((ext_vector_type(2)));
constexpr int BM = 256, BK = 64, HALF = 128, HTB = HALF * BK * 2, STAGE_BYTES = 8 * HTB, NXCD = 8, WGM = 8;

__host__ __device__ __forceinline__ int lds_byte(int r, int c) { const int st = (r >> 4) * 2 + (c >> 5), rr = r & 15, cc = c & 31, ob = rr * 64 + cc * 2; return st * 1024 + (ob ^ (((ob >> 9) & 1) << 5)); }
__host__ __device__ __forceinline__ void stage_rc(int b, int& R, int& C) { const int st = b / 1024, sb = b % 1024, swz = sb ^ (((sb >> 9) & 1) << 5); R = (st >> 1) * 16 + swz / 64; C = (st & 1) * 32 + (swz % 64) / 2; }
__host__ __device__ __forceinline__ int perm32(int rho) { const int n = rho >> 4, i = rho & 15; return 8 * (i >> 2) + 4 * n + (i & 3); }

struct Unit { int pm, pn; };
struct Gemm { const bf16_t* A; const bf16_t* Bt; int M, N, K, lda, asplit_pn, asplit_off; };

struct StaticOrder {
    int nM, nN, nwg, G, c;
    __host__ __device__ void init(int M, int N, int G_, int c_) { nM = M / BM; nN = N / BM; nwg = nM * nN; G = G_; c = c_; }
    __host__ __device__ bool next(int i, Unit& u) const {
        const long L = (long)i * G + c; if (L >= nwg) return false;
        int wgid = (int)L; { const int q = nwg / NXCD, r = nwg % NXCD, xcd = wgid % NXCD, off = wgid / NXCD; wgid = (xcd < r ? xcd * (q + 1) : r * (q + 1) + (xcd - r) * q) + off; }
        const int nig = WGM * nN, gid = wgid / nig, fm = gid * WGM, gsz = (nM - fm) < WGM ? (nM - fm) : WGM;
        u.pm = fm + ((wgid % nig) % gsz); u.pn = (wgid % nig) / gsz; return true;
    }
    __device__ __forceinline__ void a_ready(const Unit&) const {}
    __device__ __forceinline__ void done(const Unit&) const {}
};

__device__ __forceinline__ unsigned cvt_pk_bf16(float lo, float hi) { unsigned r; asm volatile("v_cvt_pk_bf16_f32 %0, %1, %2" : "=v"(r) : "v"(lo), "v"(hi)); return r; }
__device__ __forceinline__ float bf_lo(unsigned w) { return __uint_as_float(w << 16); }
__device__ __forceinline__ float bf_hi(unsigned w) { return __uint_as_float(w & 0xffff0000u); }
__device__ __forceinline__ f32x2 gelu_pk(f32x2 v) {
    const f32x2 av = __builtin_elementwise_abs(v), d = av * 0.2316418882f + 1.0f;
    f32x2 t; t.x = __builtin_amdgcn_rcpf(d.x); t.y = __builtin_amdgcn_rcpf(d.y);
    f32x2 q = t * 0.5307027145f + (-0.7265760135f); q = q * t + 0.7107068705f; q = q * t + (-0.142248368f); q = q * t + 0.127414796f; q = q * t;
    const f32x2 s = (v * v) * (-0.72134752044f);
    f32x2 e; e.x = __builtin_amdgcn_exp2f(s.x); e.y = __builtin_amdgcn_exp2f(s.y);
    const f32x2 m = v * (q * e), r = v - m;
    f32x2 o; o.x = v.x < 0.f ? m.x : r.x; o.y = v.y < 0.f ? m.y : r.y; return o;
}
__device__ __forceinline__ f32x4 gelu4(f32x4 v) { const f32x2 a = gelu_pk((f32x2){v[0], v[1]}), b = gelu_pk((f32x2){v[2], v[3]}); return (f32x4){a.x, a.y, b.x, b.y}; }
__device__ __forceinline__ float sigmoidf_(float x) { return __builtin_amdgcn_rcpf(1.0f + __builtin_amdgcn_exp2f(x * -1.44269504f)); }
__device__ __forceinline__ f32x4 sigmoid4(f32x4 v) { return (f32x4){sigmoidf_(v[0]), sigmoidf_(v[1]), sigmoidf_(v[2]), sigmoidf_(v[3])}; }
__device__ __forceinline__ u32x4 pack8(f32x4 v0, f32x4 v1) { u32x4 w; w.x = cvt_pk_bf16(v0[0], v0[1]); w.y = cvt_pk_bf16(v0[2], v0[3]); w.z = cvt_pk_bf16(v1[0], v1[1]); w.w = cvt_pk_bf16(v1[2], v1[3]); return w; }
__device__ __forceinline__ float rstd_of(const float* slots, int row) { const f32x4* s = (const f32x4*)(slots + (size_t)row * 16); const f32x4 t = (s[0] + s[1]) + (s[2] + s[3]);
    return __builtin_amdgcn_rsqf(((t[0] + t[1]) + (t[2] + t[3])) * (1.0f / 1024.0f) + EPS); }

__device__ __forceinline__ void wave_rstd(const float* slots, int rowbase, int lane, int fr, float (&rs)[2][4]) {
    float val[2];
#pragma unroll
    for (int ai = 0; ai < 2; ++ai) { const f32x4* s = (const f32x4*)(slots + (size_t)(rowbase + ai * HALF + lane) * 16); const f32x4 t = (s[0] + s[1]) + (s[2] + s[3]);
        val[ai] = __builtin_amdgcn_rsqf(((t[0] + t[1]) + (t[2] + t[3])) * (1.0f / 1024.0f) + EPS); }
#pragma unroll
    for (int ai = 0; ai < 2; ++ai)
#pragma unroll
        for (int m = 0; m < 4; ++m) rs[ai][m] = __shfl(val[ai], m * 16 + fr);
}
__device__ __forceinline__ f32x4 unpk_lo(u32x4 w) { return (f32x4){bf_lo(w[0]), bf_hi(w[0]), bf_lo(w[1]), bf_hi(w[1])}; }
__device__ __forceinline__ f32x4 unpk_hi(u32x4 w) { return (f32x4){bf_lo(w[2]), bf_hi(w[2]), bf_lo(w[3]), bf_hi(w[3])}; }

struct EpiA {
    static constexpr bool PERM = true, AFTER_DRAIN = false;
    bf16_t* AB; bf16_t* GV; bf16_t* CH; const float* ssq; float* lns;
    __device__ __forceinline__ void operator()(const f32x4 (&acc)[2][2][4][2], const Unit& u, int wr, int wc, int fr, int fq) const {
        const int row0 = u.pm * BM + wr * 64 + fr, cw = wc * 32 + 8 * fq, pn = u.pn;
        float rsv[2][4]; wave_rstd(ssq, u.pm * BM + wr * 64, fr + 16 * fq, fr, rsv);
        if (pn < 4) {
#pragma unroll
            for (int ai = 0; ai < 2; ++ai)
#pragma unroll
                for (int m = 0; m < 4; ++m) { const int row = row0 + ai * HALF + m * 16; const float rs = rsv[ai][m]; bf16_t* rowp = AB + (size_t)row * 2048 + pn * 256 + cw;
#pragma unroll
                    for (int bj = 0; bj < 2; ++bj) *(u32x4*)(rowp + bj * HALF) = pack8(gelu4(acc[ai][bj][m][0] * rs), gelu4(acc[ai][bj][m][1] * rs)); }
        } else if (pn < 8) {
#pragma unroll
            for (int ai = 0; ai < 2; ++ai)
#pragma unroll
                for (int m = 0; m < 4; ++m) { const int row = row0 + ai * HALF + m * 16; const float rs = rsv[ai][m]; bf16_t* rowp = GV + (size_t)row * 1024 + (pn - 4) * 256 + cw;
                    float s = 0.f, q = 0.f;
#pragma unroll
                    for (int bj = 0; bj < 2; ++bj) { const u32x4 w = pack8(gelu4(acc[ai][bj][m][0] * rs), gelu4(acc[ai][bj][m][1] * rs)); *(u32x4*)(rowp + bj * HALF) = w;
#pragma unroll
                        for (int e = 0; e < 4; ++e) { const float a = bf_lo(w[e]), b = bf_hi(w[e]); s += a + b; q += a * a + b * b; } }
                    s += __shfl_xor(s, 16); s += __shfl_xor(s, 32); q += __shfl_xor(q, 16); q += __shfl_xor(q, 32);
                    if (fq == 0) *(f32x2*)(lns + ((size_t)row * 16 + (pn - 4) * 4 + wc) * 2) = (f32x2){s, q}; }
        } else if (pn < 12) {
#pragma unroll
            for (int ai = 0; ai < 2; ++ai)
#pragma unroll
                for (int m = 0; m < 4; ++m) { const int row = row0 + ai * HALF + m * 16; const float rs = rsv[ai][m]; bf16_t* rowp = AB + (size_t)row * 2048 + 1024 + (pn - 8) * 256 + cw;
#pragma unroll
                    for (int bj = 0; bj < 2; ++bj) *(u32x4*)(rowp + bj * HALF) = pack8(acc[ai][bj][m][0] * rs, acc[ai][bj][m][1] * rs); }
        } else {
#pragma unroll
            for (int ai = 0; ai < 2; ++ai)
#pragma unroll
                for (int m = 0; m < 4; ++m) { const int row = row0 + ai * HALF + m * 16; const float rs = rsv[ai][m]; const float rs2 = rs * rs;
                    *(u32x4*)(CH + (size_t)row * 1024 + (pn - 12) * 128 + cw) = pack8(acc[ai][0][m][0] * acc[ai][1][m][0] * rs2, acc[ai][0][m][1] * acc[ai][1][m][1] * rs2); }
        }
    }
};
struct EpiC {
    static constexpr bool PERM = true, AFTER_DRAIN = false;
    bf16_t* T;
    __device__ __forceinline__ void operator()(const f32x4 (&acc)[2][2][4][2], const Unit& u, int wr, int wc, int fr, int fq) const {
        const int row0 = u.pm * BM + wr * 64 + fr, cw = u.pn * 256 + wc * 32 + 8 * fq;
#pragma unroll
        for (int ai = 0; ai < 2; ++ai)
#pragma unroll
            for (int m = 0; m < 4; ++m) { bf16_t* rowp = T + (size_t)(row0 + ai * HALF + m * 16) * 2048 + cw;
#pragma unroll
                for (int bj = 0; bj < 2; ++bj) *(u32x4*)(rowp + bj * HALF) = pack8(acc[ai][bj][m][0], acc[ai][bj][m][1]); }
    }
};
struct EpiD {
    static constexpr bool PERM = true, AFTER_DRAIN = false;
    const bf16_t* T; bf16_t* MM; const float* ssq;
    __device__ __forceinline__ void operator()(const f32x4 (&acc)[2][2][4][2], const Unit& u, int wr, int wc, int fr, int fq) const {
        const int row0 = u.pm * BM + wr * 64 + fr, cw = u.pn * 128 + wc * 32 + 8 * fq;
        float rsv[2][4]; wave_rstd(ssq, u.pm * BM + wr * 64, fr + 16 * fq, fr, rsv);
#pragma unroll
        for (int ai = 0; ai < 2; ++ai) {
            u32x4 tt[4][2];
#pragma unroll
            for (int m = 0; m < 4; ++m) { const bf16_t* tp = T + (size_t)(row0 + ai * HALF + m * 16) * 2048 + cw; tt[m][0] = *(const u32x4*)tp; tt[m][1] = *(const u32x4*)(tp + 1024); }
#pragma unroll
            for (int m = 0; m < 4; ++m) { const int row = row0 + ai * HALF + m * 16; const float rs = rsv[ai][m];
                const u32x4 t1 = tt[m][0], t2 = tt[m][1];
                const f32x4 a0 = sigmoid4(acc[ai][0][m][0] * rs), a1 = sigmoid4(acc[ai][0][m][1] * rs), b0 = sigmoid4(acc[ai][1][m][0] * rs), b1 = sigmoid4(acc[ai][1][m][1] * rs);
                const f32x4 p0 = {bf_lo(t1[0]), bf_hi(t1[0]), bf_lo(t1[1]), bf_hi(t1[1])}, p1 = {bf_lo(t1[2]), bf_hi(t1[2]), bf_lo(t1[3]), bf_hi(t1[3])};
                const f32x4 q0 = {bf_lo(t2[0]), bf_hi(t2[0]), bf_lo(t2[1]), bf_hi(t2[1])}, q1 = {bf_lo(t2[2]), bf_hi(t2[2]), bf_lo(t2[3]), bf_hi(t2[3])};
                *(u32x4*)(MM + (size_t)row * 1024 + cw) = pack8(a0 * p0 + b0 * q0, a1 * p1 + b1 * q1); }
            asm volatile("" ::: "memory");
        }
    }
};
struct EpiRes {
    static constexpr bool PERM = true, AFTER_DRAIN = false;
    bf16_t* xb; float* ssq;
    __device__ __forceinline__ void operator()(const f32x4 (&acc)[2][2][4][2], const Unit& u, int wr, int wc, int fr, int fq) const {
        const int row0 = u.pm * BM + wr * 64 + fr, cw = u.pn * BM + wc * 32 + 8 * fq;
#pragma unroll
        for (int ai = 0; ai < 2; ++ai) {
            u32x4 xo[4][2];
#pragma unroll
            for (int m = 0; m < 4; ++m)
#pragma unroll
                for (int bj = 0; bj < 2; ++bj) xo[m][bj] = *(const u32x4*)(xb + (size_t)(row0 + ai * HALF + m * 16) * DM + cw + bj * HALF);
#pragma unroll
            for (int m = 0; m < 4; ++m) { const int row = row0 + ai * HALF + m * 16; float q = 0.f;
#pragma unroll
                for (int bj = 0; bj < 2; ++bj) { const u32x4 w = pack8(acc[ai][bj][m][0] + unpk_lo(xo[m][bj]), acc[ai][bj][m][1] + unpk_hi(xo[m][bj]));
                    *(u32x4*)(xb + (size_t)row * DM + cw + bj * HALF) = w;
#pragma unroll
                    for (int e = 0; e < 4; ++e) { const float a = bf_lo(w[e]), b = bf_hi(w[e]); q += a * a + b * b; } }
                q += __shfl_xor(q, 16); q += __shfl_xor(q, 32);
                if (fq == 0) ssq[(size_t)row * 16 + u.pn * 4 + wc] = q; }
            asm volatile("" ::: "memory");
        }
    }
};
struct EpiF {
    static constexpr bool PERM = true, AFTER_DRAIN = false;
    bf16_t* H; const float* ssq;
    __device__ __forceinline__ void operator()(const f32x4 (&acc)[2][2][4][2], const Unit& u, int wr, int wc, int fr, int fq) const {
        const int row0 = u.pm * BM + wr * 64 + fr, cw = u.pn * 128 + wc * 32 + 8 * fq;
        float rsv[2][4]; wave_rstd(ssq, u.pm * BM + wr * 64, fr + 16 * fq, fr, rsv);
#pragma unroll
        for (int ai = 0; ai < 2; ++ai)
#pragma unroll
            for (int m = 0; m < 4; ++m) { const int row = row0 + ai * HALF + m * 16; const float rs = rsv[ai][m];
                const f32x4 g0 = acc[ai][0][m][0] * rs, g1 = acc[ai][0][m][1] * rs, u0 = acc[ai][1][m][0] * rs, u1 = acc[ai][1][m][1] * rs;
                *(u32x4*)(H + (size_t)row * DFF + cw) = pack8(g0 * sigmoid4(g0) * u0, g1 * sigmoid4(g1) * u1); }
    }
};

template <class Epi, class Sched>
__device__ __forceinline__ void gemm_phase(PG8_LAS unsigned char* lds, const Gemm g, const Sched& S, const Epi& E) {
    int tid = threadIdx.x; asm volatile("" : "+v"(tid));
    const int wid = __builtin_amdgcn_readfirstlane(tid >> 6), lane = tid & 63, wr = wid >> 2, wc = wid & 3, fr = lane & 15, fq = lane >> 4;
    const int K = g.K, nt = K / BK, lda = g.lda;
    unsigned voffA[2], voffB[2];
#pragma unroll
    for (int i = 0; i < 2; ++i) { int R, C; stage_rc(tid * 16 + i * 8192, R, C); const int Rb = Epi::PERM ? ((R & ~31) + perm32(R & 31)) : R;
        voffA[i] = (unsigned)(R * lda + C) * 2u; voffB[i] = (unsigned)(Rb * K + C) * 2u; }
    const size_t kstep = (size_t)(BK * 2);
    const size_t hstepA = (size_t)HALF * lda * 2, hstepB = (size_t)HALF * K * 2;
    const size_t tstepA = 2 * hstepA, tstepB = 2 * hstepB;
    const unsigned ldsw = (unsigned)wid * 1024u;
    const int aoff = lds_byte(wr * 64 + fr, fq * 8), boff = lds_byte(wc * 32 + fr, fq * 8);
#define PG8_SA(b, h) (((b) * 2 + (h)) * HTB)
#define PG8_SB(b, h) ((4 + (b) * 2 + (h)) * HTB)
#define PG8_STAGE(bufoff, gbase, voff) do { _Pragma("unroll") for (int _i = 0; _i < 2; ++_i) \
        __builtin_amdgcn_global_load_lds((const unsigned*)((const char*)(gbase) + (voff)[_i]), (PG8_LAS unsigned*)(lds + (bufoff) + ldsw + _i * 8192), 16, 0, 0); } while (0)
#define PG8_LDA(dst, b, h) do { _Pragma("unroll") for (int m = 0; m < 4; ++m) _Pragma("unroll") for (int k = 0; k < 2; ++k) dst[m][k] = *(const PG8_LAS bf16x8*)(lds + PG8_SA(b, h) + aoff + m * 2048 + k * 1024); } while (0)
#define PG8_LDB(dst, b, h) do { _Pragma("unroll") for (int n = 0; n < 2; ++n) _Pragma("unroll") for (int k = 0; k < 2; ++k) dst[n][k] = *(const PG8_LAS bf16x8*)(lds + PG8_SB(b, h) + boff + n * 2048 + k * 1024); } while (0)
#define PG8_MMA(ai, bj, At, Bt) do { __builtin_amdgcn_s_setprio(1); _Pragma("unroll") for (int m = 0; m < 4; ++m) _Pragma("unroll") for (int n = 0; n < 2; ++n) _Pragma("unroll") for (int k = 0; k < 2; ++k) \
        acc[ai][bj][m][n] = __builtin_amdgcn_mfma_f32_16x16x32_bf16(Bt[n][k], At[m][k], acc[ai][bj][m][n], 0, 0, 0); __builtin_amdgcn_s_setprio(0); } while (0)
#define PG8_WAIT_V(n) asm volatile("s_waitcnt vmcnt(" #n ")" ::: "memory")
#define PG8_WAIT_L(n) asm volatile("s_waitcnt lgkmcnt(" #n ")" ::: "memory")
#define PG8_BAR __builtin_amdgcn_s_barrier()
#define PG8_SCHED __builtin_amdgcn_sched_barrier(0)
#define PG8_APTR(u) ((const char*)g.A + (size_t)(u).pm * tstepA + (((u).pn >= g.asplit_pn) ? (size_t)g.asplit_off * 2 : (size_t)0))
    Unit cur, nxt; int ui = 0;
    if (!S.next(0, cur)) return;
    f32x4 acc[2][2][4][2];
#pragma unroll
    for (int a = 0; a < 2; ++a)
#pragma unroll
        for (int b = 0; b < 2; ++b)
#pragma unroll
            for (int m = 0; m < 4; ++m)
#pragma unroll
                for (int n = 0; n < 2; ++n) acc[a][b][m][n] = (f32x4){0.f, 0.f, 0.f, 0.f};
    bf16x8 At[4][2], B0[2][2], B1[2][2];
    const char* cA = PG8_APTR(cur); const char* cB = (const char*)g.Bt + (size_t)cur.pn * tstepB;
    S.a_ready(cur);
    PG8_STAGE(PG8_SB(0, 0), cB, voffB); PG8_STAGE(PG8_SA(0, 0), cA, voffA); PG8_STAGE(PG8_SB(0, 1), cB + hstepB, voffB); PG8_STAGE(PG8_SA(0, 1), cA + hstepA, voffA);
    if (wr == 1) PG8_BAR;
    PG8_WAIT_V(4); PG8_BAR;
    PG8_STAGE(PG8_SB(1, 0), cB + kstep, voffB); PG8_STAGE(PG8_SA(1, 0), cA + kstep, voffA); PG8_STAGE(PG8_SB(1, 1), cB + hstepB + kstep, voffB);
    PG8_WAIT_V(6); PG8_BAR;
    for (;;) {
        const bool has_next = S.next(ui + 1, nxt);
        const char* nA = has_next ? PG8_APTR(nxt) : cA; const char* nB = has_next ? (const char*)g.Bt + (size_t)nxt.pn * tstepB : cB;
        for (int t = 0; t < nt; t += 2) {
            const bool last = (t == nt - 2);
            const char* a1 = cA + (size_t)(t + 1) * kstep;
            const char* a2 = last ? nA : cA + (size_t)(t + 2) * kstep; const char* b2 = last ? nB : cB + (size_t)(t + 2) * kstep;
            const char* a3 = a2 + kstep; const char* b3 = b2 + kstep;
            if (last && has_next) S.a_ready(nxt);
            PG8_LDB(B0, 0, 0); PG8_SCHED; PG8_LDA(At, 0, 0); PG8_STAGE(PG8_SA(1, 1), a1 + hstepA, voffA);
            PG8_WAIT_L(8); PG8_BAR; PG8_WAIT_L(0); PG8_MMA(0, 0, At, B0); PG8_BAR; PG8_SCHED;
            PG8_LDB(B1, 0, 1); PG8_STAGE(PG8_SB(0, 0), b2, voffB);
            PG8_BAR; PG8_WAIT_L(0); PG8_MMA(0, 1, At, B1); PG8_BAR;
            PG8_LDA(At, 0, 1); PG8_STAGE(PG8_SA(0, 0), a2, voffA);
            PG8_BAR; PG8_WAIT_L(0); PG8_MMA(1, 0, At, B0); PG8_BAR; PG8_SCHED;
            PG8_STAGE(PG8_SB(0, 1), b2 + hstepB, voffB);
            PG8_WAIT_V(6); PG8_BAR; PG8_MMA(1, 1, At, B1); PG8_BAR;
            PG8_LDB(B0, 1, 0); PG8_SCHED; PG8_LDA(At, 1, 0); PG8_STAGE(PG8_SA(0, 1), a2 + hstepA, voffA);
            PG8_WAIT_L(8); PG8_BAR; PG8_WAIT_L(0); PG8_MMA(0, 0, At, B0); PG8_BAR; PG8_SCHED;
            PG8_LDB(B1, 1, 1); PG8_STAGE(PG8_SB(1, 0), b3, voffB);
            PG8_BAR; PG8_WAIT_L(0); PG8_MMA(0, 1, At, B1); PG8_BAR;
            PG8_LDA(At, 1, 1); PG8_STAGE(PG8_SA(1, 0), a3, voffA);
            PG8_BAR; PG8_WAIT_L(0); PG8_MMA(1, 0, At, B0); PG8_BAR; PG8_SCHED;
            PG8_STAGE(PG8_SB(1, 1), b3 + hstepB, voffB);
            PG8_WAIT_V(6); PG8_BAR; PG8_MMA(1, 1, At, B1); PG8_BAR;
        }
        E(acc, cur, wr, wc, fr, fq); S.done(cur);
        if (!has_next) break;
#pragma unroll
        for (int a = 0; a < 2; ++a)
#pragma unroll
            for (int b = 0; b < 2; ++b)
#pragma unroll
                for (int m = 0; m < 4; ++m)
#pragma unroll
                    for (int n = 0; n < 2; ++n) acc[a][b][m][n] = (f32x4){0.f, 0.f, 0.f, 0.f};
        cur = nxt; cA = nA; cB = nB; ++ui;
    }
    PG8_WAIT_V(0);
    if (wr == 0) PG8_BAR;
    PG8_BAR;
#undef PG8_APTR
#undef PG8_SA
#undef PG8_SB
#undef PG8_STAGE
#undef PG8_LDA
#undef PG8_LDB
#undef PG8_MMA
#undef PG8_WAIT_V
#undef PG8_WAIT_L
#undef PG8_BAR
#undef PG8_SCHED
}
}

using pg8::bf16_t; using pg8::f32x4; using pg8::u32x4; using pg8::u32x2; using pg8::bf16x8;
using pg8::cvt_pk_bf16; using pg8::bf_lo; using pg8::bf_hi;

struct Params {
    const float* x_prompt; const float* x_sample; const float* state_conv; const float* norm_mix; const float* w_in; const float* ln_g; const float* ln_b;
    const float* w_s; const float* b_s; const float* conv_w; const float* w_pa; const float* w_pb; const float* w_o; const float* norm_ffn;
    const float* w_gate; const float* w_up; const float* w_down; const float* norm_final;
    float* out; unsigned char* ws; int ph_lo, ph_hi;
};
constexpr int LDS_BYTES = pg8::STAGE_BYTES + 256;
constexpr int NPHASE = 2 + 7 * NL;

__device__ __forceinline__ void transpose_tile(const float* __restrict__ src, int ld, int k0, int col0, const float* __restrict__ scale, bf16_t* __restrict__ dst, int K, float* t, int tid) {
    const int r = tid >> 4, c4 = tid & 15;
#pragma unroll
    for (int pass = 0; pass < 2; ++pass) { const int k = r + 32 * pass; const f32x4 v = *(const f32x4*)(src + (size_t)(k0 + k) * ld + col0 + 4 * c4); const float s = scale ? scale[k0 + k] : 1.0f;
        t[k * 65 + 4 * c4 + 0] = v[0] * s; t[k * 65 + 4 * c4 + 1] = v[1] * s; t[k * 65 + 4 * c4 + 2] = v[2] * s; t[k * 65 + 4 * c4 + 3] = v[3] * s; }
    __syncthreads();
    const int n = tid >> 3, kc = tid & 7; u32x4 w;
    w.x = cvt_pk_bf16(t[(8 * kc + 0) * 65 + n], t[(8 * kc + 1) * 65 + n]); w.y = cvt_pk_bf16(t[(8 * kc + 2) * 65 + n], t[(8 * kc + 3) * 65 + n]);
    w.z = cvt_pk_bf16(t[(8 * kc + 4) * 65 + n], t[(8 * kc + 5) * 65 + n]); w.w = cvt_pk_bf16(t[(8 * kc + 6) * 65 + n], t[(8 * kc + 7) * 65 + n]);
    *(u32x4*)(dst + (size_t)n * K + k0 + 8 * kc) = w;
    __syncthreads();
}
constexpr int IT_WIN = (NIN / 64) * 16, IT_WPAB = 32 * 16, IT_WO = 16 * 16, IT_WGU = (2 * DFF / 64) * 16, IT_WD = 16 * (DFF / 64), IT_LAYER = IT_WIN + IT_WPAB + IT_WO + IT_WGU + IT_WD;

__device__ __forceinline__ void p0_prologue(const Params& p, float* ldsf) {
    unsigned char* ws = p.ws;
    float* ssqm = (float*)(ws + WS_SSQM);
    int tid = threadIdx.x; asm volatile("" : "+v"(tid));
    const int G = gridDim.x, b = blockIdx.x;
    for (int it = b; it < NL * IT_LAYER; it += G) {
        const int l = it / IT_LAYER; int r = it % IT_LAYER; unsigned char* lw = ws + WS_W + (size_t)l * LW_BYTES;
        if (r < IT_WIN) { const int ntile = r >> 4, kt = r & 15, n0 = ntile * 64; int col;
            if (n0 < 3072) col = n0; else if (n0 < 5120) { const int t = n0 - 3072; col = ((t & 128) ? 4096 : 3072) + (t >> 8) * 128 + (t & 127); } else { const int t = n0 - 5120; col = ((t & 128) ? 6144 : 5120) + (t >> 8) * 128 + (t & 127); }
            transpose_tile(p.w_in + (size_t)l * DM * NIN, NIN, kt * 64, col, p.norm_mix + l * DM, (bf16_t*)(lw + LW_WIN) + (size_t)n0 * DM, DM, ldsf, tid); continue; }
        r -= IT_WIN;
        if (r < IT_WPAB) { const int ntile = r >> 4, kt = r & 15, n0 = ntile * 64;
            const float* src = (n0 < 1024) ? p.w_pa + (size_t)l * DM * DM : p.w_pb + (size_t)l * DM * DM;
            transpose_tile(src, DM, kt * 64, n0 & 1023, nullptr, (bf16_t*)(lw + LW_WPAB) + (size_t)n0 * DM, DM, ldsf, tid); continue; }
        r -= IT_WPAB;
        if (r < IT_WO) { const int ntile = r >> 4, kt = r & 15, n0 = ntile * 64;
            transpose_tile(p.w_o + (size_t)l * DM * DM, DM, kt * 64, n0, nullptr, (bf16_t*)(lw + LW_WO) + (size_t)n0 * DM, DM, ldsf, tid); continue; }
        r -= IT_WO;
        if (r < IT_WGU) { const int ntile = r >> 4, kt = r & 15, n0 = ntile * 64;
            const float* src = ((n0 & 128) ? p.w_up : p.w_gate) + (size_t)l * DM * DFF; const int col = (n0 >> 8) * 128 + (n0 & 127);
            transpose_tile(src, DFF, kt * 64, col, p.norm_ffn + l * DM, (bf16_t*)(lw + LW_WGU) + (size_t)n0 * DM, DM, ldsf, tid); continue; }
        r -= IT_WGU;
        { const int ntile = r / (DFF / 64), kt = r % (DFF / 64), n0 = ntile * 64;
            transpose_tile(p.w_down + (size_t)l * DFF * DM, DM, kt * 64, n0, nullptr, (bf16_t*)(lw + LW_WD) + (size_t)n0 * DFF, DFF, ldsf, tid); }
    }
    for (int i = b * 512 + tid; i < NL * 8 * 128 * 128; i += G * 512) {
        const int l = i >> 17, rem = i & 131071, ii = (rem >> 7) & 127, jj = rem & 127;
        const float* wsrc = p.w_s + (size_t)(i - rem);
        const int grp = rem >> 14;
        unsigned char* lw = ws + WS_W + (size_t)l * LW_BYTES;
        const float vp = (jj <= ii) ? p.w_s[i] : 0.f;
        const float vs = ((ii >> 5) == (jj >> 5) && (jj & 31) <= (ii & 31)) ? wsrc[grp * 16384 + (ii & 31) * 128 + (jj & 31)] : 0.f;
        ((bf16_t*)(lw + LW_WSP))[rem] = (bf16_t)(cvt_pk_bf16(vp, 0.f) & 0xffffu);
        ((bf16_t*)(lw + LW_WSS))[rem] = (bf16_t)(cvt_pk_bf16(vs, 0.f) & 0xffffu);
    }
    { const int wave = tid >> 6, lane = tid & 63; bf16_t* xb = (bf16_t*)(ws + WS_XB);
      for (int row = b * 8 + wave; row < MT; row += G * 8) {
          const float* xr = (row < MP) ? p.x_prompt + (size_t)row * DM : p.x_sample + (size_t)(row - MP) * DM; float q = 0.f;
#pragma unroll
          for (int j = 0; j < 4; ++j) { const f32x4 v = *(const f32x4*)(xr + 4 * (lane + 64 * j)); q += (v[0] * v[0] + v[1] * v[1]) + (v[2] * v[2] + v[3] * v[3]);
              u32x2 w; w.x = cvt_pk_bf16(v[0], v[1]); w.y = cvt_pk_bf16(v[2], v[3]); *(u32x2*)(xb + (size_t)row * DM + 4 * (lane + 64 * j)) = w; }
#pragma unroll
          for (int o = 32; o >= 1; o >>= 1) q += __shfl_xor(q, o);
          if (lane < 4) ((f32x4*)(ssqm + (size_t)row * 16))[lane] = (f32x4){lane == 0 ? q : 0.f, 0.f, 0.f, 0.f};
      } }
}

constexpr int VT_PITCH = 136;
__device__ __forceinline__ void gate_conv_phase(const Params& p, int l, unsigned char* lds) {
    unsigned char* ws = p.ws;
    const float* lns = (const float*)(ws + WS_LNS);
    bf16_t* AB = (bf16_t*)(ws + WS_AB); const bf16_t* GV = (const bf16_t*)(ws + WS_GV); const bf16_t* CH = (const bf16_t*)(ws + WS_CH);
    const unsigned char* lw = ws + WS_W + (size_t)l * LW_BYTES;
    bf16_t* vT = (bf16_t*)lds;
    float* mr = (float*)(lds + 128 * VT_PITCH * 2);
    int tid = threadIdx.x; asm volatile("" : "+v"(tid));
    const int lane = tid & 63, w = tid >> 6, fr = lane & 15, fq = lane >> 4;
    const int jg = tid >> 5, cq = tid & 31;
    const int ci = tid & 15;
    const int nks = (w >> 1) + 1;
    for (int item = blockIdx.x; item < (MT / 128) * 8; item += gridDim.x) {
        const int ct = item >> 3, g = item & 7, row0 = ct * 128, c0 = g * 128; const bool smp = ct >= MP / 128;
        const f32x4 lg = *(const f32x4*)(p.ln_g + l * DM + c0 + 4 * cq), lb = *(const f32x4*)(p.ln_b + l * DM + c0 + 4 * cq);
        const bf16_t* Wsrc = (const bf16_t*)(lw + (smp ? LW_WSS : LW_WSP)) + g * 16384 + (16 * w + fr) * 128 + 8 * fq;
        bf16x8 wf[4];
#pragma unroll
        for (int ks = 0; ks < 4; ++ks) wf[ks] = *(const bf16x8*)(Wsrc + 32 * ks);
        const int irow = 16 * w + fr; const float bs = p.b_s[(l * 8 + g) * 128 + (smp ? (irow & 31) : irow)];
        const float* cwp = p.conv_w + (size_t)l * 3 * DM + c0 + 8 * ci;
        const f32x4 w0a = *(const f32x4*)(cwp), w0b = *(const f32x4*)(cwp + 4), w1a = *(const f32x4*)(cwp + DM), w1b = *(const f32x4*)(cwp + DM + 4), w2a = *(const f32x4*)(cwp + 2 * DM), w2b = *(const f32x4*)(cwp + 2 * DM + 4);
        const f32x4* sl = (const f32x4*)(lns + (size_t)(row0 + (tid >> 2)) * 32 + (tid & 3) * 8);
        const f32x4 sl0 = sl[0], sl1 = sl[1];
        u32x2 gv[8];
#pragma unroll
        for (int jj = 0; jj < 8; ++jj) gv[jj] = *(const u32x2*)(GV + (size_t)(row0 + 8 * jg + jj) * DM + c0 + 4 * cq);
        bf16_t* rowp = AB + (size_t)(row0 + irow) * 2048 + c0 + 8 * fq;
        u32x4 uu[4];
#pragma unroll
        for (int pp = 0; pp < 4; ++pp) uu[pp] = *(const u32x4*)(rowp + 32 * pp);
        { float sm = (sl0[0] + sl0[2]) + (sl1[0] + sl1[2]), sq = (sl0[1] + sl0[3]) + (sl1[1] + sl1[3]);
          sm += __shfl_xor(sm, 1); sq += __shfl_xor(sq, 1); sm += __shfl_xor(sm, 2); sq += __shfl_xor(sq, 2);
          if ((tid & 3) == 0) { const float mean = sm * (1.0f / 1024.0f), var = sq * (1.0f / 1024.0f) - mean * mean; mr[2 * (tid >> 2)] = mean; mr[2 * (tid >> 2) + 1] = __builtin_amdgcn_rsqf(fmaxf(var, 0.f) + EPS); } }
        __syncthreads();
        { float v[8][4];
#pragma unroll
          for (int jj = 0; jj < 8; ++jj) { const float mean = mr[2 * (8 * jg + jj)], rstd = mr[2 * (8 * jg + jj) + 1];
              v[jj][0] = (bf_lo(gv[jj].x) - mean) * rstd * lg[0] + lb[0]; v[jj][1] = (bf_hi(gv[jj].x) - mean) * rstd * lg[1] + lb[1];
              v[jj][2] = (bf_lo(gv[jj].y) - mean) * rstd * lg[2] + lb[2]; v[jj][3] = (bf_hi(gv[jj].y) - mean) * rstd * lg[3] + lb[3];
              if (smp) *(f32x4*)(p.out + OUT_V + ((size_t)l * MS + (row0 + 8 * jg + jj - MP)) * DM + c0 + 4 * cq) = (f32x4){v[jj][0], v[jj][1], v[jj][2], v[jj][3]}; }
#pragma unroll
          for (int e = 0; e < 4; ++e) { u32x4 wv; wv.x = cvt_pk_bf16(v[0][e], v[1][e]); wv.y = cvt_pk_bf16(v[2][e], v[3][e]); wv.z = cvt_pk_bf16(v[4][e], v[5][e]); wv.w = cvt_pk_bf16(v[6][e], v[7][e]);
              *(u32x4*)(vT + (4 * cq + e) * VT_PITCH + 8 * jg) = wv; } }
        u32x4 ch0[4], ch1[4], ch2[4], bg[4];
#pragma unroll
        for (int vv = 0; vv < 4; ++vv) { const int i = (tid >> 4) + 32 * vv, row = row0 + i, c = c0 + 8 * ci; const int pos = smp ? ((row - MP) & 31) : (row & 2047);
            const u32x4 z4 = {0u, 0u, 0u, 0u};
            ch0[vv] = *(const u32x4*)(CH + (size_t)row * DM + c);
            ch1[vv] = (pos >= 1) ? *(const u32x4*)(CH + (size_t)(row - 1) * DM + c) : z4;
            ch2[vv] = (pos >= 2) ? *(const u32x4*)(CH + (size_t)(row - 2) * DM + c) : z4;
            bg[vv] = *(const u32x4*)(AB + (size_t)row * 2048 + 1024 + c); }
        __syncthreads();
        { f32x4 acc[8];
#pragma unroll
          for (int dt = 0; dt < 8; ++dt) acc[dt] = (f32x4){0.f, 0.f, 0.f, 0.f};
#pragma unroll
          for (int ks = 0; ks < 4; ++ks) if (ks < nks) {
#pragma unroll
              for (int dt = 0; dt < 8; ++dt) { const int d = 32 * (dt >> 1) + 8 * (fr >> 2) + 4 * (dt & 1) + (fr & 3);
                  const bf16x8 vf = *(const bf16x8*)(vT + d * VT_PITCH + 32 * ks + 8 * fq);
                  acc[dt] = __builtin_amdgcn_mfma_f32_16x16x32_bf16(vf, wf[ks], acc[dt], 0, 0, 0); } }
#pragma unroll
          for (int pp = 0; pp < 4; ++pp) { const f32x4 s0 = acc[2 * pp] + bs, s1 = acc[2 * pp + 1] + bs;
              const f32x4 u0 = {bf_lo(uu[pp][0]), bf_hi(uu[pp][0]), bf_lo(uu[pp][1]), bf_hi(uu[pp][1])}, u1 = {bf_lo(uu[pp][2]), bf_hi(uu[pp][2]), bf_lo(uu[pp][3]), bf_hi(uu[pp][3])};
              *(u32x4*)(rowp + 32 * pp) = pg8::pack8(u0 * s0, u1 * s1); } }
#pragma unroll
        for (int vv = 0; vv < 4; ++vv) { const int i = (tid >> 4) + 32 * vv, row = row0 + i, c = c0 + 8 * ci; const int pos = smp ? ((row - MP) & 31) : (row & 2047);
            float f0[8], f1[8], f2[8], o[8];
#pragma unroll
            for (int e = 0; e < 4; ++e) { f0[2 * e] = bf_lo(ch0[vv][e]); f0[2 * e + 1] = bf_hi(ch0[vv][e]); f1[2 * e] = bf_lo(ch1[vv][e]); f1[2 * e + 1] = bf_hi(ch1[vv][e]); f2[2 * e] = bf_lo(ch2[vv][e]); f2[2 * e + 1] = bf_hi(ch2[vv][e]); }
            if (smp && pos < 2) { const int sq = (row - MP) >> 5; const float* stp = p.state_conv + ((size_t)(l * 32 + sq) * 2) * DM + c;
                if (pos == 0) { const f32x4 a = *(const f32x4*)(stp + DM), bq = *(const f32x4*)(stp + DM + 4); f1[0] = a[0]; f1[1] = a[1]; f1[2] = a[2]; f1[3] = a[3]; f1[4] = bq[0]; f1[5] = bq[1]; f1[6] = bq[2]; f1[7] = bq[3]; }
                { const float* s2 = stp + (pos == 0 ? 0 : DM); const f32x4 a = *(const f32x4*)(s2), bq = *(const f32x4*)(s2 + 4); f2[0] = a[0]; f2[1] = a[1]; f2[2] = a[2]; f2[3] = a[3]; f2[4] = bq[0]; f2[5] = bq[1]; f2[6] = bq[2]; f2[7] = bq[3]; } }
#pragma unroll
            for (int e = 0; e < 4; ++e) { o[e] = w0a[e] * f2[e] + w1a[e] * f1[e] + w2a[e] * f0[e]; o[4 + e] = w0b[e] * f2[4 + e] + w1b[e] * f1[4 + e] + w2b[e] * f0[4 + e]; }
            u32x4 ov;
#pragma unroll
            for (int e = 0; e < 4; ++e) ov[e] = cvt_pk_bf16(o[2 * e] * bf_lo(bg[vv][e]), o[2 * e + 1] * bf_hi(bg[vv][e]));
            *(u32x4*)(AB + (size_t)row * 2048 + 1024 + c) = ov;
            const int lastpos = smp ? 31 : 2047;
            if (pos >= lastpos - 1) { float* op = smp ? p.out + OUT_NCS + (((size_t)l * 32 + ((row - MP) >> 5)) * 2 + (pos - (lastpos - 1))) * DM + c
                                                      : p.out + OUT_NCP + (((size_t)l * 32 + (row >> 11)) * 2 + (pos - (lastpos - 1))) * DM + c;
                *(f32x4*)op = (f32x4){f0[0], f0[1], f0[2], f0[3]}; *(f32x4*)(op + 4) = (f32x4){f0[4], f0[5], f0[6], f0[7]}; } }
        __syncthreads();
    }
}

__device__ __forceinline__ void final_norm_phase(const Params& p) {
    const float* ssq = (const float*)(p.ws + WS_SSQM); const bf16_t* xb = (const bf16_t*)(p.ws + WS_XB);
    const size_t n8 = (size_t)MT * DM / 8;
    for (size_t i = (size_t)blockIdx.x * 512 + threadIdx.x; i < n8; i += (size_t)gridDim.x * 512) {
        const int row = (int)(i >> 7), c = (int)(i & 127) * 8; const float rs = pg8::rstd_of(ssq, row);
        const u32x4 w = *(const u32x4*)(xb + i * 8); const f32x4 g0 = *(const f32x4*)(p.norm_final + c), g1 = *(const f32x4*)(p.norm_final + c + 4);
        ((f32x4*)p.out)[2 * i] = pg8::unpk_lo(w) * rs * g0; ((f32x4*)p.out)[2 * i + 1] = pg8::unpk_hi(w) * rs * g1; }
}

#define LAS __attribute__((address_space(3)))
#define XB_TMO      128
#define XB_XCNT(j)  (256  + 64 * (j))
#define XB_XSUB(j)  (1280 + 64 * (j))
#define XB_XGEN(j)  (2304 + 64 * (j))
#define XB_TOP      3328
#define XB_TOPGEN   3392
#define XCD_BAR_WORDS 3456
#define XB_SPIN_CAP (1u << 18)

__device__ __forceinline__ unsigned xb_ld(unsigned* p)              { return __hip_atomic_load(p, __ATOMIC_RELAXED, __HIP_MEMORY_SCOPE_AGENT); }
__device__ __forceinline__ unsigned xb_add(unsigned* p, unsigned v) { return __hip_atomic_fetch_add(p, v, __ATOMIC_RELAXED, __HIP_MEMORY_SCOPE_AGENT); }
__device__ __forceinline__ unsigned xb_xcc_id() { return (unsigned)__builtin_amdgcn_s_getreg((3 << 11) | 20) & 0xFu; }
#define XB_SPIN(cond, bar) do { unsigned _sp = 0; while (cond) { __builtin_amdgcn_s_sleep(1); \
    if ((++_sp & 255u) == 0u) { if (xb_ld(&(bar)[XB_TMO])) break; if (_sp > XB_SPIN_CAP) { atomicAdd(&(bar)[XB_TMO], 1u); break; } } } } while (0)

struct XcdBarrier {
    unsigned* bar; unsigned x;
    volatile LAS unsigned* st;
};

__device__ __forceinline__ XcdBarrier xcd_barrier_post(unsigned* bar, volatile LAS unsigned* st) {
    XcdBarrier b; b.bar = bar; b.x = xb_xcc_id(); b.st = st;
    if (threadIdx.x == 0) (void)xb_add(&bar[XB_XCNT(b.x)], 1u);
    return b;
}
__device__ __forceinline__ void xcd_barrier_complete(unsigned* bar, unsigned x, unsigned& nloc, unsigned& nx) {
    const unsigned G = gridDim.x * gridDim.y * gridDim.z;
    unsigned sum, cnt, mine, sp = 0u;
    for (;;) {
        sum = 0u; cnt = 0u; mine = 0u;
#pragma unroll
        for (unsigned j = 0; j < 16; ++j) { const unsigned c = xb_ld(&bar[XB_XCNT(j)]); sum += c; cnt += (c > 0u) ? 1u : 0u; mine = (j == x) ? c : mine; }
        if (sum == G) break;
        __builtin_amdgcn_s_sleep(1);
        if ((++sp & 255u) == 0u) { if (xb_ld(&bar[XB_TMO])) break; if (sp > XB_SPIN_CAP) { atomicAdd(&bar[XB_TMO], 1u); break; } }
    }
    nloc = mine > 0u ? mine : 1u; nx = cnt > 0u ? cnt : 1u;
}

__device__ __forceinline__ void xcd_barrier(const XcdBarrier& b) {
    asm volatile("s_waitcnt vmcnt(0)" ::: "memory");
    __syncthreads();
    if (threadIdx.x == 0) {
        unsigned* bar = b.bar;
        __builtin_amdgcn_s_waitcnt(0);
        unsigned nloc = b.st[0], nx = b.st[1];
        if (nloc == 0u) { xcd_barrier_complete(bar, b.x, nloc, nx); b.st[0] = nloc; b.st[1] = nx; }
        const unsigned old = xb_add(&bar[XB_XSUB(b.x)], 1u);
        const unsigned gen = old / nloc;
        if (old + 1u == (gen + 1u) * nloc) {
            __builtin_amdgcn_fence(__ATOMIC_RELEASE, "agent");
            asm volatile("s_waitcnt vmcnt(0)" ::: "memory");
            const unsigned og = xb_add(&bar[XB_TOP], 1u);
            const unsigned tg = og / nx;
            if (og + 1u == (tg + 1u) * nx) xb_add(&bar[XB_TOPGEN], 1u);
            else XB_SPIN(xb_ld(&bar[XB_TOPGEN]) == tg, bar);
            __builtin_amdgcn_fence(__ATOMIC_ACQUIRE, "agent");
            xb_add(&bar[XB_XGEN(b.x)], 1u);
            asm volatile("s_waitcnt vmcnt(0)" ::: "memory");
        } else {
            XB_SPIN(xb_ld(&bar[XB_XGEN(b.x)]) == gen, bar);
            __builtin_amdgcn_fence(__ATOMIC_ACQUIRE, "agent");
            asm volatile("s_waitcnt vmcnt(0)" ::: "memory");
        }
    }
    __syncthreads();
}

__global__ void __launch_bounds__(512, 2) mk_fwd(Params p) {
    extern __shared__ __attribute__((aligned(16))) unsigned char lds[];
    unsigned char* ws = p.ws;
    float* ssq_mix = (float*)(ws + WS_SSQM); float* ssq_ffn = (float*)(ws + WS_SSQF); float* lns = (float*)(ws + WS_LNS);
    bf16_t* XB = (bf16_t*)(ws + WS_XB); bf16_t* AB = (bf16_t*)(ws + WS_AB); bf16_t* GV = (bf16_t*)(ws + WS_GV); bf16_t* CH = (bf16_t*)(ws + WS_CH);
    bf16_t* T12 = GV; bf16_t* MMb = AB; bf16_t* Hb = AB;
    const int G = gridDim.x, c = blockIdx.x;
    PG8_LAS unsigned char* ring = (PG8_LAS unsigned char*)lds;
#if MK_MULTI
#define GRID_SYNC() do { } while (0)
#else
    cg::grid_group grid = cg::this_grid();
    volatile LAS unsigned* bst = (volatile LAS unsigned*)((LAS unsigned char*)lds + pg8::STAGE_BYTES);
    if (threadIdx.x < 2) bst[threadIdx.x] = 0u;
    __syncthreads();
    XcdBarrier xbar = xcd_barrier_post((unsigned*)(ws + WS_CTL), bst);
#define GRID_SYNC() do { if (ph == 0) grid.sync(); else xcd_barrier(xbar); } while (0)
#endif
    for (int ph = p.ph_lo; ph < p.ph_hi; ++ph) {
        if (ph == 0) { if (PHASE_MASK & 1) { if (PROBE_DUP & 512) p0_prologue(p, (float*)lds); p0_prologue(p, (float*)lds); } }
        else if (ph == NPHASE - 1) { if (PHASE_MASK & 2) final_norm_phase(p); }
        else {
            const int l = (ph - 1) / 7, s = (ph - 1) % 7;
            for (int rep_ = 0; rep_ < (((PROBE_DUP >> s) & 1) ? 2 : 1); ++rep_) {
            const unsigned char* lw = ws + WS_W + (size_t)l * LW_BYTES;
            if (s == 0) { if (PHASE_MASK & 4) {
                pg8::Gemm g{XB, (const bf16_t*)(lw + LW_WIN), MT, 5120, DM, DM, 1 << 30, 0}; pg8::StaticOrder S; S.init(MT, 5120, G, c);
                pg8::EpiA E{AB, GV, CH, ssq_mix, lns};
                pg8::gemm_phase<pg8::EpiA, pg8::StaticOrder>(ring, g, S, E); }
            } else if (s == 1) {
                if (PHASE_MASK & 8) gate_conv_phase(p, l, lds);
            } else if (s == 2) { if (PHASE_MASK & 16) {
                pg8::Gemm g{AB, (const bf16_t*)(lw + LW_WPAB), MT, 2048, DM, 2048, 4, 1024}; pg8::StaticOrder S; S.init(MT, 2048, G, c);
                pg8::EpiC E{T12};
                pg8::gemm_phase<pg8::EpiC, pg8::StaticOrder>(ring, g, S, E); }
            } else if (s == 3) { if (PHASE_MASK & 32) {
                pg8::Gemm g{XB, (const bf16_t*)(lw + LW_WIN) + (size_t)5120 * DM, MT, 2048, DM, DM, 1 << 30, 0}; pg8::StaticOrder S; S.init(MT, 2048, G, c);
                pg8::EpiD E{T12, MMb, ssq_mix};
                pg8::gemm_phase<pg8::EpiD, pg8::StaticOrder>(ring, g, S, E); }
            } else if (s == 4) { if (PHASE_MASK & 64) {
                pg8::Gemm g{MMb, (const bf16_t*)(lw + LW_WO), MT, DM, DM, DM, 1 << 30, 0}; pg8::StaticOrder S; S.init(MT, DM, G, c);
                pg8::EpiRes E{XB, ssq_ffn};
                pg8::gemm_phase<pg8::EpiRes, pg8::StaticOrder>(ring, g, S, E); }
            } else if (s == 5) { if (PHASE_MASK & 128) {
                pg8::Gemm g{XB, (const bf16_t*)(lw + LW_WGU), MT, 2 * DFF, DM, DM, 1 << 30, 0}; pg8::StaticOrder S; S.init(MT, 2 * DFF, G, c);
                pg8::EpiF E{Hb, ssq_ffn};
                pg8::gemm_phase<pg8::EpiF, pg8::StaticOrder>(ring, g, S, E); }
            } else { if (PHASE_MASK & 256) {
                pg8::Gemm g{Hb, (const bf16_t*)(lw + LW_WD), MT, DM, DFF, DFF, 1 << 30, 0}; pg8::StaticOrder S; S.init(MT, DM, G, c);
                pg8::EpiRes E{XB, ssq_mix};
                pg8::gemm_phase<pg8::EpiRes, pg8::StaticOrder>(ring, g, S, E); }
            }
            }
        }
        if (ph + 1 < p.ph_hi) { GRID_SYNC(); }
    }
}

extern "C" void kernel_launch(void* const* d_in, const int* in_sizes, int n_in, void* d_out, int out_size, void* d_ws, size_t ws_size, hipStream_t stream) {
    static int grid = 0;
    if (grid == 0) {
        if (n_in != 18 || in_sizes[0] != MP * DM || (size_t)out_size != OUT_TOTAL || ws_size < WS_END) {
            fprintf(stderr, "kernel_launch: unexpected shapes: n_in %d in0 %d out %d ws %zu (need %zu)\n", n_in, n_in > 0 ? in_sizes[0] : -1, out_size, ws_size, (size_t)WS_END); grid = -1; return; }
        int dev = 0, cus = 0, per_cu = 0;
        (void)hipGetDevice(&dev); (void)hipDeviceGetAttribute(&cus, hipDeviceAttributeMultiprocessorCount, dev);
        if (hipFuncSetAttribute((const void*)mk_fwd, hipFuncAttributeMaxDynamicSharedMemorySize, LDS_BYTES) != hipSuccess) { fprintf(stderr, "kernel_launch: hipFuncSetAttribute failed\n"); grid = -1; return; }
        if (hipOccupancyMaxActiveBlocksPerMultiprocessor(&per_cu, (const void*)mk_fwd, 512, LDS_BYTES) != hipSuccess || per_cu < 1) { fprintf(stderr, "kernel_launch: occupancy query says %d\n", per_cu); per_cu = 1; }
        (void)hipGetLastError();
        grid = cus * 1;
        fprintf(stderr, "kernel_launch: cus %d per_cu %d grid %d\n", cus, per_cu, grid);
    }
    if (grid < 0) return;
    if (hipMemsetAsync((char*)d_ws + WS_CTL, 0, CTL_BYTES, stream) != hipSuccess) { fprintf(stderr, "kernel_launch: memset failed\n"); return; }
    Params p{};
    const float** pp = (const float**)&p;
    for (int i = 0; i < 18; ++i) pp[i] = (const float*)d_in[i];
    p.out = (float*)d_out; p.ws = (unsigned char*)d_ws;
#if MK_MULTI
    for (int ph = 0; ph < NPHASE; ++ph) { p.ph_lo = ph; p.ph_hi = ph + 1; hipLaunchKernelGGL(mk_fwd, dim3(grid), dim3(512), LDS_BYTES, stream, p); }
#else
    p.ph_lo = 0; p.ph_hi = NPHASE;
    void* args[] = {&p};
    hipError_t e = hipLaunchCooperativeKernel((const void*)mk_fwd, dim3(grid), dim3(512), args, LDS_BYTES, stream);
    if (e != hipSuccess) fprintf(stderr, "kernel_launch: cooperative launch failed: %s (grid %d)\n", hipGetErrorString(e), grid);
#endif
}
```

```cpp
#include <hip/hip_runtime.h>
#include <hip/hip_cooperative_groups.h>
#include <cstdio>
#include <cstdint>
namespace cg = cooperative_groups;

#ifndef PHASE_MASK
#define PHASE_MASK 511
#endif
#ifndef PROBE_DUP
#define PROBE_DUP 0
#endif
#ifndef MK_MULTI
#define MK_MULTI 0
#endif

constexpr int MP = 65536, MS = 1024, MT = MP + MS, DM = 1024, NL = 4, DFF = 2816, NIN = 7168;
constexpr float EPS = 1e-6f;
constexpr size_t OUT_YS = (size_t)MP * DM, OUT_NCP = OUT_YS + (size_t)MS * DM, OUT_NCS = OUT_NCP + (size_t)NL * 32 * 2 * DM, OUT_V = OUT_NCS + (size_t)NL * 32 * 2 * DM;
constexpr size_t OUT_TOTAL = OUT_V + (size_t)NL * 32 * 32 * DM;

constexpr size_t MiB = (size_t)1 << 20;
constexpr size_t WS_SSQM = 0, WS_SSQF = 5 * MiB, WS_LNS = 10 * MiB;
constexpr size_t WS_CTL = 20 * MiB, CTL_BYTES = 16384;
constexpr size_t WS_W = 24 * MiB;
constexpr size_t LW_WIN = 0, LW_WPAB = LW_WIN + (size_t)NIN * DM * 2, LW_WO = LW_WPAB + (size_t)2048 * DM * 2, LW_WGU = LW_WO + (size_t)DM * DM * 2,
                 LW_WD = LW_WGU + (size_t)2 * DFF * DM * 2, LW_WSP = LW_WD + (size_t)DM * DFF * 2, LW_WSS = LW_WSP + (size_t)8 * 128 * 128 * 2, LW_BYTES = LW_WSS + (size_t)8 * 128 * 128 * 2;
constexpr size_t WS_XB = 176 * MiB;
constexpr size_t WS_AB = 306 * MiB;
constexpr size_t WS_GV = 566 * MiB;
constexpr size_t WS_CH = 696 * MiB;
constexpr size_t WS_END = 826 * MiB;
static_assert(WS_W + NL * LW_BYTES <= WS_XB, "weights overflow");

namespace pg8 {
#define PG8_LAS __attribute__((address_space(3)))
typedef unsigned short bf16_t;
typedef short bf16x8 __attribute__((ext_vector_type(8)));
typedef float f32x4 __attribute__((ext_vector_type(4)));
typedef float f32x2 __attribute__((ext_vector_type(2)));
typedef unsigned u32x4 __attribute__((ext_vector_type(4)));
typedef unsigned u32x2 __attribute__((ext_vector_type(2)));
constexpr int BM = 256, BK = 64, HALF = 128, HTB = HALF * BK * 2, STAGE_BYTES = 8 * HTB, NXCD = 8, WGM = 8;

__host__ __device__ __forceinline__ int lds_byte(int r, int c) { const int st = (r >> 4) * 2 + (c >> 5), rr = r & 15, cc = c & 31, ob = rr * 64 + cc * 2; return st * 1024 + (ob ^ (((ob >> 9) & 1) << 5)); }
__host__ __device__ __forceinline__ void stage_rc(int b, int& R, int& C) { const int st = b / 1024, sb = b % 1024, swz = sb ^ (((sb >> 9) & 1) << 5); R = (st >> 1) * 16 + swz / 64; C = (st & 1) * 32 + (swz % 64) / 2; }
__host__ __device__ __forceinline__ int perm32(int rho) { const int n = rho >> 4, i = rho & 15; return 8 * (i >> 2) + 4 * n + (i & 3); }

struct Unit { int pm, pn; };
struct Gemm { const bf16_t* A; const bf16_t* Bt; int M, N, K, lda, asplit_pn, asplit_off; };

struct StaticOrder {
    int nM, nN, nwg, G, c;
    __host__ __device__ void init(int M, int N, int G_, int c_) { nM = M / BM; nN = N / BM; nwg = nM * nN; G = G_; c = c_; }
    __host__ __device__ bool next(int i, Unit& u) const {
        const long L = (long)i * G + c; if (L >= nwg) return false;
        int wgid = (int)L; { const int q = nwg / NXCD, r = nwg % NXCD, xcd = wgid % NXCD, off = wgid / NXCD; wgid = (xcd < r ? xcd * (q + 1) : r * (q + 1) + (xcd - r) * q) + off; }
        const int nig = WGM * nN, gid = wgid / nig, fm = gid * WGM, gsz = (nM - fm) < WGM ? (nM - fm) : WGM;
        u.pm = fm + ((wgid % nig) % gsz); u.pn = (wgid % nig) / gsz; return true;
    }
    __device__ __forceinline__ void a_ready(const Unit&) const {}
    __device__ __forceinline__ void done(const Unit&) const {}
};

__device__ __forceinline__ unsigned cvt_pk_bf16(float lo, float hi) { unsigned r; asm volatile("v_cvt_pk_bf16_f32 %0, %1, %2" : "=v"(r) : "v"(lo), "v"(hi)); return r; }
__device__ __forceinline__ float bf_lo(unsigned w) { return __uint_as_float(w << 16); }
__device__ __forceinline__ float bf_hi(unsigned w) { return __uint_as_float(w & 0xffff0000u); }
__device__ __forceinline__ f32x2 gelu_pk(f32x2 v) {
    const f32x2 av = __builtin_elementwise_abs(v), d = av * 0.2316418882f + 1.0f;
    f32x2 t; t.x = __builtin_amdgcn_rcpf(d.x); t.y = __builtin_amdgcn_rcpf(d.y);
    f32x2 q = t * 0.5307027145f + (-0.7265760135f); q = q * t + 0.7107068705f; q = q * t + (-0.142248368f); q = q * t + 0.127414796f; q = q * t;
    const f32x2 s = (v * v) * (-0.72134752044f);
    f32x2 e; e.x = __builtin_amdgcn_exp2f(s.x); e.y = __builtin_amdgcn_exp2f(s.y);
    const f32x2 m = v * (q * e), r = v - m;
    f32x2 o; o.x = v.x < 0.f ? m.x : r.x; o.y = v.y < 0.f ? m.y : r.y; return o;
}
__device__ __forceinline__ f32x4 gelu4(f32x4 v) { const f32x2 a = gelu_pk((f32x2){v[0], v[1]}), b = gelu_pk((f32x2){v[2], v[3]}); return (f32x4){a.x, a.y, b.x, b.y}; }
__device__ __forceinline__ float sigmoidf_(float x) { return __builtin_amdgcn_rcpf(1.0f + __builtin_amdgcn_exp2f(x * -1.44269504f)); }
__device__ __forceinline__ f32x4 sigmoid4(f32x4 v) { return (f32x4){sigmoidf_(v[0]), sigmoidf_(v[1]), sigmoidf_(v[2]), sigmoidf_(v[3])}; }
__device__ __forceinline__ u32x4 pack8(f32x4 v0, f32x4 v1) { u32x4 w; w.x = cvt_pk_bf16(v0[0], v0[1]); w.y = cvt_pk_bf16(v0[2], v0[3]); w.z = cvt_pk_bf16(v1[0], v1[1]); w.w = cvt_pk_bf16(v1[2], v1[3]); return w; }
__device__ __forceinline__ float rstd_of(const float* slots, int row) { const f32x4* s = (const f32x4*)(slots + (size_t)row * 16); const f32x4 t = (s[0] + s[1]) + (s[2] + s[3]);
    return __builtin_amdgcn_rsqf(((t[0] + t[1]) + (t[2] + t[3])) * (1.0f / 1024.0f) + EPS); }

__device__ __forceinline__ void wave_rstd(const float* slots, int rowbase, int lane, int fr, float (&rs)[2][4]) {
    float val[2];
    const f32x4* sa = (const f32x4*)(slots + (size_t)(rowbase + lane) * 16); const f32x4* sb = (const f32x4*)(slots + (size_t)(rowbase + HALF + lane) * 16);
    const f32x4 a0 = sa[0], a1 = sa[1], a2 = sa[2], a3 = sa[3], b0 = sb[0], b1 = sb[1], b2 = sb[2], b3 = sb[3];
    __builtin_amdgcn_sched_barrier(0);
    { const f32x4 t = (a0 + a1) + (a2 + a3); val[0] = __builtin_amdgcn_rsqf(((t[0] + t[1]) + (t[2] + t[3])) * (1.0f / 1024.0f) + EPS); }
    { const f32x4 t = (b0 + b1) + (b2 + b3); val[1] = __builtin_amdgcn_rsqf(((t[0] + t[1]) + (t[2] + t[3])) * (1.0f / 1024.0f) + EPS); }
#pragma unroll
    for (int ai = 0; ai < 2; ++ai)
#pragma unroll
        for (int m = 0; m < 4; ++m) rs[ai][m] = __shfl(val[ai], m * 16 + fr);
}
__device__ __forceinline__ f32x4 unpk_lo(u32x4 w) { return (f32x4){bf_lo(w[0]), bf_hi(w[0]), bf_lo(w[1]), bf_hi(w[1])}; }
__device__ __forceinline__ f32x4 unpk_hi(u32x4 w) { return (f32x4){bf_lo(w[2]), bf_hi(w[2]), bf_lo(w[3]), bf_hi(w[3])}; }

struct EpiA {
    static constexpr bool PERM = true, AFTER_DRAIN = false;
    bf16_t* AB; bf16_t* GV; bf16_t* CH; const float* ssq; float* lns;
    __device__ __forceinline__ void operator()(const f32x4 (&acc)[2][2][4][2], const Unit& u, int wr, int wc, int fr, int fq) const {
        const int row0 = u.pm * BM + wr * 64 + fr, cw = wc * 32 + 8 * fq, pn = u.pn;
        float rsv[2][4]; wave_rstd(ssq, u.pm * BM + wr * 64, fr + 16 * fq, fr, rsv);
        if (pn < 4) {
#pragma unroll
            for (int ai = 0; ai < 2; ++ai)
#pragma unroll
                for (int m = 0; m < 4; ++m) { const int row = row0 + ai * HALF + m * 16; const float rs = rsv[ai][m]; bf16_t* rowp = AB + (size_t)row * 2048 + pn * 256 + cw;
#pragma unroll
                    for (int bj = 0; bj < 2; ++bj) *(u32x4*)(rowp + bj * HALF) = pack8(gelu4(acc[ai][bj][m][0] * rs), gelu4(acc[ai][bj][m][1] * rs)); }
        } else if (pn < 8) {
#pragma unroll
            for (int ai = 0; ai < 2; ++ai)
#pragma unroll
                for (int m = 0; m < 4; ++m) { const int row = row0 + ai * HALF + m * 16; const float rs = rsv[ai][m]; bf16_t* rowp = GV + (size_t)row * 1024 + (pn - 4) * 256 + cw;
                    float s = 0.f, q = 0.f;
#pragma unroll
                    for (int bj = 0; bj < 2; ++bj) { const u32x4 w = pack8(gelu4(acc[ai][bj][m][0] * rs), gelu4(acc[ai][bj][m][1] * rs)); *(u32x4*)(rowp + bj * HALF) = w;
#pragma unroll
                        for (int e = 0; e < 4; ++e) { const float a = bf_lo(w[e]), b = bf_hi(w[e]); s += a + b; q += a * a + b * b; } }
                    s += __shfl_xor(s, 16); s += __shfl_xor(s, 32); q += __shfl_xor(q, 16); q += __shfl_xor(q, 32);
                    if (fq == 0) *(f32x2*)(lns + ((size_t)row * 16 + (pn - 4) * 4 + wc) * 2) = (f32x2){s, q}; }
        } else if (pn < 12) {
#pragma unroll
            for (int ai = 0; ai < 2; ++ai)
#pragma unroll
                for (int m = 0; m < 4; ++m) { const int row = row0 + ai * HALF + m * 16; const float rs = rsv[ai][m]; bf16_t* rowp = AB + (size_t)row * 2048 + 1024 + (pn - 8) * 256 + cw;
#pragma unroll
                    for (int bj = 0; bj < 2; ++bj) *(u32x4*)(rowp + bj * HALF) = pack8(acc[ai][bj][m][0] * rs, acc[ai][bj][m][1] * rs); }
        } else {
#pragma unroll
            for (int ai = 0; ai < 2; ++ai)
#pragma unroll
                for (int m = 0; m < 4; ++m) { const int row = row0 + ai * HALF + m * 16; const float rs = rsv[ai][m]; const float rs2 = rs * rs;
                    *(u32x4*)(CH + (size_t)row * 1024 + (pn - 12) * 128 + cw) = pack8(acc[ai][0][m][0] * acc[ai][1][m][0] * rs2, acc[ai][0][m][1] * acc[ai][1][m][1] * rs2); }
        }
    }
};
struct EpiC {
    static constexpr bool PERM = true, AFTER_DRAIN = false;
    bf16_t* T;
    __device__ __forceinline__ void operator()(const f32x4 (&acc)[2][2][4][2], const Unit& u, int wr, int wc, int fr, int fq) const {
        const int row0 = u.pm * BM + wr * 64 + fr, cw = u.pn * 256 + wc * 32 + 8 * fq;
#pragma unroll
        for (int ai = 0; ai < 2; ++ai)
#pragma unroll
            for (int m = 0; m < 4; ++m) { bf16_t* rowp = T + (size_t)(row0 + ai * HALF + m * 16) * 2048 + cw;
#pragma unroll
                for (int bj = 0; bj < 2; ++bj) *(u32x4*)(rowp + bj * HALF) = pack8(acc[ai][bj][m][0], acc[ai][bj][m][1]); }
    }
};
struct EpiD {
    static constexpr bool PERM = true, AFTER_DRAIN = false;
    const bf16_t* T; bf16_t* MM; const float* ssq;
    __device__ __forceinline__ void operator()(const f32x4 (&acc)[2][2][4][2], const Unit& u, int wr, int wc, int fr, int fq) const {
        const int row0 = u.pm * BM + wr * 64 + fr, cw = u.pn * 128 + wc * 32 + 8 * fq;
        u32x4 tt[4][2];
#pragma unroll
        for (int m = 0; m < 4; ++m) { const bf16_t* tp = T + (size_t)(row0 + m * 16) * 2048 + cw; tt[m][0] = *(const u32x4*)tp; tt[m][1] = *(const u32x4*)(tp + 1024); }
        float rsv[2][4]; wave_rstd(ssq, u.pm * BM + wr * 64, fr + 16 * fq, fr, rsv);
#pragma unroll
        for (int ai = 0; ai < 2; ++ai) {
            if (ai == 1) {
#pragma unroll
                for (int m = 0; m < 4; ++m) { const bf16_t* tp = T + (size_t)(row0 + HALF + m * 16) * 2048 + cw; tt[m][0] = *(const u32x4*)tp; tt[m][1] = *(const u32x4*)(tp + 1024); } }
#pragma unroll
            for (int m = 0; m < 4; ++m) { const int row = row0 + ai * HALF + m * 16; const float rs = rsv[ai][m];
                const u32x4 t1 = tt[m][0], t2 = tt[m][1];
                const f32x4 a0 = sigmoid4(acc[ai][0][m][0] * rs), a1 = sigmoid4(acc[ai][0][m][1] * rs), b0 = sigmoid4(acc[ai][1][m][0] * rs), b1 = sigmoid4(acc[ai][1][m][1] * rs);
                const f32x4 p0 = {bf_lo(t1[0]), bf_hi(t1[0]), bf_lo(t1[1]), bf_hi(t1[1])}, p1 = {bf_lo(t1[2]), bf_hi(t1[2]), bf_lo(t1[3]), bf_hi(t1[3])};
                const f32x4 q0 = {bf_lo(t2[0]), bf_hi(t2[0]), bf_lo(t2[1]), bf_hi(t2[1])}, q1 = {bf_lo(t2[2]), bf_hi(t2[2]), bf_lo(t2[3]), bf_hi(t2[3])};
                *(u32x4*)(MM + (size_t)row * 1024 + cw) = pack8(a0 * p0 + b0 * q0, a1 * p1 + b1 * q1); }
            asm volatile("" ::: "memory");
        }
    }
};
struct EpiRes {
    static constexpr bool PERM = true, AFTER_DRAIN = false;
    bf16_t* xb; float* ssq;
    __device__ __forceinline__ void operator()(const f32x4 (&acc)[2][2][4][2], const Unit& u, int wr, int wc, int fr, int fq) const {
        const int row0 = u.pm * BM + wr * 64 + fr, cw = u.pn * BM + wc * 32 + 8 * fq;
#pragma unroll
        for (int ai = 0; ai < 2; ++ai) {
            u32x4 xo[4][2];
#pragma unroll
            for (int m = 0; m < 4; ++m)
#pragma unroll
                for (int bj = 0; bj < 2; ++bj) xo[m][bj] = *(const u32x4*)(xb + (size_t)(row0 + ai * HALF + m * 16) * DM + cw + bj * HALF);
#pragma unroll
            for (int m = 0; m < 4; ++m) { const int row = row0 + ai * HALF + m * 16; float q = 0.f;
#pragma unroll
                for (int bj = 0; bj < 2; ++bj) { const u32x4 w = pack8(acc[ai][bj][m][0] + unpk_lo(xo[m][bj]), acc[ai][bj][m][1] + unpk_hi(xo[m][bj]));
                    *(u32x4*)(xb + (size_t)row * DM + cw + bj * HALF) = w;
#pragma unroll
                    for (int e = 0; e < 4; ++e) { const float a = bf_lo(w[e]), b = bf_hi(w[e]); q += a * a + b * b; } }
                q += __shfl_xor(q, 16); q += __shfl_xor(q, 32);
                if (fq == 0) ssq[(size_t)row * 16 + u.pn * 4 + wc] = q; }
            asm volatile("" ::: "memory");
        }
    }
};
struct EpiF {
    static constexpr bool PERM = true, AFTER_DRAIN = false;
    bf16_t* H; const float* ssq;
    __device__ __forceinline__ void operator()(const f32x4 (&acc)[2][2][4][2], const Unit& u, int wr, int wc, int fr, int fq) const {
        const int row0 = u.pm * BM + wr * 64 + fr, cw = u.pn * 128 + wc * 32 + 8 * fq;
        float rsv[2][4]; wave_rstd(ssq, u.pm * BM + wr * 64, fr + 16 * fq, fr, rsv);
#pragma unroll
        for (int ai = 0; ai < 2; ++ai)
#pragma unroll
            for (int m = 0; m < 4; ++m) { const int row = row0 + ai * HALF + m * 16; const float rs = rsv[ai][m];
                const f32x4 g0 = acc[ai][0][m][0] * rs, g1 = acc[ai][0][m][1] * rs, u0 = acc[ai][1][m][0] * rs, u1 = acc[ai][1][m][1] * rs;
                *(u32x4*)(H + (size_t)row * DFF + cw) = pack8(g0 * sigmoid4(g0) * u0, g1 * sigmoid4(g1) * u1); }
    }
};

#ifndef PG8_SP2
#define PG8_SP2 true
#endif
template <class Epi, class Sched, bool SP2 = PG8_SP2>
__device__ __forceinline__ void gemm_phase(PG8_LAS unsigned char* lds, const Gemm g, const Sched& S, const Epi& E) {
    int tid = threadIdx.x; asm volatile("" : "+v"(tid));
    const int wid = __builtin_amdgcn_readfirstlane(tid >> 6), lane = tid & 63, wr = wid >> 2, wc = wid & 3, fr = lane & 15, fq = lane >> 4;
    const int K = g.K, nt = K / BK, lda = g.lda;
    unsigned voffA[2], voffB[2];
#pragma unroll
    for (int i = 0; i < 2; ++i) { int R, C; stage_rc(tid * 16 + i * 8192, R, C); const int Rb = Epi::PERM ? ((R & ~31) + perm32(R & 31)) : R;
        voffA[i] = (unsigned)(R * lda + C) * 2u; voffB[i] = (unsigned)(Rb * K + C) * 2u; }
    const size_t kstep = (size_t)(BK * 2);
    const size_t hstepA = (size_t)HALF * lda * 2, hstepB = (size_t)HALF * K * 2;
    const size_t tstepA = 2 * hstepA, tstepB = 2 * hstepB;
    const unsigned ldsw = (unsigned)wid * 1024u;
    const int aoff = lds_byte(wr * 64 + fr, fq * 8), boff = lds_byte(wc * 32 + fr, fq * 8);
#define PG8_SA(b, h) (((b) * 2 + (h)) * HTB)
#define PG8_SB(b, h) ((4 + (b) * 2 + (h)) * HTB)
#define PG8_STAGE(bufoff, gbase, voff) do { _Pragma("unroll") for (int _i = 0; _i < 2; ++_i) \
        __builtin_amdgcn_global_load_lds((const unsigned*)((const char*)(gbase) + (voff)[_i]), (PG8_LAS unsigned*)(lds + (bufoff) + ldsw + _i * 8192), 16, 0, 0); } while (0)
#define PG8_LDA(dst, b, h) do { _Pragma("unroll") for (int m = 0; m < 4; ++m) _Pragma("unroll") for (int k = 0; k < 2; ++k) dst[m][k] = *(const PG8_LAS bf16x8*)(lds + PG8_SA(b, h) + aoff + m * 2048 + k * 1024); } while (0)
#define PG8_LDB(dst, b, h) do { _Pragma("unroll") for (int n = 0; n < 2; ++n) _Pragma("unroll") for (int k = 0; k < 2; ++k) dst[n][k] = *(const PG8_LAS bf16x8*)(lds + PG8_SB(b, h) + boff + n * 2048 + k * 1024); } while (0)
#define PG8_MMA(ai, bj, At, Bt) do { __builtin_amdgcn_s_setprio(1); _Pragma("unroll") for (int m = 0; m < 4; ++m) _Pragma("unroll") for (int n = 0; n < 2; ++n) _Pragma("unroll") for (int k = 0; k < 2; ++k) \
        acc[ai][bj][m][n] = __builtin_amdgcn_mfma_f32_16x16x32_bf16(Bt[n][k], At[m][k], acc[ai][bj][m][n], 0, 0, 0); __builtin_amdgcn_s_setprio(0); } while (0)
#define PG8_WAIT_V(n) asm volatile("s_waitcnt vmcnt(" #n ")" ::: "memory")
#define PG8_WAIT_L(n) asm volatile("s_waitcnt lgkmcnt(" #n ")" ::: "memory")
#define PG8_BAR __builtin_amdgcn_s_barrier()
#define PG8_SCHED __builtin_amdgcn_sched_barrier(0)
#define PG8_APTR(u) ((const char*)g.A + (size_t)(u).pm * tstepA + (((u).pn >= g.asplit_pn) ? (size_t)g.asplit_off * 2 : (size_t)0))
    Unit cur, nxt; int ui = 0;
    if (!S.next(0, cur)) return;
    f32x4 acc[2][2][4][2];
#pragma unroll
    for (int a = 0; a < 2; ++a)
#pragma unroll
        for (int b = 0; b < 2; ++b)
#pragma unroll
            for (int m = 0; m < 4; ++m)
#pragma unroll
                for (int n = 0; n < 2; ++n) acc[a][b][m][n] = (f32x4){0.f, 0.f, 0.f, 0.f};
    bf16x8 At[4][2], B0[2][2], B1[2][2];
    const char* cA = PG8_APTR(cur); const char* cB = (const char*)g.Bt + (size_t)cur.pn * tstepB;
    S.a_ready(cur);
    if constexpr (SP2) {
        PG8_STAGE(PG8_SB(0, 0), cB, voffB); PG8_STAGE(PG8_SB(0, 1), cB + hstepB, voffB); PG8_STAGE(PG8_SA(0, 0), cA, voffA); PG8_STAGE(PG8_SA(0, 1), cA + hstepA, voffA);
        if (wr == 1) PG8_BAR;
        PG8_WAIT_V(2); PG8_BAR;
        PG8_STAGE(PG8_SB(1, 0), cB + kstep, voffB); PG8_STAGE(PG8_SA(1, 0), cA + kstep, voffA); PG8_STAGE(PG8_SB(1, 1), cB + hstepB + kstep, voffB);
        PG8_WAIT_V(6); PG8_BAR;
    } else {
    PG8_STAGE(PG8_SB(0, 0), cB, voffB); PG8_STAGE(PG8_SA(0, 0), cA, voffA); PG8_STAGE(PG8_SB(0, 1), cB + hstepB, voffB); PG8_STAGE(PG8_SA(0, 1), cA + hstepA, voffA);
    if (wr == 1) PG8_BAR;
    PG8_WAIT_V(4); PG8_BAR;
    PG8_STAGE(PG8_SB(1, 0), cB + kstep, voffB); PG8_STAGE(PG8_SA(1, 0), cA + kstep, voffA); PG8_STAGE(PG8_SB(1, 1), cB + hstepB + kstep, voffB);
    PG8_WAIT_V(6); PG8_BAR;
    }
    for (;;) {
        const bool has_next = S.next(ui + 1, nxt);
        const char* nA = has_next ? PG8_APTR(nxt) : cA; const char* nB = has_next ? (const char*)g.Bt + (size_t)nxt.pn * tstepB : cB;
        for (int t = 0; t < nt; t += 2) {
            const bool last = (t == nt - 2);
            const char* a1 = cA + (size_t)(t + 1) * kstep;
            const char* a2 = last ? nA : cA + (size_t)(t + 2) * kstep; const char* b2 = last ? nB : cB + (size_t)(t + 2) * kstep;
            const char* a3 = a2 + kstep; const char* b3 = b2 + kstep;
            if (last && has_next) S.a_ready(nxt);
            if constexpr (SP2) {
            PG8_LDB(B0, 0, 0); PG8_LDB(B1, 0, 1); PG8_SCHED; PG8_LDA(At, 0, 0); PG8_STAGE(PG8_SA(1, 1), a1 + hstepA, voffA);
            PG8_WAIT_V(8); PG8_WAIT_L(0); PG8_BAR; PG8_MMA(0, 0, At, B0); PG8_MMA(0, 1, At, B1); PG8_BAR; PG8_SCHED;
            PG8_LDA(At, 0, 1); PG8_STAGE(PG8_SB(0, 0), b2, voffB); PG8_STAGE(PG8_SB(0, 1), b2 + hstepB, voffB); PG8_STAGE(PG8_SA(0, 0), a2, voffA);
            PG8_WAIT_V(8); PG8_WAIT_L(0); PG8_BAR; PG8_MMA(1, 0, At, B0); PG8_MMA(1, 1, At, B1); PG8_BAR; PG8_SCHED;
            PG8_LDB(B0, 1, 0); PG8_LDB(B1, 1, 1); PG8_SCHED; PG8_LDA(At, 1, 0); PG8_STAGE(PG8_SA(0, 1), a2 + hstepA, voffA);
            PG8_WAIT_V(8); PG8_WAIT_L(0); PG8_BAR; PG8_MMA(0, 0, At, B0); PG8_MMA(0, 1, At, B1); PG8_BAR; PG8_SCHED;
            PG8_LDA(At, 1, 1); PG8_STAGE(PG8_SB(1, 0), b3, voffB); PG8_STAGE(PG8_SB(1, 1), b3 + hstepB, voffB); PG8_STAGE(PG8_SA(1, 0), a3, voffA);
            PG8_WAIT_V(8); PG8_WAIT_L(0); PG8_BAR; PG8_MMA(1, 0, At, B0); PG8_MMA(1, 1, At, B1); PG8_BAR; PG8_SCHED;
            } else {
            PG8_LDB(B0, 0, 0); PG8_SCHED; PG8_LDA(At, 0, 0); PG8_STAGE(PG8_SA(1, 1), a1 + hstepA, voffA);
            PG8_WAIT_L(8); PG8_BAR; PG8_WAIT_L(0); PG8_MMA(0, 0, At, B0); PG8_BAR; PG8_SCHED;
            PG8_LDB(B1, 0, 1); PG8_STAGE(PG8_SB(0, 0), b2, voffB);
            PG8_BAR; PG8_WAIT_L(0); PG8_MMA(0, 1, At, B1); PG8_BAR;
            PG8_LDA(At, 0, 1); PG8_STAGE(PG8_SA(0, 0), a2, voffA);
            PG8_BAR; PG8_WAIT_L(0); PG8_MMA(1, 0, At, B0); PG8_BAR; PG8_SCHED;
            PG8_STAGE(PG8_SB(0, 1), b2 + hstepB, voffB);
            PG8_WAIT_V(6); PG8_BAR; PG8_MMA(1, 1, At, B1); PG8_BAR;
            PG8_LDB(B0, 1, 0); PG8_SCHED; PG8_LDA(At, 1, 0); PG8_STAGE(PG8_SA(0, 1), a2 + hstepA, voffA);
            PG8_WAIT_L(8); PG8_BAR; PG8_WAIT_L(0); PG8_MMA(0, 0, At, B0); PG8_BAR; PG8_SCHED;
            PG8_LDB(B1, 1, 1); PG8_STAGE(PG8_SB(1, 0), b3, voffB);
            PG8_BAR; PG8_WAIT_L(0); PG8_MMA(0, 1, At, B1); PG8_BAR;
            PG8_LDA(At, 1, 1); PG8_STAGE(PG8_SA(1, 0), a3, voffA);
            PG8_BAR; PG8_WAIT_L(0); PG8_MMA(1, 0, At, B0); PG8_BAR; PG8_SCHED;
            PG8_STAGE(PG8_SB(1, 1), b3 + hstepB, voffB);
            PG8_WAIT_V(6); PG8_BAR; PG8_MMA(1, 1, At, B1); PG8_BAR;
            }
        }
        E(acc, cur, wr, wc, fr, fq); S.done(cur);
        if (!has_next) break;
#pragma unroll
        for (int a = 0; a < 2; ++a)
#pragma unroll
            for (int b = 0; b < 2; ++b)
#pragma unroll
                for (int m = 0; m < 4; ++m)
#pragma unroll
                    for (int n = 0; n < 2; ++n) acc[a][b][m][n] = (f32x4){0.f, 0.f, 0.f, 0.f};
        cur = nxt; cA = nA; cB = nB; ++ui;
    }
    PG8_WAIT_V(0);
    if (wr == 0) PG8_BAR;
    PG8_BAR;
#undef PG8_APTR
#undef PG8_SA
#undef PG8_SB
#undef PG8_STAGE
#undef PG8_LDA
#undef PG8_LDB
#undef PG8_MMA
#undef PG8_WAIT_V
#undef PG8_WAIT_L
#undef PG8_BAR
#undef PG8_SCHED
}
}

using pg8::bf16_t; using pg8::f32x4; using pg8::u32x4; using pg8::u32x2; using pg8::bf16x8;
using pg8::cvt_pk_bf16; using pg8::bf_lo; using pg8::bf_hi;

struct Params {
    const float* x_prompt; const float* x_sample; const float* state_conv; const float* norm_mix; const float* w_in; const float* ln_g; const float* ln_b;
    const float* w_s; const float* b_s; const float* conv_w; const float* w_pa; const float* w_pb; const float* w_o; const float* norm_ffn;
    const float* w_gate; const float* w_up; const float* w_down; const float* norm_final;
    float* out; unsigned char* ws; int ph_lo, ph_hi;
};
constexpr int LDS_BYTES = pg8::STAGE_BYTES + 256;
constexpr int NPHASE = 2 + 7 * NL;

__device__ __forceinline__ void transpose_tile(const float* __restrict__ src, int ld, int k0, int col0, const float* __restrict__ scale, bf16_t* __restrict__ dst, int K, float* t, int tid) {
    const int r = tid >> 4, c4 = tid & 15;
#pragma unroll
    for (int pass = 0; pass < 2; ++pass) { const int k = r + 32 * pass; const f32x4 v = *(const f32x4*)(src + (size_t)(k0 + k) * ld + col0 + 4 * c4); const float s = scale ? scale[k0 + k] : 1.0f;
        t[k * 65 + 4 * c4 + 0] = v[0] * s; t[k * 65 + 4 * c4 + 1] = v[1] * s; t[k * 65 + 4 * c4 + 2] = v[2] * s; t[k * 65 + 4 * c4 + 3] = v[3] * s; }
    __syncthreads();
    const int n = tid >> 3, kc = tid & 7; u32x4 w;
    w.x = cvt_pk_bf16(t[(8 * kc + 0) * 65 + n], t[(8 * kc + 1) * 65 + n]); w.y = cvt_pk_bf16(t[(8 * kc + 2) * 65 + n], t[(8 * kc + 3) * 65 + n]);
    w.z = cvt_pk_bf16(t[(8 * kc + 4) * 65 + n], t[(8 * kc + 5) * 65 + n]); w.w = cvt_pk_bf16(t[(8 * kc + 6) * 65 + n], t[(8 * kc + 7) * 65 + n]);
    *(u32x4*)(dst + (size_t)n * K + k0 + 8 * kc) = w;
    __syncthreads();
}
constexpr int IT_WIN = (NIN / 64) * 16, IT_WPAB = 32 * 16, IT_WO = 16 * 16, IT_WGU = (2 * DFF / 64) * 16, IT_WD = 16 * (DFF / 64), IT_LAYER = IT_WIN + IT_WPAB + IT_WO + IT_WGU + IT_WD;

__device__ __forceinline__ void p0_prologue(const Params& p, float* ldsf) {
    unsigned char* ws = p.ws;
    float* ssqm = (float*)(ws + WS_SSQM);
    int tid = threadIdx.x; asm volatile("" : "+v"(tid));
    const int G = gridDim.x, b = blockIdx.x;
    for (int it = b; it < NL * IT_LAYER; it += G) {
        const int l = it / IT_LAYER; int r = it % IT_LAYER; unsigned char* lw = ws + WS_W + (size_t)l * LW_BYTES;
        if (r < IT_WIN) { const int ntile = r >> 4, kt = r & 15, n0 = ntile * 64; int col;
            if (n0 < 3072) col = n0; else if (n0 < 5120) { const int t = n0 - 3072; col = ((t & 128) ? 4096 : 3072) + (t >> 8) * 128 + (t & 127); } else { const int t = n0 - 5120; col = ((t & 128) ? 6144 : 5120) + (t >> 8) * 128 + (t & 127); }
            transpose_tile(p.w_in + (size_t)l * DM * NIN, NIN, kt * 64, col, p.norm_mix + l * DM, (bf16_t*)(lw + LW_WIN) + (size_t)n0 * DM, DM, ldsf, tid); continue; }
        r -= IT_WIN;
        if (r < IT_WPAB) { const int ntile = r >> 4, kt = r & 15, n0 = ntile * 64;
            const float* src = (n0 < 1024) ? p.w_pa + (size_t)l * DM * DM : p.w_pb + (size_t)l * DM * DM;
            transpose_tile(src, DM, kt * 64, n0 & 1023, nullptr, (bf16_t*)(lw + LW_WPAB) + (size_t)n0 * DM, DM, ldsf, tid); continue; }
        r -= IT_WPAB;
        if (r < IT_WO) { const int ntile = r >> 4, kt = r & 15, n0 = ntile * 64;
            transpose_tile(p.w_o + (size_t)l * DM * DM, DM, kt * 64, n0, nullptr, (bf16_t*)(lw + LW_WO) + (size_t)n0 * DM, DM, ldsf, tid); continue; }
        r -= IT_WO;
        if (r < IT_WGU) { const int ntile = r >> 4, kt = r & 15, n0 = ntile * 64;
            const float* src = ((n0 & 128) ? p.w_up : p.w_gate) + (size_t)l * DM * DFF; const int col = (n0 >> 8) * 128 + (n0 & 127);
            transpose_tile(src, DFF, kt * 64, col, p.norm_ffn + l * DM, (bf16_t*)(lw + LW_WGU) + (size_t)n0 * DM, DM, ldsf, tid); continue; }
        r -= IT_WGU;
        { const int ntile = r / (DFF / 64), kt = r % (DFF / 64), n0 = ntile * 64;
            transpose_tile(p.w_down + (size_t)l * DFF * DM, DM, kt * 64, n0, nullptr, (bf16_t*)(lw + LW_WD) + (size_t)n0 * DFF, DFF, ldsf, tid); }
    }
    for (int i = b * 512 + tid; i < NL * 8 * 128 * 128; i += G * 512) {
        const int l = i >> 17, rem = i & 131071, ii = (rem >> 7) & 127, jj = rem & 127;
        const float* wsrc = p.w_s + (size_t)(i - rem);
        const int grp = rem >> 14;
        unsigned char* lw = ws + WS_W + (size_t)l * LW_BYTES;
        const float vp = (jj <= ii) ? p.w_s[i] : 0.f;
        const float vs = ((ii >> 5) == (jj >> 5) && (jj & 31) <= (ii & 31)) ? wsrc[grp * 16384 + (ii & 31) * 128 + (jj & 31)] : 0.f;
        ((bf16_t*)(lw + LW_WSP))[rem] = (bf16_t)(cvt_pk_bf16(vp, 0.f) & 0xffffu);
        ((bf16_t*)(lw + LW_WSS))[rem] = (bf16_t)(cvt_pk_bf16(vs, 0.f) & 0xffffu);
    }
    { const int wave = tid >> 6, lane = tid & 63; bf16_t* xb = (bf16_t*)(ws + WS_XB);
      for (int row = b * 8 + wave; row < MT; row += G * 8) {
          const float* xr = (row < MP) ? p.x_prompt + (size_t)row * DM : p.x_sample + (size_t)(row - MP) * DM; float q = 0.f;
#pragma unroll
          for (int j = 0; j < 4; ++j) { const f32x4 v = *(const f32x4*)(xr + 4 * (lane + 64 * j)); q += (v[0] * v[0] + v[1] * v[1]) + (v[2] * v[2] + v[3] * v[3]);
              u32x2 w; w.x = cvt_pk_bf16(v[0], v[1]); w.y = cvt_pk_bf16(v[2], v[3]); *(u32x2*)(xb + (size_t)row * DM + 4 * (lane + 64 * j)) = w; }
#pragma unroll
          for (int o = 32; o >= 1; o >>= 1) q += __shfl_xor(q, o);
          if (lane < 4) ((f32x4*)(ssqm + (size_t)row * 16))[lane] = (f32x4){lane == 0 ? q : 0.f, 0.f, 0.f, 0.f};
      } }
}

constexpr int VT_PITCH = 136;
__device__ __forceinline__ void gate_conv_phase(const Params& p, int l, unsigned char* lds) {
    unsigned char* ws = p.ws;
    const float* lns = (const float*)(ws + WS_LNS);
    bf16_t* AB = (bf16_t*)(ws + WS_AB); const bf16_t* GV = (const bf16_t*)(ws + WS_GV); const bf16_t* CH = (const bf16_t*)(ws + WS_CH);
    const unsigned char* lw = ws + WS_W + (size_t)l * LW_BYTES;
    bf16_t* vT = (bf16_t*)lds;
    float* mr = (float*)(lds + 128 * VT_PITCH * 2);
    int tid = threadIdx.x; asm volatile("" : "+v"(tid));
    const int lane = tid & 63, w = tid >> 6, fr = lane & 15, fq = lane >> 4;
    const int jg = tid >> 5, cq = tid & 31;
    const int ci = tid & 15;
    const int nks = (w >> 1) + 1;
    const int total = (MT / 128) * 8;
    int item = blockIdx.x; if (item >= total) return;
    const int g = item & 7, c0 = g * 128, irow = 16 * w + fr;
    const bf16_t* WsP = (const bf16_t*)(lw + LW_WSP) + g * 16384 + irow * 128 + 8 * fq;
    bf16x8 wf[4];
#pragma unroll
    for (int ks = 0; ks < 4; ++ks) wf[ks] = *(const bf16x8*)(WsP + 32 * ks);
    float bs = p.b_s[(l * 8 + g) * 128 + irow];
    const float* cwp = p.conv_w + (size_t)l * 3 * DM + c0 + 8 * ci;
    bool was_smp = false;
    f32x4 sl0, sl1; u32x2 gv[8]; u32x4 uu[4];
#define GC_LOAD(it) do { const int r0_ = ((it) >> 3) * 128; \
        const f32x4* sl_ = (const f32x4*)(lns + (size_t)(r0_ + (tid >> 2)) * 32 + (tid & 3) * 8); sl0 = sl_[0]; sl1 = sl_[1]; \
        _Pragma("unroll") for (int jj = 0; jj < 8; ++jj) gv[jj] = *(const u32x2*)(GV + (size_t)(r0_ + 8 * jg + jj) * DM + c0 + 4 * cq); } while (0)
#define GC_LOADU(it) do { const int r0_ = ((it) >> 3) * 128; \
        _Pragma("unroll") for (int pp = 0; pp < 4; ++pp) uu[pp] = *(const u32x4*)(AB + (size_t)(r0_ + irow) * 2048 + c0 + 8 * fq + 32 * pp); } while (0)
    GC_LOAD(item); GC_LOADU(item);
    for (;;) {
        const int ct = item >> 3, row0 = ct * 128; const bool smp = ct >= MP / 128;
        if (smp && !was_smp) {
            const bf16_t* WsS = (const bf16_t*)(lw + LW_WSS) + g * 16384 + irow * 128 + 8 * fq;
#pragma unroll
            for (int ks = 0; ks < 4; ++ks) wf[ks] = *(const bf16x8*)(WsS + 32 * ks);
            bs = p.b_s[(l * 8 + g) * 128 + (irow & 31)]; was_smp = true; }
        bf16_t* rowp = AB + (size_t)(row0 + irow) * 2048 + c0 + 8 * fq;
        const f32x4 lg = *(const f32x4*)(p.ln_g + l * DM + c0 + 4 * cq), lb = *(const f32x4*)(p.ln_b + l * DM + c0 + 4 * cq);
        { float sm = (sl0[0] + sl0[2]) + (sl1[0] + sl1[2]), sq = (sl0[1] + sl0[3]) + (sl1[1] + sl1[3]);
          sm += __shfl_xor(sm, 1); sq += __shfl_xor(sq, 1); sm += __shfl_xor(sm, 2); sq += __shfl_xor(sq, 2);
          if ((tid & 3) == 0) { const float mean = sm * (1.0f / 1024.0f), var = sq * (1.0f / 1024.0f) - mean * mean; mr[2 * (tid >> 2)] = mean; mr[2 * (tid >> 2) + 1] = __builtin_amdgcn_rsqf(fmaxf(var, 0.f) + EPS); } }
        __syncthreads();
        { float v[8][4];
#pragma unroll
          for (int jj = 0; jj < 8; ++jj) { const float mean = mr[2 * (8 * jg + jj)], rstd = mr[2 * (8 * jg + jj) + 1];
              v[jj][0] = (bf_lo(gv[jj].x) - mean) * rstd * lg[0] + lb[0]; v[jj][1] = (bf_hi(gv[jj].x) - mean) * rstd * lg[1] + lb[1];
              v[jj][2] = (bf_lo(gv[jj].y) - mean) * rstd * lg[2] + lb[2]; v[jj][3] = (bf_hi(gv[jj].y) - mean) * rstd * lg[3] + lb[3];
              if (smp) *(f32x4*)(p.out + OUT_V + ((size_t)l * MS + (row0 + 8 * jg + jj - MP)) * DM + c0 + 4 * cq) = (f32x4){v[jj][0], v[jj][1], v[jj][2], v[jj][3]}; }
#pragma unroll
          for (int e = 0; e < 4; ++e) { u32x4 wv; wv.x = cvt_pk_bf16(v[0][e], v[1][e]); wv.y = cvt_pk_bf16(v[2][e], v[3][e]); wv.z = cvt_pk_bf16(v[4][e], v[5][e]); wv.w = cvt_pk_bf16(v[6][e], v[7][e]);
              *(u32x4*)(vT + (4 * cq + e) * VT_PITCH + 8 * jg) = wv; } }
        u32x4 ch0[4], ch1[4], ch2[4], bg[4];
#pragma unroll
        for (int vv = 0; vv < 4; ++vv) { const int i = (tid >> 4) + 32 * vv, row = row0 + i, c = c0 + 8 * ci; const int pos = smp ? ((row - MP) & 31) : (row & 2047);
            const u32x4 z4 = {0u, 0u, 0u, 0u};
            ch0[vv] = *(const u32x4*)(CH + (size_t)row * DM + c);
            ch1[vv] = (pos >= 1) ? *(const u32x4*)(CH + (size_t)(row - 1) * DM + c) : z4;
            ch2[vv] = (pos >= 2) ? *(const u32x4*)(CH + (size_t)(row - 2) * DM + c) : z4;
            bg[vv] = *(const u32x4*)(AB + (size_t)row * 2048 + 1024 + c); }
        const int nitem = item + (int)gridDim.x; const bool has_next = nitem < total;
        if (has_next) GC_LOAD(nitem);
        __syncthreads();
        { f32x4 acc[8];
#pragma unroll
          for (int dt = 0; dt < 8; ++dt) acc[dt] = (f32x4){0.f, 0.f, 0.f, 0.f};
#pragma unroll
          for (int ks = 0; ks < 4; ++ks) if (ks < nks) {
#pragma unroll
              for (int dt = 0; dt < 8; ++dt) { const int d = 32 * (dt >> 1) + 8 * (fr >> 2) + 4 * (dt & 1) + (fr & 3);
                  const bf16x8 vf = *(const bf16x8*)(vT + d * VT_PITCH + 32 * ks + 8 * fq);
                  acc[dt] = __builtin_amdgcn_mfma_f32_16x16x32_bf16(vf, wf[ks], acc[dt], 0, 0, 0); } }
#pragma unroll
          for (int pp = 0; pp < 4; ++pp) { const f32x4 s0 = acc[2 * pp] + bs, s1 = acc[2 * pp + 1] + bs;
              const f32x4 u0 = {bf_lo(uu[pp][0]), bf_hi(uu[pp][0]), bf_lo(uu[pp][1]), bf_hi(uu[pp][1])}, u1 = {bf_lo(uu[pp][2]), bf_hi(uu[pp][2]), bf_lo(uu[pp][3]), bf_hi(uu[pp][3])};
              *(u32x4*)(rowp + 32 * pp) = pg8::pack8(u0 * s0, u1 * s1); } }
        if (has_next) GC_LOADU(nitem);
        const f32x4 w0a = *(const f32x4*)(cwp), w0b = *(const f32x4*)(cwp + 4), w1a = *(const f32x4*)(cwp + DM), w1b = *(const f32x4*)(cwp + DM + 4), w2a = *(const f32x4*)(cwp + 2 * DM), w2b = *(const f32x4*)(cwp + 2 * DM + 4);
#pragma unroll
        for (int vv = 0; vv < 4; ++vv) { const int i = (tid >> 4) + 32 * vv, row = row0 + i, c = c0 + 8 * ci; const int pos = smp ? ((row - MP) & 31) : (row & 2047);
            float f0[8], f1[8], f2[8], o[8];
#pragma unroll
            for (int e = 0; e < 4; ++e) { f0[2 * e] = bf_lo(ch0[vv][e]); f0[2 * e + 1] = bf_hi(ch0[vv][e]); f1[2 * e] = bf_lo(ch1[vv][e]); f1[2 * e + 1] = bf_hi(ch1[vv][e]); f2[2 * e] = bf_lo(ch2[vv][e]); f2[2 * e + 1] = bf_hi(ch2[vv][e]); }
            if (smp && pos < 2) { const int sq = (row - MP) >> 5; const float* stp = p.state_conv + ((size_t)(l * 32 + sq) * 2) * DM + c;
                if (pos == 0) { const f32x4 a = *(const f32x4*)(stp + DM), bq = *(const f32x4*)(stp + DM + 4); f1[0] = a[0]; f1[1] = a[1]; f1[2] = a[2]; f1[3] = a[3]; f1[4] = bq[0]; f1[5] = bq[1]; f1[6] = bq[2]; f1[7] = bq[3]; }
                { const float* s2 = stp + (pos == 0 ? 0 : DM); const f32x4 a = *(const f32x4*)(s2), bq = *(const f32x4*)(s2 + 4); f2[0] = a[0]; f2[1] = a[1]; f2[2] = a[2]; f2[3] = a[3]; f2[4] = bq[0]; f2[5] = bq[1]; f2[6] = bq[2]; f2[7] = bq[3]; } }
#pragma unroll
            for (int e = 0; e < 4; ++e) { o[e] = w0a[e] * f2[e] + w1a[e] * f1[e] + w2a[e] * f0[e]; o[4 + e] = w0b[e] * f2[4 + e] + w1b[e] * f1[4 + e] + w2b[e] * f0[4 + e]; }
            u32x4 ov;
#pragma unroll
            for (int e = 0; e < 4; ++e) ov[e] = cvt_pk_bf16(o[2 * e] * bf_lo(bg[vv][e]), o[2 * e + 1] * bf_hi(bg[vv][e]));
            *(u32x4*)(AB + (size_t)row * 2048 + 1024 + c) = ov;
            const int lastpos = smp ? 31 : 2047;
            if (pos >= lastpos - 1) { float* op = smp ? p.out + OUT_NCS + (((size_t)l * 32 + ((row - MP) >> 5)) * 2 + (pos - (lastpos - 1))) * DM + c
                                                      : p.out + OUT_NCP + (((size_t)l * 32 + (row >> 11)) * 2 + (pos - (lastpos - 1))) * DM + c;
                *(f32x4*)op = (f32x4){f0[0], f0[1], f0[2], f0[3]}; *(f32x4*)(op + 4) = (f32x4){f0[4], f0[5], f0[6], f0[7]}; } }
        __syncthreads();
        if (!has_next) break;
        item = nitem;
    }
#undef GC_LOAD
#undef GC_LOADU
}

__device__ __forceinline__ void final_norm_phase(const Params& p) {
    const float* ssq = (const float*)(p.ws + WS_SSQM); const bf16_t* xb = (const bf16_t*)(p.ws + WS_XB);
    const size_t n8 = (size_t)MT * DM / 8;
    int tid = threadIdx.x; asm volatile("" : "+v"(tid));
    for (size_t i = (size_t)blockIdx.x * 512 + tid; i < n8; i += (size_t)gridDim.x * 512) {
        const int row = (int)(i >> 7), c = (int)(i & 127) * 8; const float rs = pg8::rstd_of(ssq, row);
        const u32x4 w = *(const u32x4*)(xb + i * 8); const f32x4 g0 = *(const f32x4*)(p.norm_final + c), g1 = *(const f32x4*)(p.norm_final + c + 4);
        ((f32x4*)p.out)[2 * i] = pg8::unpk_lo(w) * rs * g0; ((f32x4*)p.out)[2 * i + 1] = pg8::unpk_hi(w) * rs * g1; }
}

#define LAS __attribute__((address_space(3)))
#define XB_TMO      128
#define XB_XCNT(j)  (256  + 64 * (j))
#define XB_XSUB(j)  (1280 + 64 * (j))
#define XB_XGEN(j)  (2304 + 64 * (j))
#define XB_TOP      3328
#define XB_TOPGEN   3392
#define XCD_BAR_WORDS 3456
#define XB_SPIN_CAP (1u << 18)

__device__ __forceinline__ unsigned xb_ld(unsigned* p)              { return __hip_atomic_load(p, __ATOMIC_RELAXED, __HIP_MEMORY_SCOPE_AGENT); }
__device__ __forceinline__ unsigned xb_add(unsigned* p, unsigned v) { return __hip_atomic_fetch_add(p, v, __ATOMIC_RELAXED, __HIP_MEMORY_SCOPE_AGENT); }
__device__ __forceinline__ unsigned xb_xcc_id() { return (unsigned)__builtin_amdgcn_s_getreg((3 << 11) | 20) & 0xFu; }
#define XB_SPIN(cond, bar) do { unsigned _sp = 0; while (cond) { __builtin_amdgcn_s_sleep(1); \
    if ((++_sp & 255u) == 0u) { if (xb_ld(&(bar)[XB_TMO])) break; if (_sp > XB_SPIN_CAP) { atomicAdd(&(bar)[XB_TMO], 1u); break; } } } } while (0)

struct XcdBarrier {
    unsigned* bar; unsigned x;
    volatile LAS unsigned* st;
};

__device__ __forceinline__ XcdBarrier xcd_barrier_post(unsigned* bar, volatile LAS unsigned* st) {
    XcdBarrier b; b.bar = bar; b.x = xb_xcc_id(); b.st = st;
    if (threadIdx.x == 0) (void)xb_add(&bar[XB_XCNT(b.x)], 1u);
    return b;
}
__device__ __forceinline__ void xcd_barrier_complete(unsigned* bar, unsigned x, unsigned& nloc, unsigned& nx) {
    const unsigned G = gridDim.x * gridDim.y * gridDim.z;
    unsigned sum, cnt, mine, sp = 0u;
    for (;;) {
        sum = 0u; cnt = 0u; mine = 0u;
#pragma unroll
        for (unsigned j = 0; j < 16; ++j) { const unsigned c = xb_ld(&bar[XB_XCNT(j)]); sum += c; cnt += (c > 0u) ? 1u : 0u; mine = (j == x) ? c : mine; }
        if (sum == G) break;
        __builtin_amdgcn_s_sleep(1);
        if ((++sp & 255u) == 0u) { if (xb_ld(&bar[XB_TMO])) break; if (sp > XB_SPIN_CAP) { atomicAdd(&bar[XB_TMO], 1u); break; } }
    }
    nloc = mine > 0u ? mine : 1u; nx = cnt > 0u ? cnt : 1u;
}

__device__ __forceinline__ void xcd_barrier(const XcdBarrier& b) {
    asm volatile("s_waitcnt vmcnt(0)" ::: "memory");
    __syncthreads();
    if (threadIdx.x == 0) {
        unsigned* bar = b.bar;
        __builtin_amdgcn_s_waitcnt(0);
        unsigned nloc = b.st[0], nx = b.st[1];
        if (nloc == 0u) { xcd_barrier_complete(bar, b.x, nloc, nx); b.st[0] = nloc; b.st[1] = nx; }
        const unsigned old = xb_add(&bar[XB_XSUB(b.x)], 1u);
        const unsigned gen = old / nloc;
        if (old + 1u == (gen + 1u) * nloc) {
            __builtin_amdgcn_fence(__ATOMIC_RELEASE, "agent");
            asm volatile("s_waitcnt vmcnt(0)" ::: "memory");
            const unsigned og = xb_add(&bar[XB_TOP], 1u);
            const unsigned tg = og / nx;
            if (og + 1u == (tg + 1u) * nx) xb_add(&bar[XB_TOPGEN], 1u);
            else XB_SPIN(xb_ld(&bar[XB_TOPGEN]) == tg, bar);
            __builtin_amdgcn_fence(__ATOMIC_ACQUIRE, "agent");
            xb_add(&bar[XB_XGEN(b.x)], 1u);
            asm volatile("s_waitcnt vmcnt(0)" ::: "memory");
        } else {
            XB_SPIN(xb_ld(&bar[XB_XGEN(b.x)]) == gen, bar);
            __builtin_amdgcn_fence(__ATOMIC_ACQUIRE, "agent");
            asm volatile("s_waitcnt vmcnt(0)" ::: "memory");
        }
    }
    __syncthreads();
}

__global__ void __launch_bounds__(512, 2) mk_fwd(Params p) {
    extern __shared__ __attribute__((aligned(16))) unsigned char lds[];
    unsigned char* ws = p.ws;
    float* ssq_mix = (float*)(ws + WS_SSQM); float* ssq_ffn = (float*)(ws + WS_SSQF); float* lns = (float*)(ws + WS_LNS);
    bf16_t* XB = (bf16_t*)(ws + WS_XB); bf16_t* AB = (bf16_t*)(ws + WS_AB); bf16_t* GV = (bf16_t*)(ws + WS_GV); bf16_t* CH = (bf16_t*)(ws + WS_CH);
    bf16_t* T12 = GV; bf16_t* MMb = AB; bf16_t* Hb = AB;
    const int G = gridDim.x, c = blockIdx.x;
    PG8_LAS unsigned char* ring = (PG8_LAS unsigned char*)lds;
#if MK_MULTI
#define GRID_SYNC() do { } while (0)
#else
    cg::grid_group grid = cg::this_grid();
    volatile LAS unsigned* bst = (volatile LAS unsigned*)((LAS unsigned char*)lds + pg8::STAGE_BYTES);
    if (threadIdx.x < 2) bst[threadIdx.x] = 0u;
    __syncthreads();
    XcdBarrier xbar = xcd_barrier_post((unsigned*)(ws + WS_CTL), bst);
#define GRID_SYNC() do { if (ph == 0) grid.sync(); else xcd_barrier(xbar); } while (0)
#endif
    for (int ph = p.ph_lo; ph < p.ph_hi; ++ph) {
        if (ph == 0) { if (PHASE_MASK & 1) { if (PROBE_DUP & 512) p0_prologue(p, (float*)lds); p0_prologue(p, (float*)lds); } }
        else if (ph == NPHASE - 1) { if (PHASE_MASK & 2) final_norm_phase(p); }
        else {
            const int l = (ph - 1) / 7, s = (ph - 1) % 7;
            for (int rep_ = 0; rep_ < (((PROBE_DUP >> s) & 1) ? 2 : 1); ++rep_) {
            const unsigned char* lw = ws + WS_W + (size_t)l * LW_BYTES;
            if (s == 0) { if (PHASE_MASK & 4) {
                pg8::Gemm g{XB, (const bf16_t*)(lw + LW_WIN), MT, 5120, DM, DM, 1 << 30, 0}; pg8::StaticOrder S; S.init(MT, 5120, G, c);
                pg8::EpiA E{AB, GV, CH, ssq_mix, lns};
                pg8::gemm_phase<pg8::EpiA, pg8::StaticOrder>(ring, g, S, E); }
            } else if (s == 1) {
                if (PHASE_MASK & 8) gate_conv_phase(p, l, lds);
            } else if (s == 2) { if (PHASE_MASK & 16) {
                pg8::Gemm g{AB, (const bf16_t*)(lw + LW_WPAB), MT, 2048, DM, 2048, 4, 1024}; pg8::StaticOrder S; S.init(MT, 2048, G, c);
                pg8::EpiC E{T12};
                pg8::gemm_phase<pg8::EpiC, pg8::StaticOrder>(ring, g, S, E); }
            } else if (s == 3) { if (PHASE_MASK & 32) {
                pg8::Gemm g{XB, (const bf16_t*)(lw + LW_WIN) + (size_t)5120 * DM, MT, 2048, DM, DM, 1 << 30, 0}; pg8::StaticOrder S; S.init(MT, 2048, G, c);
                pg8::EpiD E{T12, MMb, ssq_mix};
                pg8::gemm_phase<pg8::EpiD, pg8::StaticOrder>(ring, g, S, E); }
            } else if (s == 4) { if (PHASE_MASK & 64) {
                pg8::Gemm g{MMb, (const bf16_t*)(lw + LW_WO), MT, DM, DM, DM, 1 << 30, 0}; pg8::StaticOrder S; S.init(MT, DM, G, c);
                pg8::EpiRes E{XB, ssq_ffn};
                pg8::gemm_phase<pg8::EpiRes, pg8::StaticOrder>(ring, g, S, E); }
            } else if (s == 5) { if (PHASE_MASK & 128) {
                pg8::Gemm g{XB, (const bf16_t*)(lw + LW_WGU), MT, 2 * DFF, DM, DM, 1 << 30, 0}; pg8::StaticOrder S; S.init(MT, 2 * DFF, G, c);
                pg8::EpiF E{Hb, ssq_ffn};
                pg8::gemm_phase<pg8::EpiF, pg8::StaticOrder>(ring, g, S, E); }
            } else { if (PHASE_MASK & 256) {
                pg8::Gemm g{Hb, (const bf16_t*)(lw + LW_WD), MT, DM, DFF, DFF, 1 << 30, 0}; pg8::StaticOrder S; S.init(MT, DM, G, c);
                pg8::EpiRes E{XB, ssq_mix};
                pg8::gemm_phase<pg8::EpiRes, pg8::StaticOrder>(ring, g, S, E); }
            }
            }
        }
        if (ph + 1 < p.ph_hi) { GRID_SYNC(); }
    }
}

extern "C" void kernel_launch(void* const* d_in, const int* in_sizes, int n_in, void* d_out, int out_size, void* d_ws, size_t ws_size, hipStream_t stream) {
    static int grid = 0;
    if (grid == 0) {
        if (n_in != 18 || in_sizes[0] != MP * DM || (size_t)out_size != OUT_TOTAL || ws_size < WS_END) {
            fprintf(stderr, "kernel_launch: unexpected shapes: n_in %d in0 %d out %d ws %zu (need %zu)\n", n_in, n_in > 0 ? in_sizes[0] : -1, out_size, ws_size, (size_t)WS_END); grid = -1; return; }
        int dev = 0, cus = 0, per_cu = 0;
        (void)hipGetDevice(&dev); (void)hipDeviceGetAttribute(&cus, hipDeviceAttributeMultiprocessorCount, dev);
        if (hipFuncSetAttribute((const void*)mk_fwd, hipFuncAttributeMaxDynamicSharedMemorySize, LDS_BYTES) != hipSuccess) { fprintf(stderr, "kernel_launch: hipFuncSetAttribute failed\n"); grid = -1; return; }
        if (hipOccupancyMaxActiveBlocksPerMultiprocessor(&per_cu, (const void*)mk_fwd, 512, LDS_BYTES) != hipSuccess || per_cu < 1) { fprintf(stderr, "kernel_launch: occupancy query says %d\n", per_cu); per_cu = 1; }
        (void)hipGetLastError();
        grid = cus * 1;
        fprintf(stderr, "kernel_launch: cus %d per_cu %d grid %d\n", cus, per_cu, grid);
    }
    if (grid < 0) return;
    if (hipMemsetAsync((char*)d_ws + WS_CTL, 0, CTL_BYTES, stream) != hipSuccess) { fprintf(stderr, "kernel_launch: memset failed\n"); return; }
    Params p{};
    const float** pp = (const float**)&p;
    for (int i = 0; i < 18; ++i) pp[i] = (const float*)d_in[i];
    p.out = (float*)d_out; p.ws = (unsigned char*)d_ws;
#if MK_MULTI
    for (int ph = 0; ph < NPHASE; ++ph) { p.ph_lo = ph; p.ph_hi = ph + 1; hipLaunchKernelGGL(mk_fwd, dim3(grid), dim3(512), LDS_BYTES, stream, p); }
#else
    p.ph_lo = 0; p.ph_hi = NPHASE;
    void* args[] = {&p};
    hipError_t e = hipLaunchCooperativeKernel((const void*)mk_fwd, dim3(grid), dim3(512), args, LDS_BYTES, stream);
    if (e != hipSuccess) fprintf(stderr, "kernel_launch: cooperative launch failed: %s (grid %d)\n", hipGetErrorString(e), grid);
#endif
}
```

```cpp
#include <hip/hip_runtime.h>
#include <hip/hip_cooperative_groups.h>
#include <cstdio>
#include <cstdint>
namespace cg = cooperative_groups;

#ifndef PHASE_MASK
#define PHASE_MASK 511
#endif
#ifndef PROBE_DUP
#define PROBE_DUP 0
#endif
#ifndef MK_MULTI
#define MK_MULTI 0
#endif

constexpr int MP = 65536, MS = 1024, MT = MP + MS, DM = 1024, NL = 4, DFF = 2816, NIN = 7168;
constexpr float EPS = 1e-6f;
constexpr size_t OUT_YS = (size_t)MP * DM, OUT_NCP = OUT_YS + (size_t)MS * DM, OUT_NCS = OUT_NCP + (size_t)NL * 32 * 2 * DM, OUT_V = OUT_NCS + (size_t)NL * 32 * 2 * DM;
constexpr size_t OUT_TOTAL = OUT_V + (size_t)NL * 32 * 32 * DM;

constexpr size_t MiB = (size_t)1 << 20;
constexpr size_t WS_SSQM = 0, WS_SSQF = 5 * MiB, WS_LNS = 10 * MiB;
constexpr size_t WS_CTL = 20 * MiB, CTL_BYTES = 16384;
constexpr size_t WS_W = 24 * MiB;
constexpr size_t LW_WIN = 0, LW_WPAB = LW_WIN + (size_t)NIN * DM * 2, LW_WO = LW_WPAB + (size_t)2048 * DM * 2, LW_WGU = LW_WO + (size_t)DM * DM * 2,
                 LW_WD = LW_WGU + (size_t)2 * DFF * DM * 2, LW_WSP = LW_WD + (size_t)DM * DFF * 2, LW_WSS = LW_WSP + (size_t)8 * 128 * 128 * 2, LW_BYTES = LW_WSS + (size_t)8 * 128 * 128 * 2;
constexpr size_t WS_XB = 176 * MiB;
constexpr size_t WS_AB = 306 * MiB;
constexpr size_t WS_GV = 566 * MiB;
constexpr size_t WS_CH = 696 * MiB;
constexpr size_t WS_END = 826 * MiB;
static_assert(WS_W + NL * LW_BYTES <= WS_XB, "weights overflow");

namespace pg8 {
#define PG8_LAS __attribute__((address_space(3)))
typedef unsigned short bf16_t;
typedef short bf16x8 __attribute__((ext_vector_type(8)));
typedef float f32x4 __attribute__((ext_vector_type(4)));
typedef float f32x2 __attribute__((ext_vector_type(2)));
typedef unsigned u32x4 __attribute__((ext_vector_type(4)));
typedef unsigned u32x2 __attribute__((ext_vector_type(2)));
constexpr int BM = 256, BK = 64, HALF = 128, HTB = HALF * BK * 2, STAGE_BYTES = 8 * HTB, NXCD = 8, WGM = 8;

__host__ __device__ __forceinline__ int lds_byte(int r, int c) { const int st = (r >> 4) * 2 + (c >> 5), rr = r & 15, cc = c & 31, ob = rr * 64 + cc * 2; return st * 1024 + (ob ^ (((ob >> 9) & 1) << 5)); }
__host__ __device__ __forceinline__ void stage_rc(int b, int& R, int& C) { const int st = b / 1024, sb = b % 1024, swz = sb ^ (((sb >> 9) & 1) << 5); R = (st >> 1) * 16 + swz / 64; C = (st & 1) * 32 + (swz % 64) / 2; }
__host__ __device__ __forceinline__ int perm32(int rho) { const int n = rho >> 4, i = rho & 15; return 8 * (i >> 2) + 4 * n + (i & 3); }

struct Unit { int pm, pn; };
struct Gemm { const bf16_t* A; const bf16_t* Bt; int M, N, K, lda, asplit_pn, asplit_off; };

struct StaticOrder {
    int nM, nN, nwg, G, c;
    __host__ __device__ void init(int M, int N, int G_, int c_) { nM = M / BM; nN = N / BM; nwg = nM * nN; G = G_; c = c_; }
    __host__ __device__ bool next(int i, Unit& u) const {
        const long L = (long)i * G + c; if (L >= nwg) return false;
        int wgid = (int)L; { const int q = nwg / NXCD, r = nwg % NXCD, xcd = wgid % NXCD, off = wgid / NXCD; wgid = (xcd < r ? xcd * (q + 1) : r * (q + 1) + (xcd - r) * q) + off; }
        const int nig = WGM * nN, gid = wgid / nig, fm = gid * WGM, gsz = (nM - fm) < WGM ? (nM - fm) : WGM;
        u.pm = fm + ((wgid % nig) % gsz); u.pn = (wgid % nig) / gsz; return true;
    }
    __device__ __forceinline__ void a_ready(const Unit&) const {}
    __device__ __forceinline__ void done(const Unit&) const {}
};

__device__ __forceinline__ unsigned cvt_pk_bf16(float lo, float hi) { unsigned r; asm volatile("v_cvt_pk_bf16_f32 %0, %1, %2" : "=v"(r) : "v"(lo), "v"(hi)); return r; }
__device__ __forceinline__ float bf_lo(unsigned w) { return __uint_as_float(w << 16); }
__device__ __forceinline__ float bf_hi(unsigned w) { return __uint_as_float(w & 0xffff0000u); }
__device__ __forceinline__ f32x2 gelu_pk(f32x2 v) {
    const f32x2 av = __builtin_elementwise_abs(v), d = av * 0.2316418882f + 1.0f;
    f32x2 t; t.x = __builtin_amdgcn_rcpf(d.x); t.y = __builtin_amdgcn_rcpf(d.y);
    f32x2 q = t * 0.5307027145f + (-0.7265760135f); q = q * t + 0.7107068705f; q = q * t + (-0.142248368f); q = q * t + 0.127414796f; q = q * t;
    const f32x2 s = (v * v) * (-0.72134752044f);
    f32x2 e; e.x = __builtin_amdgcn_exp2f(s.x); e.y = __builtin_amdgcn_exp2f(s.y);
    const f32x2 m = v * (q * e), r = v - m;
    f32x2 o; o.x = v.x < 0.f ? m.x : r.x; o.y = v.y < 0.f ? m.y : r.y; return o;
}
__device__ __forceinline__ f32x4 gelu4(f32x4 v) { const f32x2 a = gelu_pk((f32x2){v[0], v[1]}), b = gelu_pk((f32x2){v[2], v[3]}); return (f32x4){a.x, a.y, b.x, b.y}; }
__device__ __forceinline__ float sigmoidf_(float x) { return __builtin_amdgcn_rcpf(1.0f + __builtin_amdgcn_exp2f(x * -1.44269504f)); }
__device__ __forceinline__ f32x4 sigmoid4(f32x4 v) { return (f32x4){sigmoidf_(v[0]), sigmoidf_(v[1]), sigmoidf_(v[2]), sigmoidf_(v[3])}; }
__device__ __forceinline__ u32x4 pack8(f32x4 v0, f32x4 v1) { u32x4 w; w.x = cvt_pk_bf16(v0[0], v0[1]); w.y = cvt_pk_bf16(v0[2], v0[3]); w.z = cvt_pk_bf16(v1[0], v1[1]); w.w = cvt_pk_bf16(v1[2], v1[3]); return w; }
__device__ __forceinline__ float rstd_of(const float* slots, int row) { const f32x4* s = (const f32x4*)(slots + (size_t)row * 16); const f32x4 t = (s[0] + s[1]) + (s[2] + s[3]);
    return __builtin_amdgcn_rsqf(((t[0] + t[1]) + (t[2] + t[3])) * (1.0f / 1024.0f) + EPS); }

__device__ __forceinline__ void wave_rstd(const float* slots, int rowbase, int lane, int fr, float (&rs)[2][4]) {
    float val[2];
    const f32x4* sa = (const f32x4*)(slots + (size_t)(rowbase + lane) * 16); const f32x4* sb = (const f32x4*)(slots + (size_t)(rowbase + HALF + lane) * 16);
    const f32x4 a0 = sa[0], a1 = sa[1], a2 = sa[2], a3 = sa[3], b0 = sb[0], b1 = sb[1], b2 = sb[2], b3 = sb[3];
    __builtin_amdgcn_sched_barrier(0);
    { const f32x4 t = (a0 + a1) + (a2 + a3); val[0] = __builtin_amdgcn_rsqf(((t[0] + t[1]) + (t[2] + t[3])) * (1.0f / 1024.0f) + EPS); }
    { const f32x4 t = (b0 + b1) + (b2 + b3); val[1] = __builtin_amdgcn_rsqf(((t[0] + t[1]) + (t[2] + t[3])) * (1.0f / 1024.0f) + EPS); }
#pragma unroll
    for (int ai = 0; ai < 2; ++ai)
#pragma unroll
        for (int m = 0; m < 4; ++m) rs[ai][m] = __shfl(val[ai], m * 16 + fr);
}
__device__ __forceinline__ f32x4 unpk_lo(u32x4 w) { return (f32x4){bf_lo(w[0]), bf_hi(w[0]), bf_lo(w[1]), bf_hi(w[1])}; }
__device__ __forceinline__ f32x4 unpk_hi(u32x4 w) { return (f32x4){bf_lo(w[2]), bf_hi(w[2]), bf_lo(w[3]), bf_hi(w[3])}; }

struct EpiA {
    static constexpr bool PERM = true, AFTER_DRAIN = false;
    bf16_t* AB; bf16_t* GV; bf16_t* CH; const float* ssq; float* lns;
    __device__ __forceinline__ void operator()(const f32x4 (&acc)[2][2][4][2], const Unit& u, int wr, int wc, int fr, int fq) const {
        const int row0 = u.pm * BM + wr * 64 + fr, cw = wc * 32 + 8 * fq, pn = u.pn;
        float rsv[2][4]; wave_rstd(ssq, u.pm * BM + wr * 64, fr + 16 * fq, fr, rsv);
        if (pn < 4) {
#pragma unroll
            for (int ai = 0; ai < 2; ++ai)
#pragma unroll
                for (int m = 0; m < 4; ++m) { const int row = row0 + ai * HALF + m * 16; const float rs = rsv[ai][m]; bf16_t* rowp = AB + (size_t)row * 2048 + pn * 256 + cw;
#pragma unroll
                    for (int bj = 0; bj < 2; ++bj) *(u32x4*)(rowp + bj * HALF) = pack8(gelu4(acc[ai][bj][m][0] * rs), gelu4(acc[ai][bj][m][1] * rs)); }
        } else if (pn < 8) {
#pragma unroll
            for (int ai = 0; ai < 2; ++ai)
#pragma unroll
                for (int m = 0; m < 4; ++m) { const int row = row0 + ai * HALF + m * 16; const float rs = rsv[ai][m]; bf16_t* rowp = GV + (size_t)row * 1024 + (pn - 4) * 256 + cw;
                    float s = 0.f, q = 0.f;
#pragma unroll
                    for (int bj = 0; bj < 2; ++bj) { const u32x4 w = pack8(gelu4(acc[ai][bj][m][0] * rs), gelu4(acc[ai][bj][m][1] * rs)); *(u32x4*)(rowp + bj * HALF) = w;
#pragma unroll
                        for (int e = 0; e < 4; ++e) { const float a = bf_lo(w[e]), b = bf_hi(w[e]); s += a + b; q += a * a + b * b; } }
                    s += __shfl_xor(s, 16); s += __shfl_xor(s, 32); q += __shfl_xor(q, 16); q += __shfl_xor(q, 32);
                    if (fq == 0) *(f32x2*)(lns + ((size_t)row * 16 + (pn - 4) * 4 + wc) * 2) = (f32x2){s, q}; }
        } else if (pn < 12) {
#pragma unroll
            for (int ai = 0; ai < 2; ++ai)
#pragma unroll
                for (int m = 0; m < 4; ++m) { const int row = row0 + ai * HALF + m * 16; const float rs = rsv[ai][m]; bf16_t* rowp = AB + (size_t)row * 2048 + 1024 + (pn - 8) * 256 + cw;
#pragma unroll
                    for (int bj = 0; bj < 2; ++bj) *(u32x4*)(rowp + bj * HALF) = pack8(acc[ai][bj][m][0] * rs, acc[ai][bj][m][1] * rs); }
        } else {
#pragma unroll
            for (int ai = 0; ai < 2; ++ai)
#pragma unroll
                for (int m = 0; m < 4; ++m) { const int row = row0 + ai * HALF + m * 16; const float rs = rsv[ai][m]; const float rs2 = rs * rs;
                    *(u32x4*)(CH + (size_t)row * 1024 + (pn - 12) * 128 + cw) = pack8(acc[ai][0][m][0] * acc[ai][1][m][0] * rs2, acc[ai][0][m][1] * acc[ai][1][m][1] * rs2); }
        }
    }
};
struct EpiC {
    static constexpr bool PERM = true, AFTER_DRAIN = false;
    bf16_t* T;
    __device__ __forceinline__ void operator()(const f32x4 (&acc)[2][2][4][2], const Unit& u, int wr, int wc, int fr, int fq) const {
        const int row0 = u.pm * BM + wr * 64 + fr, cw = u.pn * 256 + wc * 32 + 8 * fq;
#pragma unroll
        for (int ai = 0; ai < 2; ++ai)
#pragma unroll
            for (int m = 0; m < 4; ++m) { bf16_t* rowp = T + (size_t)(row0 + ai * HALF + m * 16) * 2048 + cw;
#pragma unroll
                for (int bj = 0; bj < 2; ++bj) *(u32x4*)(rowp + bj * HALF) = pack8(acc[ai][bj][m][0], acc[ai][bj][m][1]); }
    }
};
struct EpiD {
    static constexpr bool PERM = true, AFTER_DRAIN = false;
    const bf16_t* T; bf16_t* MM; const float* ssq;
    __device__ __forceinline__ void operator()(const f32x4 (&acc)[2][2][4][2], const Unit& u, int wr, int wc, int fr, int fq) const {
        const int row0 = u.pm * BM + wr * 64 + fr, cw = u.pn * 128 + wc * 32 + 8 * fq;
        u32x4 tt[4][2];
#pragma unroll
        for (int m = 0; m < 4; ++m) { const bf16_t* tp = T + (size_t)(row0 + m * 16) * 2048 + cw; tt[m][0] = *(const u32x4*)tp; tt[m][1] = *(const u32x4*)(tp + 1024); }
        float rsv[2][4]; wave_rstd(ssq, u.pm * BM + wr * 64, fr + 16 * fq, fr, rsv);
#pragma unroll
        for (int ai = 0; ai < 2; ++ai) {
            if (ai == 1) {
#pragma unroll
                for (int m = 0; m < 4; ++m) { const bf16_t* tp = T + (size_t)(row0 + HALF + m * 16) * 2048 + cw; tt[m][0] = *(const u32x4*)tp; tt[m][1] = *(const u32x4*)(tp + 1024); } }
#pragma unroll
            for (int m = 0; m < 4; ++m) { const int row = row0 + ai * HALF + m * 16; const float rs = rsv[ai][m];
                const u32x4 t1 = tt[m][0], t2 = tt[m][1];
                const f32x4 a0 = sigmoid4(acc[ai][0][m][0] * rs), a1 = sigmoid4(acc[ai][0][m][1] * rs), b0 = sigmoid4(acc[ai][1][m][0] * rs), b1 = sigmoid4(acc[ai][1][m][1] * rs);
                const f32x4 p0 = {bf_lo(t1[0]), bf_hi(t1[0]), bf_lo(t1[1]), bf_hi(t1[1])}, p1 = {bf_lo(t1[2]), bf_hi(t1[2]), bf_lo(t1[3]), bf_hi(t1[3])};
                const f32x4 q0 = {bf_lo(t2[0]), bf_hi(t2[0]), bf_lo(t2[1]), bf_hi(t2[1])}, q1 = {bf_lo(t2[2]), bf_hi(t2[2]), bf_lo(t2[3]), bf_hi(t2[3])};
                *(u32x4*)(MM + (size_t)row * 1024 + cw) = pack8(a0 * p0 + b0 * q0, a1 * p1 + b1 * q1); }
            asm volatile("" ::: "memory");
        }
    }
};
struct EpiRes {
    static constexpr bool PERM = true, AFTER_DRAIN = false;
    bf16_t* xb; float* ssq;
    __device__ __forceinline__ void operator()(const f32x4 (&acc)[2][2][4][2], const Unit& u, int wr, int wc, int fr, int fq) const {
        const int row0 = u.pm * BM + wr * 64 + fr, cw = u.pn * BM + wc * 32 + 8 * fq;
#pragma unroll
        for (int ai = 0; ai < 2; ++ai) {
            u32x4 xo[4][2];
#pragma unroll
            for (int m = 0; m < 4; ++m)
#pragma unroll
                for (int bj = 0; bj < 2; ++bj) xo[m][bj] = *(const u32x4*)(xb + (size_t)(row0 + ai * HALF + m * 16) * DM + cw + bj * HALF);
#pragma unroll
            for (int m = 0; m < 4; ++m) { const int row = row0 + ai * HALF + m * 16; float q = 0.f;
#pragma unroll
                for (int bj = 0; bj < 2; ++bj) { const u32x4 w = pack8(acc[ai][bj][m][0] + unpk_lo(xo[m][bj]), acc[ai][bj][m][1] + unpk_hi(xo[m][bj]));
                    *(u32x4*)(xb + (size_t)row * DM + cw + bj * HALF) = w;
#pragma unroll
                    for (int e = 0; e < 4; ++e) { const float a = bf_lo(w[e]), b = bf_hi(w[e]); q += a * a + b * b; } }
                q += __shfl_xor(q, 16); q += __shfl_xor(q, 32);
                if (fq == 0) ssq[(size_t)row * 16 + u.pn * 4 + wc] = q; }
            asm volatile("" ::: "memory");
        }
    }
};
struct EpiF {
    static constexpr bool PERM = true, AFTER_DRAIN = false;
    bf16_t* H; const float* ssq;
    __device__ __forceinline__ void operator()(const f32x4 (&acc)[2][2][4][2], const Unit& u, int wr, int wc, int fr, int fq) const {
        const int row0 = u.pm * BM + wr * 64 + fr, cw = u.pn * 128 + wc * 32 + 8 * fq;
        float rsv[2][4]; wave_rstd(ssq, u.pm * BM + wr * 64, fr + 16 * fq, fr, rsv);
#pragma unroll
        for (int ai = 0; ai < 2; ++ai)
#pragma unroll
            for (int m = 0; m < 4; ++m) { const int row = row0 + ai * HALF + m * 16; const float rs = rsv[ai][m];
                const f32x4 g0 = acc[ai][0][m][0] * rs, g1 = acc[ai][0][m][1] * rs, u0 = acc[ai][1][m][0] * rs, u1 = acc[ai][1][m][1] * rs;
                *(u32x4*)(H + (size_t)row * DFF + cw) = pack8(g0 * sigmoid4(g0) * u0, g1 * sigmoid4(g1) * u1); }
    }
};

#ifndef PG8_SP2
#define PG8_SP2 true
#endif
#ifndef PG8_ALIGN
#define PG8_ALIGN true
#endif
template <class Epi, class Sched, bool SP2 = PG8_SP2, bool ALIGN_EPI = PG8_ALIGN>
__device__ __forceinline__ void gemm_phase(PG8_LAS unsigned char* lds, const Gemm g, const Sched& S, const Epi& E) {
    int tid = threadIdx.x; asm volatile("" : "+v"(tid));
    const int wid = __builtin_amdgcn_readfirstlane(tid >> 6), lane = tid & 63, wr = wid >> 2, wc = wid & 3, fr = lane & 15, fq = lane >> 4;
    const int K = g.K, nt = K / BK, lda = g.lda;
    unsigned voffA[2], voffB[2];
#pragma unroll
    for (int i = 0; i < 2; ++i) { int R, C; stage_rc(tid * 16 + i * 8192, R, C); const int Rb = Epi::PERM ? ((R & ~31) + perm32(R & 31)) : R;
        voffA[i] = (unsigned)(R * lda + C) * 2u; voffB[i] = (unsigned)(Rb * K + C) * 2u; }
    const size_t kstep = (size_t)(BK * 2);
    const size_t hstepA = (size_t)HALF * lda * 2, hstepB = (size_t)HALF * K * 2;
    const size_t tstepA = 2 * hstepA, tstepB = 2 * hstepB;
    const unsigned ldsw = (unsigned)wid * 1024u;
    const int aoff = lds_byte(wr * 64 + fr, fq * 8), boff = lds_byte(wc * 32 + fr, fq * 8);
#define PG8_SA(b, h) (((b) * 2 + (h)) * HTB)
#define PG8_SB(b, h) ((4 + (b) * 2 + (h)) * HTB)
#define PG8_STAGE(bufoff, gbase, voff) do { _Pragma("unroll") for (int _i = 0; _i < 2; ++_i) \
        __builtin_amdgcn_global_load_lds((const unsigned*)((const char*)(gbase) + (voff)[_i]), (PG8_LAS unsigned*)(lds + (bufoff) + ldsw + _i * 8192), 16, 0, 0); } while (0)
#define PG8_LDA(dst, b, h) do { _Pragma("unroll") for (int m = 0; m < 4; ++m) _Pragma("unroll") for (int k = 0; k < 2; ++k) dst[m][k] = *(const PG8_LAS bf16x8*)(lds + PG8_SA(b, h) + aoff + m * 2048 + k * 1024); } while (0)
#define PG8_LDB(dst, b, h) do { _Pragma("unroll") for (int n = 0; n < 2; ++n) _Pragma("unroll") for (int k = 0; k < 2; ++k) dst[n][k] = *(const PG8_LAS bf16x8*)(lds + PG8_SB(b, h) + boff + n * 2048 + k * 1024); } while (0)
#define PG8_MMA(ai, bj, At, Bt) do { __builtin_amdgcn_s_setprio(1); _Pragma("unroll") for (int m = 0; m < 4; ++m) _Pragma("unroll") for (int n = 0; n < 2; ++n) _Pragma("unroll") for (int k = 0; k < 2; ++k) \
        acc[ai][bj][m][n] = __builtin_amdgcn_mfma_f32_16x16x32_bf16(Bt[n][k], At[m][k], acc[ai][bj][m][n], 0, 0, 0); __builtin_amdgcn_s_setprio(0); } while (0)
#define PG8_WAIT_V(n) asm volatile("s_waitcnt vmcnt(" #n ")" ::: "memory")
#define PG8_WAIT_L(n) asm volatile("s_waitcnt lgkmcnt(" #n ")" ::: "memory")
#define PG8_BAR __builtin_amdgcn_s_barrier()
#define PG8_SCHED __builtin_amdgcn_sched_barrier(0)
#define PG8_APTR(u) ((const char*)g.A + (size_t)(u).pm * tstepA + (((u).pn >= g.asplit_pn) ? (size_t)g.asplit_off * 2 : (size_t)0))
    Unit cur, nxt; int ui = 0;
    if (!S.next(0, cur)) return;
    f32x4 acc[2][2][4][2];
#pragma unroll
    for (int a = 0; a < 2; ++a)
#pragma unroll
        for (int b = 0; b < 2; ++b)
#pragma unroll
            for (int m = 0; m < 4; ++m)
#pragma unroll
                for (int n = 0; n < 2; ++n) acc[a][b][m][n] = (f32x4){0.f, 0.f, 0.f, 0.f};
    bf16x8 At[4][2], B0[2][2], B1[2][2];
    const char* cA = PG8_APTR(cur); const char* cB = (const char*)g.Bt + (size_t)cur.pn * tstepB;
    S.a_ready(cur);
    if constexpr (SP2) {
        PG8_STAGE(PG8_SB(0, 0), cB, voffB); PG8_STAGE(PG8_SB(0, 1), cB + hstepB, voffB); PG8_STAGE(PG8_SA(0, 0), cA, voffA); PG8_STAGE(PG8_SA(0, 1), cA + hstepA, voffA);
        if (wr == 1) PG8_BAR;
        PG8_WAIT_V(2); PG8_BAR;
        PG8_STAGE(PG8_SB(1, 0), cB + kstep, voffB); PG8_STAGE(PG8_SA(1, 0), cA + kstep, voffA); PG8_STAGE(PG8_SB(1, 1), cB + hstepB + kstep, voffB);
        PG8_WAIT_V(6); PG8_BAR;
    } else {
    PG8_STAGE(PG8_SB(0, 0), cB, voffB); PG8_STAGE(PG8_SA(0, 0), cA, voffA); PG8_STAGE(PG8_SB(0, 1), cB + hstepB, voffB); PG8_STAGE(PG8_SA(0, 1), cA + hstepA, voffA);
    if (wr == 1) PG8_BAR;
    PG8_WAIT_V(4); PG8_BAR;
    PG8_STAGE(PG8_SB(1, 0), cB + kstep, voffB); PG8_STAGE(PG8_SA(1, 0), cA + kstep, voffA); PG8_STAGE(PG8_SB(1, 1), cB + hstepB + kstep, voffB);
    PG8_WAIT_V(6); PG8_BAR;
    }
    for (;;) {
        const bool has_next = S.next(ui + 1, nxt);
        const char* nA = has_next ? PG8_APTR(nxt) : cA; const char* nB = has_next ? (const char*)g.Bt + (size_t)nxt.pn * tstepB : cB;
        for (int t = 0; t < nt; t += 2) {
            const bool last = (t == nt - 2);
            const char* a1 = cA + (size_t)(t + 1) * kstep;
            const char* a2 = last ? nA : cA + (size_t)(t + 2) * kstep; const char* b2 = last ? nB : cB + (size_t)(t + 2) * kstep;
            const char* a3 = a2 + kstep; const char* b3 = b2 + kstep;
            if (last && has_next) S.a_ready(nxt);
            if constexpr (SP2) {
            PG8_LDB(B0, 0, 0); PG8_LDB(B1, 0, 1); PG8_SCHED; PG8_LDA(At, 0, 0); PG8_STAGE(PG8_SA(1, 1), a1 + hstepA, voffA);
            PG8_WAIT_V(8); PG8_WAIT_L(0); PG8_BAR; PG8_MMA(0, 0, At, B0); PG8_MMA(0, 1, At, B1); PG8_BAR; PG8_SCHED;
            PG8_LDA(At, 0, 1); PG8_STAGE(PG8_SB(0, 0), b2, voffB); PG8_STAGE(PG8_SB(0, 1), b2 + hstepB, voffB); PG8_STAGE(PG8_SA(0, 0), a2, voffA);
            PG8_WAIT_V(8); PG8_WAIT_L(0); PG8_BAR; PG8_MMA(1, 0, At, B0); PG8_MMA(1, 1, At, B1); PG8_BAR; PG8_SCHED;
            PG8_LDB(B0, 1, 0); PG8_LDB(B1, 1, 1); PG8_SCHED; PG8_LDA(At, 1, 0); PG8_STAGE(PG8_SA(0, 1), a2 + hstepA, voffA);
            PG8_WAIT_V(8); PG8_WAIT_L(0); PG8_BAR; PG8_MMA(0, 0, At, B0); PG8_MMA(0, 1, At, B1); PG8_BAR; PG8_SCHED;
            PG8_LDA(At, 1, 1); PG8_STAGE(PG8_SB(1, 0), b3, voffB); PG8_STAGE(PG8_SB(1, 1), b3 + hstepB, voffB); PG8_STAGE(PG8_SA(1, 0), a3, voffA);
            PG8_WAIT_V(8); PG8_WAIT_L(0); PG8_BAR; PG8_MMA(1, 0, At, B0); PG8_MMA(1, 1, At, B1); PG8_BAR; PG8_SCHED;
            } else {
            PG8_LDB(B0, 0, 0); PG8_SCHED; PG8_LDA(At, 0, 0); PG8_STAGE(PG8_SA(1, 1), a1 + hstepA, voffA);
            PG8_WAIT_L(8); PG8_BAR; PG8_WAIT_L(0); PG8_MMA(0, 0, At, B0); PG8_BAR; PG8_SCHED;
            PG8_LDB(B1, 0, 1); PG8_STAGE(PG8_SB(0, 0), b2, voffB);
            PG8_BAR; PG8_WAIT_L(0); PG8_MMA(0, 1, At, B1); PG8_BAR;
            PG8_LDA(At, 0, 1); PG8_STAGE(PG8_SA(0, 0), a2, voffA);
            PG8_BAR; PG8_WAIT_L(0); PG8_MMA(1, 0, At, B0); PG8_BAR; PG8_SCHED;
            PG8_STAGE(PG8_SB(0, 1), b2 + hstepB, voffB);
            PG8_WAIT_V(6); PG8_BAR; PG8_MMA(1, 1, At, B1); PG8_BAR;
            PG8_LDB(B0, 1, 0); PG8_SCHED; PG8_LDA(At, 1, 0); PG8_STAGE(PG8_SA(0, 1), a2 + hstepA, voffA);
            PG8_WAIT_L(8); PG8_BAR; PG8_WAIT_L(0); PG8_MMA(0, 0, At, B0); PG8_BAR; PG8_SCHED;
            PG8_LDB(B1, 1, 1); PG8_STAGE(PG8_SB(1, 0), b3, voffB);
            PG8_BAR; PG8_WAIT_L(0); PG8_MMA(0, 1, At, B1); PG8_BAR;
            PG8_LDA(At, 1, 1); PG8_STAGE(PG8_SA(1, 0), a3, voffA);
            PG8_BAR; PG8_WAIT_L(0); PG8_MMA(1, 0, At, B0); PG8_BAR; PG8_SCHED;
            PG8_STAGE(PG8_SB(1, 1), b3 + hstepB, voffB);
            PG8_WAIT_V(6); PG8_BAR; PG8_MMA(1, 1, At, B1); PG8_BAR;
            }
        }
        if constexpr (ALIGN_EPI) { if (wr == 0) PG8_BAR; }
        E(acc, cur, wr, wc, fr, fq); S.done(cur);
        if (!has_next) break;
#pragma unroll
        for (int a = 0; a < 2; ++a)
#pragma unroll
            for (int b = 0; b < 2; ++b)
#pragma unroll
                for (int m = 0; m < 4; ++m)
#pragma unroll
                    for (int n = 0; n < 2; ++n) acc[a][b][m][n] = (f32x4){0.f, 0.f, 0.f, 0.f};
        cur = nxt; cA = nA; cB = nB; ++ui;
        if constexpr (ALIGN_EPI) { if (wr == 1) PG8_BAR; }
    }
    PG8_WAIT_V(0);
    if constexpr (!ALIGN_EPI) { if (wr == 0) PG8_BAR; }
    PG8_BAR;
#undef PG8_APTR
#undef PG8_SA
#undef PG8_SB
#undef PG8_STAGE
#undef PG8_LDA
#undef PG8_LDB
#undef PG8_MMA
#undef PG8_WAIT_V
#undef PG8_WAIT_L
#undef PG8_BAR
#undef PG8_SCHED
}
}

using pg8::bf16_t; using pg8::f32x4; using pg8::u32x4; using pg8::u32x2; using pg8::bf16x8;
using pg8::cvt_pk_bf16; using pg8::bf_lo; using pg8::bf_hi;

struct Params {
    const float* x_prompt; const float* x_sample; const float* state_conv; const float* norm_mix; const float* w_in; const float* ln_g; const float* ln_b;
    const float* w_s; const float* b_s; const float* conv_w; const float* w_pa; const float* w_pb; const float* w_o; const float* norm_ffn;
    const float* w_gate; const float* w_up; const float* w_down; const float* norm_final;
    float* out; unsigned char* ws; int ph_lo, ph_hi;
};
constexpr int LDS_BYTES = pg8::STAGE_BYTES + 256;
constexpr int NPHASE = 2 + 7 * NL;

__device__ __forceinline__ void transpose_tile(const float* __restrict__ src, int ld, int k0, int col0, const float* __restrict__ scale, bf16_t* __restrict__ dst, int K, float* t, int tid) {
    const int r = tid >> 4, c4 = tid & 15;
#pragma unroll
    for (int pass = 0; pass < 2; ++pass) { const int k = r + 32 * pass; const f32x4 v = *(const f32x4*)(src + (size_t)(k0 + k) * ld + col0 + 4 * c4); const float s = scale ? scale[k0 + k] : 1.0f;
        t[k * 65 + 4 * c4 + 0] = v[0] * s; t[k * 65 + 4 * c4 + 1] = v[1] * s; t[k * 65 + 4 * c4 + 2] = v[2] * s; t[k * 65 + 4 * c4 + 3] = v[3] * s; }
    __syncthreads();
    const int n = tid >> 3, kc = tid & 7; u32x4 w;
    w.x = cvt_pk_bf16(t[(8 * kc + 0) * 65 + n], t[(8 * kc + 1) * 65 + n]); w.y = cvt_pk_bf16(t[(8 * kc + 2) * 65 + n], t[(8 * kc + 3) * 65 + n]);
    w.z = cvt_pk_bf16(t[(8 * kc + 4) * 65 + n], t[(8 * kc + 5) * 65 + n]); w.w = cvt_pk_bf16(t[(8 * kc + 6) * 65 + n], t[(8 * kc + 7) * 65 + n]);
    *(u32x4*)(dst + (size_t)n * K + k0 + 8 * kc) = w;
    __syncthreads();
}
constexpr int IT_WIN = (NIN / 64) * 16, IT_WPAB = 32 * 16, IT_WO = 16 * 16, IT_WGU = (2 * DFF / 64) * 16, IT_WD = 16 * (DFF / 64), IT_LAYER = IT_WIN + IT_WPAB + IT_WO + IT_WGU + IT_WD;

__device__ __forceinline__ void p0_prologue(const Params& p, float* ldsf) {
    unsigned char* ws = p.ws;
    float* ssqm = (float*)(ws + WS_SSQM);
    int tid = threadIdx.x; asm volatile("" : "+v"(tid));
    const int G = gridDim.x, b = blockIdx.x;
    for (int it = b; it < NL * IT_LAYER; it += G) {
        const int l = it / IT_LAYER; int r = it % IT_LAYER; unsigned char* lw = ws + WS_W + (size_t)l * LW_BYTES;
        if (r < IT_WIN) { const int ntile = r >> 4, kt = r & 15, n0 = ntile * 64; int col;
            if (n0 < 3072) col = n0; else if (n0 < 5120) { const int t = n0 - 3072; col = ((t & 128) ? 4096 : 3072) + (t >> 8) * 128 + (t & 127); } else { const int t = n0 - 5120; col = ((t & 128) ? 6144 : 5120) + (t >> 8) * 128 + (t & 127); }
            transpose_tile(p.w_in + (size_t)l * DM * NIN, NIN, kt * 64, col, p.norm_mix + l * DM, (bf16_t*)(lw + LW_WIN) + (size_t)n0 * DM, DM, ldsf, tid); continue; }
        r -= IT_WIN;
        if (r < IT_WPAB) { const int ntile = r >> 4, kt = r & 15, n0 = ntile * 64;
            const float* src = (n0 < 1024) ? p.w_pa + (size_t)l * DM * DM : p.w_pb + (size_t)l * DM * DM;
            transpose_tile(src, DM, kt * 64, n0 & 1023, nullptr, (bf16_t*)(lw + LW_WPAB) + (size_t)n0 * DM, DM, ldsf, tid); continue; }
        r -= IT_WPAB;
        if (r < IT_WO) { const int ntile = r >> 4, kt = r & 15, n0 = ntile * 64;
            transpose_tile(p.w_o + (size_t)l * DM * DM, DM, kt * 64, n0, nullptr, (bf16_t*)(lw + LW_WO) + (size_t)n0 * DM, DM, ldsf, tid); continue; }
        r -= IT_WO;
        if (r < IT_WGU) { const int ntile = r >> 4, kt = r & 15, n0 = ntile * 64;
            const float* src = ((n0 & 128) ? p.w_up : p.w_gate) + (size_t)l * DM * DFF; const int col = (n0 >> 8) * 128 + (n0 & 127);
            transpose_tile(src, DFF, kt * 64, col, p.norm_ffn + l * DM, (bf16_t*)(lw + LW_WGU) + (size_t)n0 * DM, DM, ldsf, tid); continue; }
        r -= IT_WGU;
        { const int ntile = r / (DFF / 64), kt = r % (DFF / 64), n0 = ntile * 64;
            transpose_tile(p.w_down + (size_t)l * DFF * DM, DM, kt * 64, n0, nullptr, (bf16_t*)(lw + LW_WD) + (size_t)n0 * DFF, DFF, ldsf, tid); }
    }
    for (int i = b * 512 + tid; i < NL * 8 * 128 * 128; i += G * 512) {
        const int l = i >> 17, rem = i & 131071, ii = (rem >> 7) & 127, jj = rem & 127;
        const float* wsrc = p.w_s + (size_t)(i - rem);
        const int grp = rem >> 14;
        unsigned char* lw = ws + WS_W + (size_t)l * LW_BYTES;
        const float vp = (jj <= ii) ? p.w_s[i] : 0.f;
        const float vs = ((ii >> 5) == (jj >> 5) && (jj & 31) <= (ii & 31)) ? wsrc[grp * 16384 + (ii & 31) * 128 + (jj & 31)] : 0.f;
        ((bf16_t*)(lw + LW_WSP))[rem] = (bf16_t)(cvt_pk_bf16(vp, 0.f) & 0xffffu);
        ((bf16_t*)(lw + LW_WSS))[rem] = (bf16_t)(cvt_pk_bf16(vs, 0.f) & 0xffffu);
    }
    { const int wave = tid >> 6, lane = tid & 63; bf16_t* xb = (bf16_t*)(ws + WS_XB);
      for (int row = b * 8 + wave; row < MT; row += 2 * G * 8) {
          const int row2 = row + G * 8; const bool has2 = row2 < MT;
          const float* xr = (row < MP) ? p.x_prompt + (size_t)row * DM : p.x_sample + (size_t)(row - MP) * DM;
          const float* xr2 = has2 ? ((row2 < MP) ? p.x_prompt + (size_t)row2 * DM : p.x_sample + (size_t)(row2 - MP) * DM) : xr;
          f32x4 v[4], v2[4];
#pragma unroll
          for (int j = 0; j < 4; ++j) { v[j] = *(const f32x4*)(xr + 4 * (lane + 64 * j)); v2[j] = *(const f32x4*)(xr2 + 4 * (lane + 64 * j)); }
          float q = 0.f, q2 = 0.f;
#pragma unroll
          for (int j = 0; j < 4; ++j) { q += (v[j][0] * v[j][0] + v[j][1] * v[j][1]) + (v[j][2] * v[j][2] + v[j][3] * v[j][3]); q2 += (v2[j][0] * v2[j][0] + v2[j][1] * v2[j][1]) + (v2[j][2] * v2[j][2] + v2[j][3] * v2[j][3]);
              u32x2 w; w.x = cvt_pk_bf16(v[j][0], v[j][1]); w.y = cvt_pk_bf16(v[j][2], v[j][3]); *(u32x2*)(xb + (size_t)row * DM + 4 * (lane + 64 * j)) = w;
              if (has2) { u32x2 w2; w2.x = cvt_pk_bf16(v2[j][0], v2[j][1]); w2.y = cvt_pk_bf16(v2[j][2], v2[j][3]); *(u32x2*)(xb + (size_t)row2 * DM + 4 * (lane + 64 * j)) = w2; } }
#pragma unroll
          for (int o = 32; o >= 1; o >>= 1) { q += __shfl_xor(q, o); q2 += __shfl_xor(q2, o); }
          if (lane < 4) { ((f32x4*)(ssqm + (size_t)row * 16))[lane] = (f32x4){lane == 0 ? q : 0.f, 0.f, 0.f, 0.f};
              if (has2) ((f32x4*)(ssqm + (size_t)row2 * 16))[lane] = (f32x4){lane == 0 ? q2 : 0.f, 0.f, 0.f, 0.f}; }
      } }
}

constexpr int VT_PITCH = 136;
__device__ __forceinline__ void gate_conv_phase(const Params& p, int l, unsigned char* lds) {
    unsigned char* ws = p.ws;
    const float* lns = (const float*)(ws + WS_LNS);
    bf16_t* AB = (bf16_t*)(ws + WS_AB); const bf16_t* GV = (const bf16_t*)(ws + WS_GV); const bf16_t* CH = (const bf16_t*)(ws + WS_CH);
    const unsigned char* lw = ws + WS_W + (size_t)l * LW_BYTES;
    bf16_t* vT = (bf16_t*)lds;
    float* mr = (float*)(lds + 128 * VT_PITCH * 2);
    int tid = threadIdx.x; asm volatile("" : "+v"(tid));
    const int lane = tid & 63, w = tid >> 6, fr = lane & 15, fq = lane >> 4;
    const int jg = tid >> 5, cq = tid & 31;
    const int ci = tid & 15;
    const int nks = (w >> 1) + 1;
    const int total = (MT / 128) * 8;
    int item = blockIdx.x; if (item >= total) return;
    const int g = item & 7, c0 = g * 128, irow = 16 * w + fr;
    const bf16_t* WsP = (const bf16_t*)(lw + LW_WSP) + g * 16384 + irow * 128 + 8 * fq;
    bf16x8 wf[4];
#pragma unroll
    for (int ks = 0; ks < 4; ++ks) wf[ks] = *(const bf16x8*)(WsP + 32 * ks);
    float bs = p.b_s[(l * 8 + g) * 128 + irow];
    const float* cwp = p.conv_w + (size_t)l * 3 * DM + c0 + 8 * ci;
    bool was_smp = false;
    f32x4 sl0, sl1; u32x2 gv[8]; u32x4 uu[4];
#define GC_LOAD(it) do { const int r0_ = ((it) >> 3) * 128; \
        const f32x4* sl_ = (const f32x4*)(lns + (size_t)(r0_ + (tid >> 2)) * 32 + (tid & 3) * 8); sl0 = sl_[0]; sl1 = sl_[1]; \
        _Pragma("unroll") for (int jj = 0; jj < 8; ++jj) gv[jj] = *(const u32x2*)(GV + (size_t)(r0_ + 8 * jg + jj) * DM + c0 + 4 * cq); } while (0)
#define GC_LOADU(it) do { const int r0_ = ((it) >> 3) * 128; \
        _Pragma("unroll") for (int pp = 0; pp < 4; ++pp) uu[pp] = *(const u32x4*)(AB + (size_t)(r0_ + irow) * 2048 + c0 + 8 * fq + 32 * pp); } while (0)
    GC_LOAD(item); GC_LOADU(item);
    for (;;) {
        const int ct = item >> 3, row0 = ct * 128; const bool smp = ct >= MP / 128;
        if (smp && !was_smp) {
            const bf16_t* WsS = (const bf16_t*)(lw + LW_WSS) + g * 16384 + irow * 128 + 8 * fq;
#pragma unroll
            for (int ks = 0; ks < 4; ++ks) wf[ks] = *(const bf16x8*)(WsS + 32 * ks);
            bs = p.b_s[(l * 8 + g) * 128 + (irow & 31)]; was_smp = true; }
        bf16_t* rowp = AB + (size_t)(row0 + irow) * 2048 + c0 + 8 * fq;
        const f32x4 lg = *(const f32x4*)(p.ln_g + l * DM + c0 + 4 * cq), lb = *(const f32x4*)(p.ln_b + l * DM + c0 + 4 * cq);
        { float sm = (sl0[0] + sl0[2]) + (sl1[0] + sl1[2]), sq = (sl0[1] + sl0[3]) + (sl1[1] + sl1[3]);
          sm += __shfl_xor(sm, 1); sq += __shfl_xor(sq, 1); sm += __shfl_xor(sm, 2); sq += __shfl_xor(sq, 2);
          if ((tid & 3) == 0) { const float mean = sm * (1.0f / 1024.0f), var = sq * (1.0f / 1024.0f) - mean * mean; mr[2 * (tid >> 2)] = mean; mr[2 * (tid >> 2) + 1] = __builtin_amdgcn_rsqf(fmaxf(var, 0.f) + EPS); } }
        __syncthreads();
        { float v[8][4];
#pragma unroll
          for (int jj = 0; jj < 8; ++jj) { const float mean = mr[2 * (8 * jg + jj)], rstd = mr[2 * (8 * jg + jj) + 1];
              v[jj][0] = (bf_lo(gv[jj].x) - mean) * rstd * lg[0] + lb[0]; v[jj][1] = (bf_hi(gv[jj].x) - mean) * rstd * lg[1] + lb[1];
              v[jj][2] = (bf_lo(gv[jj].y) - mean) * rstd * lg[2] + lb[2]; v[jj][3] = (bf_hi(gv[jj].y) - mean) * rstd * lg[3] + lb[3];
              if (smp) *(f32x4*)(p.out + OUT_V + ((size_t)l * MS + (row0 + 8 * jg + jj - MP)) * DM + c0 + 4 * cq) = (f32x4){v[jj][0], v[jj][1], v[jj][2], v[jj][3]}; }
#pragma unroll
          for (int e = 0; e < 4; ++e) { u32x4 wv; wv.x = cvt_pk_bf16(v[0][e], v[1][e]); wv.y = cvt_pk_bf16(v[2][e], v[3][e]); wv.z = cvt_pk_bf16(v[4][e], v[5][e]); wv.w = cvt_pk_bf16(v[6][e], v[7][e]);
              *(u32x4*)(vT + (4 * cq + e) * VT_PITCH + 8 * jg) = wv; } }
        u32x4 ch0[4], ch1[4], ch2[4], bg[4];
#pragma unroll
        for (int vv = 0; vv < 4; ++vv) { const int i = (tid >> 4) + 32 * vv, row = row0 + i, c = c0 + 8 * ci; const int pos = smp ? ((row - MP) & 31) : (row & 2047);
            const u32x4 z4 = {0u, 0u, 0u, 0u};
            ch0[vv] = *(const u32x4*)(CH + (size_t)row * DM + c);
            ch1[vv] = (pos >= 1) ? *(const u32x4*)(CH + (size_t)(row - 1) * DM + c) : z4;
            ch2[vv] = (pos >= 2) ? *(const u32x4*)(CH + (size_t)(row - 2) * DM + c) : z4;
            bg[vv] = *(const u32x4*)(AB + (size_t)row * 2048 + 1024 + c); }
        const int nitem = item + (int)gridDim.x; const bool has_next = nitem < total;
        if (has_next) GC_LOAD(nitem);
        __syncthreads();
        { f32x4 acc[8];
#pragma unroll
          for (int dt = 0; dt < 8; ++dt) acc[dt] = (f32x4){0.f, 0.f, 0.f, 0.f};
#pragma unroll
          for (int ks = 0; ks < 4; ++ks) if (ks < nks) {
#pragma unroll
              for (int dt = 0; dt < 8; ++dt) { const int d = 32 * (dt >> 1) + 8 * (fr >> 2) + 4 * (dt & 1) + (fr & 3);
                  const bf16x8 vf = *(const bf16x8*)(vT + d * VT_PITCH + 32 * ks + 8 * fq);
                  acc[dt] = __builtin_amdgcn_mfma_f32_16x16x32_bf16(vf, wf[ks], acc[dt], 0, 0, 0); } }
#pragma unroll
          for (int pp = 0; pp < 4; ++pp) { const f32x4 s0 = acc[2 * pp] + bs, s1 = acc[2 * pp + 1] + bs;
              const f32x4 u0 = {bf_lo(uu[pp][0]), bf_hi(uu[pp][0]), bf_lo(uu[pp][1]), bf_hi(uu[pp][1])}, u1 = {bf_lo(uu[pp][2]), bf_hi(uu[pp][2]), bf_lo(uu[pp][3]), bf_hi(uu[pp][3])};
              *(u32x4*)(rowp + 32 * pp) = pg8::pack8(u0 * s0, u1 * s1); } }
        if (has_next) GC_LOADU(nitem);
        const f32x4 w0a = *(const f32x4*)(cwp), w0b = *(const f32x4*)(cwp + 4), w1a = *(const f32x4*)(cwp + DM), w1b = *(const f32x4*)(cwp + DM + 4), w2a = *(const f32x4*)(cwp + 2 * DM), w2b = *(const f32x4*)(cwp + 2 * DM + 4);
#pragma unroll
        for (int vv = 0; vv < 4; ++vv) { const int i = (tid >> 4) + 32 * vv, row = row0 + i, c = c0 + 8 * ci; const int pos = smp ? ((row - MP) & 31) : (row & 2047);
            float f0[8], f1[8], f2[8], o[8];
#pragma unroll
            for (int e = 0; e < 4; ++e) { f0[2 * e] = bf_lo(ch0[vv][e]); f0[2 * e + 1] = bf_hi(ch0[vv][e]); f1[2 * e] = bf_lo(ch1[vv][e]); f1[2 * e + 1] = bf_hi(ch1[vv][e]); f2[2 * e] = bf_lo(ch2[vv][e]); f2[2 * e + 1] = bf_hi(ch2[vv][e]); }
            if (smp && pos < 2) { const int sq = (row - MP) >> 5; const float* stp = p.state_conv + ((size_t)(l * 32 + sq) * 2) * DM + c;
                if (pos == 0) { const f32x4 a = *(const f32x4*)(stp + DM), bq = *(const f32x4*)(stp + DM + 4); f1[0] = a[0]; f1[1] = a[1]; f1[2] = a[2]; f1[3] = a[3]; f1[4] = bq[0]; f1[5] = bq[1]; f1[6] = bq[2]; f1[7] = bq[3]; }
                { const float* s2 = stp + (pos == 0 ? 0 : DM); const f32x4 a = *(const f32x4*)(s2), bq = *(const f32x4*)(s2 + 4); f2[0] = a[0]; f2[1] = a[1]; f2[2] = a[2]; f2[3] = a[3]; f2[4] = bq[0]; f2[5] = bq[1]; f2[6] = bq[2]; f2[7] = bq[3]; } }
#pragma unroll
            for (int e = 0; e < 4; ++e) { o[e] = w0a[e] * f2[e] + w1a[e] * f1[e] + w2a[e] * f0[e]; o[4 + e] = w0b[e] * f2[4 + e] + w1b[e] * f1[4 + e] + w2b[e] * f0[4 + e]; }
            u32x4 ov;
#pragma unroll
            for (int e = 0; e < 4; ++e) ov[e] = cvt_pk_bf16(o[2 * e] * bf_lo(bg[vv][e]), o[2 * e + 1] * bf_hi(bg[vv][e]));
            *(u32x4*)(AB + (size_t)row * 2048 + 1024 + c) = ov;
            const int lastpos = smp ? 31 : 2047;
            if (pos >= lastpos - 1) { float* op = smp ? p.out + OUT_NCS + (((size_t)l * 32 + ((row - MP) >> 5)) * 2 + (pos - (lastpos - 1))) * DM + c
                                                      : p.out + OUT_NCP + (((size_t)l * 32 + (row >> 11)) * 2 + (pos - (lastpos - 1))) * DM + c;
                *(f32x4*)op = (f32x4){f0[0], f0[1], f0[2], f0[3]}; *(f32x4*)(op + 4) = (f32x4){f0[4], f0[5], f0[6], f0[7]}; } }
        __syncthreads();
        if (!has_next) break;
        item = nitem;
    }
#undef GC_LOAD
#undef GC_LOADU
}

__device__ __forceinline__ void final_norm_phase(const Params& p) {
    const float* __restrict__ ssq = (const float*)(p.ws + WS_SSQM); const bf16_t* __restrict__ xb = (const bf16_t*)(p.ws + WS_XB); float* __restrict__ out = p.out;
    const size_t n8 = (size_t)MT * DM / 8;
    int tid = threadIdx.x; asm volatile("" : "+v"(tid));
    const size_t stride = (size_t)gridDim.x * 512;
    const int c = (tid & 127) * 8;
    const f32x4 g0 = *(const f32x4*)(p.norm_final + c), g1 = *(const f32x4*)(p.norm_final + c + 4);
    for (size_t i = (size_t)blockIdx.x * 512 + tid; i < n8; i += 4 * stride) {
        u32x4 w[4]; f32x4 s0[4], s1[4], s2[4], s3[4];
#pragma unroll
        for (int k = 0; k < 4; ++k) { const size_t ii = i + k * stride; if (ii < n8) { w[k] = *(const u32x4*)(xb + ii * 8); const f32x4* s = (const f32x4*)(ssq + (ii >> 7) * 16); s0[k] = s[0]; s1[k] = s[1]; s2[k] = s[2]; s3[k] = s[3]; } }
#pragma unroll
        for (int k = 0; k < 4; ++k) { const size_t ii = i + k * stride; if (ii < n8) { const f32x4 t = (s0[k] + s1[k]) + (s2[k] + s3[k]);
            const float rs = __builtin_amdgcn_rsqf(((t[0] + t[1]) + (t[2] + t[3])) * (1.0f / 1024.0f) + EPS);
            ((f32x4*)out)[2 * ii] = pg8::unpk_lo(w[k]) * rs * g0; ((f32x4*)out)[2 * ii + 1] = pg8::unpk_hi(w[k]) * rs * g1; } }
    }
}

#define LAS __attribute__((address_space(3)))
#define XB_TMO      128
#define XB_XCNT(j)  (256  + 64 * (j))
#define XB_XSUB(j)  (1280 + 64 * (j))
#define XB_XGEN(j)  (2304 + 64 * (j))
#define XB_TOP      3328
#define XB_TOPGEN   3392
#define XCD_BAR_WORDS 3456
#define XB_SPIN_CAP (1u << 18)

__device__ __forceinline__ unsigned xb_ld(unsigned* p)              { return __hip_atomic_load(p, __ATOMIC_RELAXED, __HIP_MEMORY_SCOPE_AGENT); }
__device__ __forceinline__ unsigned xb_add(unsigned* p, unsigned v) { return __hip_atomic_fetch_add(p, v, __ATOMIC_RELAXED, __HIP_MEMORY_SCOPE_AGENT); }
__device__ __forceinline__ unsigned xb_xcc_id() { return (unsigned)__builtin_amdgcn_s_getreg((3 << 11) | 20) & 0xFu; }
#define XB_SPIN(cond, bar) do { unsigned _sp = 0; while (cond) { __builtin_amdgcn_s_sleep(1); \
    if ((++_sp & 255u) == 0u) { if (xb_ld(&(bar)[XB_TMO])) break; if (_sp > XB_SPIN_CAP) { atomicAdd(&(bar)[XB_TMO], 1u); break; } } } } while (0)

struct XcdBarrier {
    unsigned* bar; unsigned x;
    volatile LAS unsigned* st;
};

__device__ __forceinline__ XcdBarrier xcd_barrier_post(unsigned* bar, volatile LAS unsigned* st) {
    XcdBarrier b; b.bar = bar; b.x = xb_xcc_id(); b.st = st;
    if (threadIdx.x == 0) (void)xb_add(&bar[XB_XCNT(b.x)], 1u);
    return b;
}
__device__ __forceinline__ void xcd_barrier_complete(unsigned* bar, unsigned x, unsigned& nloc, unsigned& nx) {
    const unsigned G = gridDim.x * gridDim.y * gridDim.z;
    unsigned sum, cnt, mine, sp = 0u;
    for (;;) {
        sum = 0u; cnt = 0u; mine = 0u;
#pragma unroll
        for (unsigned j = 0; j < 16; ++j) { const unsigned c = xb_ld(&bar[XB_XCNT(j)]); sum += c; cnt += (c > 0u) ? 1u : 0u; mine = (j == x) ? c : mine; }
        if (sum == G) break;
        __builtin_amdgcn_s_sleep(1);
        if ((++sp & 255u) == 0u) { if (xb_ld(&bar[XB_TMO])) break; if (sp > XB_SPIN_CAP) { atomicAdd(&bar[XB_TMO], 1u); break; } }
    }
    nloc = mine > 0u ? mine : 1u; nx = cnt > 0u ? cnt : 1u;
}

__device__ __forceinline__ void xcd_barrier(const XcdBarrier& b) {
    asm volatile("s_waitcnt vmcnt(0)" ::: "memory");
    __syncthreads();
    if (threadIdx.x == 0) {
        unsigned* bar = b.bar;
        __builtin_amdgcn_s_waitcnt(0);
        unsigned nloc = b.st[0], nx = b.st[1];
        if (nloc == 0u) { xcd_barrier_complete(bar, b.x, nloc, nx); b.st[0] = nloc; b.st[1] = nx; }
        const unsigned old = xb_add(&bar[XB_XSUB(b.x)], 1u);
        const unsigned gen = old / nloc;
        if (old + 1u == (gen + 1u) * nloc) {
            __builtin_amdgcn_fence(__ATOMIC_RELEASE, "agent");
            asm volatile("s_waitcnt vmcnt(0)" ::: "memory");
            const unsigned og = xb_add(&bar[XB_TOP], 1u);
            const unsigned tg = og / nx;
            if (og + 1u == (tg + 1u) * nx) xb_add(&bar[XB_TOPGEN], 1u);
            else XB_SPIN(xb_ld(&bar[XB_TOPGEN]) == tg, bar);
            __builtin_amdgcn_fence(__ATOMIC_ACQUIRE, "agent");
            xb_add(&bar[XB_XGEN(b.x)], 1u);
            asm volatile("s_waitcnt vmcnt(0)" ::: "memory");
        } else {
            XB_SPIN(xb_ld(&bar[XB_XGEN(b.x)]) == gen, bar);
            __builtin_amdgcn_fence(__ATOMIC_ACQUIRE, "agent");
            asm volatile("s_waitcnt vmcnt(0)" ::: "memory");
        }
    }
    __syncthreads();
}

__global__ void __launch_bounds__(512, 2) mk_fwd(Params p) {
    extern __shared__ __attribute__((aligned(16))) unsigned char lds[];
    unsigned char* ws = p.ws;
    float* ssq_mix = (float*)(ws + WS_SSQM); float* ssq_ffn = (float*)(ws + WS_SSQF); float* lns = (float*)(ws + WS_LNS);
    bf16_t* XB = (bf16_t*)(ws + WS_XB); bf16_t* AB = (bf16_t*)(ws + WS_AB); bf16_t* GV = (bf16_t*)(ws + WS_GV); bf16_t* CH = (bf16_t*)(ws + WS_CH);
    bf16_t* T12 = GV; bf16_t* MMb = AB; bf16_t* Hb = AB;
    const int G = gridDim.x, c = blockIdx.x;
    PG8_LAS unsigned char* ring = (PG8_LAS unsigned char*)lds;
#if MK_MULTI
#define GRID_SYNC() do { } while (0)
#else
    cg::grid_group grid = cg::this_grid();
    volatile LAS unsigned* bst = (volatile LAS unsigned*)((LAS unsigned char*)lds + pg8::STAGE_BYTES);
    if (threadIdx.x < 2) bst[threadIdx.x] = 0u;
    __syncthreads();
    XcdBarrier xbar = xcd_barrier_post((unsigned*)(ws + WS_CTL), bst);
#define GRID_SYNC() do { if (ph == 0) grid.sync(); else xcd_barrier(xbar); } while (0)
#endif
    for (int ph = p.ph_lo; ph < p.ph_hi; ++ph) {
        if (ph == 0) { if (PHASE_MASK & 1) { if (PROBE_DUP & 512) p0_prologue(p, (float*)lds); p0_prologue(p, (float*)lds); } }
        else if (ph == NPHASE - 1) { if (PHASE_MASK & 2) final_norm_phase(p); }
        else {
            const int l = (ph - 1) / 7, s = (ph - 1) % 7;
            for (int rep_ = 0; rep_ < (((PROBE_DUP >> s) & 1) ? 2 : 1); ++rep_) {
            const unsigned char* lw = ws + WS_W + (size_t)l * LW_BYTES;
            if (s == 0) { if (PHASE_MASK & 4) {
                pg8::Gemm g{XB, (const bf16_t*)(lw + LW_WIN), MT, 5120, DM, DM, 1 << 30, 0}; pg8::StaticOrder S; S.init(MT, 5120, G, c);
                pg8::EpiA E{AB, GV, CH, ssq_mix, lns};
                pg8::gemm_phase<pg8::EpiA, pg8::StaticOrder>(ring, g, S, E); }
            } else if (s == 1) {
                if (PHASE_MASK & 8) gate_conv_phase(p, l, lds);
            } else if (s == 2) { if (PHASE_MASK & 16) {
                pg8::Gemm g{AB, (const bf16_t*)(lw + LW_WPAB), MT, 2048, DM, 2048, 4, 1024}; pg8::StaticOrder S; S.init(MT, 2048, G, c);
                pg8::EpiC E{T12};
                pg8::gemm_phase<pg8::EpiC, pg8::StaticOrder>(ring, g, S, E); }
            } else if (s == 3) { if (PHASE_MASK & 32) {
                pg8::Gemm g{XB, (const bf16_t*)(lw + LW_WIN) + (size_t)5120 * DM, MT, 2048, DM, DM, 1 << 30, 0}; pg8::StaticOrder S; S.init(MT, 2048, G, c);
                pg8::EpiD E{T12, MMb, ssq_mix};
                pg8::gemm_phase<pg8::EpiD, pg8::StaticOrder>(ring, g, S, E); }
            } else if (s == 4) { if (PHASE_MASK & 64) {
                pg8::Gemm g{MMb, (const bf16_t*)(lw + LW_WO), MT, DM, DM, DM, 1 << 30, 0}; pg8::StaticOrder S; S.init(MT, DM, G, c);
                pg8::EpiRes E{XB, ssq_ffn};
                pg8::gemm_phase<pg8::EpiRes, pg8::StaticOrder>(ring, g, S, E); }
            } else if (s == 5) { if (PHASE_MASK & 128) {
                pg8::Gemm g{XB, (const bf16_t*)(lw + LW_WGU), MT, 2 * DFF, DM, DM, 1 << 30, 0}; pg8::StaticOrder S; S.init(MT, 2 * DFF, G, c);
                pg8::EpiF E{Hb, ssq_ffn};
                pg8::gemm_phase<pg8::EpiF, pg8::StaticOrder>(ring, g, S, E); }
            } else { if (PHASE_MASK & 256) {
                pg8::Gemm g{Hb, (const bf16_t*)(lw + LW_WD), MT, DM, DFF, DFF, 1 << 30, 0}; pg8::StaticOrder S; S.init(MT, DM, G, c);
                pg8::EpiRes E{XB, ssq_mix};
                pg8::gemm_phase<pg8::EpiRes, pg8::StaticOrder>(ring, g, S, E); }
            }
            }
        }
        if (ph + 1 < p.ph_hi) { GRID_SYNC(); }
    }
}

extern "C" void kernel_launch(void* const* d_in, const int* in_sizes, int n_in, void* d_out, int out_size, void* d_ws, size_t ws_size, hipStream_t stream) {
    static int grid = 0;
    if (grid == 0) {
        if (n_in != 18 || in_sizes[0] != MP * DM || (size_t)out_size != OUT_TOTAL || ws_size < WS_END) {
            fprintf(stderr, "kernel_launch: unexpected shapes: n_in %d in0 %d out %d ws %zu (need %zu)\n", n_in, n_in > 0 ? in_sizes[0] : -1, out_size, ws_size, (size_t)WS_END); grid = -1; return; }
        int dev = 0, cus = 0, per_cu = 0;
        (void)hipGetDevice(&dev); (void)hipDeviceGetAttribute(&cus, hipDeviceAttributeMultiprocessorCount, dev);
        if (hipFuncSetAttribute((const void*)mk_fwd, hipFuncAttributeMaxDynamicSharedMemorySize, LDS_BYTES) != hipSuccess) { fprintf(stderr, "kernel_launch: hipFuncSetAttribute failed\n"); grid = -1; return; }
        if (hipOccupancyMaxActiveBlocksPerMultiprocessor(&per_cu, (const void*)mk_fwd, 512, LDS_BYTES) != hipSuccess || per_cu < 1) { fprintf(stderr, "kernel_launch: occupancy query says %d\n", per_cu); per_cu = 1; }
        (void)hipGetLastError();
        grid = cus * 1;
        fprintf(stderr, "kernel_launch: cus %d per_cu %d grid %d\n", cus, per_cu, grid);
    }
    if (grid < 0) return;
    if (hipMemsetAsync((char*)d_ws + WS_CTL, 0, CTL_BYTES, stream) != hipSuccess) { fprintf(stderr, "kernel_launch: memset failed\n"); return; }
    Params p{};
    const float** pp = (const float**)&p;
    for (int i = 0; i < 18; ++i) pp[i] = (const float*)d_in[i];
    p.out = (float*)d_out; p.ws = (unsigned char*)d_ws;
#if MK_MULTI
    for (int ph = 0; ph < NPHASE; ++ph) { p.ph_lo = ph; p.ph_hi = ph + 1; hipLaunchKernelGGL(mk_fwd, dim3(grid), dim3(512), LDS_BYTES, stream, p); }
#else
    p.ph_lo = 0; p.ph_hi = NPHASE;
    void* args[] = {&p};
    hipError_t e = hipLaunchCooperativeKernel((const void*)mk_fwd, dim3(grid), dim3(512), args, LDS_BYTES, stream);
    if (e != hipSuccess) fprintf(stderr, "kernel_launch: cooperative launch failed: %s (grid %d)\n", hipGetErrorString(e), grid);
#endif
}
```

```cpp
#include <hip/hip_runtime.h>
#include <hip/hip_cooperative_groups.h>
#include <cstdio>
#include <cstdint>
namespace cg = cooperative_groups;

#ifndef PHASE_MASK
#define PHASE_MASK 511
#endif
#ifndef PROBE_DUP
#define PROBE_DUP 0
#endif
#ifndef MK_MULTI
#define MK_MULTI 0
#endif

constexpr int MP = 65536, MS = 1024, MT = MP + MS, DM = 1024, NL = 4, DFF = 2816, NIN = 7168;
constexpr float EPS = 1e-6f;
constexpr size_t OUT_YS = (size_t)MP * DM, OUT_NCP = OUT_YS + (size_t)MS * DM, OUT_NCS = OUT_NCP + (size_t)NL * 32 * 2 * DM, OUT_V = OUT_NCS + (size_t)NL * 32 * 2 * DM;
constexpr size_t OUT_TOTAL = OUT_V + (size_t)NL * 32 * 32 * DM;

constexpr size_t MiB = (size_t)1 << 20;
constexpr size_t WS_SSQM = 0, WS_SSQF = 5 * MiB, WS_LNS = 10 * MiB;
constexpr size_t WS_CTL = 20 * MiB, CTL_BYTES = 16384;
constexpr size_t WS_W = 24 * MiB;
constexpr size_t LW_WIN = 0, LW_WPAB = LW_WIN + (size_t)NIN * DM * 2, LW_WO = LW_WPAB + (size_t)2048 * DM * 2, LW_WGU = LW_WO + (size_t)DM * DM * 2,
                 LW_WD = LW_WGU + (size_t)2 * DFF * DM * 2, LW_WSP = LW_WD + (size_t)DM * DFF * 2, LW_WSS = LW_WSP + (size_t)8 * 128 * 128 * 2, LW_BYTES = LW_WSS + (size_t)8 * 128 * 128 * 2;
constexpr size_t WS_XB = 176 * MiB;
constexpr size_t WS_AB = 306 * MiB;
constexpr size_t WS_GV = 566 * MiB;
constexpr size_t WS_CH = 696 * MiB;
constexpr size_t WS_END = 826 * MiB;
static_assert(WS_W + NL * LW_BYTES <= WS_XB, "weights overflow");

namespace pg8 {
#define PG8_LAS __attribute__((address_space(3)))
typedef unsigned short bf16_t;
typedef short bf16x8 __attribute__((ext_vector_type(8)));
typedef float f32x4 __attribute__((ext_vector_type(4)));
typedef float f32x2 __attribute__((ext_vector_type(2)));
typedef unsigned u32x4 __attribute__((ext_vector_type(4)));
typedef unsigned u32x2 __attribute__((ext_vector_type(2)));
constexpr int BM = 256, BK = 64, HALF = 128, HTB = HALF * BK * 2, STAGE_BYTES = 8 * HTB, NXCD = 8, WGM = 8;

__host__ __device__ __forceinline__ int lds_byte(int r, int c) { const int st = (r >> 4) * 2 + (c >> 5), rr = r & 15, cc = c & 31, ob = rr * 64 + cc * 2; return st * 1024 + (ob ^ (((ob >> 9) & 1) << 5)); }
__host__ __device__ __forceinline__ void stage_rc(int b, int& R, int& C) { const int st = b / 1024, sb = b % 1024, swz = sb ^ (((sb >> 9) & 1) << 5); R = (st >> 1) * 16 + swz / 64; C = (st & 1) * 32 + (swz % 64) / 2; }
__host__ __device__ __forceinline__ int perm32(int rho) { const int n = rho >> 4, i = rho & 15; return 8 * (i >> 2) + 4 * n + (i & 3); }

struct Unit { int pm, pn, half, rbase; };
struct Gemm { const bf16_t* A; const bf16_t* Bt; int M, N, K, lda, asplit_pn, asplit_off; };

struct StaticOrder {
    int nM, nN, nwg, G, c, ntot;
    __host__ __device__ void init(int M, int N, int G_, int c_) { nM = MP / BM; nN = N / BM; nwg = nM * nN; G = G_; c = c_; ntot = nwg + 2 * ((M / BM) - nM) * nN; }
    __host__ __device__ bool next(int i, Unit& u) const {
        const long L = (long)i * G + c; if (L >= ntot) return false;
        if (L >= nwg) { const int h = (int)L - nwg, hp = h / nN; u.pn = h - hp * nN; u.pm = nM + (hp >> 1); u.half = 1; u.rbase = u.pm * BM + (hp & 1) * HALF; return true; }
        int wgid = (int)L; { const int q = nwg / NXCD, r = nwg % NXCD, xcd = wgid % NXCD, off = wgid / NXCD; wgid = (xcd < r ? xcd * (q + 1) : r * (q + 1) + (xcd - r) * q) + off; }
        const int nig = WGM * nN, gid = wgid / nig, fm = gid * WGM, gsz = (nM - fm) < WGM ? (nM - fm) : WGM;
        u.pm = fm + ((wgid % nig) % gsz); u.pn = (wgid % nig) / gsz; u.half = 0; u.rbase = u.pm * BM; return true;
    }
    __device__ __forceinline__ void a_ready(const Unit&) const {}
    __device__ __forceinline__ void done(const Unit&) const {}
};

__device__ __forceinline__ unsigned cvt_pk_bf16(float lo, float hi) { unsigned r; asm volatile("v_cvt_pk_bf16_f32 %0, %1, %2" : "=v"(r) : "v"(lo), "v"(hi)); return r; }
__device__ __forceinline__ float bf_lo(unsigned w) { return __uint_as_float(w << 16); }
__device__ __forceinline__ float bf_hi(unsigned w) { return __uint_as_float(w & 0xffff0000u); }
__device__ __forceinline__ f32x2 gelu_pk(f32x2 v) {
    const f32x2 av = __builtin_elementwise_abs(v), d = av * 0.2316418882f + 1.0f;
    f32x2 t; t.x = __builtin_amdgcn_rcpf(d.x); t.y = __builtin_amdgcn_rcpf(d.y);
    f32x2 q = t * 0.5307027145f + (-0.7265760135f); q = q * t + 0.7107068705f; q = q * t + (-0.142248368f); q = q * t + 0.127414796f; q = q * t;
    const f32x2 s = (v * v) * (-0.72134752044f);
    f32x2 e; e.x = __builtin_amdgcn_exp2f(s.x); e.y = __builtin_amdgcn_exp2f(s.y);
    const f32x2 m = v * (q * e), r = v - m;
    f32x2 o; o.x = v.x < 0.f ? m.x : r.x; o.y = v.y < 0.f ? m.y : r.y; return o;
}
__device__ __forceinline__ f32x4 gelu4(f32x4 v) { const f32x2 a = gelu_pk((f32x2){v[0], v[1]}), b = gelu_pk((f32x2){v[2], v[3]}); return (f32x4){a.x, a.y, b.x, b.y}; }
__device__ __forceinline__ float sigmoidf_(float x) { return __builtin_amdgcn_rcpf(1.0f + __builtin_amdgcn_exp2f(x * -1.44269504f)); }
__device__ __forceinline__ f32x4 sigmoid4(f32x4 v) { return (f32x4){sigmoidf_(v[0]), sigmoidf_(v[1]), sigmoidf_(v[2]), sigmoidf_(v[3])}; }
__device__ __forceinline__ u32x4 pack8(f32x4 v0, f32x4 v1) { u32x4 w; w.x = cvt_pk_bf16(v0[0], v0[1]); w.y = cvt_pk_bf16(v0[2], v0[3]); w.z = cvt_pk_bf16(v1[0], v1[1]); w.w = cvt_pk_bf16(v1[2], v1[3]); return w; }
__device__ __forceinline__ float rstd_of(const float* slots, int row) { const f32x4* s = (const f32x4*)(slots + (size_t)row * 16); const f32x4 t = (s[0] + s[1]) + (s[2] + s[3]);
    return __builtin_amdgcn_rsqf(((t[0] + t[1]) + (t[2] + t[3])) * (1.0f / 1024.0f) + EPS); }

__device__ __forceinline__ void wave_rstd(const float* slots, int rowbase, int lane, int fr, float (&rs)[2][4]) {
    float val[2];
    const f32x4* sa = (const f32x4*)(slots + (size_t)(rowbase + lane) * 16); const f32x4* sb = (const f32x4*)(slots + (size_t)(rowbase + HALF + lane) * 16);
    const f32x4 a0 = sa[0], a1 = sa[1], a2 = sa[2], a3 = sa[3], b0 = sb[0], b1 = sb[1], b2 = sb[2], b3 = sb[3];
    __builtin_amdgcn_sched_barrier(0);
    { const f32x4 t = (a0 + a1) + (a2 + a3); val[0] = __builtin_amdgcn_rsqf(((t[0] + t[1]) + (t[2] + t[3])) * (1.0f / 1024.0f) + EPS); }
    { const f32x4 t = (b0 + b1) + (b2 + b3); val[1] = __builtin_amdgcn_rsqf(((t[0] + t[1]) + (t[2] + t[3])) * (1.0f / 1024.0f) + EPS); }
#pragma unroll
    for (int ai = 0; ai < 2; ++ai)
#pragma unroll
        for (int m = 0; m < 4; ++m) rs[ai][m] = __shfl(val[ai], m * 16 + fr);
}
__device__ __forceinline__ f32x4 unpk_lo(u32x4 w) { return (f32x4){bf_lo(w[0]), bf_hi(w[0]), bf_lo(w[1]), bf_hi(w[1])}; }
__device__ __forceinline__ f32x4 unpk_hi(u32x4 w) { return (f32x4){bf_lo(w[2]), bf_hi(w[2]), bf_lo(w[3]), bf_hi(w[3])}; }

struct EpiA {
    static constexpr bool PERM = true, AFTER_DRAIN = false;
    bf16_t* AB; bf16_t* GV; bf16_t* CH; const float* ssq; float* lns;
    __device__ __forceinline__ void operator()(const f32x4 (&acc)[2][2][4][2], const Unit& u, int wr, int wc, int fr, int fq) const {
        const int row0 = u.rbase + wr * 64 + fr, cw = wc * 32 + 8 * fq, pn = u.pn;
        float rsv[2][4]; wave_rstd(ssq, u.rbase + wr * 64, fr + 16 * fq, fr, rsv);
        if (pn < 4) {
#pragma unroll
            for (int ai = 0; ai < 2; ++ai)
#pragma unroll
                for (int m = 0; m < 4; ++m) { if (ai == 1 && u.half) continue; const int row = row0 + ai * HALF + m * 16; const float rs = rsv[ai][m]; bf16_t* rowp = AB + (size_t)row * 2048 + pn * 256 + cw;
#pragma unroll
                    for (int bj = 0; bj < 2; ++bj) *(u32x4*)(rowp + bj * HALF) = pack8(gelu4(acc[ai][bj][m][0] * rs), gelu4(acc[ai][bj][m][1] * rs)); }
        } else if (pn < 8) {
#pragma unroll
            for (int ai = 0; ai < 2; ++ai)
#pragma unroll
                for (int m = 0; m < 4; ++m) { if (ai == 1 && u.half) continue; const int row = row0 + ai * HALF + m * 16; const float rs = rsv[ai][m]; bf16_t* rowp = GV + (size_t)row * 1024 + (pn - 4) * 256 + cw;
                    float s = 0.f, q = 0.f;
#pragma unroll
                    for (int bj = 0; bj < 2; ++bj) { const u32x4 w = pack8(gelu4(acc[ai][bj][m][0] * rs), gelu4(acc[ai][bj][m][1] * rs)); *(u32x4*)(rowp + bj * HALF) = w;
#pragma unroll
                        for (int e = 0; e < 4; ++e) { const float a = bf_lo(w[e]), b = bf_hi(w[e]); s += a + b; q += a * a + b * b; } }
                    s += __shfl_xor(s, 16); s += __shfl_xor(s, 32); q += __shfl_xor(q, 16); q += __shfl_xor(q, 32);
                    if (fq == 0) *(f32x2*)(lns + ((size_t)row * 16 + (pn - 4) * 4 + wc) * 2) = (f32x2){s, q}; }
        } else if (pn < 12) {
#pragma unroll
            for (int ai = 0; ai < 2; ++ai)
#pragma unroll
                for (int m = 0; m < 4; ++m) { if (ai == 1 && u.half) continue; const int row = row0 + ai * HALF + m * 16; const float rs = rsv[ai][m]; bf16_t* rowp = AB + (size_t)row * 2048 + 1024 + (pn - 8) * 256 + cw;
#pragma unroll
                    for (int bj = 0; bj < 2; ++bj) *(u32x4*)(rowp + bj * HALF) = pack8(acc[ai][bj][m][0] * rs, acc[ai][bj][m][1] * rs); }
        } else {
#pragma unroll
            for (int ai = 0; ai < 2; ++ai)
#pragma unroll
                for (int m = 0; m < 4; ++m) { if (ai == 1 && u.half) continue; const int row = row0 + ai * HALF + m * 16; const float rs = rsv[ai][m]; const float rs2 = rs * rs;
                    *(u32x4*)(CH + (size_t)row * 1024 + (pn - 12) * 128 + cw) = pack8(acc[ai][0][m][0] * acc[ai][1][m][0] * rs2, acc[ai][0][m][1] * acc[ai][1][m][1] * rs2); }
        }
    }
};
struct EpiC {
    static constexpr bool PERM = true, AFTER_DRAIN = false;
    bf16_t* T;
    __device__ __forceinline__ void operator()(const f32x4 (&acc)[2][2][4][2], const Unit& u, int wr, int wc, int fr, int fq) const {
        const int row0 = u.rbase + wr * 64 + fr, cw = u.pn * 256 + wc * 32 + 8 * fq;
#pragma unroll
        for (int ai = 0; ai < 2; ++ai)
#pragma unroll
            for (int m = 0; m < 4; ++m) { if (ai == 1 && u.half) continue; bf16_t* rowp = T + (size_t)(row0 + ai * HALF + m * 16) * 2048 + cw;
#pragma unroll
                for (int bj = 0; bj < 2; ++bj) *(u32x4*)(rowp + bj * HALF) = pack8(acc[ai][bj][m][0], acc[ai][bj][m][1]); }
    }
};
struct EpiD {
    static constexpr bool PERM = true, AFTER_DRAIN = false;
    const bf16_t* T; bf16_t* MM; const float* ssq;
    __device__ __forceinline__ void operator()(const f32x4 (&acc)[2][2][4][2], const Unit& u, int wr, int wc, int fr, int fq) const {
        const int row0 = u.rbase + wr * 64 + fr, cw = u.pn * 128 + wc * 32 + 8 * fq;
        u32x4 tt[4][2];
#pragma unroll
        for (int m = 0; m < 4; ++m) { const bf16_t* tp = T + (size_t)(row0 + m * 16) * 2048 + cw; tt[m][0] = *(const u32x4*)tp; tt[m][1] = *(const u32x4*)(tp + 1024); }
        float rsv[2][4]; wave_rstd(ssq, u.rbase + wr * 64, fr + 16 * fq, fr, rsv);
#pragma unroll
        for (int ai = 0; ai < 2; ++ai) {
            if (ai == 1 && u.half) break;
            if (ai == 1) {
#pragma unroll
                for (int m = 0; m < 4; ++m) { const bf16_t* tp = T + (size_t)(row0 + HALF + m * 16) * 2048 + cw; tt[m][0] = *(const u32x4*)tp; tt[m][1] = *(const u32x4*)(tp + 1024); } }
#pragma unroll
            for (int m = 0; m < 4; ++m) { const int row = row0 + ai * HALF + m * 16; const float rs = rsv[ai][m];
                const u32x4 t1 = tt[m][0], t2 = tt[m][1];
                const f32x4 a0 = sigmoid4(acc[ai][0][m][0] * rs), a1 = sigmoid4(acc[ai][0][m][1] * rs), b0 = sigmoid4(acc[ai][1][m][0] * rs), b1 = sigmoid4(acc[ai][1][m][1] * rs);
                const f32x4 p0 = {bf_lo(t1[0]), bf_hi(t1[0]), bf_lo(t1[1]), bf_hi(t1[1])}, p1 = {bf_lo(t1[2]), bf_hi(t1[2]), bf_lo(t1[3]), bf_hi(t1[3])};
                const f32x4 q0 = {bf_lo(t2[0]), bf_hi(t2[0]), bf_lo(t2[1]), bf_hi(t2[1])}, q1 = {bf_lo(t2[2]), bf_hi(t2[2]), bf_lo(t2[3]), bf_hi(t2[3])};
                *(u32x4*)(MM + (size_t)row * 1024 + cw) = pack8(a0 * p0 + b0 * q0, a1 * p1 + b1 * q1); }
            asm volatile("" ::: "memory");
        }
    }
};
struct EpiRes {
    static constexpr bool PERM = true, AFTER_DRAIN = false;
    bf16_t* xb; float* ssq;
    __device__ __forceinline__ void operator()(const f32x4 (&acc)[2][2][4][2], const Unit& u, int wr, int wc, int fr, int fq) const {
        const int row0 = u.rbase + wr * 64 + fr, cw = u.pn * BM + wc * 32 + 8 * fq;
#pragma unroll
        for (int ai = 0; ai < 2; ++ai) {
            if (ai == 1 && u.half) break;
            u32x4 xo[4][2];
#pragma unroll
            for (int m = 0; m < 4; ++m)
#pragma unroll
                for (int bj = 0; bj < 2; ++bj) xo[m][bj] = *(const u32x4*)(xb + (size_t)(row0 + ai * HALF + m * 16) * DM + cw + bj * HALF);
#pragma unroll
            for (int m = 0; m < 4; ++m) { const int row = row0 + ai * HALF + m * 16; float q = 0.f;
#pragma unroll
                for (int bj = 0; bj < 2; ++bj) { const u32x4 w = pack8(acc[ai][bj][m][0] + unpk_lo(xo[m][bj]), acc[ai][bj][m][1] + unpk_hi(xo[m][bj]));
                    *(u32x4*)(xb + (size_t)row * DM + cw + bj * HALF) = w;
#pragma unroll
                    for (int e = 0; e < 4; ++e) { const float a = bf_lo(w[e]), b = bf_hi(w[e]); q += a * a + b * b; } }
                q += __shfl_xor(q, 16); q += __shfl_xor(q, 32);
                if (fq == 0) ssq[(size_t)row * 16 + u.pn * 4 + wc] = q; }
            asm volatile("" ::: "memory");
        }
    }
};
struct EpiF {
    static constexpr bool PERM = true, AFTER_DRAIN = false;
    bf16_t* H; const float* ssq;
    __device__ __forceinline__ void operator()(const f32x4 (&acc)[2][2][4][2], const Unit& u, int wr, int wc, int fr, int fq) const {
        const int row0 = u.rbase + wr * 64 + fr, cw = u.pn * 128 + wc * 32 + 8 * fq;
        float rsv[2][4]; wave_rstd(ssq, u.rbase + wr * 64, fr + 16 * fq, fr, rsv);
#pragma unroll
        for (int ai = 0; ai < 2; ++ai)
#pragma unroll
            for (int m = 0; m < 4; ++m) { if (ai == 1 && u.half) continue; const int row = row0 + ai * HALF + m * 16; const float rs = rsv[ai][m];
                const f32x4 g0 = acc[ai][0][m][0] * rs, g1 = acc[ai][0][m][1] * rs, u0 = acc[ai][1][m][0] * rs, u1 = acc[ai][1][m][1] * rs;
                *(u32x4*)(H + (size_t)row * DFF + cw) = pack8(g0 * sigmoid4(g0) * u0, g1 * sigmoid4(g1) * u1); }
    }
};

#ifndef PG8_SP2
#define PG8_SP2 true
#endif
#ifndef PG8_ALIGN
#define PG8_ALIGN true
#endif
template <class Epi, class Sched, bool SP2 = PG8_SP2, bool ALIGN_EPI = PG8_ALIGN>
__device__ __forceinline__ void gemm_phase(PG8_LAS unsigned char* lds, const Gemm g, const Sched& S, const Epi& E) {
    int tid = threadIdx.x; asm volatile("" : "+v"(tid));
    const int wid = __builtin_amdgcn_readfirstlane(tid >> 6), lane = tid & 63, wr = wid >> 2, wc = wid & 3, fr = lane & 15, fq = lane >> 4;
    const int K = g.K, nt = K / BK, lda = g.lda;
    unsigned voffA[2], voffB[2];
#pragma unroll
    for (int i = 0; i < 2; ++i) { int R, C; stage_rc(tid * 16 + i * 8192, R, C); const int Rb = Epi::PERM ? ((R & ~31) + perm32(R & 31)) : R;
        voffA[i] = (unsigned)(R * lda + C) * 2u; voffB[i] = (unsigned)(Rb * K + C) * 2u; }
    const size_t kstep = (size_t)(BK * 2);
    const size_t hstepA = (size_t)HALF * lda * 2, hstepB = (size_t)HALF * K * 2;
    const size_t tstepA = 2 * hstepA, tstepB = 2 * hstepB;
    const unsigned ldsw = (unsigned)wid * 1024u;
    const int aoff = lds_byte(wr * 64 + fr, fq * 8), boff = lds_byte(wc * 32 + fr, fq * 8);
#define PG8_SA(b, h) (((b) * 2 + (h)) * HTB)
#define PG8_SB(b, h) ((4 + (b) * 2 + (h)) * HTB)
#define PG8_STAGE(bufoff, gbase, voff) do { _Pragma("unroll") for (int _i = 0; _i < 2; ++_i) \
        __builtin_amdgcn_global_load_lds((const unsigned*)((const char*)(gbase) + (voff)[_i]), (PG8_LAS unsigned*)(lds + (bufoff) + ldsw + _i * 8192), 16, 0, 0); } while (0)
#define PG8_LDA(dst, b, h) do { _Pragma("unroll") for (int m = 0; m < 4; ++m) _Pragma("unroll") for (int k = 0; k < 2; ++k) dst[m][k] = *(const PG8_LAS bf16x8*)(lds + PG8_SA(b, h) + aoff + m * 2048 + k * 1024); } while (0)
#define PG8_LDB(dst, b, h) do { _Pragma("unroll") for (int n = 0; n < 2; ++n) _Pragma("unroll") for (int k = 0; k < 2; ++k) dst[n][k] = *(const PG8_LAS bf16x8*)(lds + PG8_SB(b, h) + boff + n * 2048 + k * 1024); } while (0)
#define PG8_MMA(ai, bj, At, Bt) do { __builtin_amdgcn_s_setprio(1); _Pragma("unroll") for (int m = 0; m < 4; ++m) _Pragma("unroll") for (int n = 0; n < 2; ++n) _Pragma("unroll") for (int k = 0; k < 2; ++k) \
        acc[ai][bj][m][n] = __builtin_amdgcn_mfma_f32_16x16x32_bf16(Bt[n][k], At[m][k], acc[ai][bj][m][n], 0, 0, 0); __builtin_amdgcn_s_setprio(0); } while (0)
#define PG8_WAIT_V(n) asm volatile("s_waitcnt vmcnt(" #n ")" ::: "memory")
#define PG8_WAIT_L(n) asm volatile("s_waitcnt lgkmcnt(" #n ")" ::: "memory")
#define PG8_BAR __builtin_amdgcn_s_barrier()
#define PG8_SCHED __builtin_amdgcn_sched_barrier(0)
#define PG8_APTR(u) ((const char*)g.A + (size_t)((u).rbase) * lda * 2 + (((u).pn >= g.asplit_pn) ? (size_t)g.asplit_off * 2 : (size_t)0))
    Unit cur, nxt; int ui = 0;
    if (!S.next(0, cur)) return;
    f32x4 acc[2][2][4][2];
#pragma unroll
    for (int a = 0; a < 2; ++a)
#pragma unroll
        for (int b = 0; b < 2; ++b)
#pragma unroll
            for (int m = 0; m < 4; ++m)
#pragma unroll
                for (int n = 0; n < 2; ++n) acc[a][b][m][n] = (f32x4){0.f, 0.f, 0.f, 0.f};
    bf16x8 At[4][2], B0[2][2], B1[2][2];
    const char* cA = PG8_APTR(cur); const char* cB = (const char*)g.Bt + (size_t)cur.pn * tstepB;
    S.a_ready(cur);
    if constexpr (SP2) {
        PG8_STAGE(PG8_SB(0, 0), cB, voffB); PG8_STAGE(PG8_SB(0, 1), cB + hstepB, voffB); PG8_STAGE(PG8_SA(0, 0), cA, voffA); PG8_STAGE(PG8_SA(0, 1), cA + hstepA, voffA);
        if (wr == 1) PG8_BAR;
        PG8_WAIT_V(2); PG8_BAR;
        PG8_STAGE(PG8_SB(1, 0), cB + kstep, voffB); PG8_STAGE(PG8_SA(1, 0), cA + kstep, voffA); PG8_STAGE(PG8_SB(1, 1), cB + hstepB + kstep, voffB);
        PG8_WAIT_V(6); PG8_BAR;
    } else {
    PG8_STAGE(PG8_SB(0, 0), cB, voffB); PG8_STAGE(PG8_SA(0, 0), cA, voffA); PG8_STAGE(PG8_SB(0, 1), cB + hstepB, voffB); PG8_STAGE(PG8_SA(0, 1), cA + hstepA, voffA);
    if (wr == 1) PG8_BAR;
    PG8_WAIT_V(4); PG8_BAR;
    PG8_STAGE(PG8_SB(1, 0), cB + kstep, voffB); PG8_STAGE(PG8_SA(1, 0), cA + kstep, voffA); PG8_STAGE(PG8_SB(1, 1), cB + hstepB + kstep, voffB);
    PG8_WAIT_V(6); PG8_BAR;
    }
    for (;;) {
        const bool has_next = S.next(ui + 1, nxt);
        const char* nA = has_next ? PG8_APTR(nxt) : cA; const char* nB = has_next ? (const char*)g.Bt + (size_t)nxt.pn * tstepB : cB;
        const bool hlf = cur.half != 0;
        for (int t = 0; t < nt; t += 2) {
            const bool last = (t == nt - 2);
            const char* a1 = cA + (size_t)(t + 1) * kstep;
            const char* a2 = last ? nA : cA + (size_t)(t + 2) * kstep; const char* b2 = last ? nB : cB + (size_t)(t + 2) * kstep;
            const char* a3 = a2 + kstep; const char* b3 = b2 + kstep;
            if (last && has_next) S.a_ready(nxt);
            if constexpr (SP2) {
            PG8_LDB(B0, 0, 0); PG8_LDB(B1, 0, 1); PG8_SCHED; PG8_LDA(At, 0, 0); PG8_STAGE(PG8_SA(1, 1), a1 + hstepA, voffA);
            PG8_WAIT_V(8); PG8_WAIT_L(0); PG8_BAR; PG8_MMA(0, 0, At, B0); PG8_MMA(0, 1, At, B1); PG8_BAR; PG8_SCHED;
            if (!hlf) { PG8_LDA(At, 0, 1); } PG8_STAGE(PG8_SB(0, 0), b2, voffB); PG8_STAGE(PG8_SB(0, 1), b2 + hstepB, voffB); PG8_STAGE(PG8_SA(0, 0), a2, voffA);
            PG8_WAIT_V(8); PG8_WAIT_L(0); PG8_BAR; if (!hlf) { PG8_MMA(1, 0, At, B0); PG8_MMA(1, 1, At, B1); } PG8_BAR; PG8_SCHED;
            PG8_LDB(B0, 1, 0); PG8_LDB(B1, 1, 1); PG8_SCHED; PG8_LDA(At, 1, 0); PG8_STAGE(PG8_SA(0, 1), a2 + hstepA, voffA);
            PG8_WAIT_V(8); PG8_WAIT_L(0); PG8_BAR; PG8_MMA(0, 0, At, B0); PG8_MMA(0, 1, At, B1); PG8_BAR; PG8_SCHED;
            if (!hlf) { PG8_LDA(At, 1, 1); } PG8_STAGE(PG8_SB(1, 0), b3, voffB); PG8_STAGE(PG8_SB(1, 1), b3 + hstepB, voffB); PG8_STAGE(PG8_SA(1, 0), a3, voffA);
            PG8_WAIT_V(8); PG8_WAIT_L(0); PG8_BAR; if (!hlf) { PG8_MMA(1, 0, At, B0); PG8_MMA(1, 1, At, B1); } PG8_BAR; PG8_SCHED;
            } else {
            PG8_LDB(B0, 0, 0); PG8_SCHED; PG8_LDA(At, 0, 0); PG8_STAGE(PG8_SA(1, 1), a1 + hstepA, voffA);
            PG8_WAIT_L(8); PG8_BAR; PG8_WAIT_L(0); PG8_MMA(0, 0, At, B0); PG8_BAR; PG8_SCHED;
            PG8_LDB(B1, 0, 1); PG8_STAGE(PG8_SB(0, 0), b2, voffB);
            PG8_BAR; PG8_WAIT_L(0); PG8_MMA(0, 1, At, B1); PG8_BAR;
            PG8_LDA(At, 0, 1); PG8_STAGE(PG8_SA(0, 0), a2, voffA);
            PG8_BAR; PG8_WAIT_L(0); PG8_MMA(1, 0, At, B0); PG8_BAR; PG8_SCHED;
            PG8_STAGE(PG8_SB(0, 1), b2 + hstepB, voffB);
            PG8_WAIT_V(6); PG8_BAR; PG8_MMA(1, 1, At, B1); PG8_BAR;
            PG8_LDB(B0, 1, 0); PG8_SCHED; PG8_LDA(At, 1, 0); PG8_STAGE(PG8_SA(0, 1), a2 + hstepA, voffA);
            PG8_WAIT_L(8); PG8_BAR; PG8_WAIT_L(0); PG8_MMA(0, 0, At, B0); PG8_BAR; PG8_SCHED;
            PG8_LDB(B1, 1, 1); PG8_STAGE(PG8_SB(1, 0), b3, voffB);
            PG8_BAR; PG8_WAIT_L(0); PG8_MMA(0, 1, At, B1); PG8_BAR;
            PG8_LDA(At, 1, 1); PG8_STAGE(PG8_SA(1, 0), a3, voffA);
            PG8_BAR; PG8_WAIT_L(0); PG8_MMA(1, 0, At, B0); PG8_BAR; PG8_SCHED;
            PG8_STAGE(PG8_SB(1, 1), b3 + hstepB, voffB);
            PG8_WAIT_V(6); PG8_BAR; PG8_MMA(1, 1, At, B1); PG8_BAR;
            }
        }
        if constexpr (ALIGN_EPI) { if (wr == 0) PG8_BAR; }
        E(acc, cur, wr, wc, fr, fq); S.done(cur);
        if (!has_next) break;
#pragma unroll
        for (int a = 0; a < 2; ++a)
#pragma unroll
            for (int b = 0; b < 2; ++b)
#pragma unroll
                for (int m = 0; m < 4; ++m)
#pragma unroll
                    for (int n = 0; n < 2; ++n) acc[a][b][m][n] = (f32x4){0.f, 0.f, 0.f, 0.f};
        cur = nxt; cA = nA; cB = nB; ++ui;
        if constexpr (ALIGN_EPI) { if (wr == 1) PG8_BAR; }
    }
    PG8_WAIT_V(0);
    if constexpr (!ALIGN_EPI) { if (wr == 0) PG8_BAR; }
    PG8_BAR;
#undef PG8_APTR
#undef PG8_SA
#undef PG8_SB
#undef PG8_STAGE
#undef PG8_LDA
#undef PG8_LDB
#undef PG8_MMA
#undef PG8_WAIT_V
#undef PG8_WAIT_L
#undef PG8_BAR
#undef PG8_SCHED
}
}

using pg8::bf16_t; using pg8::f32x4; using pg8::u32x4; using pg8::u32x2; using pg8::bf16x8;
using pg8::cvt_pk_bf16; using pg8::bf_lo; using pg8::bf_hi;

struct Params {
    const float* x_prompt; const float* x_sample; const float* state_conv; const float* norm_mix; const float* w_in; const float* ln_g; const float* ln_b;
    const float* w_s; const float* b_s; const float* conv_w; const float* w_pa; const float* w_pb; const float* w_o; const float* norm_ffn;
    const float* w_gate; const float* w_up; const float* w_down; const float* norm_final;
    float* out; unsigned char* ws; int ph_lo, ph_hi;
};
constexpr int LDS_BYTES = pg8::STAGE_BYTES + 256;
constexpr int NPHASE = 2 + 7 * NL;

__device__ __forceinline__ void transpose_tile(const float* __restrict__ src, int ld, int k0, int col0, const float* __restrict__ scale, bf16_t* __restrict__ dst, int K, float* t, int tid) {
    const int r = tid >> 4, c4 = tid & 15;
#pragma unroll
    for (int pass = 0; pass < 2; ++pass) { const int k = r + 32 * pass; const f32x4 v = *(const f32x4*)(src + (size_t)(k0 + k) * ld + col0 + 4 * c4); const float s = scale ? scale[k0 + k] : 1.0f;
        t[k * 65 + 4 * c4 + 0] = v[0] * s; t[k * 65 + 4 * c4 + 1] = v[1] * s; t[k * 65 + 4 * c4 + 2] = v[2] * s; t[k * 65 + 4 * c4 + 3] = v[3] * s; }
    __syncthreads();
    const int n = tid >> 3, kc = tid & 7; u32x4 w;
    w.x = cvt_pk_bf16(t[(8 * kc + 0) * 65 + n], t[(8 * kc + 1) * 65 + n]); w.y = cvt_pk_bf16(t[(8 * kc + 2) * 65 + n], t[(8 * kc + 3) * 65 + n]);
    w.z = cvt_pk_bf16(t[(8 * kc + 4) * 65 + n], t[(8 * kc + 5) * 65 + n]); w.w = cvt_pk_bf16(t[(8 * kc + 6) * 65 + n], t[(8 * kc + 7) * 65 + n]);
    *(u32x4*)(dst + (size_t)n * K + k0 + 8 * kc) = w;
    __syncthreads();
}
constexpr int IT_WIN = (NIN / 64) * 16, IT_WPAB = 32 * 16, IT_WO = 16 * 16, IT_WGU = (2 * DFF / 64) * 16, IT_WD = 16 * (DFF / 64), IT_LAYER = IT_WIN + IT_WPAB + IT_WO + IT_WGU + IT_WD;

__device__ __forceinline__ void p0_prologue(const Params& p, float* ldsf) {
    unsigned char* ws = p.ws;
    float* ssqm = (float*)(ws + WS_SSQM);
    int tid = threadIdx.x; asm volatile("" : "+v"(tid));
    const int G = gridDim.x, b = blockIdx.x;
    for (int it = b; it < NL * IT_LAYER; it += G) {
        const int l = it / IT_LAYER; int r = it % IT_LAYER; unsigned char* lw = ws + WS_W + (size_t)l * LW_BYTES;
        if (r < IT_WIN) { const int ntile = r >> 4, kt = r & 15, n0 = ntile * 64; int col;
            if (n0 < 3072) col = n0; else if (n0 < 5120) { const int t = n0 - 3072; col = ((t & 128) ? 4096 : 3072) + (t >> 8) * 128 + (t & 127); } else { const int t = n0 - 5120; col = ((t & 128) ? 6144 : 5120) + (t >> 8) * 128 + (t & 127); }
            transpose_tile(p.w_in + (size_t)l * DM * NIN, NIN, kt * 64, col, p.norm_mix + l * DM, (bf16_t*)(lw + LW_WIN) + (size_t)n0 * DM, DM, ldsf, tid); continue; }
        r -= IT_WIN;
        if (r < IT_WPAB) { const int ntile = r >> 4, kt = r & 15, n0 = ntile * 64;
            const float* src = (n0 < 1024) ? p.w_pa + (size_t)l * DM * DM : p.w_pb + (size_t)l * DM * DM;
            transpose_tile(src, DM, kt * 64, n0 & 1023, nullptr, (bf16_t*)(lw + LW_WPAB) + (size_t)n0 * DM, DM, ldsf, tid); continue; }
        r -= IT_WPAB;
        if (r < IT_WO) { const int ntile = r >> 4, kt = r & 15, n0 = ntile * 64;
            transpose_tile(p.w_o + (size_t)l * DM * DM, DM, kt * 64, n0, nullptr, (bf16_t*)(lw + LW_WO) + (size_t)n0 * DM, DM, ldsf, tid); continue; }
        r -= IT_WO;
        if (r < IT_WGU) { const int ntile = r >> 4, kt = r & 15, n0 = ntile * 64;
            const float* src = ((n0 & 128) ? p.w_up : p.w_gate) + (size_t)l * DM * DFF; const int col = (n0 >> 8) * 128 + (n0 & 127);
            transpose_tile(src, DFF, kt * 64, col, p.norm_ffn + l * DM, (bf16_t*)(lw + LW_WGU) + (size_t)n0 * DM, DM, ldsf, tid); continue; }
        r -= IT_WGU;
        { const int ntile = r / (DFF / 64), kt = r % (DFF / 64), n0 = ntile * 64;
            transpose_tile(p.w_down + (size_t)l * DFF * DM, DM, kt * 64, n0, nullptr, (bf16_t*)(lw + LW_WD) + (size_t)n0 * DFF, DFF, ldsf, tid); }
    }
    for (int i = b * 512 + tid; i < NL * 8 * 128 * 128; i += G * 512) {
        const int l = i >> 17, rem = i & 131071, ii = (rem >> 7) & 127, jj = rem & 127;
        const float* wsrc = p.w_s + (size_t)(i - rem);
        const int grp = rem >> 14;
        unsigned char* lw = ws + WS_W + (size_t)l * LW_BYTES;
        const float vp = (jj <= ii) ? p.w_s[i] : 0.f;
        const float vs = ((ii >> 5) == (jj >> 5) && (jj & 31) <= (ii & 31)) ? wsrc[grp * 16384 + (ii & 31) * 128 + (jj & 31)] : 0.f;
        ((bf16_t*)(lw + LW_WSP))[rem] = (bf16_t)(cvt_pk_bf16(vp, 0.f) & 0xffffu);
        ((bf16_t*)(lw + LW_WSS))[rem] = (bf16_t)(cvt_pk_bf16(vs, 0.f) & 0xffffu);
    }
    { const int wave = tid >> 6, lane = tid & 63; bf16_t* xb = (bf16_t*)(ws + WS_XB);
      for (int row = b * 8 + wave; row < MT; row += 2 * G * 8) {
          const int row2 = row + G * 8; const bool has2 = row2 < MT;
          const float* xr = (row < MP) ? p.x_prompt + (size_t)row * DM : p.x_sample + (size_t)(row - MP) * DM;
          const float* xr2 = has2 ? ((row2 < MP) ? p.x_prompt + (size_t)row2 * DM : p.x_sample + (size_t)(row2 - MP) * DM) : xr;
          f32x4 v[4], v2[4];
#pragma unroll
          for (int j = 0; j < 4; ++j) { v[j] = *(const f32x4*)(xr + 4 * (lane + 64 * j)); v2[j] = *(const f32x4*)(xr2 + 4 * (lane + 64 * j)); }
          float q = 0.f, q2 = 0.f;
#pragma unroll
          for (int j = 0; j < 4; ++j) { q += (v[j][0] * v[j][0] + v[j][1] * v[j][1]) + (v[j][2] * v[j][2] + v[j][3] * v[j][3]); q2 += (v2[j][0] * v2[j][0] + v2[j][1] * v2[j][1]) + (v2[j][2] * v2[j][2] + v2[j][3] * v2[j][3]);
              u32x2 w; w.x = cvt_pk_bf16(v[j][0], v[j][1]); w.y = cvt_pk_bf16(v[j][2], v[j][3]); *(u32x2*)(xb + (size_t)row * DM + 4 * (lane + 64 * j)) = w;
              if (has2) { u32x2 w2; w2.x = cvt_pk_bf16(v2[j][0], v2[j][1]); w2.y = cvt_pk_bf16(v2[j][2], v2[j][3]); *(u32x2*)(xb + (size_t)row2 * DM + 4 * (lane + 64 * j)) = w2; } }
#pragma unroll
          for (int o = 32; o >= 1; o >>= 1) { q += __shfl_xor(q, o); q2 += __shfl_xor(q2, o); }
          if (lane < 4) { ((f32x4*)(ssqm + (size_t)row * 16))[lane] = (f32x4){lane == 0 ? q : 0.f, 0.f, 0.f, 0.f};
              if (has2) ((f32x4*)(ssqm + (size_t)row2 * 16))[lane] = (f32x4){lane == 0 ? q2 : 0.f, 0.f, 0.f, 0.f}; }
      } }
}

constexpr int VT_PITCH = 136;
__device__ __forceinline__ void gate_conv_phase(const Params& p, int l, unsigned char* lds) {
    unsigned char* ws = p.ws;
    const float* lns = (const float*)(ws + WS_LNS);
    bf16_t* AB = (bf16_t*)(ws + WS_AB); const bf16_t* GV = (const bf16_t*)(ws + WS_GV); const bf16_t* CH = (const bf16_t*)(ws + WS_CH);
    const unsigned char* lw = ws + WS_W + (size_t)l * LW_BYTES;
    bf16_t* vT = (bf16_t*)lds;
    float* mr = (float*)(lds + 128 * VT_PITCH * 2);
    int tid = threadIdx.x; asm volatile("" : "+v"(tid));
    const int lane = tid & 63, w = tid >> 6, fr = lane & 15, fq = lane >> 4;
    const int jg = tid >> 5, cq = tid & 31;
    const int ci = tid & 15;
    const int nks = (w >> 1) + 1;
    const int total = (MT / 128) * 8;
    int item = blockIdx.x; if (item >= total) return;
    const int g = item & 7, c0 = g * 128, irow = 16 * w + fr;
    const bf16_t* WsP = (const bf16_t*)(lw + LW_WSP) + g * 16384 + irow * 128 + 8 * fq;
    bf16x8 wf[4];
#pragma unroll
    for (int ks = 0; ks < 4; ++ks) wf[ks] = *(const bf16x8*)(WsP + 32 * ks);
    float bs = p.b_s[(l * 8 + g) * 128 + irow];
    const float* cwp = p.conv_w + (size_t)l * 3 * DM + c0 + 8 * ci;
    bool was_smp = false;
    f32x4 sl0, sl1; u32x2 gv[8]; u32x4 uu[4];
#define GC_LOAD(it) do { const int r0_ = ((it) >> 3) * 128; \
        const f32x4* sl_ = (const f32x4*)(lns + (size_t)(r0_ + (tid >> 2)) * 32 + (tid & 3) * 8); sl0 = sl_[0]; sl1 = sl_[1]; \
        _Pragma("unroll") for (int jj = 0; jj < 8; ++jj) gv[jj] = *(const u32x2*)(GV + (size_t)(r0_ + 8 * jg + jj) * DM + c0 + 4 * cq); } while (0)
#define GC_LOADU(it) do { const int r0_ = ((it) >> 3) * 128; \
        _Pragma("unroll") for (int pp = 0; pp < 4; ++pp) uu[pp] = *(const u32x4*)(AB + (size_t)(r0_ + irow) * 2048 + c0 + 8 * fq + 32 * pp); } while (0)
    GC_LOAD(item); GC_LOADU(item);
    for (;;) {
        const int ct = item >> 3, row0 = ct * 128; const bool smp = ct >= MP / 128;
        if (smp && !was_smp) {
            const bf16_t* WsS = (const bf16_t*)(lw + LW_WSS) + g * 16384 + irow * 128 + 8 * fq;
#pragma unroll
            for (int ks = 0; ks < 4; ++ks) wf[ks] = *(const bf16x8*)(WsS + 32 * ks);
            bs = p.b_s[(l * 8 + g) * 128 + (irow & 31)]; was_smp = true; }
        bf16_t* rowp = AB + (size_t)(row0 + irow) * 2048 + c0 + 8 * fq;
        const f32x4 lg = *(const f32x4*)(p.ln_g + l * DM + c0 + 4 * cq), lb = *(const f32x4*)(p.ln_b + l * DM + c0 + 4 * cq);
        { float sm = (sl0[0] + sl0[2]) + (sl1[0] + sl1[2]), sq = (sl0[1] + sl0[3]) + (sl1[1] + sl1[3]);
          sm += __shfl_xor(sm, 1); sq += __shfl_xor(sq, 1); sm += __shfl_xor(sm, 2); sq += __shfl_xor(sq, 2);
          if ((tid & 3) == 0) { const float mean = sm * (1.0f / 1024.0f), var = sq * (1.0f / 1024.0f) - mean * mean; mr[2 * (tid >> 2)] = mean; mr[2 * (tid >> 2) + 1] = __builtin_amdgcn_rsqf(fmaxf(var, 0.f) + EPS); } }
        __syncthreads();
        { float v[8][4];
#pragma unroll
          for (int jj = 0; jj < 8; ++jj) { const float mean = mr[2 * (8 * jg + jj)], rstd = mr[2 * (8 * jg + jj) + 1];
              v[jj][0] = (bf_lo(gv[jj].x) - mean) * rstd * lg[0] + lb[0]; v[jj][1] = (bf_hi(gv[jj].x) - mean) * rstd * lg[1] + lb[1];
              v[jj][2] = (bf_lo(gv[jj].y) - mean) * rstd * lg[2] + lb[2]; v[jj][3] = (bf_hi(gv[jj].y) - mean) * rstd * lg[3] + lb[3];
              if (smp) *(f32x4*)(p.out + OUT_V + ((size_t)l * MS + (row0 + 8 * jg + jj - MP)) * DM + c0 + 4 * cq) = (f32x4){v[jj][0], v[jj][1], v[jj][2], v[jj][3]}; }
#pragma unroll
          for (int e = 0; e < 4; ++e) { u32x4 wv; wv.x = cvt_pk_bf16(v[0][e], v[1][e]); wv.y = cvt_pk_bf16(v[2][e], v[3][e]); wv.z = cvt_pk_bf16(v[4][e], v[5][e]); wv.w = cvt_pk_bf16(v[6][e], v[7][e]);
              *(u32x4*)(vT + (4 * cq + e) * VT_PITCH + 8 * jg) = wv; } }
        u32x4 ch0[4], ch1[4], ch2[4], bg[4];
#pragma unroll
        for (int vv = 0; vv < 4; ++vv) { const int i = (tid >> 4) + 32 * vv, row = row0 + i, c = c0 + 8 * ci; const int pos = smp ? ((row - MP) & 31) : (row & 2047);
            const u32x4 z4 = {0u, 0u, 0u, 0u};
            ch0[vv] = *(const u32x4*)(CH + (size_t)row * DM + c);
            ch1[vv] = (pos >= 1) ? *(const u32x4*)(CH + (size_t)(row - 1) * DM + c) : z4;
            ch2[vv] = (pos >= 2) ? *(const u32x4*)(CH + (size_t)(row - 2) * DM + c) : z4;
            bg[vv] = *(const u32x4*)(AB + (size_t)row * 2048 + 1024 + c); }
        const int nitem = item + (int)gridDim.x; const bool has_next = nitem < total;
        if (has_next) GC_LOAD(nitem);
        __syncthreads();
        { f32x4 acc[8];
#pragma unroll
          for (int dt = 0; dt < 8; ++dt) acc[dt] = (f32x4){0.f, 0.f, 0.f, 0.f};
#pragma unroll
          for (int ks = 0; ks < 4; ++ks) if (ks < nks) {
#pragma unroll
              for (int dt = 0; dt < 8; ++dt) { const int d = 32 * (dt >> 1) + 8 * (fr >> 2) + 4 * (dt & 1) + (fr & 3);
                  const bf16x8 vf = *(const bf16x8*)(vT + d * VT_PITCH + 32 * ks + 8 * fq);
                  acc[dt] = __builtin_amdgcn_mfma_f32_16x16x32_bf16(vf, wf[ks], acc[dt], 0, 0, 0); } }
#pragma unroll
          for (int pp = 0; pp < 4; ++pp) { const f32x4 s0 = acc[2 * pp] + bs, s1 = acc[2 * pp + 1] + bs;
              const f32x4 u0 = {bf_lo(uu[pp][0]), bf_hi(uu[pp][0]), bf_lo(uu[pp][1]), bf_hi(uu[pp][1])}, u1 = {bf_lo(uu[pp][2]), bf_hi(uu[pp][2]), bf_lo(uu[pp][3]), bf_hi(uu[pp][3])};
              *(u32x4*)(rowp + 32 * pp) = pg8::pack8(u0 * s0, u1 * s1); } }
        if (has_next) GC_LOADU(nitem);
        const f32x4 w0a = *(const f32x4*)(cwp), w0b = *(const f32x4*)(cwp + 4), w1a = *(const f32x4*)(cwp + DM), w1b = *(const f32x4*)(cwp + DM + 4), w2a = *(const f32x4*)(cwp + 2 * DM), w2b = *(const f32x4*)(cwp + 2 * DM + 4);
#pragma unroll
        for (int vv = 0; vv < 4; ++vv) { const int i = (tid >> 4) + 32 * vv, row = row0 + i, c = c0 + 8 * ci; const int pos = smp ? ((row - MP) & 31) : (row & 2047);
            float f0[8], f1[8], f2[8], o[8];
#pragma unroll
            for (int e = 0; e < 4; ++e) { f0[2 * e] = bf_lo(ch0[vv][e]); f0[2 * e + 1] = bf_hi(ch0[vv][e]); f1[2 * e] = bf_lo(ch1[vv][e]); f1[2 * e + 1] = bf_hi(ch1[vv][e]); f2[2 * e] = bf_lo(ch2[vv][e]); f2[2 * e + 1] = bf_hi(ch2[vv][e]); }
            if (smp && pos < 2) { const int sq = (row - MP) >> 5; const float* stp = p.state_conv + ((size_t)(l * 32 + sq) * 2) * DM + c;
                if (pos == 0) { const f32x4 a = *(const f32x4*)(stp + DM), bq = *(const f32x4*)(stp + DM + 4); f1[0] = a[0]; f1[1] = a[1]; f1[2] = a[2]; f1[3] = a[3]; f1[4] = bq[0]; f1[5] = bq[1]; f1[6] = bq[2]; f1[7] = bq[3]; }
                { const float* s2 = stp + (pos == 0 ? 0 : DM); const f32x4 a = *(const f32x4*)(s2), bq = *(const f32x4*)(s2 + 4); f2[0] = a[0]; f2[1] = a[1]; f2[2] = a[2]; f2[3] = a[3]; f2[4] = bq[0]; f2[5] = bq[1]; f2[6] = bq[2]; f2[7] = bq[3]; } }
#pragma unroll
            for (int e = 0; e < 4; ++e) { o[e] = w0a[e] * f2[e] + w1a[e] * f1[e] + w2a[e] * f0[e]; o[4 + e] = w0b[e] * f2[4 + e] + w1b[e] * f1[4 + e] + w2b[e] * f0[4 + e]; }
            u32x4 ov;
#pragma unroll
            for (int e = 0; e < 4; ++e) ov[e] = cvt_pk_bf16(o[2 * e] * bf_lo(bg[vv][e]), o[2 * e + 1] * bf_hi(bg[vv][e]));
            *(u32x4*)(AB + (size_t)row * 2048 + 1024 + c) = ov;
            const int lastpos = smp ? 31 : 2047;
            if (pos >= lastpos - 1) { float* op = smp ? p.out + OUT_NCS + (((size_t)l * 32 + ((row - MP) >> 5)) * 2 + (pos - (lastpos - 1))) * DM + c
                                                      : p.out + OUT_NCP + (((size_t)l * 32 + (row >> 11)) * 2 + (pos - (lastpos - 1))) * DM + c;
                *(f32x4*)op = (f32x4){f0[0], f0[1], f0[2], f0[3]}; *(f32x4*)(op + 4) = (f32x4){f0[4], f0[5], f0[6], f0[7]}; } }
        __syncthreads();
        if (!has_next) break;
        item = nitem;
    }
#undef GC_LOAD
#undef GC_LOADU
}

__device__ __forceinline__ void final_norm_phase(const Params& p) {
    const float* __restrict__ ssq = (const float*)(p.ws + WS_SSQM); const bf16_t* __restrict__ xb = (const bf16_t*)(p.ws + WS_XB); float* __restrict__ out = p.out;
    const size_t n8 = (size_t)MT * DM / 8;
    int tid = threadIdx.x; asm volatile("" : "+v"(tid));
    const size_t stride = (size_t)gridDim.x * 512;
    const int c = (tid & 127) * 8;
    const f32x4 g0 = *(const f32x4*)(p.norm_final + c), g1 = *(const f32x4*)(p.norm_final + c + 4);
    for (size_t i = (size_t)blockIdx.x * 512 + tid; i < n8; i += 4 * stride) {
        u32x4 w[4]; f32x4 s0[4], s1[4], s2[4], s3[4];
#pragma unroll
        for (int k = 0; k < 4; ++k) { const size_t ii = i + k * stride; if (ii < n8) { w[k] = *(const u32x4*)(xb + ii * 8); const f32x4* s = (const f32x4*)(ssq + (ii >> 7) * 16); s0[k] = s[0]; s1[k] = s[1]; s2[k] = s[2]; s3[k] = s[3]; } }
#pragma unroll
        for (int k = 0; k < 4; ++k) { const size_t ii = i + k * stride; if (ii < n8) { const f32x4 t = (s0[k] + s1[k]) + (s2[k] + s3[k]);
            const float rs = __builtin_amdgcn_rsqf(((t[0] + t[1]) + (t[2] + t[3])) * (1.0f / 1024.0f) + EPS);
            ((f32x4*)out)[2 * ii] = pg8::unpk_lo(w[k]) * rs * g0; ((f32x4*)out)[2 * ii + 1] = pg8::unpk_hi(w[k]) * rs * g1; } }
    }
}

#define LAS __attribute__((address_space(3)))
#define XB_TMO      128
#define XB_XCNT(j)  (256  + 64 * (j))
#define XB_XSUB(j)  (1280 + 64 * (j))
#define XB_XGEN(j)  (2304 + 64 * (j))
#define XB_TOP      3328
#define XB_TOPGEN   3392
#define XCD_BAR_WORDS 3456
#define XB_SPIN_CAP (1u << 18)

__device__ __forceinline__ unsigned xb_ld(unsigned* p)              { return __hip_atomic_load(p, __ATOMIC_RELAXED, __HIP_MEMORY_SCOPE_AGENT); }
__device__ __forceinline__ unsigned xb_add(unsigned* p, unsigned v) { return __hip_atomic_fetch_add(p, v, __ATOMIC_RELAXED, __HIP_MEMORY_SCOPE_AGENT); }
__device__ __forceinline__ unsigned xb_xcc_id() { return (unsigned)__builtin_amdgcn_s_getreg((3 << 11) | 20) & 0xFu; }
#define XB_SPIN(cond, bar) do { unsigned _sp = 0; while (cond) { __builtin_amdgcn_s_sleep(1); \
    if ((++_sp & 255u) == 0u) { if (xb_ld(&(bar)[XB_TMO])) break; if (_sp > XB_SPIN_CAP) { atomicAdd(&(bar)[XB_TMO], 1u); break; } } } } while (0)

struct XcdBarrier {
    unsigned* bar; unsigned x;
    volatile LAS unsigned* st;
};

__device__ __forceinline__ XcdBarrier xcd_barrier_post(unsigned* bar, volatile LAS unsigned* st) {
    XcdBarrier b; b.bar = bar; b.x = xb_xcc_id(); b.st = st;
    if (threadIdx.x == 0) (void)xb_add(&bar[XB_XCNT(b.x)], 1u);
    return b;
}
__device__ __forceinline__ void xcd_barrier_complete(unsigned* bar, unsigned x, unsigned& nloc, unsigned& nx) {
    const unsigned G = gridDim.x * gridDim.y * gridDim.z;
    unsigned sum, cnt, mine, sp = 0u;
    for (;;) {
        sum = 0u; cnt = 0u; mine = 0u;
#pragma unroll
        for (unsigned j = 0; j < 16; ++j) { const unsigned c = xb_ld(&bar[XB_XCNT(j)]); sum += c; cnt += (c > 0u) ? 1u : 0u; mine = (j == x) ? c : mine; }
        if (sum == G) break;
        __builtin_amdgcn_s_sleep(1);
        if ((++sp & 255u) == 0u) { if (xb_ld(&bar[XB_TMO])) break; if (sp > XB_SPIN_CAP) { atomicAdd(&bar[XB_TMO], 1u); break; } }
    }
    nloc = mine > 0u ? mine : 1u; nx = cnt > 0u ? cnt : 1u;
}

__device__ __forceinline__ void xcd_barrier(const XcdBarrier& b) {
    asm volatile("s_waitcnt vmcnt(0)" ::: "memory");
    __syncthreads();
    if (threadIdx.x == 0) {
        unsigned* bar = b.bar;
        __builtin_amdgcn_s_waitcnt(0);
        unsigned nloc = b.st[0], nx = b.st[1];
        if (nloc == 0u) { xcd_barrier_complete(bar, b.x, nloc, nx); b.st[0] = nloc; b.st[1] = nx; }
        const unsigned old = xb_add(&bar[XB_XSUB(b.x)], 1u);
        const unsigned gen = old / nloc;
        if (old + 1u == (gen + 1u) * nloc) {
            __builtin_amdgcn_fence(__ATOMIC_RELEASE, "agent");
            asm volatile("s_waitcnt vmcnt(0)" ::: "memory");
            const unsigned og = xb_add(&bar[XB_TOP], 1u);
            const unsigned tg = og / nx;
            if (og + 1u == (tg + 1u) * nx) xb_add(&bar[XB_TOPGEN], 1u);
            else XB_SPIN(xb_ld(&bar[XB_TOPGEN]) == tg, bar);
            __builtin_amdgcn_fence(__ATOMIC_ACQUIRE, "agent");
            xb_add(&bar[XB_XGEN(b.x)], 1u);
            asm volatile("s_waitcnt vmcnt(0)" ::: "memory");
        } else {
            XB_SPIN(xb_ld(&bar[XB_XGEN(b.x)]) == gen, bar);
            __builtin_amdgcn_fence(__ATOMIC_ACQUIRE, "agent");
            asm volatile("s_waitcnt vmcnt(0)" ::: "memory");
        }
    }
    __syncthreads();
}

__global__ void __launch_bounds__(512, 2) mk_fwd(Params p) {
    extern __shared__ __attribute__((aligned(16))) unsigned char lds[];
    unsigned char* ws0 = p.ws;
    PG8_LAS unsigned char* ring = (PG8_LAS unsigned char*)lds;
#if MK_MULTI
#define GRID_SYNC() do { } while (0)
#else
    cg::grid_group grid = cg::this_grid();
    volatile LAS unsigned* bst = (volatile LAS unsigned*)((LAS unsigned char*)lds + pg8::STAGE_BYTES);
    if (threadIdx.x < 2) bst[threadIdx.x] = 0u;
    __syncthreads();
    XcdBarrier xbar = xcd_barrier_post((unsigned*)(ws0 + WS_CTL), bst);
#define GRID_SYNC() do { if (ph == 0) grid.sync(); else xcd_barrier(xbar); } while (0)
#endif
    for (int ph = p.ph_lo; ph < p.ph_hi; ++ph) {
        unsigned char* ws = ws0; int G = gridDim.x, c = blockIdx.x; asm volatile("" : "+s"(ws), "+s"(G), "+s"(c));
        float* ssq_mix = (float*)(ws + WS_SSQM); float* ssq_ffn = (float*)(ws + WS_SSQF); float* lns = (float*)(ws + WS_LNS);
        bf16_t* XB = (bf16_t*)(ws + WS_XB); bf16_t* AB = (bf16_t*)(ws + WS_AB); bf16_t* GV = (bf16_t*)(ws + WS_GV); bf16_t* CH = (bf16_t*)(ws + WS_CH);
        bf16_t* T12 = GV; bf16_t* MMb = AB; bf16_t* Hb = AB;
        if (ph == 0) { if (PHASE_MASK & 1) { if (PROBE_DUP & 512) p0_prologue(p, (float*)lds); p0_prologue(p, (float*)lds); } }
        else if (ph == NPHASE - 1) { if (PHASE_MASK & 2) final_norm_phase(p); }
        else {
            const int l = (ph - 1) / 7, s = (ph - 1) % 7;
            for (int rep_ = 0; rep_ < (((PROBE_DUP >> s) & 1) ? 2 : 1); ++rep_) {
            const unsigned char* lw = ws + WS_W + (size_t)l * LW_BYTES;
            if (s == 0) { if (PHASE_MASK & 4) {
                pg8::Gemm g{XB, (const bf16_t*)(lw + LW_WIN), MT, 5120, DM, DM, 1 << 30, 0}; pg8::StaticOrder S; S.init(MT, 5120, G, c);
                pg8::EpiA E{AB, GV, CH, ssq_mix, lns};
                pg8::gemm_phase<pg8::EpiA, pg8::StaticOrder>(ring, g, S, E); }
            } else if (s == 1) {
                if (PHASE_MASK & 8) gate_conv_phase(p, l, lds);
            } else if (s == 2) { if (PHASE_MASK & 16) {
                pg8::Gemm g{AB, (const bf16_t*)(lw + LW_WPAB), MT, 2048, DM, 2048, 4, 1024}; pg8::StaticOrder S; S.init(MT, 2048, G, c);
                pg8::EpiC E{T12};
                pg8::gemm_phase<pg8::EpiC, pg8::StaticOrder>(ring, g, S, E); }
            } else if (s == 3) { if (PHASE_MASK & 32) {
                pg8::Gemm g{XB, (const bf16_t*)(lw + LW_WIN) + (size_t)5120 * DM, MT, 2048, DM, DM, 1 << 30, 0}; pg8::StaticOrder S; S.init(MT, 2048, G, c);
                pg8::EpiD E{T12, MMb, ssq_mix};
                pg8::gemm_phase<pg8::EpiD, pg8::StaticOrder>(ring, g, S, E); }
            } else if (s == 4) { if (PHASE_MASK & 64) {
                pg8::Gemm g{MMb, (const bf16_t*)(lw + LW_WO), MT, DM, DM, DM, 1 << 30, 0}; pg8::StaticOrder S; S.init(MT, DM, G, c);
                pg8::EpiRes E{XB, ssq_ffn};
                pg8::gemm_phase<pg8::EpiRes, pg8::StaticOrder>(ring, g, S, E); }
            } else if (s == 5) { if (PHASE_MASK & 128) {
                pg8::Gemm g{XB, (const bf16_t*)(lw + LW_WGU), MT, 2 * DFF, DM, DM, 1 << 30, 0}; pg8::StaticOrder S; S.init(MT, 2 * DFF, G, c);
                pg8::EpiF E{Hb, ssq_ffn};
                pg8::gemm_phase<pg8::EpiF, pg8::StaticOrder>(ring, g, S, E); }
            } else { if (PHASE_MASK & 256) {
                pg8::Gemm g{Hb, (const bf16_t*)(lw + LW_WD), MT, DM, DFF, DFF, 1 << 30, 0}; pg8::StaticOrder S; S.init(MT, DM, G, c);
                pg8::EpiRes E{XB, ssq_mix};
                pg8::gemm_phase<pg8::EpiRes, pg8::StaticOrder>(ring, g, S, E); }
            }
            }
        }
        if (ph + 1 < p.ph_hi) { GRID_SYNC(); }
    }
}

extern "C" void kernel_launch(void* const* d_in, const int* in_sizes, int n_in, void* d_out, int out_size, void* d_ws, size_t ws_size, hipStream_t stream) {
    static int grid = 0;
    if (grid == 0) {
        if (n_in != 18 || in_sizes[0] != MP * DM || (size_t)out_size != OUT_TOTAL || ws_size < WS_END) {
            fprintf(stderr, "kernel_launch: unexpected shapes: n_in %d in0 %d out %d ws %zu (need %zu)\n", n_in, n_in > 0 ? in_sizes[0] : -1, out_size, ws_size, (size_t)WS_END); grid = -1; return; }
        int dev = 0, cus = 0, per_cu = 0;
        (void)hipGetDevice(&dev); (void)hipDeviceGetAttribute(&cus, hipDeviceAttributeMultiprocessorCount, dev);
        if (hipFuncSetAttribute((const void*)mk_fwd, hipFuncAttributeMaxDynamicSharedMemorySize, LDS_BYTES) != hipSuccess) { fprintf(stderr, "kernel_launch: hipFuncSetAttribute failed\n"); grid = -1; return; }
        if (hipOccupancyMaxActiveBlocksPerMultiprocessor(&per_cu, (const void*)mk_fwd, 512, LDS_BYTES) != hipSuccess || per_cu < 1) { fprintf(stderr, "kernel_launch: occupancy query says %d\n", per_cu); per_cu = 1; }
        (void)hipGetLastError();
        grid = cus * 1;
        fprintf(stderr, "kernel_launch: cus %d per_cu %d grid %d\n", cus, per_cu, grid);
    }
    if (grid < 0) return;
    if (hipMemsetAsync((char*)d_ws + WS_CTL, 0, CTL_BYTES, stream) != hipSuccess) { fprintf(stderr, "kernel_launch: memset failed\n"); return; }
    Params p{};
    const float** pp = (const float**)&p;
    for (int i = 0; i < 18; ++i) pp[i] = (const float*)d_in[i];
    p.out = (float*)d_out; p.ws = (unsigned char*)d_ws;
#if MK_MULTI
    for (int ph = 0; ph < NPHASE; ++ph) { p.ph_lo = ph; p.ph_hi = ph + 1; hipLaunchKernelGGL(mk_fwd, dim3(grid), dim3(512), LDS_BYTES, stream, p); }
#else
    p.ph_lo = 0; p.ph_hi = NPHASE;
    void* args[] = {&p};
    hipError_t e = hipLaunchCooperativeKernel((const void*)mk_fwd, dim3(grid), dim3(512), args, LDS_BYTES, stream);
    if (e != hipSuccess) fprintf(stderr, "kernel_launch: cooperative launch failed: %s (grid %d)\n", hipGetErrorString(e), grid);
#endif
}
```

```cpp
#include <hip/hip_runtime.h>
#include <hip/hip_cooperative_groups.h>
#include <cstdio>
#include <cstdint>
namespace cg = cooperative_groups;

#ifndef PHASE_MASK
#define PHASE_MASK 511
#endif
#ifndef PROBE_DUP
#define PROBE_DUP 0
#endif
#ifndef MK_MULTI
#define MK_MULTI 0
#endif

constexpr int MP = 65536, MS = 1024, MT = MP + MS, DM = 1024, NL = 4, DFF = 2816, NIN = 7168;
constexpr float EPS = 1e-6f;
constexpr size_t OUT_YS = (size_t)MP * DM, OUT_NCP = OUT_YS + (size_t)MS * DM, OUT_NCS = OUT_NCP + (size_t)NL * 32 * 2 * DM, OUT_V = OUT_NCS + (size_t)NL * 32 * 2 * DM;
constexpr size_t OUT_TOTAL = OUT_V + (size_t)NL * 32 * 32 * DM;

constexpr size_t MiB = (size_t)1 << 20;
constexpr size_t WS_SSQM = 0, WS_SSQF = 5 * MiB, WS_LNS = 10 * MiB;
constexpr size_t WS_CTL = 20 * MiB, CTL_BYTES = 16384;
constexpr size_t WS_W = 24 * MiB;
constexpr size_t LW_WIN = 0, LW_WPAB = LW_WIN + (size_t)NIN * DM * 2, LW_WO = LW_WPAB + (size_t)2048 * DM * 2, LW_WGU = LW_WO + (size_t)DM * DM * 2,
                 LW_WD = LW_WGU + (size_t)2 * DFF * DM * 2, LW_WSP = LW_WD + (size_t)DM * DFF * 2, LW_WSS = LW_WSP + (size_t)8 * 128 * 128 * 2, LW_BYTES = LW_WSS + (size_t)8 * 128 * 128 * 2;
constexpr size_t WS_XB = 176 * MiB;
constexpr size_t WS_AB = 306 * MiB;
constexpr size_t WS_GV = 566 * MiB;
constexpr size_t WS_CH = 696 * MiB;
constexpr size_t WS_END = 826 * MiB;
static_assert(WS_W + NL * LW_BYTES <= WS_XB, "weights overflow");

namespace pg8 {
#define PG8_LAS __attribute__((address_space(3)))
typedef unsigned short bf16_t;
typedef short bf16x8 __attribute__((ext_vector_type(8)));
typedef float f32x4 __attribute__((ext_vector_type(4)));
typedef float f32x2 __attribute__((ext_vector_type(2)));
typedef unsigned u32x4 __attribute__((ext_vector_type(4)));
typedef unsigned u32x2 __attribute__((ext_vector_type(2)));
constexpr int BM = 256, BK = 64, HALF = 128, HTB = HALF * BK * 2, STAGE_BYTES = 8 * HTB, NXCD = 8, WGM = 8;

__host__ __device__ __forceinline__ int lds_byte(int r, int c) { const int st = (r >> 4) * 2 + (c >> 5), rr = r & 15, cc = c & 31, ob = rr * 64 + cc * 2; return st * 1024 + (ob ^ (((ob >> 9) & 1) << 5)); }
__host__ __device__ __forceinline__ void stage_rc(int b, int& R, int& C) { const int st = b / 1024, sb = b % 1024, swz = sb ^ (((sb >> 9) & 1) << 5); R = (st >> 1) * 16 + swz / 64; C = (st & 1) * 32 + (swz % 64) / 2; }
__host__ __device__ __forceinline__ int perm32(int rho) { const int n = rho >> 4, i = rho & 15; return 8 * (i >> 2) + 4 * n + (i & 3); }

struct Unit { int pm, pn, half, rbase; };
struct Gemm { const bf16_t* A; const bf16_t* Bt; int M, N, K, lda, asplit_pn, asplit_off; };

struct StaticOrder {
    int nM, nN, nwg, G, c, ntot;
    __host__ __device__ void init(int M, int N, int G_, int c_) { nM = MP / BM; nN = N / BM; nwg = nM * nN; G = G_; c = c_; ntot = nwg + 2 * ((M / BM) - nM) * nN; }
    __host__ __device__ bool next(int i, Unit& u) const {
        const long L = (long)i * G + c; if (L >= ntot) return false;
        if (L >= nwg) { const int h = (int)L - nwg, hp = h / nN; u.pn = h - hp * nN; u.pm = nM + (hp >> 1); u.half = 1; u.rbase = u.pm * BM + (hp & 1) * HALF; return true; }
        int wgid = (int)L; { const int q = nwg / NXCD, r = nwg % NXCD, xcd = wgid % NXCD, off = wgid / NXCD; wgid = (xcd < r ? xcd * (q + 1) : r * (q + 1) + (xcd - r) * q) + off; }
        const int nig = WGM * nN, gid = wgid / nig, fm = gid * WGM, gsz = (nM - fm) < WGM ? (nM - fm) : WGM;
        u.pm = fm + ((wgid % nig) % gsz); u.pn = (wgid % nig) / gsz; u.half = 0; u.rbase = u.pm * BM; return true;
    }
    __device__ __forceinline__ void a_ready(const Unit&) const {}
    __device__ __forceinline__ void done(const Unit&) const {}
};

__device__ __forceinline__ unsigned cvt_pk_bf16(float lo, float hi) { unsigned r; asm volatile("v_cvt_pk_bf16_f32 %0, %1, %2" : "=v"(r) : "v"(lo), "v"(hi)); return r; }
__device__ __forceinline__ float bf_lo(unsigned w) { return __uint_as_float(w << 16); }
__device__ __forceinline__ float bf_hi(unsigned w) { return __uint_as_float(w & 0xffff0000u); }
__device__ __forceinline__ f32x2 gelu_pk(f32x2 v) {
    const f32x2 av = __builtin_elementwise_abs(v), d = av * 0.2316418882f + 1.0f;
    f32x2 t; t.x = __builtin_amdgcn_rcpf(d.x); t.y = __builtin_amdgcn_rcpf(d.y);
    f32x2 q = t * 0.5307027145f + (-0.7265760135f); q = q * t + 0.7107068705f; q = q * t + (-0.142248368f); q = q * t + 0.127414796f; q = q * t;
    const f32x2 s = (v * v) * (-0.72134752044f);
    f32x2 e; e.x = __builtin_amdgcn_exp2f(s.x); e.y = __builtin_amdgcn_exp2f(s.y);
    const f32x2 m = v * (q * e), r = v - m;
    f32x2 o; o.x = v.x < 0.f ? m.x : r.x; o.y = v.y < 0.f ? m.y : r.y; return o;
}
__device__ __forceinline__ f32x4 gelu4(f32x4 v) { const f32x2 a = gelu_pk((f32x2){v[0], v[1]}), b = gelu_pk((f32x2){v[2], v[3]}); return (f32x4){a.x, a.y, b.x, b.y}; }
__device__ __forceinline__ float sigmoidf_(float x) { return __builtin_amdgcn_rcpf(1.0f + __builtin_amdgcn_exp2f(x * -1.44269504f)); }
__device__ __forceinline__ f32x4 sigmoid4(f32x4 v) { return (f32x4){sigmoidf_(v[0]), sigmoidf_(v[1]), sigmoidf_(v[2]), sigmoidf_(v[3])}; }
__device__ __forceinline__ u32x4 pack8(f32x4 v0, f32x4 v1) { u32x4 w; w.x = cvt_pk_bf16(v0[0], v0[1]); w.y = cvt_pk_bf16(v0[2], v0[3]); w.z = cvt_pk_bf16(v1[0], v1[1]); w.w = cvt_pk_bf16(v1[2], v1[3]); return w; }
__device__ __forceinline__ float rstd_of(const float* slots, int row) { const f32x4* s = (const f32x4*)(slots + (size_t)row * 16); const f32x4 t = (s[0] + s[1]) + (s[2] + s[3]);
    return __builtin_amdgcn_rsqf(((t[0] + t[1]) + (t[2] + t[3])) * (1.0f / 1024.0f) + EPS); }

__device__ __forceinline__ void wave_rstd(const float* slots, int rowbase, int lane, int fr, float (&rs)[2][4]) {
    float val[2];
    const f32x4* sa = (const f32x4*)(slots + (size_t)(rowbase + lane) * 16); const f32x4* sb = (const f32x4*)(slots + (size_t)(rowbase + HALF + lane) * 16);
    const f32x4 a0 = sa[0], a1 = sa[1], a2 = sa[2], a3 = sa[3], b0 = sb[0], b1 = sb[1], b2 = sb[2], b3 = sb[3];
    __builtin_amdgcn_sched_barrier(0);
    { const f32x4 t = (a0 + a1) + (a2 + a3); val[0] = __builtin_amdgcn_rsqf(((t[0] + t[1]) + (t[2] + t[3])) * (1.0f / 1024.0f) + EPS); }
    { const f32x4 t = (b0 + b1) + (b2 + b3); val[1] = __builtin_amdgcn_rsqf(((t[0] + t[1]) + (t[2] + t[3])) * (1.0f / 1024.0f) + EPS); }
#pragma unroll
    for (int ai = 0; ai < 2; ++ai)
#pragma unroll
        for (int m = 0; m < 4; ++m) rs[ai][m] = __shfl(val[ai], m * 16 + fr);
}
__device__ __forceinline__ f32x4 unpk_lo(u32x4 w) { return (f32x4){bf_lo(w[0]), bf_hi(w[0]), bf_lo(w[1]), bf_hi(w[1])}; }
__device__ __forceinline__ f32x4 unpk_hi(u32x4 w) { return (f32x4){bf_lo(w[2]), bf_hi(w[2]), bf_lo(w[3]), bf_hi(w[3])}; }

struct EpiA {
    static constexpr bool PERM = true, AFTER_DRAIN = false; static constexpr int NVM = 16;

    bf16_t* AB; bf16_t* GV; bf16_t* CH; const float* ssq; float* lns;
    __device__ __forceinline__ void operator()(const f32x4 (&acc)[2][2][4][2], const Unit& u, int wr, int wc, int fr, int fq) const {
        const int row0 = u.rbase + wr * 64 + fr, cw = wc * 32 + 8 * fq, pn = u.pn;
        float rsv[2][4]; wave_rstd(ssq, u.rbase + wr * 64, fr + 16 * fq, fr, rsv);
        if (pn < 4) {
#pragma unroll
            for (int ai = 0; ai < 2; ++ai)
#pragma unroll
                for (int m = 0; m < 4; ++m) { if (ai == 1 && u.half) continue; const int row = row0 + ai * HALF + m * 16; const float rs = rsv[ai][m]; bf16_t* rowp = AB + (size_t)row * 2048 + pn * 256 + cw;
#pragma unroll
                    for (int bj = 0; bj < 2; ++bj) *(u32x4*)(rowp + bj * HALF) = pack8(gelu4(acc[ai][bj][m][0] * rs), gelu4(acc[ai][bj][m][1] * rs)); }
        } else if (pn < 8) {
#pragma unroll
            for (int ai = 0; ai < 2; ++ai)
#pragma unroll
                for (int m = 0; m < 4; ++m) { if (ai == 1 && u.half) continue; const int row = row0 + ai * HALF + m * 16; const float rs = rsv[ai][m]; bf16_t* rowp = GV + (size_t)row * 1024 + (pn - 4) * 256 + cw;
                    float s = 0.f, q = 0.f;
#pragma unroll
                    for (int bj = 0; bj < 2; ++bj) { const u32x4 w = pack8(gelu4(acc[ai][bj][m][0] * rs), gelu4(acc[ai][bj][m][1] * rs)); *(u32x4*)(rowp + bj * HALF) = w;
#pragma unroll
                        for (int e = 0; e < 4; ++e) { const float a = bf_lo(w[e]), b = bf_hi(w[e]); s += a + b; q += a * a + b * b; } }
                    s += __shfl_xor(s, 16); s += __shfl_xor(s, 32); q += __shfl_xor(q, 16); q += __shfl_xor(q, 32);
                    if (fq == 0) *(f32x2*)(lns + ((size_t)row * 16 + (pn - 4) * 4 + wc) * 2) = (f32x2){s, q}; }
        } else if (pn < 12) {
#pragma unroll
            for (int ai = 0; ai < 2; ++ai)
#pragma unroll
                for (int m = 0; m < 4; ++m) { if (ai == 1 && u.half) continue; const int row = row0 + ai * HALF + m * 16; const float rs = rsv[ai][m]; bf16_t* rowp = AB + (size_t)row * 2048 + 1024 + (pn - 8) * 256 + cw;
#pragma unroll
                    for (int bj = 0; bj < 2; ++bj) *(u32x4*)(rowp + bj * HALF) = pack8(acc[ai][bj][m][0] * rs, acc[ai][bj][m][1] * rs); }
        } else {
#pragma unroll
            for (int ai = 0; ai < 2; ++ai)
#pragma unroll
                for (int m = 0; m < 4; ++m) { if (ai == 1 && u.half) continue; const int row = row0 + ai * HALF + m * 16; const float rs = rsv[ai][m]; const float rs2 = rs * rs;
                    *(u32x4*)(CH + (size_t)row * 1024 + (pn - 12) * 128 + cw) = pack8(acc[ai][0][m][0] * acc[ai][1][m][0] * rs2, acc[ai][0][m][1] * acc[ai][1][m][1] * rs2); }
        }
    }
};
struct EpiC {
    static constexpr bool PERM = true, AFTER_DRAIN = false; static constexpr int NVM = 16;

    bf16_t* T;
    __device__ __forceinline__ void operator()(const f32x4 (&acc)[2][2][4][2], const Unit& u, int wr, int wc, int fr, int fq) const {
        const int row0 = u.rbase + wr * 64 + fr, cw = u.pn * 256 + wc * 32 + 8 * fq;
#pragma unroll
        for (int ai = 0; ai < 2; ++ai)
#pragma unroll
            for (int m = 0; m < 4; ++m) { if (ai == 1 && u.half) continue; bf16_t* rowp = T + (size_t)(row0 + ai * HALF + m * 16) * 2048 + cw;
#pragma unroll
                for (int bj = 0; bj < 2; ++bj) *(u32x4*)(rowp + bj * HALF) = pack8(acc[ai][bj][m][0], acc[ai][bj][m][1]); }
    }
};
struct EpiD {
    static constexpr bool PERM = true, AFTER_DRAIN = false; static constexpr int NVM = 24;

    const bf16_t* T; bf16_t* MM; const float* ssq;
    __device__ __forceinline__ void operator()(const f32x4 (&acc)[2][2][4][2], const Unit& u, int wr, int wc, int fr, int fq) const {
        const int row0 = u.rbase + wr * 64 + fr, cw = u.pn * 128 + wc * 32 + 8 * fq;
        u32x4 tt[4][2];
#pragma unroll
        for (int m = 0; m < 4; ++m) { const bf16_t* tp = T + (size_t)(row0 + m * 16) * 2048 + cw; tt[m][0] = *(const u32x4*)tp; tt[m][1] = *(const u32x4*)(tp + 1024); }
        float rsv[2][4]; wave_rstd(ssq, u.rbase + wr * 64, fr + 16 * fq, fr, rsv);
#pragma unroll
        for (int ai = 0; ai < 2; ++ai) {
            if (ai == 1 && u.half) break;
            if (ai == 1) {
#pragma unroll
                for (int m = 0; m < 4; ++m) { const bf16_t* tp = T + (size_t)(row0 + HALF + m * 16) * 2048 + cw; tt[m][0] = *(const u32x4*)tp; tt[m][1] = *(const u32x4*)(tp + 1024); } }
#pragma unroll
            for (int m = 0; m < 4; ++m) { const int row = row0 + ai * HALF + m * 16; const float rs = rsv[ai][m];
                const u32x4 t1 = tt[m][0], t2 = tt[m][1];
                const f32x4 a0 = sigmoid4(acc[ai][0][m][0] * rs), a1 = sigmoid4(acc[ai][0][m][1] * rs), b0 = sigmoid4(acc[ai][1][m][0] * rs), b1 = sigmoid4(acc[ai][1][m][1] * rs);
                const f32x4 p0 = {bf_lo(t1[0]), bf_hi(t1[0]), bf_lo(t1[1]), bf_hi(t1[1])}, p1 = {bf_lo(t1[2]), bf_hi(t1[2]), bf_lo(t1[3]), bf_hi(t1[3])};
                const f32x4 q0 = {bf_lo(t2[0]), bf_hi(t2[0]), bf_lo(t2[1]), bf_hi(t2[1])}, q1 = {bf_lo(t2[2]), bf_hi(t2[2]), bf_lo(t2[3]), bf_hi(t2[3])};
                *(u32x4*)(MM + (size_t)row * 1024 + cw) = pack8(a0 * p0 + b0 * q0, a1 * p1 + b1 * q1); }
            asm volatile("" ::: "memory");
        }
    }
};
struct EpiRes {
    static constexpr bool PERM = true, AFTER_DRAIN = false; static constexpr int NVM = 24;

    bf16_t* xb; float* ssq;
    __device__ __forceinline__ void operator()(const f32x4 (&acc)[2][2][4][2], const Unit& u, int wr, int wc, int fr, int fq) const {
        const int row0 = u.rbase + wr * 64 + fr, cw = u.pn * BM + wc * 32 + 8 * fq;
#pragma unroll
        for (int ai = 0; ai < 2; ++ai) {
            if (ai == 1 && u.half) break;
            u32x4 xo[4][2];
#pragma unroll
            for (int m = 0; m < 4; ++m)
#pragma unroll
                for (int bj = 0; bj < 2; ++bj) xo[m][bj] = *(const u32x4*)(xb + (size_t)(row0 + ai * HALF + m * 16) * DM + cw + bj * HALF);
#pragma unroll
            for (int m = 0; m < 4; ++m) { const int row = row0 + ai * HALF + m * 16; float q = 0.f;
#pragma unroll
                for (int bj = 0; bj < 2; ++bj) { const u32x4 w = pack8(acc[ai][bj][m][0] + unpk_lo(xo[m][bj]), acc[ai][bj][m][1] + unpk_hi(xo[m][bj]));
                    *(u32x4*)(xb + (size_t)row * DM + cw + bj * HALF) = w;
#pragma unroll
                    for (int e = 0; e < 4; ++e) { const float a = bf_lo(w[e]), b = bf_hi(w[e]); q += a * a + b * b; } }
                q += __shfl_xor(q, 16); q += __shfl_xor(q, 32);
                if (fq == 0) ssq[(size_t)row * 16 + u.pn * 4 + wc] = q; }
            asm volatile("" ::: "memory");
        }
    }
};
struct EpiF {
    static constexpr bool PERM = true, AFTER_DRAIN = false; static constexpr int NVM = 16;

    bf16_t* H; const float* ssq;
    __device__ __forceinline__ void operator()(const f32x4 (&acc)[2][2][4][2], const Unit& u, int wr, int wc, int fr, int fq) const {
        const int row0 = u.rbase + wr * 64 + fr, cw = u.pn * 128 + wc * 32 + 8 * fq;
        float rsv[2][4]; wave_rstd(ssq, u.rbase + wr * 64, fr + 16 * fq, fr, rsv);
#pragma unroll
        for (int ai = 0; ai < 2; ++ai)
#pragma unroll
            for (int m = 0; m < 4; ++m) { if (ai == 1 && u.half) continue; const int row = row0 + ai * HALF + m * 16; const float rs = rsv[ai][m];
                const f32x4 g0 = acc[ai][0][m][0] * rs, g1 = acc[ai][0][m][1] * rs, u0 = acc[ai][1][m][0] * rs, u1 = acc[ai][1][m][1] * rs;
                *(u32x4*)(H + (size_t)row * DFF + cw) = pack8(g0 * sigmoid4(g0) * u0, g1 * sigmoid4(g1) * u1); }
    }
};

#ifndef PG8_SP2
#define PG8_SP2 true
#endif
#ifndef PG8_ALIGN
#define PG8_ALIGN true
#endif
template <class Epi, class Sched, bool SP2 = PG8_SP2, bool ALIGN_EPI = PG8_ALIGN>
__device__ __forceinline__ void gemm_phase(PG8_LAS unsigned char* lds, const Gemm g, const Sched& S, const Epi& E) {
    int tid = threadIdx.x; asm volatile("" : "+v"(tid));
    const int wid = __builtin_amdgcn_readfirstlane(tid >> 6), lane = tid & 63, wr = wid >> 2, wc = wid & 3, fr = lane & 15, fq = lane >> 4;
    const int K = g.K, nt = K / BK, lda = g.lda;
    unsigned voffA[2], voffB[2];
#pragma unroll
    for (int i = 0; i < 2; ++i) { int R, C; stage_rc(tid * 16 + i * 8192, R, C); const int Rb = Epi::PERM ? ((R & ~31) + perm32(R & 31)) : R;
        voffA[i] = (unsigned)(R * lda + C) * 2u; voffB[i] = (unsigned)(Rb * K + C) * 2u; }
    const size_t kstep = (size_t)(BK * 2);
    const size_t hstepA = (size_t)HALF * lda * 2, hstepB = (size_t)HALF * K * 2;
    const size_t tstepA = 2 * hstepA, tstepB = 2 * hstepB;
    const unsigned ldsw = (unsigned)wid * 1024u;
    const int aoff = lds_byte(wr * 64 + fr, fq * 8), boff = lds_byte(wc * 32 + fr, fq * 8);
#define PG8_SA(b, h) (((b) * 2 + (h)) * HTB)
#define PG8_SB(b, h) ((4 + (b) * 2 + (h)) * HTB)
#define PG8_STAGE(bufoff, gbase, voff) do { _Pragma("unroll") for (int _i = 0; _i < 2; ++_i) \
        __builtin_amdgcn_global_load_lds((const unsigned*)((const char*)(gbase) + (voff)[_i]), (PG8_LAS unsigned*)(lds + (bufoff) + ldsw + _i * 8192), 16, 0, 0); } while (0)
#define PG8_LDA(dst, b, h) do { _Pragma("unroll") for (int m = 0; m < 4; ++m) _Pragma("unroll") for (int k = 0; k < 2; ++k) dst[m][k] = *(const PG8_LAS bf16x8*)(lds + PG8_SA(b, h) + aoff + m * 2048 + k * 1024); } while (0)
#define PG8_LDB(dst, b, h) do { _Pragma("unroll") for (int n = 0; n < 2; ++n) _Pragma("unroll") for (int k = 0; k < 2; ++k) dst[n][k] = *(const PG8_LAS bf16x8*)(lds + PG8_SB(b, h) + boff + n * 2048 + k * 1024); } while (0)
#define PG8_MMA(ai, bj, At, Bt) do { __builtin_amdgcn_s_setprio(1); _Pragma("unroll") for (int m = 0; m < 4; ++m) _Pragma("unroll") for (int n = 0; n < 2; ++n) _Pragma("unroll") for (int k = 0; k < 2; ++k) \
        acc[ai][bj][m][n] = __builtin_amdgcn_mfma_f32_16x16x32_bf16(Bt[n][k], At[m][k], acc[ai][bj][m][n], 0, 0, 0); __builtin_amdgcn_s_setprio(0); } while (0)
#define PG8_WAIT_V(n) asm volatile("s_waitcnt vmcnt(" #n ")" ::: "memory")
#define PG8_WAIT_L(n) asm volatile("s_waitcnt lgkmcnt(" #n ")" ::: "memory")
#define PG8_WAIT_V8X do { if constexpr (Epi::NVM >= 24) asm volatile("s_cmp_eq_u32 %0, 0\n\ts_cbranch_scc1 1f\n\ts_waitcnt vmcnt(8)\n1:\n\ts_waitcnt vmcnt(32)" :: "s"(t) : "scc", "memory"); \
        else asm volatile("s_cmp_eq_u32 %0, 0\n\ts_cbranch_scc1 1f\n\ts_waitcnt vmcnt(8)\n1:\n\ts_waitcnt vmcnt(24)" :: "s"(t) : "scc", "memory"); } while (0)
#define PG8_BAR __builtin_amdgcn_s_barrier()
#define PG8_SCHED __builtin_amdgcn_sched_barrier(0)
#define PG8_APTR(u) ((const char*)g.A + (size_t)((u).rbase) * lda * 2 + (((u).pn >= g.asplit_pn) ? (size_t)g.asplit_off * 2 : (size_t)0))
    Unit cur, nxt; int ui = 0;
    if (!S.next(0, cur)) return;
    f32x4 acc[2][2][4][2];
#pragma unroll
    for (int a = 0; a < 2; ++a)
#pragma unroll
        for (int b = 0; b < 2; ++b)
#pragma unroll
            for (int m = 0; m < 4; ++m)
#pragma unroll
                for (int n = 0; n < 2; ++n) acc[a][b][m][n] = (f32x4){0.f, 0.f, 0.f, 0.f};
    bf16x8 At[4][2], B0[2][2], B1[2][2];
    const char* cA = PG8_APTR(cur); const char* cB = (const char*)g.Bt + (size_t)cur.pn * tstepB;
    S.a_ready(cur);
    if constexpr (SP2) {
        PG8_STAGE(PG8_SB(0, 0), cB, voffB); PG8_STAGE(PG8_SB(0, 1), cB + hstepB, voffB); PG8_STAGE(PG8_SA(0, 0), cA, voffA); PG8_STAGE(PG8_SA(0, 1), cA + hstepA, voffA);
        if (wr == 1) PG8_BAR;
        PG8_WAIT_V(2); PG8_BAR;
        PG8_STAGE(PG8_SB(1, 0), cB + kstep, voffB); PG8_STAGE(PG8_SA(1, 0), cA + kstep, voffA); PG8_STAGE(PG8_SB(1, 1), cB + hstepB + kstep, voffB);
        PG8_WAIT_V(0); PG8_BAR;
    } else {
    PG8_STAGE(PG8_SB(0, 0), cB, voffB); PG8_STAGE(PG8_SA(0, 0), cA, voffA); PG8_STAGE(PG8_SB(0, 1), cB + hstepB, voffB); PG8_STAGE(PG8_SA(0, 1), cA + hstepA, voffA);
    if (wr == 1) PG8_BAR;
    PG8_WAIT_V(4); PG8_BAR;
    PG8_STAGE(PG8_SB(1, 0), cB + kstep, voffB); PG8_STAGE(PG8_SA(1, 0), cA + kstep, voffA); PG8_STAGE(PG8_SB(1, 1), cB + hstepB + kstep, voffB);
    PG8_WAIT_V(6); PG8_BAR;
    }
    for (;;) {
        const bool has_next = S.next(ui + 1, nxt);
        const char* nA = has_next ? PG8_APTR(nxt) : cA; const char* nB = has_next ? (const char*)g.Bt + (size_t)nxt.pn * tstepB : cB;
        const bool hlf = cur.half != 0;
        for (int t = 0; t < nt; t += 2) {
            const bool last = (t == nt - 2);
            const char* a1 = cA + (size_t)(t + 1) * kstep;
            const char* a2 = last ? nA : cA + (size_t)(t + 2) * kstep; const char* b2 = last ? nB : cB + (size_t)(t + 2) * kstep;
            const char* a3 = a2 + kstep; const char* b3 = b2 + kstep;
            if (last && has_next) S.a_ready(nxt);
            if constexpr (SP2) {
            PG8_LDB(B0, 0, 0); PG8_LDB(B1, 0, 1); PG8_SCHED; PG8_LDA(At, 0, 0); PG8_STAGE(PG8_SA(1, 1), a1 + hstepA, voffA);
            PG8_WAIT_V8X; PG8_WAIT_L(0); PG8_BAR; PG8_MMA(0, 0, At, B0); PG8_MMA(0, 1, At, B1); PG8_BAR; PG8_SCHED;
            if (!hlf) { PG8_LDA(At, 0, 1); } PG8_STAGE(PG8_SB(0, 0), b2, voffB); PG8_STAGE(PG8_SB(0, 1), b2 + hstepB, voffB); PG8_STAGE(PG8_SA(0, 0), a2, voffA);
            PG8_WAIT_V8X; PG8_WAIT_L(0); PG8_BAR; if (!hlf) { PG8_MMA(1, 0, At, B0); PG8_MMA(1, 1, At, B1); } PG8_BAR; PG8_SCHED;
            PG8_LDB(B0, 1, 0); PG8_LDB(B1, 1, 1); PG8_SCHED; PG8_LDA(At, 1, 0); PG8_STAGE(PG8_SA(0, 1), a2 + hstepA, voffA);
            PG8_WAIT_V(8); PG8_WAIT_L(0); PG8_BAR; PG8_MMA(0, 0, At, B0); PG8_MMA(0, 1, At, B1); PG8_BAR; PG8_SCHED;
            if (!hlf) { PG8_LDA(At, 1, 1); } PG8_STAGE(PG8_SB(1, 0), b3, voffB); PG8_STAGE(PG8_SB(1, 1), b3 + hstepB, voffB); PG8_STAGE(PG8_SA(1, 0), a3, voffA);
            PG8_WAIT_V(8); PG8_WAIT_L(0); PG8_BAR; if (!hlf) { PG8_MMA(1, 0, At, B0); PG8_MMA(1, 1, At, B1); } PG8_BAR; PG8_SCHED;
            } else {
            PG8_LDB(B0, 0, 0); PG8_SCHED; PG8_LDA(At, 0, 0); PG8_STAGE(PG8_SA(1, 1), a1 + hstepA, voffA);
            PG8_WAIT_L(8); PG8_BAR; PG8_WAIT_L(0); PG8_MMA(0, 0, At, B0); PG8_BAR; PG8_SCHED;
            PG8_LDB(B1, 0, 1); PG8_STAGE(PG8_SB(0, 0), b2, voffB);
            PG8_BAR; PG8_WAIT_L(0); PG8_MMA(0, 1, At, B1); PG8_BAR;
            PG8_LDA(At, 0, 1); PG8_STAGE(PG8_SA(0, 0), a2, voffA);
            PG8_BAR; PG8_WAIT_L(0); PG8_MMA(1, 0, At, B0); PG8_BAR; PG8_SCHED;
            PG8_STAGE(PG8_SB(0, 1), b2 + hstepB, voffB);
            PG8_WAIT_V(6); PG8_BAR; PG8_MMA(1, 1, At, B1); PG8_BAR;
            PG8_LDB(B0, 1, 0); PG8_SCHED; PG8_LDA(At, 1, 0); PG8_STAGE(PG8_SA(0, 1), a2 + hstepA, voffA);
            PG8_WAIT_L(8); PG8_BAR; PG8_WAIT_L(0); PG8_MMA(0, 0, At, B0); PG8_BAR; PG8_SCHED;
            PG8_LDB(B1, 1, 1); PG8_STAGE(PG8_SB(1, 0), b3, voffB);
            PG8_BAR; PG8_WAIT_L(0); PG8_MMA(0, 1, At, B1); PG8_BAR;
            PG8_LDA(At, 1, 1); PG8_STAGE(PG8_SA(1, 0), a3, voffA);
            PG8_BAR; PG8_WAIT_L(0); PG8_MMA(1, 0, At, B0); PG8_BAR; PG8_SCHED;
            PG8_STAGE(PG8_SB(1, 1), b3 + hstepB, voffB);
            PG8_WAIT_V(6); PG8_BAR; PG8_MMA(1, 1, At, B1); PG8_BAR;
            }
        }
        if constexpr (ALIGN_EPI) { if (wr == 0) PG8_BAR; }
        E(acc, cur, wr, wc, fr, fq); S.done(cur);
        if (!has_next) break;
#pragma unroll
        for (int a = 0; a < 2; ++a)
#pragma unroll
            for (int b = 0; b < 2; ++b)
#pragma unroll
                for (int m = 0; m < 4; ++m)
#pragma unroll
                    for (int n = 0; n < 2; ++n) acc[a][b][m][n] = (f32x4){0.f, 0.f, 0.f, 0.f};
        cur = nxt; cA = nA; cB = nB; ++ui;
        if constexpr (ALIGN_EPI) { if (wr == 1) PG8_BAR; }
    }
    PG8_WAIT_V(0);
    if constexpr (!ALIGN_EPI) { if (wr == 0) PG8_BAR; }
    PG8_BAR;
#undef PG8_APTR
#undef PG8_SA
#undef PG8_SB
#undef PG8_STAGE
#undef PG8_LDA
#undef PG8_LDB
#undef PG8_MMA
#undef PG8_WAIT_V
#undef PG8_WAIT_L
#undef PG8_WAIT_V8X
#undef PG8_BAR
#undef PG8_SCHED
}
}

using pg8::bf16_t; using pg8::f32x4; using pg8::u32x4; using pg8::u32x2; using pg8::bf16x8;
using pg8::cvt_pk_bf16; using pg8::bf_lo; using pg8::bf_hi;

struct Params {
    const float* x_prompt; const float* x_sample; const float* state_conv; const float* norm_mix; const float* w_in; const float* ln_g; const float* ln_b;
    const float* w_s; const float* b_s; const float* conv_w; const float* w_pa; const float* w_pb; const float* w_o; const float* norm_ffn;
    const float* w_gate; const float* w_up; const float* w_down; const float* norm_final;
    float* out; unsigned char* ws; int ph_lo, ph_hi;
};
constexpr int LDS_BYTES = pg8::STAGE_BYTES + 256;
constexpr int NPHASE = 2 + 7 * NL;

__device__ __forceinline__ void transpose_tile(const float* __restrict__ src, int ld, int k0, int col0, const float* __restrict__ scale, bf16_t* __restrict__ dst, int K, float* t, int tid) {
    const int r = tid >> 4, c4 = tid & 15;
#pragma unroll
    for (int pass = 0; pass < 2; ++pass) { const int k = r + 32 * pass; const f32x4 v = *(const f32x4*)(src + (size_t)(k0 + k) * ld + col0 + 4 * c4); const float s = scale ? scale[k0 + k] : 1.0f;
        t[k * 65 + 4 * c4 + 0] = v[0] * s; t[k * 65 + 4 * c4 + 1] = v[1] * s; t[k * 65 + 4 * c4 + 2] = v[2] * s; t[k * 65 + 4 * c4 + 3] = v[3] * s; }
    __syncthreads();
    const int n = tid >> 3, kc = tid & 7; u32x4 w;
    w.x = cvt_pk_bf16(t[(8 * kc + 0) * 65 + n], t[(8 * kc + 1) * 65 + n]); w.y = cvt_pk_bf16(t[(8 * kc + 2) * 65 + n], t[(8 * kc + 3) * 65 + n]);
    w.z = cvt_pk_bf16(t[(8 * kc + 4) * 65 + n], t[(8 * kc + 5) * 65 + n]); w.w = cvt_pk_bf16(t[(8 * kc + 6) * 65 + n], t[(8 * kc + 7) * 65 + n]);
    *(u32x4*)(dst + (size_t)n * K + k0 + 8 * kc) = w;
    __syncthreads();
}
constexpr int IT_WIN = (NIN / 64) * 16, IT_WPAB = 32 * 16, IT_WO = 16 * 16, IT_WGU = (2 * DFF / 64) * 16, IT_WD = 16 * (DFF / 64), IT_LAYER = IT_WIN + IT_WPAB + IT_WO + IT_WGU + IT_WD;

__device__ __forceinline__ void p0_prologue(const Params& p, float* ldsf) {
    unsigned char* ws = p.ws;
    float* ssqm = (float*)(ws + WS_SSQM);
    int tid = threadIdx.x; asm volatile("" : "+v"(tid));
    const int G = gridDim.x, b = blockIdx.x;
    for (int it = b; it < NL * IT_LAYER; it += G) {
        const int l = it / IT_LAYER; int r = it % IT_LAYER; unsigned char* lw = ws + WS_W + (size_t)l * LW_BYTES;
        if (r < IT_WIN) { const int ntile = r >> 4, kt = r & 15, n0 = ntile * 64; int col;
            if (n0 < 3072) col = n0; else if (n0 < 5120) { const int t = n0 - 3072; col = ((t & 128) ? 4096 : 3072) + (t >> 8) * 128 + (t & 127); } else { const int t = n0 - 5120; col = ((t & 128) ? 6144 : 5120) + (t >> 8) * 128 + (t & 127); }
            transpose_tile(p.w_in + (size_t)l * DM * NIN, NIN, kt * 64, col, p.norm_mix + l * DM, (bf16_t*)(lw + LW_WIN) + (size_t)n0 * DM, DM, ldsf, tid); continue; }
        r -= IT_WIN;
        if (r < IT_WPAB) { const int ntile = r >> 4, kt = r & 15, n0 = ntile * 64;
            const float* src = (n0 < 1024) ? p.w_pa + (size_t)l * DM * DM : p.w_pb + (size_t)l * DM * DM;
            transpose_tile(src, DM, kt * 64, n0 & 1023, nullptr, (bf16_t*)(lw + LW_WPAB) + (size_t)n0 * DM, DM, ldsf, tid); continue; }
        r -= IT_WPAB;
        if (r < IT_WO) { const int ntile = r >> 4, kt = r & 15, n0 = ntile * 64;
            transpose_tile(p.w_o + (size_t)l * DM * DM, DM, kt * 64, n0, nullptr, (bf16_t*)(lw + LW_WO) + (size_t)n0 * DM, DM, ldsf, tid); continue; }
        r -= IT_WO;
        if (r < IT_WGU) { const int ntile = r >> 4, kt = r & 15, n0 = ntile * 64;
            const float* src = ((n0 & 128) ? p.w_up : p.w_gate) + (size_t)l * DM * DFF; const int col = (n0 >> 8) * 128 + (n0 & 127);
            transpose_tile(src, DFF, kt * 64, col, p.norm_ffn + l * DM, (bf16_t*)(lw + LW_WGU) + (size_t)n0 * DM, DM, ldsf, tid); continue; }
        r -= IT_WGU;
        { const int ntile = r / (DFF / 64), kt = r % (DFF / 64), n0 = ntile * 64;
            transpose_tile(p.w_down + (size_t)l * DFF * DM, DM, kt * 64, n0, nullptr, (bf16_t*)(lw + LW_WD) + (size_t)n0 * DFF, DFF, ldsf, tid); }
    }
    for (int i = b * 512 + tid; i < NL * 8 * 128 * 128; i += G * 512) {
        const int l = i >> 17, rem = i & 131071, ii = (rem >> 7) & 127, jj = rem & 127;
        const float* wsrc = p.w_s + (size_t)(i - rem);
        const int grp = rem >> 14;
        unsigned char* lw = ws + WS_W + (size_t)l * LW_BYTES;
        const float vp = (jj <= ii) ? p.w_s[i] : 0.f;
        const float vs = ((ii >> 5) == (jj >> 5) && (jj & 31) <= (ii & 31)) ? wsrc[grp * 16384 + (ii & 31) * 128 + (jj & 31)] : 0.f;
        ((bf16_t*)(lw + LW_WSP))[rem] = (bf16_t)(cvt_pk_bf16(vp, 0.f) & 0xffffu);
        ((bf16_t*)(lw + LW_WSS))[rem] = (bf16_t)(cvt_pk_bf16(vs, 0.f) & 0xffffu);
    }
    { const int wave = tid >> 6, lane = tid & 63; bf16_t* xb = (bf16_t*)(ws + WS_XB);
      for (int row = b * 8 + wave; row < MT; row += 2 * G * 8) {
          const int row2 = row + G * 8; const bool has2 = row2 < MT;
          const float* xr = (row < MP) ? p.x_prompt + (size_t)row * DM : p.x_sample + (size_t)(row - MP) * DM;
          const float* xr2 = has2 ? ((row2 < MP) ? p.x_prompt + (size_t)row2 * DM : p.x_sample + (size_t)(row2 - MP) * DM) : xr;
          f32x4 v[4], v2[4];
#pragma unroll
          for (int j = 0; j < 4; ++j) { v[j] = *(const f32x4*)(xr + 4 * (lane + 64 * j)); v2[j] = *(const f32x4*)(xr2 + 4 * (lane + 64 * j)); }
          float q = 0.f, q2 = 0.f;
#pragma unroll
          for (int j = 0; j < 4; ++j) { q += (v[j][0] * v[j][0] + v[j][1] * v[j][1]) + (v[j][2] * v[j][2] + v[j][3] * v[j][3]); q2 += (v2[j][0] * v2[j][0] + v2[j][1] * v2[j][1]) + (v2[j][2] * v2[j][2] + v2[j][3] * v2[j][3]);
              u32x2 w; w.x = cvt_pk_bf16(v[j][0], v[j][1]); w.y = cvt_pk_bf16(v[j][2], v[j][3]); *(u32x2*)(xb + (size_t)row * DM + 4 * (lane + 64 * j)) = w;
              if (has2) { u32x2 w2; w2.x = cvt_pk_bf16(v2[j][0], v2[j][1]); w2.y = cvt_pk_bf16(v2[j][2], v2[j][3]); *(u32x2*)(xb + (size_t)row2 * DM + 4 * (lane + 64 * j)) = w2; } }
#pragma unroll
          for (int o = 32; o >= 1; o >>= 1) { q += __shfl_xor(q, o); q2 += __shfl_xor(q2, o); }
          if (lane < 4) { ((f32x4*)(ssqm + (size_t)row * 16))[lane] = (f32x4){lane == 0 ? q : 0.f, 0.f, 0.f, 0.f};
              if (has2) ((f32x4*)(ssqm + (size_t)row2 * 16))[lane] = (f32x4){lane == 0 ? q2 : 0.f, 0.f, 0.f, 0.f}; }
      } }
}

constexpr int VT_PITCH = 136;
__device__ __forceinline__ void gate_conv_phase(const Params& p, int l, unsigned char* lds) {
    unsigned char* ws = p.ws;
    const float* lns = (const float*)(ws + WS_LNS);
    bf16_t* AB = (bf16_t*)(ws + WS_AB); const bf16_t* GV = (const bf16_t*)(ws + WS_GV); const bf16_t* CH = (const bf16_t*)(ws + WS_CH);
    const unsigned char* lw = ws + WS_W + (size_t)l * LW_BYTES;
    bf16_t* vT = (bf16_t*)lds;
    float* mr = (float*)(lds + 128 * VT_PITCH * 2);
    int tid = threadIdx.x; asm volatile("" : "+v"(tid));
    const int lane = tid & 63, w = tid >> 6, fr = lane & 15, fq = lane >> 4;
    const int jg = tid >> 5, cq = tid & 31;
    const int ci = tid & 15;
    const int nks = (w >> 1) + 1;
    const int total = (MT / 128) * 8;
    int item = blockIdx.x; if (item >= total) return;
    const int g = item & 7, c0 = g * 128, irow = 16 * w + fr;
    const bf16_t* WsP = (const bf16_t*)(lw + LW_WSP) + g * 16384 + irow * 128 + 8 * fq;
    bf16x8 wf[4];
#pragma unroll
    for (int ks = 0; ks < 4; ++ks) wf[ks] = *(const bf16x8*)(WsP + 32 * ks);
    float bs = p.b_s[(l * 8 + g) * 128 + irow];
    const float* cwp = p.conv_w + (size_t)l * 3 * DM + c0 + 8 * ci;
    bool was_smp = false;
    f32x4 sl0, sl1; u32x2 gv[8]; u32x4 uu[4];
#define GC_LOAD(it) do { const int r0_ = ((it) >> 3) * 128; \
        const f32x4* sl_ = (const f32x4*)(lns + (size_t)(r0_ + (tid >> 2)) * 32 + (tid & 3) * 8); sl0 = sl_[0]; sl1 = sl_[1]; \
        _Pragma("unroll") for (int jj = 0; jj < 8; ++jj) gv[jj] = *(const u32x2*)(GV + (size_t)(r0_ + 8 * jg + jj) * DM + c0 + 4 * cq); } while (0)
#define GC_LOADU(it) do { const int r0_ = ((it) >> 3) * 128; \
        _Pragma("unroll") for (int pp = 0; pp < 4; ++pp) uu[pp] = *(const u32x4*)(AB + (size_t)(r0_ + irow) * 2048 + c0 + 8 * fq + 32 * pp); } while (0)
    GC_LOAD(item); GC_LOADU(item);
    for (;;) {
        const int ct = item >> 3, row0 = ct * 128; const bool smp = ct >= MP / 128;
        if (smp && !was_smp) {
            const bf16_t* WsS = (const bf16_t*)(lw + LW_WSS) + g * 16384 + irow * 128 + 8 * fq;
#pragma unroll
            for (int ks = 0; ks < 4; ++ks) wf[ks] = *(const bf16x8*)(WsS + 32 * ks);
            bs = p.b_s[(l * 8 + g) * 128 + (irow & 31)]; was_smp = true; }
        bf16_t* rowp = AB + (size_t)(row0 + irow) * 2048 + c0 + 8 * fq;
        const f32x4 lg = *(const f32x4*)(p.ln_g + l * DM + c0 + 4 * cq), lb = *(const f32x4*)(p.ln_b + l * DM + c0 + 4 * cq);
        { float sm = (sl0[0] + sl0[2]) + (sl1[0] + sl1[2]), sq = (sl0[1] + sl0[3]) + (sl1[1] + sl1[3]);
          sm += __shfl_xor(sm, 1); sq += __shfl_xor(sq, 1); sm += __shfl_xor(sm, 2); sq += __shfl_xor(sq, 2);
          if ((tid & 3) == 0) { const float mean = sm * (1.0f / 1024.0f), var = sq * (1.0f / 1024.0f) - mean * mean; mr[2 * (tid >> 2)] = mean; mr[2 * (tid >> 2) + 1] = __builtin_amdgcn_rsqf(fmaxf(var, 0.f) + EPS); } }
        __syncthreads();
        { float v[8][4];
#pragma unroll
          for (int jj = 0; jj < 8; ++jj) { const float mean = mr[2 * (8 * jg + jj)], rstd = mr[2 * (8 * jg + jj) + 1];
              v[jj][0] = (bf_lo(gv[jj].x) - mean) * rstd * lg[0] + lb[0]; v[jj][1] = (bf_hi(gv[jj].x) - mean) * rstd * lg[1] + lb[1];
              v[jj][2] = (bf_lo(gv[jj].y) - mean) * rstd * lg[2] + lb[2]; v[jj][3] = (bf_hi(gv[jj].y) - mean) * rstd * lg[3] + lb[3];
              if (smp) *(f32x4*)(p.out + OUT_V + ((size_t)l * MS + (row0 + 8 * jg + jj - MP)) * DM + c0 + 4 * cq) = (f32x4){v[jj][0], v[jj][1], v[jj][2], v[jj][3]}; }
#pragma unroll
          for (int e = 0; e < 4; ++e) { u32x4 wv; wv.x = cvt_pk_bf16(v[0][e], v[1][e]); wv.y = cvt_pk_bf16(v[2][e], v[3][e]); wv.z = cvt_pk_bf16(v[4][e], v[5][e]); wv.w = cvt_pk_bf16(v[6][e], v[7][e]);
              *(u32x4*)(vT + (4 * cq + e) * VT_PITCH + 8 * jg) = wv; } }
        u32x4 ch0[4], ch1[4], ch2[4], bg[4];
#pragma unroll
        for (int vv = 0; vv < 4; ++vv) { const int i = (tid >> 4) + 32 * vv, row = row0 + i, c = c0 + 8 * ci; const int pos = smp ? ((row - MP) & 31) : (row & 2047);
            const u32x4 z4 = {0u, 0u, 0u, 0u};
            ch0[vv] = *(const u32x4*)(CH + (size_t)row * DM + c);
            ch1[vv] = (pos >= 1) ? *(const u32x4*)(CH + (size_t)(row - 1) * DM + c) : z4;
            ch2[vv] = (pos >= 2) ? *(const u32x4*)(CH + (size_t)(row - 2) * DM + c) : z4;
            bg[vv] = *(const u32x4*)(AB + (size_t)row * 2048 + 1024 + c); }
        const int nitem = item + (int)gridDim.x; const bool has_next = nitem < total;
        if (has_next) GC_LOAD(nitem);
        __syncthreads();
        { f32x4 acc[8];
#pragma unroll
          for (int dt = 0; dt < 8; ++dt) acc[dt] = (f32x4){0.f, 0.f, 0.f, 0.f};
#pragma unroll
          for (int ks = 0; ks < 4; ++ks) if (ks < nks) {
#pragma unroll
              for (int dt = 0; dt < 8; ++dt) { const int d = 32 * (dt >> 1) + 8 * (fr >> 2) + 4 * (dt & 1) + (fr & 3);
                  const bf16x8 vf = *(const bf16x8*)(vT + d * VT_PITCH + 32 * ks + 8 * fq);
                  acc[dt] = __builtin_amdgcn_mfma_f32_16x16x32_bf16(vf, wf[ks], acc[dt], 0, 0, 0); } }
#pragma unroll
          for (int pp = 0; pp < 4; ++pp) { const f32x4 s0 = acc[2 * pp] + bs, s1 = acc[2 * pp + 1] + bs;
              const f32x4 u0 = {bf_lo(uu[pp][0]), bf_hi(uu[pp][0]), bf_lo(uu[pp][1]), bf_hi(uu[pp][1])}, u1 = {bf_lo(uu[pp][2]), bf_hi(uu[pp][2]), bf_lo(uu[pp][3]), bf_hi(uu[pp][3])};
              *(u32x4*)(rowp + 32 * pp) = pg8::pack8(u0 * s0, u1 * s1); } }
        if (has_next) GC_LOADU(nitem);
        const f32x4 w0a = *(const f32x4*)(cwp), w0b = *(const f32x4*)(cwp + 4), w1a = *(const f32x4*)(cwp + DM), w1b = *(const f32x4*)(cwp + DM + 4), w2a = *(const f32x4*)(cwp + 2 * DM), w2b = *(const f32x4*)(cwp + 2 * DM + 4);
#pragma unroll
        for (int vv = 0; vv < 4; ++vv) { const int i = (tid >> 4) + 32 * vv, row = row0 + i, c = c0 + 8 * ci; const int pos = smp ? ((row - MP) & 31) : (row & 2047);
            float f0[8], f1[8], f2[8], o[8];
#pragma unroll
            for (int e = 0; e < 4; ++e) { f0[2 * e] = bf_lo(ch0[vv][e]); f0[2 * e + 1] = bf_hi(ch0[vv][e]); f1[2 * e] = bf_lo(ch1[vv][e]); f1[2 * e + 1] = bf_hi(ch1[vv][e]); f2[2 * e] = bf_lo(ch2[vv][e]); f2[2 * e + 1] = bf_hi(ch2[vv][e]); }
            if (smp && pos < 2) { const int sq = (row - MP) >> 5; const float* stp = p.state_conv + ((size_t)(l * 32 + sq) * 2) * DM + c;
                if (pos == 0) { const f32x4 a = *(const f32x4*)(stp + DM), bq = *(const f32x4*)(stp + DM + 4); f1[0] = a[0]; f1[1] = a[1]; f1[2] = a[2]; f1[3] = a[3]; f1[4] = bq[0]; f1[5] = bq[1]; f1[6] = bq[2]; f1[7] = bq[3]; }
                { const float* s2 = stp + (pos == 0 ? 0 : DM); const f32x4 a = *(const f32x4*)(s2), bq = *(const f32x4*)(s2 + 4); f2[0] = a[0]; f2[1] = a[1]; f2[2] = a[2]; f2[3] = a[3]; f2[4] = bq[0]; f2[5] = bq[1]; f2[6] = bq[2]; f2[7] = bq[3]; } }
#pragma unroll
            for (int e = 0; e < 4; ++e) { o[e] = w0a[e] * f2[e] + w1a[e] * f1[e] + w2a[e] * f0[e]; o[4 + e] = w0b[e] * f2[4 + e] + w1b[e] * f1[4 + e] + w2b[e] * f0[4 + e]; }
            u32x4 ov;
#pragma unroll
            for (int e = 0; e < 4; ++e) ov[e] = cvt_pk_bf16(o[2 * e] * bf_lo(bg[vv][e]), o[2 * e + 1] * bf_hi(bg[vv][e]));
            *(u32x4*)(AB + (size_t)row * 2048 + 1024 + c) = ov;
            const int lastpos = smp ? 31 : 2047;
            if (pos >= lastpos - 1) { float* op = smp ? p.out + OUT_NCS + (((size_t)l * 32 + ((row - MP) >> 5)) * 2 + (pos - (lastpos - 1))) * DM + c
                                                      : p.out + OUT_NCP + (((size_t)l * 32 + (row >> 11)) * 2 + (pos - (lastpos - 1))) * DM + c;
                *(f32x4*)op = (f32x4){f0[0], f0[1], f0[2], f0[3]}; *(f32x4*)(op + 4) = (f32x4){f0[4], f0[5], f0[6], f0[7]}; } }
        __syncthreads();
        if (!has_next) break;
        item = nitem;
    }
#undef GC_LOAD
#undef GC_LOADU
}

__device__ __forceinline__ void final_norm_phase(const Params& p) {
    const float* __restrict__ ssq = (const float*)(p.ws + WS_SSQM); const bf16_t* __restrict__ xb = (const bf16_t*)(p.ws + WS_XB); float* __restrict__ out = p.out;
    const size_t n8 = (size_t)MT * DM / 8;
    int tid = threadIdx.x; asm volatile("" : "+v"(tid));
    const size_t stride = (size_t)gridDim.x * 512;
    const int c = (tid & 127) * 8;
    const f32x4 g0 = *(const f32x4*)(p.norm_final + c), g1 = *(const f32x4*)(p.norm_final + c + 4);
    for (size_t i = (size_t)blockIdx.x * 512 + tid; i < n8; i += 4 * stride) {
        u32x4 w[4]; f32x4 s0[4], s1[4], s2[4], s3[4];
#pragma unroll
        for (int k = 0; k < 4; ++k) { const size_t ii = i + k * stride; if (ii < n8) { w[k] = *(const u32x4*)(xb + ii * 8); const f32x4* s = (const f32x4*)(ssq + (ii >> 7) * 16); s0[k] = s[0]; s1[k] = s[1]; s2[k] = s[2]; s3[k] = s[3]; } }
#pragma unroll
        for (int k = 0; k < 4; ++k) { const size_t ii = i + k * stride; if (ii < n8) { const f32x4 t = (s0[k] + s1[k]) + (s2[k] + s3[k]);
            const float rs = __builtin_amdgcn_rsqf(((t[0] + t[1]) + (t[2] + t[3])) * (1.0f / 1024.0f) + EPS);
            ((f32x4*)out)[2 * ii] = pg8::unpk_lo(w[k]) * rs * g0; ((f32x4*)out)[2 * ii + 1] = pg8::unpk_hi(w[k]) * rs * g1; } }
    }
}

#define LAS __attribute__((address_space(3)))
#define XB_TMO      128
#define XB_XCNT(j)  (256  + 64 * (j))
#define XB_XSUB(j)  (1280 + 64 * (j))
#define XB_XGEN(j)  (2304 + 64 * (j))
#define XB_TOP      3328
#define XB_TOPGEN   3392
#define XCD_BAR_WORDS 3456
#define XB_SPIN_CAP (1u << 18)

__device__ __forceinline__ unsigned xb_ld(unsigned* p)              { return __hip_atomic_load(p, __ATOMIC_RELAXED, __HIP_MEMORY_SCOPE_AGENT); }
__device__ __forceinline__ unsigned xb_add(unsigned* p, unsigned v) { return __hip_atomic_fetch_add(p, v, __ATOMIC_RELAXED, __HIP_MEMORY_SCOPE_AGENT); }
__device__ __forceinline__ unsigned xb_xcc_id() { return (unsigned)__builtin_amdgcn_s_getreg((3 << 11) | 20) & 0xFu; }
#define XB_SPIN(cond, bar) do { unsigned _sp = 0; while (cond) { __builtin_amdgcn_s_sleep(1); \
    if ((++_sp & 255u) == 0u) { if (xb_ld(&(bar)[XB_TMO])) break; if (_sp > XB_SPIN_CAP) { atomicAdd(&(bar)[XB_TMO], 1u); break; } } } } while (0)

struct XcdBarrier {
    unsigned* bar; unsigned x;
    volatile LAS unsigned* st;
};

__device__ __forceinline__ XcdBarrier xcd_barrier_post(unsigned* bar, volatile LAS unsigned* st) {
    XcdBarrier b; b.bar = bar; b.x = xb_xcc_id(); b.st = st;
    if (threadIdx.x == 0) (void)xb_add(&bar[XB_XCNT(b.x)], 1u);
    return b;
}
__device__ __forceinline__ void xcd_barrier_complete(unsigned* bar, unsigned x, unsigned& nloc, unsigned& nx) {
    const unsigned G = gridDim.x * gridDim.y * gridDim.z;
    unsigned sum, cnt, mine, sp = 0u;
    for (;;) {
        sum = 0u; cnt = 0u; mine = 0u;
#pragma unroll
        for (unsigned j = 0; j < 16; ++j) { const unsigned c = xb_ld(&bar[XB_XCNT(j)]); sum += c; cnt += (c > 0u) ? 1u : 0u; mine = (j == x) ? c : mine; }
        if (sum == G) break;
        __builtin_amdgcn_s_sleep(1);
        if ((++sp & 255u) == 0u) { if (xb_ld(&bar[XB_TMO])) break; if (sp > XB_SPIN_CAP) { atomicAdd(&bar[XB_TMO], 1u); break; } }
    }
    nloc = mine > 0u ? mine : 1u; nx = cnt > 0u ? cnt : 1u;
}

__device__ __forceinline__ void xcd_barrier(const XcdBarrier& b) {
    asm volatile("s_waitcnt vmcnt(0)" ::: "memory");
    __syncthreads();
    if (threadIdx.x == 0) {
        unsigned* bar = b.bar;
        __builtin_amdgcn_s_waitcnt(0);
        unsigned nloc = b.st[0], nx = b.st[1];
        if (nloc == 0u) { xcd_barrier_complete(bar, b.x, nloc, nx); b.st[0] = nloc; b.st[1] = nx; }
        const unsigned old = xb_add(&bar[XB_XSUB(b.x)], 1u);
        const unsigned gen = old / nloc;
        if (old + 1u == (gen + 1u) * nloc) {
            __builtin_amdgcn_fence(__ATOMIC_RELEASE, "agent");
            asm volatile("s_waitcnt vmcnt(0)" ::: "memory");
            const unsigned og = xb_add(&bar[XB_TOP], 1u);
            const unsigned tg = og / nx;
            if (og + 1u == (tg + 1u) * nx) xb_add(&bar[XB_TOPGEN], 1u);
            else XB_SPIN(xb_ld(&bar[XB_TOPGEN]) == tg, bar);
            __builtin_amdgcn_fence(__ATOMIC_ACQUIRE, "agent");
            xb_add(&bar[XB_XGEN(b.x)], 1u);
            asm volatile("s_waitcnt vmcnt(0)" ::: "memory");
        } else {
            XB_SPIN(xb_ld(&bar[XB_XGEN(b.x)]) == gen, bar);
            __builtin_amdgcn_fence(__ATOMIC_ACQUIRE, "agent");
            asm volatile("s_waitcnt vmcnt(0)" ::: "memory");
        }
    }
    __syncthreads();
}

__global__ void __launch_bounds__(512, 2) mk_fwd(Params p) {
    extern __shared__ __attribute__((aligned(16))) unsigned char lds[];
    unsigned char* ws0 = p.ws;
    PG8_LAS unsigned char* ring = (PG8_LAS unsigned char*)lds;
#if MK_MULTI
#define GRID_SYNC() do { } while (0)
#else
    cg::grid_group grid = cg::this_grid();
    volatile LAS unsigned* bst = (volatile LAS unsigned*)((LAS unsigned char*)lds + pg8::STAGE_BYTES);
    if (threadIdx.x < 2) bst[threadIdx.x] = 0u;
    __syncthreads();
    XcdBarrier xbar = xcd_barrier_post((unsigned*)(ws0 + WS_CTL), bst);
#define GRID_SYNC() do { if (ph == 0) grid.sync(); else xcd_barrier(xbar); } while (0)
#endif
    for (int ph = p.ph_lo; ph < p.ph_hi; ++ph) {
        unsigned char* ws = ws0; int G = gridDim.x, c = blockIdx.x; asm volatile("" : "+s"(ws), "+s"(G), "+s"(c));
        float* ssq_mix = (float*)(ws + WS_SSQM); float* ssq_ffn = (float*)(ws + WS_SSQF); float* lns = (float*)(ws + WS_LNS);
        bf16_t* XB = (bf16_t*)(ws + WS_XB); bf16_t* AB = (bf16_t*)(ws + WS_AB); bf16_t* GV = (bf16_t*)(ws + WS_GV); bf16_t* CH = (bf16_t*)(ws + WS_CH);
        bf16_t* T12 = GV; bf16_t* MMb = AB; bf16_t* Hb = AB;
        if (ph == 0) { if (PHASE_MASK & 1) { if (PROBE_DUP & 512) p0_prologue(p, (float*)lds); p0_prologue(p, (float*)lds); } }
        else if (ph == NPHASE - 1) { if (PHASE_MASK & 2) final_norm_phase(p); }
        else {
            const int l = (ph - 1) / 7, s = (ph - 1) % 7;
            for (int rep_ = 0; rep_ < (((PROBE_DUP >> s) & 1) ? 2 : 1); ++rep_) {
            const unsigned char* lw = ws + WS_W + (size_t)l * LW_BYTES;
            if (s == 0) { if (PHASE_MASK & 4) {
                pg8::Gemm g{XB, (const bf16_t*)(lw + LW_WIN), MT, 5120, DM, DM, 1 << 30, 0}; pg8::StaticOrder S; S.init(MT, 5120, G, c);
                pg8::EpiA E{AB, GV, CH, ssq_mix, lns};
                pg8::gemm_phase<pg8::EpiA, pg8::StaticOrder>(ring, g, S, E); }
            } else if (s == 1) {
                if (PHASE_MASK & 8) gate_conv_phase(p, l, lds);
            } else if (s == 2) { if (PHASE_MASK & 16) {
                pg8::Gemm g{AB, (const bf16_t*)(lw + LW_WPAB), MT, 2048, DM, 2048, 4, 1024}; pg8::StaticOrder S; S.init(MT, 2048, G, c);
                pg8::EpiC E{T12};
                pg8::gemm_phase<pg8::EpiC, pg8::StaticOrder>(ring, g, S, E); }
            } else if (s == 3) { if (PHASE_MASK & 32) {
                pg8::Gemm g{XB, (const bf16_t*)(lw + LW_WIN) + (size_t)5120 * DM, MT, 2048, DM, DM, 1 << 30, 0}; pg8::StaticOrder S; S.init(MT, 2048, G, c);
                pg8::EpiD E{T12, MMb, ssq_mix};
                pg8::gemm_phase<pg8::EpiD, pg8::StaticOrder>(ring, g, S, E); }
            } else if (s == 4) { if (PHASE_MASK & 64) {
                pg8::Gemm g{MMb, (const bf16_t*)(lw + LW_WO), MT, DM, DM, DM, 1 << 30, 0}; pg8::StaticOrder S; S.init(MT, DM, G, c);
                pg8::EpiRes E{XB, ssq_ffn};
                pg8::gemm_phase<pg8::EpiRes, pg8::StaticOrder>(ring, g, S, E); }
            } else if (s == 5) { if (PHASE_MASK & 128) {
                pg8::Gemm g{XB, (const bf16_t*)(lw + LW_WGU), MT, 2 * DFF, DM, DM, 1 << 30, 0}; pg8::StaticOrder S; S.init(MT, 2 * DFF, G, c);
                pg8::EpiF E{Hb, ssq_ffn};
                pg8::gemm_phase<pg8::EpiF, pg8::StaticOrder>(ring, g, S, E); }
            } else { if (PHASE_MASK & 256) {
                pg8::Gemm g{Hb, (const bf16_t*)(lw + LW_WD), MT, DM, DFF, DFF, 1 << 30, 0}; pg8::StaticOrder S; S.init(MT, DM, G, c);
                pg8::EpiRes E{XB, ssq_mix};
                pg8::gemm_phase<pg8::EpiRes, pg8::StaticOrder>(ring, g, S, E); }
            }
            }
        }
        if (ph + 1 < p.ph_hi) { GRID_SYNC(); }
    }
}

extern "C" void kernel_launch(void* const* d_in, const int* in_sizes, int n_in, void* d_out, int out_size, void* d_ws, size_t ws_size, hipStream_t stream) {
    static int grid = 0;
    if (grid == 0) {
        if (n_in != 18 || in_sizes[0] != MP * DM || (size_t)out_size != OUT_TOTAL || ws_size < WS_END) {
            fprintf(stderr, "kernel_launch: unexpected shapes: n_in %d in0 %d out %d ws %zu (need %zu)\n", n_in, n_in > 0 ? in_sizes[0] : -1, out_size, ws_size, (size_t)WS_END); grid = -1; return; }
        int dev = 0, cus = 0, per_cu = 0;
        (void)hipGetDevice(&dev); (void)hipDeviceGetAttribute(&cus, hipDeviceAttributeMultiprocessorCount, dev);
        if (hipFuncSetAttribute((const void*)mk_fwd, hipFuncAttributeMaxDynamicSharedMemorySize, LDS_BYTES) != hipSuccess) { fprintf(stderr, "kernel_launch: hipFuncSetAttribute failed\n"); grid = -1; return; }
        if (hipOccupancyMaxActiveBlocksPerMultiprocessor(&per_cu, (const void*)mk_fwd, 512, LDS_BYTES) != hipSuccess || per_cu < 1) { fprintf(stderr, "kernel_launch: occupancy query says %d\n", per_cu); per_cu = 1; }
        (void)hipGetLastError();
        grid = cus * 1;
        fprintf(stderr, "kernel_launch: cus %d per_cu %d grid %d\n", cus, per_cu, grid);
    }
    if (grid < 0) return;
    if (hipMemsetAsync((char*)d_ws + WS_CTL, 0, CTL_BYTES, stream) != hipSuccess) { fprintf(stderr, "kernel_launch: memset failed\n"); return; }
    Params p{};
    const float** pp = (const float**)&p;
    for (int i = 0; i < 18; ++i) pp[i] = (const float*)d_in[i];
    p.out = (float*)d_out; p.ws = (unsigned char*)d_ws;
#if MK_MULTI
    for (int ph = 0; ph < NPHASE; ++ph) { p.ph_lo = ph; p.ph_hi = ph + 1; hipLaunchKernelGGL(mk_fwd, dim3(grid), dim3(512), LDS_BYTES, stream, p); }
#else
    p.ph_lo = 0; p.ph_hi = NPHASE;
    void* args[] = {&p};
    hipError_t e = hipLaunchCooperativeKernel((const void*)mk_fwd, dim3(grid), dim3(512), args, LDS_BYTES, stream);
    if (e != hipSuccess) fprintf(stderr, "kernel_launch: cooperative launch failed: %s (grid %d)\n", hipGetErrorString(e), grid);
#endif
}
```

```cpp
#include <hip/hip_runtime.h>
#include <hip/hip_cooperative_groups.h>
#include <cstdio>
#include <cstdint>
namespace cg = cooperative_groups;

#ifndef PHASE_MASK
#define PHASE_MASK 511
#endif
#ifndef PROBE_DUP
#define PROBE_DUP 0
#endif
#ifndef MK_MULTI
#define MK_MULTI 0
#endif

constexpr int MP = 65536, MS = 1024, MT = MP + MS, DM = 1024, NL = 4, DFF = 2816, NIN = 7168;
constexpr float EPS = 1e-6f;
constexpr size_t OUT_YS = (size_t)MP * DM, OUT_NCP = OUT_YS + (size_t)MS * DM, OUT_NCS = OUT_NCP + (size_t)NL * 32 * 2 * DM, OUT_V = OUT_NCS + (size_t)NL * 32 * 2 * DM;
constexpr size_t OUT_TOTAL = OUT_V + (size_t)NL * 32 * 32 * DM;

constexpr size_t MiB = (size_t)1 << 20;
constexpr size_t WS_SSQM = 0, WS_SSQF = 5 * MiB, WS_LNS = 10 * MiB;
constexpr size_t WS_CTL = 20 * MiB, CTL_BYTES = 16384;
constexpr size_t WS_W = 24 * MiB;
constexpr size_t LW_WIN = 0, LW_WPAB = LW_WIN + (size_t)NIN * DM * 2, LW_WO = LW_WPAB + (size_t)2048 * DM * 2, LW_WGU = LW_WO + (size_t)DM * DM * 2,
                 LW_WD = LW_WGU + (size_t)2 * DFF * DM * 2, LW_WSP = LW_WD + (size_t)DM * DFF * 2, LW_WSS = LW_WSP + (size_t)8 * 128 * 128 * 2, LW_BYTES = LW_WSS + (size_t)8 * 128 * 128 * 2;
constexpr size_t WS_XB = 176 * MiB;
constexpr size_t WS_AB = 306 * MiB;
constexpr size_t WS_GV = 566 * MiB;
constexpr size_t WS_CH = 696 * MiB;
constexpr size_t WS_END = 826 * MiB;
static_assert(WS_W + NL * LW_BYTES <= WS_XB, "weights overflow");

namespace pg8 {
#define PG8_LAS __attribute__((address_space(3)))
typedef unsigned short bf16_t;
typedef short bf16x8 __attribute__((ext_vector_type(8)));
typedef float f32x4 __attribute__((ext_vector_type(4)));
typedef float f32x2 __attribute__((ext_vector_type(2)));
typedef unsigned u32x4 __attribute__((ext_vector_type(4)));
typedef unsigned u32x2 __attribute__((ext_vector_type(2)));
constexpr int BM = 256, BK = 64, HALF = 128, HTB = HALF * BK * 2, STAGE_BYTES = 8 * HTB, NXCD = 8, WGM = 8;

__host__ __device__ __forceinline__ int lds_byte(int r, int c) { const int st = (r >> 4) * 2 + (c >> 5), rr = r & 15, cc = c & 31, ob = rr * 64 + cc * 2; return st * 1024 + (ob ^ (((ob >> 9) & 1) << 5)); }
__host__ __device__ __forceinline__ void stage_rc(int b, int& R, int& C) { const int st = b / 1024, sb = b % 1024, swz = sb ^ (((sb >> 9) & 1) << 5); R = (st >> 1) * 16 + swz / 64; C = (st & 1) * 32 + (swz % 64) / 2; }
__host__ __device__ __forceinline__ int perm32(int rho) { const int n = rho >> 4, i = rho & 15; return 8 * (i >> 2) + 4 * n + (i & 3); }

struct Unit { int pm, pn, half, rbase; };
struct Gemm { const bf16_t* A; const bf16_t* Bt; int M, N, K, lda, asplit_pn, asplit_off; };

struct StaticOrder {
    int nM, nN, nwg, G, c, ntot;
    __host__ __device__ void init(int M, int N, int G_, int c_) { nM = MP / BM; nN = N / BM; nwg = nM * nN; G = G_; c = c_; ntot = nwg + 2 * ((M / BM) - nM) * nN; }
    __host__ __device__ bool next(int i, Unit& u) const {
        const long L = (long)i * G + c; if (L >= ntot) return false;
        if (L >= nwg) { const int h = (int)L - nwg, hp = h / nN; u.pn = h - hp * nN; u.pm = nM + (hp >> 1); u.half = 1; u.rbase = u.pm * BM + (hp & 1) * HALF; return true; }
        int wgid = (int)L; { const int q = nwg / NXCD, r = nwg % NXCD, xcd = wgid % NXCD, off = wgid / NXCD; wgid = (xcd < r ? xcd * (q + 1) : r * (q + 1) + (xcd - r) * q) + off; }
        const int nig = WGM * nN, gid = wgid / nig, fm = gid * WGM, gsz = (nM - fm) < WGM ? (nM - fm) : WGM;
        u.pm = fm + ((wgid % nig) % gsz); u.pn = (wgid % nig) / gsz; u.half = 0; u.rbase = u.pm * BM; return true;
    }
    __device__ __forceinline__ void a_ready(const Unit&) const {}
    __device__ __forceinline__ void done(const Unit&) const {}
};

__device__ __forceinline__ unsigned cvt_pk_bf16(float lo, float hi) { unsigned r; asm volatile("v_cvt_pk_bf16_f32 %0, %1, %2" : "=v"(r) : "v"(lo), "v"(hi)); return r; }
__device__ __forceinline__ float bf_lo(unsigned w) { return __uint_as_float(w << 16); }
__device__ __forceinline__ float bf_hi(unsigned w) { return __uint_as_float(w & 0xffff0000u); }
__device__ __forceinline__ f32x2 gelu_pk(f32x2 v) {
    const f32x2 av = __builtin_elementwise_abs(v), d = av * 0.2316418882f + 1.0f;
    f32x2 t; t.x = __builtin_amdgcn_rcpf(d.x); t.y = __builtin_amdgcn_rcpf(d.y);
    f32x2 q = t * 0.5307027145f + (-0.7265760135f); q = q * t + 0.7107068705f; q = q * t + (-0.142248368f); q = q * t + 0.127414796f; q = q * t;
    const f32x2 s = (v * v) * (-0.72134752044f);
    f32x2 e; e.x = __builtin_amdgcn_exp2f(s.x); e.y = __builtin_amdgcn_exp2f(s.y);
    const f32x2 m = v * (q * e), r = v - m;
    f32x2 o; o.x = v.x < 0.f ? m.x : r.x; o.y = v.y < 0.f ? m.y : r.y; return o;
}
__device__ __forceinline__ f32x4 gelu4(f32x4 v) { const f32x2 a = gelu_pk((f32x2){v[0], v[1]}), b = gelu_pk((f32x2){v[2], v[3]}); return (f32x4){a.x, a.y, b.x, b.y}; }
__device__ __forceinline__ float sigmoidf_(float x) { return __builtin_amdgcn_rcpf(1.0f + __builtin_amdgcn_exp2f(x * -1.44269504f)); }
__device__ __forceinline__ f32x4 sigmoid4(f32x4 v) { return (f32x4){sigmoidf_(v[0]), sigmoidf_(v[1]), sigmoidf_(v[2]), sigmoidf_(v[3])}; }
__device__ __forceinline__ u32x4 pack8(f32x4 v0, f32x4 v1) { u32x4 w; w.x = cvt_pk_bf16(v0[0], v0[1]); w.y = cvt_pk_bf16(v0[2], v0[3]); w.z = cvt_pk_bf16(v1[0], v1[1]); w.w = cvt_pk_bf16(v1[2], v1[3]); return w; }
__device__ __forceinline__ float rstd_of(const float* slots, int row) { const f32x4* s = (const f32x4*)(slots + (size_t)row * 16); const f32x4 t = (s[0] + s[1]) + (s[2] + s[3]);
    return __builtin_amdgcn_rsqf(((t[0] + t[1]) + (t[2] + t[3])) * (1.0f / 1024.0f) + EPS); }

__device__ __forceinline__ void wave_rstd(const float* slots, int rowbase, int lane, int fr, float (&rs)[2][4]) {
    float val[2];
    const f32x4* sa = (const f32x4*)(slots + (size_t)(rowbase + lane) * 16); const f32x4* sb = (const f32x4*)(slots + (size_t)(rowbase + HALF + lane) * 16);
    const f32x4 a0 = sa[0], a1 = sa[1], a2 = sa[2], a3 = sa[3], b0 = sb[0], b1 = sb[1], b2 = sb[2], b3 = sb[3];
    __builtin_amdgcn_sched_barrier(0);
    { const f32x4 t = (a0 + a1) + (a2 + a3); val[0] = __builtin_amdgcn_rsqf(((t[0] + t[1]) + (t[2] + t[3])) * (1.0f / 1024.0f) + EPS); }
    { const f32x4 t = (b0 + b1) + (b2 + b3); val[1] = __builtin_amdgcn_rsqf(((t[0] + t[1]) + (t[2] + t[3])) * (1.0f / 1024.0f) + EPS); }
#pragma unroll
    for (int ai = 0; ai < 2; ++ai)
#pragma unroll
        for (int m = 0; m < 4; ++m) rs[ai][m] = __shfl(val[ai], m * 16 + fr);
}
__device__ __forceinline__ f32x4 unpk_lo(u32x4 w) { return (f32x4){bf_lo(w[0]), bf_hi(w[0]), bf_lo(w[1]), bf_hi(w[1])}; }
__device__ __forceinline__ f32x4 unpk_hi(u32x4 w) { return (f32x4){bf_lo(w[2]), bf_hi(w[2]), bf_lo(w[3]), bf_hi(w[3])}; }

struct EpiA {
    static constexpr bool PERM = true, AFTER_DRAIN = false; static constexpr int NVM = 16;

    bf16_t* AB; bf16_t* GV; bf16_t* CH; const float* ssq; float* lns;
    __device__ __forceinline__ void operator()(const f32x4 (&acc)[2][2][4][2], const Unit& u, int wr, int wc, int fr, int fq) const {
        const int row0 = u.rbase + wr * 64 + fr, cw = wc * 32 + 8 * fq, pn = u.pn;
        float rsv[2][4]; wave_rstd(ssq, u.rbase + wr * 64, fr + 16 * fq, fr, rsv);
        if (pn < 4) {
#pragma unroll
            for (int ai = 0; ai < 2; ++ai)
#pragma unroll
                for (int m = 0; m < 4; ++m) { if (ai == 1 && u.half) continue; const int row = row0 + ai * HALF + m * 16; const float rs = rsv[ai][m]; bf16_t* rowp = AB + (size_t)row * 2048 + pn * 256 + cw;
#pragma unroll
                    for (int bj = 0; bj < 2; ++bj) *(u32x4*)(rowp + bj * HALF) = pack8(gelu4(acc[ai][bj][m][0] * rs), gelu4(acc[ai][bj][m][1] * rs)); }
        } else if (pn < 8) {
#pragma unroll
            for (int ai = 0; ai < 2; ++ai)
#pragma unroll
                for (int m = 0; m < 4; ++m) { if (ai == 1 && u.half) continue; const int row = row0 + ai * HALF + m * 16; const float rs = rsv[ai][m]; bf16_t* rowp = GV + (size_t)row * 1024 + (pn - 4) * 256 + cw;
                    float s = 0.f, q = 0.f;
#pragma unroll
                    for (int bj = 0; bj < 2; ++bj) { const u32x4 w = pack8(gelu4(acc[ai][bj][m][0] * rs), gelu4(acc[ai][bj][m][1] * rs)); *(u32x4*)(rowp + bj * HALF) = w;
#pragma unroll
                        for (int e = 0; e < 4; ++e) { const float a = bf_lo(w[e]), b = bf_hi(w[e]); s += a + b; q += a * a + b * b; } }
                    s += __shfl_xor(s, 16); s += __shfl_xor(s, 32); q += __shfl_xor(q, 16); q += __shfl_xor(q, 32);
                    if (fq == 0) *(f32x2*)(lns + ((size_t)row * 16 + (pn - 4) * 4 + wc) * 2) = (f32x2){s, q}; }
        } else if (pn < 12) {
#pragma unroll
            for (int ai = 0; ai < 2; ++ai)
#pragma unroll
                for (int m = 0; m < 4; ++m) { if (ai == 1 && u.half) continue; const int row = row0 + ai * HALF + m * 16; const float rs = rsv[ai][m]; bf16_t* rowp = AB + (size_t)row * 2048 + 1024 + (pn - 8) * 256 + cw;
#pragma unroll
                    for (int bj = 0; bj < 2; ++bj) *(u32x4*)(rowp + bj * HALF) = pack8(acc[ai][bj][m][0] * rs, acc[ai][bj][m][1] * rs); }
        } else {
#pragma unroll
            for (int ai = 0; ai < 2; ++ai)
#pragma unroll
                for (int m = 0; m < 4; ++m) { if (ai == 1 && u.half) continue; const int row = row0 + ai * HALF + m * 16; const float rs = rsv[ai][m]; const float rs2 = rs * rs;
                    *(u32x4*)(CH + (size_t)row * 1024 + (pn - 12) * 128 + cw) = pack8(acc[ai][0][m][0] * acc[ai][1][m][0] * rs2, acc[ai][0][m][1] * acc[ai][1][m][1] * rs2); }
        }
    }
};
struct EpiC {
    static constexpr bool PERM = true, AFTER_DRAIN = false; static constexpr int NVM = 16;

    bf16_t* T;
    __device__ __forceinline__ void operator()(const f32x4 (&acc)[2][2][4][2], const Unit& u, int wr, int wc, int fr, int fq) const {
        const int row0 = u.rbase + wr * 64 + fr, cw = u.pn * 256 + wc * 32 + 8 * fq;
#pragma unroll
        for (int ai = 0; ai < 2; ++ai)
#pragma unroll
            for (int m = 0; m < 4; ++m) { if (ai == 1 && u.half) continue; bf16_t* rowp = T + (size_t)(row0 + ai * HALF + m * 16) * 2048 + cw;
#pragma unroll
                for (int bj = 0; bj < 2; ++bj) *(u32x4*)(rowp + bj * HALF) = pack8(acc[ai][bj][m][0], acc[ai][bj][m][1]); }
    }
};
struct EpiD {
    static constexpr bool PERM = true, AFTER_DRAIN = false; static constexpr int NVM = 24;

    const bf16_t* T; bf16_t* MM; const float* ssq;
    __device__ __forceinline__ void operator()(const f32x4 (&acc)[2][2][4][2], const Unit& u, int wr, int wc, int fr, int fq) const {
        const int row0 = u.rbase + wr * 64 + fr, cw = u.pn * 128 + wc * 32 + 8 * fq;
        u32x4 tt[4][2];
#pragma unroll
        for (int m = 0; m < 4; ++m) { const bf16_t* tp = T + (size_t)(row0 + m * 16) * 2048 + cw; tt[m][0] = *(const u32x4*)tp; tt[m][1] = *(const u32x4*)(tp + 1024); }
        float rsv[2][4]; wave_rstd(ssq, u.rbase + wr * 64, fr + 16 * fq, fr, rsv);
#pragma unroll
        for (int ai = 0; ai < 2; ++ai) {
            if (ai == 1 && u.half) break;
            if (ai == 1) {
#pragma unroll
                for (int m = 0; m < 4; ++m) { const bf16_t* tp = T + (size_t)(row0 + HALF + m * 16) * 2048 + cw; tt[m][0] = *(const u32x4*)tp; tt[m][1] = *(const u32x4*)(tp + 1024); } }
#pragma unroll
            for (int m = 0; m < 4; ++m) { const int row = row0 + ai * HALF + m * 16; const float rs = rsv[ai][m];
                const u32x4 t1 = tt[m][0], t2 = tt[m][1];
                const f32x4 a0 = sigmoid4(acc[ai][0][m][0] * rs), a1 = sigmoid4(acc[ai][0][m][1] * rs), b0 = sigmoid4(acc[ai][1][m][0] * rs), b1 = sigmoid4(acc[ai][1][m][1] * rs);
                const f32x4 p0 = {bf_lo(t1[0]), bf_hi(t1[0]), bf_lo(t1[1]), bf_hi(t1[1])}, p1 = {bf_lo(t1[2]), bf_hi(t1[2]), bf_lo(t1[3]), bf_hi(t1[3])};
                const f32x4 q0 = {bf_lo(t2[0]), bf_hi(t2[0]), bf_lo(t2[1]), bf_hi(t2[1])}, q1 = {bf_lo(t2[2]), bf_hi(t2[2]), bf_lo(t2[3]), bf_hi(t2[3])};
                *(u32x4*)(MM + (size_t)row * 1024 + cw) = pack8(a0 * p0 + b0 * q0, a1 * p1 + b1 * q1); }
            asm volatile("" ::: "memory");
        }
    }
};
struct EpiRes {
    static constexpr bool PERM = true, AFTER_DRAIN = false; static constexpr int NVM = 24;

    bf16_t* xb; float* ssq;
    __device__ __forceinline__ void operator()(const f32x4 (&acc)[2][2][4][2], const Unit& u, int wr, int wc, int fr, int fq) const {
        const int row0 = u.rbase + wr * 64 + fr, cw = u.pn * BM + wc * 32 + 8 * fq;
#pragma unroll
        for (int ai = 0; ai < 2; ++ai) {
            if (ai == 1 && u.half) break;
            u32x4 xo[4][2];
#pragma unroll
            for (int m = 0; m < 4; ++m)
#pragma unroll
                for (int bj = 0; bj < 2; ++bj) xo[m][bj] = *(const u32x4*)(xb + (size_t)(row0 + ai * HALF + m * 16) * DM + cw + bj * HALF);
#pragma unroll
            for (int m = 0; m < 4; ++m) { const int row = row0 + ai * HALF + m * 16; float q = 0.f;
#pragma unroll
                for (int bj = 0; bj < 2; ++bj) { const u32x4 w = pack8(acc[ai][bj][m][0] + unpk_lo(xo[m][bj]), acc[ai][bj][m][1] + unpk_hi(xo[m][bj]));
                    *(u32x4*)(xb + (size_t)row * DM + cw + bj * HALF) = w;
#pragma unroll
                    for (int e = 0; e < 4; ++e) { const float a = bf_lo(w[e]), b = bf_hi(w[e]); q += a * a + b * b; } }
                q += __shfl_xor(q, 16); q += __shfl_xor(q, 32);
                if (fq == 0) ssq[(size_t)row * 16 + u.pn * 4 + wc] = q; }
            asm volatile("" ::: "memory");
        }
    }
};
struct EpiF {
    static constexpr bool PERM = true, AFTER_DRAIN = false; static constexpr int NVM = 16;

    bf16_t* H; const float* ssq;
    __device__ __forceinline__ void operator()(const f32x4 (&acc)[2][2][4][2], const Unit& u, int wr, int wc, int fr, int fq) const {
        const int row0 = u.rbase + wr * 64 + fr, cw = u.pn * 128 + wc * 32 + 8 * fq;
        float rsv[2][4]; wave_rstd(ssq, u.rbase + wr * 64, fr + 16 * fq, fr, rsv);
#pragma unroll
        for (int ai = 0; ai < 2; ++ai)
#pragma unroll
            for (int m = 0; m < 4; ++m) { if (ai == 1 && u.half) continue; const int row = row0 + ai * HALF + m * 16; const float rs = rsv[ai][m];
                const f32x4 g0 = acc[ai][0][m][0] * rs, g1 = acc[ai][0][m][1] * rs, u0 = acc[ai][1][m][0] * rs, u1 = acc[ai][1][m][1] * rs;
                *(u32x4*)(H + (size_t)row * DFF + cw) = pack8(g0 * sigmoid4(g0) * u0, g1 * sigmoid4(g1) * u1); }
    }
};

#ifndef PG8_SP2
#define PG8_SP2 true
#endif
#ifndef PG8_ALIGN
#define PG8_ALIGN true
#endif
template <class Epi, class Sched, bool SP2 = PG8_SP2, bool ALIGN_EPI = PG8_ALIGN>
__device__ __forceinline__ void gemm_phase(PG8_LAS unsigned char* lds, const Gemm g, const Sched& S, const Epi& E) {
    int tid = threadIdx.x; asm volatile("" : "+v"(tid));
    const int wid = __builtin_amdgcn_readfirstlane(tid >> 6), lane = tid & 63, wr = wid >> 2, wc = wid & 3, fr = lane & 15, fq = lane >> 4;
    const int K = g.K, nt = K / BK, lda = g.lda;
    unsigned voffA[2], voffB[2];
#pragma unroll
    for (int i = 0; i < 2; ++i) { int R, C; stage_rc(tid * 16 + i * 8192, R, C); const int Rb = Epi::PERM ? ((R & ~31) + perm32(R & 31)) : R;
        voffA[i] = (unsigned)(R * lda + C) * 2u; voffB[i] = (unsigned)(Rb * K + C) * 2u; }
    const size_t kstep = (size_t)(BK * 2);
    const size_t hstepA = (size_t)HALF * lda * 2, hstepB = (size_t)HALF * K * 2;
    const size_t tstepA = 2 * hstepA, tstepB = 2 * hstepB;
    const unsigned ldsw = (unsigned)wid * 1024u;
    const int aoff = lds_byte(wr * 64 + fr, fq * 8), boff = lds_byte(wc * 32 + fr, fq * 8);
#define PG8_SA(b, h) (((b) * 2 + (h)) * HTB)
#define PG8_SB(b, h) ((4 + (b) * 2 + (h)) * HTB)
#define PG8_STAGE(bufoff, gbase, voff) do { _Pragma("unroll") for (int _i = 0; _i < 2; ++_i) \
        __builtin_amdgcn_global_load_lds((const unsigned*)((const char*)(gbase) + (voff)[_i]), (PG8_LAS unsigned*)(lds + (bufoff) + ldsw + _i * 8192), 16, 0, 0); } while (0)
#define PG8_LDA(dst, b, h) do { _Pragma("unroll") for (int m = 0; m < 4; ++m) _Pragma("unroll") for (int k = 0; k < 2; ++k) dst[m][k] = *(const PG8_LAS bf16x8*)(lds + PG8_SA(b, h) + aoff + m * 2048 + k * 1024); } while (0)
#define PG8_LDB(dst, b, h) do { _Pragma("unroll") for (int n = 0; n < 2; ++n) _Pragma("unroll") for (int k = 0; k < 2; ++k) dst[n][k] = *(const PG8_LAS bf16x8*)(lds + PG8_SB(b, h) + boff + n * 2048 + k * 1024); } while (0)
#define PG8_MMA(ai, bj, At, Bt) do { __builtin_amdgcn_s_setprio(1); _Pragma("unroll") for (int m = 0; m < 4; ++m) _Pragma("unroll") for (int n = 0; n < 2; ++n) _Pragma("unroll") for (int k = 0; k < 2; ++k) \
        acc[ai][bj][m][n] = __builtin_amdgcn_mfma_f32_16x16x32_bf16(Bt[n][k], At[m][k], acc[ai][bj][m][n], 0, 0, 0); __builtin_amdgcn_s_setprio(0); } while (0)
#define PG8_WAIT_V(n) asm volatile("s_waitcnt vmcnt(" #n ")" ::: "memory")
#define PG8_WAIT_L(n) asm volatile("s_waitcnt lgkmcnt(" #n ")" ::: "memory")
#define PG8_WAIT_V8X do { if constexpr (Epi::NVM >= 24) asm volatile("s_cmp_eq_u32 %0, 0\n\ts_cbranch_scc1 1f\n\ts_waitcnt vmcnt(8)\n1:\n\ts_waitcnt vmcnt(32)" :: "s"(t) : "scc", "memory"); \
        else asm volatile("s_cmp_eq_u32 %0, 0\n\ts_cbranch_scc1 1f\n\ts_waitcnt vmcnt(8)\n1:\n\ts_waitcnt vmcnt(24)" :: "s"(t) : "scc", "memory"); } while (0)
#define PG8_BAR __builtin_amdgcn_s_barrier()
#define PG8_SCHED __builtin_amdgcn_sched_barrier(0)
#define PG8_APTR(u) ((const char*)g.A + (size_t)((u).rbase) * lda * 2 + (((u).pn >= g.asplit_pn) ? (size_t)g.asplit_off * 2 : (size_t)0))
    Unit cur, nxt; int ui = 0;
    if (!S.next(0, cur)) return;
    f32x4 acc[2][2][4][2];
#pragma unroll
    for (int a = 0; a < 2; ++a)
#pragma unroll
        for (int b = 0; b < 2; ++b)
#pragma unroll
            for (int m = 0; m < 4; ++m)
#pragma unroll
                for (int n = 0; n < 2; ++n) acc[a][b][m][n] = (f32x4){0.f, 0.f, 0.f, 0.f};
    bf16x8 At[4][2], B0[2][2], B1[2][2];
    const char* cA = PG8_APTR(cur); const char* cB = (const char*)g.Bt + (size_t)cur.pn * tstepB;
    S.a_ready(cur);
    if constexpr (SP2) {
        PG8_STAGE(PG8_SB(0, 0), cB, voffB); PG8_STAGE(PG8_SB(0, 1), cB + hstepB, voffB); PG8_STAGE(PG8_SA(0, 0), cA, voffA); PG8_STAGE(PG8_SA(0, 1), cA + hstepA, voffA);
        if (wr == 1) PG8_BAR;
        PG8_WAIT_V(2); PG8_BAR;
        PG8_STAGE(PG8_SB(1, 0), cB + kstep, voffB); PG8_STAGE(PG8_SA(1, 0), cA + kstep, voffA); PG8_STAGE(PG8_SB(1, 1), cB + hstepB + kstep, voffB);
        PG8_WAIT_V(0); PG8_BAR;
    } else {
    PG8_STAGE(PG8_SB(0, 0), cB, voffB); PG8_STAGE(PG8_SA(0, 0), cA, voffA); PG8_STAGE(PG8_SB(0, 1), cB + hstepB, voffB); PG8_STAGE(PG8_SA(0, 1), cA + hstepA, voffA);
    if (wr == 1) PG8_BAR;
    PG8_WAIT_V(4); PG8_BAR;
    PG8_STAGE(PG8_SB(1, 0), cB + kstep, voffB); PG8_STAGE(PG8_SA(1, 0), cA + kstep, voffA); PG8_STAGE(PG8_SB(1, 1), cB + hstepB + kstep, voffB);
    PG8_WAIT_V(6); PG8_BAR;
    }
    for (;;) {
        const bool has_next = S.next(ui + 1, nxt);
        const char* nA = has_next ? PG8_APTR(nxt) : cA; const char* nB = has_next ? (const char*)g.Bt + (size_t)nxt.pn * tstepB : cB;
        const bool hlf = cur.half != 0;
        for (int t = 0; t < nt; t += 2) {
            const bool last = (t == nt - 2);
            const char* a1 = cA + (size_t)(t + 1) * kstep;
            const char* a2 = last ? nA : cA + (size_t)(t + 2) * kstep; const char* b2 = last ? nB : cB + (size_t)(t + 2) * kstep;
            const char* a3 = a2 + kstep; const char* b3 = b2 + kstep;
            if (last && has_next) S.a_ready(nxt);
            if constexpr (SP2) {
            PG8_LDB(B0, 0, 0); PG8_LDB(B1, 0, 1); PG8_SCHED; PG8_LDA(At, 0, 0); PG8_STAGE(PG8_SA(1, 1), a1 + hstepA, voffA);
            PG8_WAIT_V8X; PG8_WAIT_L(0); PG8_BAR; PG8_MMA(0, 0, At, B0); PG8_MMA(0, 1, At, B1); PG8_BAR; PG8_SCHED;
            if (!hlf) { PG8_LDA(At, 0, 1); } PG8_STAGE(PG8_SB(0, 0), b2, voffB); PG8_STAGE(PG8_SB(0, 1), b2 + hstepB, voffB); PG8_STAGE(PG8_SA(0, 0), a2, voffA);
            PG8_WAIT_V8X; PG8_WAIT_L(0); PG8_BAR; if (!hlf) { PG8_MMA(1, 0, At, B0); PG8_MMA(1, 1, At, B1); } PG8_BAR; PG8_SCHED;
            PG8_LDB(B0, 1, 0); PG8_LDB(B1, 1, 1); PG8_SCHED; PG8_LDA(At, 1, 0); PG8_STAGE(PG8_SA(0, 1), a2 + hstepA, voffA);
            PG8_WAIT_V(8); PG8_WAIT_L(0); PG8_BAR; PG8_MMA(0, 0, At, B0); PG8_MMA(0, 1, At, B1); PG8_BAR; PG8_SCHED;
            if (!hlf) { PG8_LDA(At, 1, 1); } PG8_STAGE(PG8_SB(1, 0), b3, voffB); PG8_STAGE(PG8_SB(1, 1), b3 + hstepB, voffB); PG8_STAGE(PG8_SA(1, 0), a3, voffA);
            PG8_WAIT_V(8); PG8_WAIT_L(0); PG8_BAR; if (!hlf) { PG8_MMA(1, 0, At, B0); PG8_MMA(1, 1, At, B1); } PG8_BAR; PG8_SCHED;
            } else {
            PG8_LDB(B0, 0, 0); PG8_SCHED; PG8_LDA(At, 0, 0); PG8_STAGE(PG8_SA(1, 1), a1 + hstepA, voffA);
            PG8_WAIT_L(8); PG8_BAR; PG8_WAIT_L(0); PG8_MMA(0, 0, At, B0); PG8_BAR; PG8_SCHED;
            PG8_LDB(B1, 0, 1); PG8_STAGE(PG8_SB(0, 0), b2, voffB);
            PG8_BAR; PG8_WAIT_L(0); PG8_MMA(0, 1, At, B1); PG8_BAR;
            PG8_LDA(At, 0, 1); PG8_STAGE(PG8_SA(0, 0), a2, voffA);
            PG8_BAR; PG8_WAIT_L(0); PG8_MMA(1, 0, At, B0); PG8_BAR; PG8_SCHED;
            PG8_STAGE(PG8_SB(0, 1), b2 + hstepB, voffB);
            PG8_WAIT_V(6); PG8_BAR; PG8_MMA(1, 1, At, B1); PG8_BAR;
            PG8_LDB(B0, 1, 0); PG8_SCHED; PG8_LDA(At, 1, 0); PG8_STAGE(PG8_SA(0, 1), a2 + hstepA, voffA);
            PG8_WAIT_L(8); PG8_BAR; PG8_WAIT_L(0); PG8_MMA(0, 0, At, B0); PG8_BAR; PG8_SCHED;
            PG8_LDB(B1, 1, 1); PG8_STAGE(PG8_SB(1, 0), b3, voffB);
            PG8_BAR; PG8_WAIT_L(0); PG8_MMA(0, 1, At, B1); PG8_BAR;
            PG8_LDA(At, 1, 1); PG8_STAGE(PG8_SA(1, 0), a3, voffA);
            PG8_BAR; PG8_WAIT_L(0); PG8_MMA(1, 0, At, B0); PG8_BAR; PG8_SCHED;
            PG8_STAGE(PG8_SB(1, 1), b3 + hstepB, voffB);
            PG8_WAIT_V(6); PG8_BAR; PG8_MMA(1, 1, At, B1); PG8_BAR;
            }
        }
        if constexpr (ALIGN_EPI) { if (wr == 0) PG8_BAR; }
        E(acc, cur, wr, wc, fr, fq); S.done(cur);
        if (!has_next) break;
#pragma unroll
        for (int a = 0; a < 2; ++a)
#pragma unroll
            for (int b = 0; b < 2; ++b)
#pragma unroll
                for (int m = 0; m < 4; ++m)
#pragma unroll
                    for (int n = 0; n < 2; ++n) acc[a][b][m][n] = (f32x4){0.f, 0.f, 0.f, 0.f};
        cur = nxt; cA = nA; cB = nB; ++ui;
        if constexpr (ALIGN_EPI) { if (wr == 1) PG8_BAR; }
    }
    PG8_WAIT_V(0);
    if constexpr (!ALIGN_EPI) { if (wr == 0) PG8_BAR; }
    PG8_BAR;
#undef PG8_APTR
#undef PG8_SA
#undef PG8_SB
#undef PG8_STAGE
#undef PG8_LDA
#undef PG8_LDB
#undef PG8_MMA
#undef PG8_WAIT_V
#undef PG8_WAIT_L
#undef PG8_WAIT_V8X
#undef PG8_BAR
#undef PG8_SCHED
}
}

using pg8::bf16_t; using pg8::f32x4; using pg8::u32x4; using pg8::u32x2; using pg8::bf16x8;
using pg8::cvt_pk_bf16; using pg8::bf_lo; using pg8::bf_hi;

struct Params {
    const float* x_prompt; const float* x_sample; const float* state_conv; const float* norm_mix; const float* w_in; const float* ln_g; const float* ln_b;
    const float* w_s; const float* b_s; const float* conv_w; const float* w_pa; const float* w_pb; const float* w_o; const float* norm_ffn;
    const float* w_gate; const float* w_up; const float* w_down; const float* norm_final;
    float* out; unsigned char* ws; int ph_lo, ph_hi;
};
constexpr int LDS_BYTES = pg8::STAGE_BYTES + 256;
constexpr int NPHASE = 2 + 7 * NL;

__device__ __forceinline__ void transpose_tile(const float* __restrict__ src, int ld, int k0, int col0, const float* __restrict__ scale, bf16_t* __restrict__ dst, int K, float* t, int tid) {
    const int r = tid >> 4, c4 = tid & 15;
#pragma unroll
    for (int pass = 0; pass < 2; ++pass) { const int k = r + 32 * pass; const f32x4 v = *(const f32x4*)(src + (size_t)(k0 + k) * ld + col0 + 4 * c4); const float s = scale ? scale[k0 + k] : 1.0f;
        t[k * 65 + 4 * c4 + 0] = v[0] * s; t[k * 65 + 4 * c4 + 1] = v[1] * s; t[k * 65 + 4 * c4 + 2] = v[2] * s; t[k * 65 + 4 * c4 + 3] = v[3] * s; }
    __syncthreads();
    const int n = tid >> 3, kc = tid & 7; u32x4 w;
    w.x = cvt_pk_bf16(t[(8 * kc + 0) * 65 + n], t[(8 * kc + 1) * 65 + n]); w.y = cvt_pk_bf16(t[(8 * kc + 2) * 65 + n], t[(8 * kc + 3) * 65 + n]);
    w.z = cvt_pk_bf16(t[(8 * kc + 4) * 65 + n], t[(8 * kc + 5) * 65 + n]); w.w = cvt_pk_bf16(t[(8 * kc + 6) * 65 + n], t[(8 * kc + 7) * 65 + n]);
    *(u32x4*)(dst + (size_t)n * K + k0 + 8 * kc) = w;
    __syncthreads();
}
constexpr int IT_WIN = (NIN / 64) * 16, IT_WPAB = 32 * 16, IT_WO = 16 * 16, IT_WGU = (2 * DFF / 64) * 16, IT_WD = 16 * (DFF / 64), IT_LAYER = IT_WIN + IT_WPAB + IT_WO + IT_WGU + IT_WD;

__device__ __forceinline__ void p0_prologue(const Params& p, float* ldsf, int layer, int first, bool misc) {
    unsigned char* ws = p.ws;
    float* ssqm = (float*)(ws + WS_SSQM);
    int tid = threadIdx.x; asm volatile("" : "+v"(tid));
    const int G = gridDim.x, b = blockIdx.x;
    for (int it = b - first; it >= 0 && it < IT_LAYER; it += G - first) {
        const int l = layer; int r = it; unsigned char* lw = ws + WS_W + (size_t)l * LW_BYTES;
        if (r < IT_WIN) { const int ntile = r >> 4, kt = r & 15, n0 = ntile * 64; int col;
            if (n0 < 3072) col = n0; else if (n0 < 5120) { const int t = n0 - 3072; col = ((t & 128) ? 4096 : 3072) + (t >> 8) * 128 + (t & 127); } else { const int t = n0 - 5120; col = ((t & 128) ? 6144 : 5120) + (t >> 8) * 128 + (t & 127); }
            transpose_tile(p.w_in + (size_t)l * DM * NIN, NIN, kt * 64, col, p.norm_mix + l * DM, (bf16_t*)(lw + LW_WIN) + (size_t)n0 * DM, DM, ldsf, tid); continue; }
        r -= IT_WIN;
        if (r < IT_WPAB) { const int ntile = r >> 4, kt = r & 15, n0 = ntile * 64;
            const float* src = (n0 < 1024) ? p.w_pa + (size_t)l * DM * DM : p.w_pb + (size_t)l * DM * DM;
            transpose_tile(src, DM, kt * 64, n0 & 1023, nullptr, (bf16_t*)(lw + LW_WPAB) + (size_t)n0 * DM, DM, ldsf, tid); continue; }
        r -= IT_WPAB;
        if (r < IT_WO) { const int ntile = r >> 4, kt = r & 15, n0 = ntile * 64;
            transpose_tile(p.w_o + (size_t)l * DM * DM, DM, kt * 64, n0, nullptr, (bf16_t*)(lw + LW_WO) + (size_t)n0 * DM, DM, ldsf, tid); continue; }
        r -= IT_WO;
        if (r < IT_WGU) { const int ntile = r >> 4, kt = r & 15, n0 = ntile * 64;
            const float* src = ((n0 & 128) ? p.w_up : p.w_gate) + (size_t)l * DM * DFF; const int col = (n0 >> 8) * 128 + (n0 & 127);
            transpose_tile(src, DFF, kt * 64, col, p.norm_ffn + l * DM, (bf16_t*)(lw + LW_WGU) + (size_t)n0 * DM, DM, ldsf, tid); continue; }
        r -= IT_WGU;
        { const int ntile = r / (DFF / 64), kt = r % (DFF / 64), n0 = ntile * 64;
            transpose_tile(p.w_down + (size_t)l * DFF * DM, DM, kt * 64, n0, nullptr, (bf16_t*)(lw + LW_WD) + (size_t)n0 * DFF, DFF, ldsf, tid); }
    }
    if (!misc) return;
    for (int i = b * 512 + tid; i < NL * 8 * 128 * 128; i += G * 512) {
        const int l = i >> 17, rem = i & 131071, ii = (rem >> 7) & 127, jj = rem & 127;
        const float* wsrc = p.w_s + (size_t)(i - rem);
        const int grp = rem >> 14;
        unsigned char* lw = ws + WS_W + (size_t)l * LW_BYTES;
        const float vp = (jj <= ii) ? p.w_s[i] : 0.f;
        const float vs = ((ii >> 5) == (jj >> 5) && (jj & 31) <= (ii & 31)) ? wsrc[grp * 16384 + (ii & 31) * 128 + (jj & 31)] : 0.f;
        ((bf16_t*)(lw + LW_WSP))[rem] = (bf16_t)(cvt_pk_bf16(vp, 0.f) & 0xffffu);
        ((bf16_t*)(lw + LW_WSS))[rem] = (bf16_t)(cvt_pk_bf16(vs, 0.f) & 0xffffu);
    }
    { const int wave = tid >> 6, lane = tid & 63; bf16_t* xb = (bf16_t*)(ws + WS_XB);
      for (int row = b * 8 + wave; row < MT; row += 2 * G * 8) {
          const int row2 = row + G * 8; const bool has2 = row2 < MT;
          const float* xr = (row < MP) ? p.x_prompt + (size_t)row * DM : p.x_sample + (size_t)(row - MP) * DM;
          const float* xr2 = has2 ? ((row2 < MP) ? p.x_prompt + (size_t)row2 * DM : p.x_sample + (size_t)(row2 - MP) * DM) : xr;
          f32x4 v[4], v2[4];
#pragma unroll
          for (int j = 0; j < 4; ++j) { v[j] = *(const f32x4*)(xr + 4 * (lane + 64 * j)); v2[j] = *(const f32x4*)(xr2 + 4 * (lane + 64 * j)); }
          float q = 0.f, q2 = 0.f;
#pragma unroll
          for (int j = 0; j < 4; ++j) { q += (v[j][0] * v[j][0] + v[j][1] * v[j][1]) + (v[j][2] * v[j][2] + v[j][3] * v[j][3]); q2 += (v2[j][0] * v2[j][0] + v2[j][1] * v2[j][1]) + (v2[j][2] * v2[j][2] + v2[j][3] * v2[j][3]);
              u32x2 w; w.x = cvt_pk_bf16(v[j][0], v[j][1]); w.y = cvt_pk_bf16(v[j][2], v[j][3]); *(u32x2*)(xb + (size_t)row * DM + 4 * (lane + 64 * j)) = w;
              if (has2) { u32x2 w2; w2.x = cvt_pk_bf16(v2[j][0], v2[j][1]); w2.y = cvt_pk_bf16(v2[j][2], v2[j][3]); *(u32x2*)(xb + (size_t)row2 * DM + 4 * (lane + 64 * j)) = w2; } }
#pragma unroll
          for (int o = 32; o >= 1; o >>= 1) { q += __shfl_xor(q, o); q2 += __shfl_xor(q2, o); }
          if (lane < 4) { ((f32x4*)(ssqm + (size_t)row * 16))[lane] = (f32x4){lane == 0 ? q : 0.f, 0.f, 0.f, 0.f};
              if (has2) ((f32x4*)(ssqm + (size_t)row2 * 16))[lane] = (f32x4){lane == 0 ? q2 : 0.f, 0.f, 0.f, 0.f}; }
      } }
}

constexpr int VT_PITCH = 136;
__device__ __forceinline__ void gate_conv_phase(const Params& p, int l, unsigned char* lds) {
    unsigned char* ws = p.ws;
    const float* lns = (const float*)(ws + WS_LNS);
    bf16_t* AB = (bf16_t*)(ws + WS_AB); const bf16_t* GV = (const bf16_t*)(ws + WS_GV); const bf16_t* CH = (const bf16_t*)(ws + WS_CH);
    const unsigned char* lw = ws + WS_W + (size_t)l * LW_BYTES;
    bf16_t* vT = (bf16_t*)lds;
    float* mr = (float*)(lds + 128 * VT_PITCH * 2);
    int tid = threadIdx.x; asm volatile("" : "+v"(tid));
    const int lane = tid & 63, w = tid >> 6, fr = lane & 15, fq = lane >> 4;
    const int jg = tid >> 5, cq = tid & 31;
    const int ci = tid & 15;
    const int nks = (w >> 1) + 1;
    const int total = (MT / 128) * 8;
    int item = blockIdx.x; if (item >= total) return;
    const int g = item & 7, c0 = g * 128, irow = 16 * w + fr;
    const bf16_t* WsP = (const bf16_t*)(lw + LW_WSP) + g * 16384 + irow * 128 + 8 * fq;
    bf16x8 wf[4];
#pragma unroll
    for (int ks = 0; ks < 4; ++ks) wf[ks] = *(const bf16x8*)(WsP + 32 * ks);
    float bs = p.b_s[(l * 8 + g) * 128 + irow];
    const float* cwp = p.conv_w + (size_t)l * 3 * DM + c0 + 8 * ci;
    bool was_smp = false;
    f32x4 sl0, sl1; u32x2 gv[8]; u32x4 uu[4];
#define GC_LOAD(it) do { const int r0_ = ((it) >> 3) * 128; \
        const f32x4* sl_ = (const f32x4*)(lns + (size_t)(r0_ + (tid >> 2)) * 32 + (tid & 3) * 8); sl0 = sl_[0]; sl1 = sl_[1]; \
        _Pragma("unroll") for (int jj = 0; jj < 8; ++jj) gv[jj] = *(const u32x2*)(GV + (size_t)(r0_ + 8 * jg + jj) * DM + c0 + 4 * cq); } while (0)
#define GC_LOADU(it) do { const int r0_ = ((it) >> 3) * 128; \
        _Pragma("unroll") for (int pp = 0; pp < 4; ++pp) uu[pp] = *(const u32x4*)(AB + (size_t)(r0_ + irow) * 2048 + c0 + 8 * fq + 32 * pp); } while (0)
    GC_LOAD(item); GC_LOADU(item);
    for (;;) {
        const int ct = item >> 3, row0 = ct * 128; const bool smp = ct >= MP / 128;
        if (smp && !was_smp) {
            const bf16_t* WsS = (const bf16_t*)(lw + LW_WSS) + g * 16384 + irow * 128 + 8 * fq;
#pragma unroll
            for (int ks = 0; ks < 4; ++ks) wf[ks] = *(const bf16x8*)(WsS + 32 * ks);
            bs = p.b_s[(l * 8 + g) * 128 + (irow & 31)]; was_smp = true; }
        bf16_t* rowp = AB + (size_t)(row0 + irow) * 2048 + c0 + 8 * fq;
        const f32x4 lg = *(const f32x4*)(p.ln_g + l * DM + c0 + 4 * cq), lb = *(const f32x4*)(p.ln_b + l * DM + c0 + 4 * cq);
        { float sm = (sl0[0] + sl0[2]) + (sl1[0] + sl1[2]), sq = (sl0[1] + sl0[3]) + (sl1[1] + sl1[3]);
          sm += __shfl_xor(sm, 1); sq += __shfl_xor(sq, 1); sm += __shfl_xor(sm, 2); sq += __shfl_xor(sq, 2);
          if ((tid & 3) == 0) { const float mean = sm * (1.0f / 1024.0f), var = sq * (1.0f / 1024.0f) - mean * mean; mr[2 * (tid >> 2)] = mean; mr[2 * (tid >> 2) + 1] = __builtin_amdgcn_rsqf(fmaxf(var, 0.f) + EPS); } }
        __syncthreads();
        { float v[8][4];
#pragma unroll
          for (int jj = 0; jj < 8; ++jj) { const float mean = mr[2 * (8 * jg + jj)], rstd = mr[2 * (8 * jg + jj) + 1];
              v[jj][0] = (bf_lo(gv[jj].x) - mean) * rstd * lg[0] + lb[0]; v[jj][1] = (bf_hi(gv[jj].x) - mean) * rstd * lg[1] + lb[1];
              v[jj][2] = (bf_lo(gv[jj].y) - mean) * rstd * lg[2] + lb[2]; v[jj][3] = (bf_hi(gv[jj].y) - mean) * rstd * lg[3] + lb[3];
              if (smp) *(f32x4*)(p.out + OUT_V + ((size_t)l * MS + (row0 + 8 * jg + jj - MP)) * DM + c0 + 4 * cq) = (f32x4){v[jj][0], v[jj][1], v[jj][2], v[jj][3]}; }
#pragma unroll
          for (int e = 0; e < 4; ++e) { u32x4 wv; wv.x = cvt_pk_bf16(v[0][e], v[1][e]); wv.y = cvt_pk_bf16(v[2][e], v[3][e]); wv.z = cvt_pk_bf16(v[4][e], v[5][e]); wv.w = cvt_pk_bf16(v[6][e], v[7][e]);
              *(u32x4*)(vT + (4 * cq + e) * VT_PITCH + 8 * jg) = wv; } }
        u32x4 ch0[4], ch1[4], ch2[4], bg[4];
#pragma unroll
        for (int vv = 0; vv < 4; ++vv) { const int i = (tid >> 4) + 32 * vv, row = row0 + i, c = c0 + 8 * ci; const int pos = smp ? ((row - MP) & 31) : (row & 2047);
            const u32x4 z4 = {0u, 0u, 0u, 0u};
            ch0[vv] = *(const u32x4*)(CH + (size_t)row * DM + c);
            ch1[vv] = (pos >= 1) ? *(const u32x4*)(CH + (size_t)(row - 1) * DM + c) : z4;
            ch2[vv] = (pos >= 2) ? *(const u32x4*)(CH + (size_t)(row - 2) * DM + c) : z4;
            bg[vv] = *(const u32x4*)(AB + (size_t)row * 2048 + 1024 + c); }
        const int nitem = item + (int)gridDim.x; const bool has_next = nitem < total;
        if (has_next) GC_LOAD(nitem);
        __syncthreads();
        { f32x4 acc[8];
#pragma unroll
          for (int dt = 0; dt < 8; ++dt) acc[dt] = (f32x4){0.f, 0.f, 0.f, 0.f};
#pragma unroll
          for (int ks = 0; ks < 4; ++ks) if (ks < nks) {
#pragma unroll
              for (int dt = 0; dt < 8; ++dt) { const int d = 32 * (dt >> 1) + 8 * (fr >> 2) + 4 * (dt & 1) + (fr & 3);
                  const bf16x8 vf = *(const bf16x8*)(vT + d * VT_PITCH + 32 * ks + 8 * fq);
                  acc[dt] = __builtin_amdgcn_mfma_f32_16x16x32_bf16(vf, wf[ks], acc[dt], 0, 0, 0); } }
#pragma unroll
          for (int pp = 0; pp < 4; ++pp) { const f32x4 s0 = acc[2 * pp] + bs, s1 = acc[2 * pp + 1] + bs;
              const f32x4 u0 = {bf_lo(uu[pp][0]), bf_hi(uu[pp][0]), bf_lo(uu[pp][1]), bf_hi(uu[pp][1])}, u1 = {bf_lo(uu[pp][2]), bf_hi(uu[pp][2]), bf_lo(uu[pp][3]), bf_hi(uu[pp][3])};
              *(u32x4*)(rowp + 32 * pp) = pg8::pack8(u0 * s0, u1 * s1); } }
        if (has_next) GC_LOADU(nitem);
        const f32x4 w0a = *(const f32x4*)(cwp), w0b = *(const f32x4*)(cwp + 4), w1a = *(const f32x4*)(cwp + DM), w1b = *(const f32x4*)(cwp + DM + 4), w2a = *(const f32x4*)(cwp + 2 * DM), w2b = *(const f32x4*)(cwp + 2 * DM + 4);
#pragma unroll
        for (int vv = 0; vv < 4; ++vv) { const int i = (tid >> 4) + 32 * vv, row = row0 + i, c = c0 + 8 * ci; const int pos = smp ? ((row - MP) & 31) : (row & 2047);
            float f0[8], f1[8], f2[8], o[8];
#pragma unroll
            for (int e = 0; e < 4; ++e) { f0[2 * e] = bf_lo(ch0[vv][e]); f0[2 * e + 1] = bf_hi(ch0[vv][e]); f1[2 * e] = bf_lo(ch1[vv][e]); f1[2 * e + 1] = bf_hi(ch1[vv][e]); f2[2 * e] = bf_lo(ch2[vv][e]); f2[2 * e + 1] = bf_hi(ch2[vv][e]); }
            if (smp && pos < 2) { const int sq = (row - MP) >> 5; const float* stp = p.state_conv + ((size_t)(l * 32 + sq) * 2) * DM + c;
                if (pos == 0) { const f32x4 a = *(const f32x4*)(stp + DM), bq = *(const f32x4*)(stp + DM + 4); f1[0] = a[0]; f1[1] = a[1]; f1[2] = a[2]; f1[3] = a[3]; f1[4] = bq[0]; f1[5] = bq[1]; f1[6] = bq[2]; f1[7] = bq[3]; }
                { const float* s2 = stp + (pos == 0 ? 0 : DM); const f32x4 a = *(const f32x4*)(s2), bq = *(const f32x4*)(s2 + 4); f2[0] = a[0]; f2[1] = a[1]; f2[2] = a[2]; f2[3] = a[3]; f2[4] = bq[0]; f2[5] = bq[1]; f2[6] = bq[2]; f2[7] = bq[3]; } }
#pragma unroll
            for (int e = 0; e < 4; ++e) { o[e] = w0a[e] * f2[e] + w1a[e] * f1[e] + w2a[e] * f0[e]; o[4 + e] = w0b[e] * f2[4 + e] + w1b[e] * f1[4 + e] + w2b[e] * f0[4 + e]; }
            u32x4 ov;
#pragma unroll
            for (int e = 0; e < 4; ++e) ov[e] = cvt_pk_bf16(o[2 * e] * bf_lo(bg[vv][e]), o[2 * e + 1] * bf_hi(bg[vv][e]));
            *(u32x4*)(AB + (size_t)row * 2048 + 1024 + c) = ov;
            const int lastpos = smp ? 31 : 2047;
            if (pos >= lastpos - 1) { float* op = smp ? p.out + OUT_NCS + (((size_t)l * 32 + ((row - MP) >> 5)) * 2 + (pos - (lastpos - 1))) * DM + c
                                                      : p.out + OUT_NCP + (((size_t)l * 32 + (row >> 11)) * 2 + (pos - (lastpos - 1))) * DM + c;
                *(f32x4*)op = (f32x4){f0[0], f0[1], f0[2], f0[3]}; *(f32x4*)(op + 4) = (f32x4){f0[4], f0[5], f0[6], f0[7]}; } }
        __syncthreads();
        if (!has_next) break;
        item = nitem;
    }
#undef GC_LOAD
#undef GC_LOADU
}

__device__ __forceinline__ void final_norm_phase(const Params& p) {
    const float* __restrict__ ssq = (const float*)(p.ws + WS_SSQM); const bf16_t* __restrict__ xb = (const bf16_t*)(p.ws + WS_XB); float* __restrict__ out = p.out;
    const size_t n8 = (size_t)MT * DM / 8;
    int tid = threadIdx.x; asm volatile("" : "+v"(tid));
    const size_t stride = (size_t)gridDim.x * 512;
    const int c = (tid & 127) * 8;
    const f32x4 g0 = *(const f32x4*)(p.norm_final + c), g1 = *(const f32x4*)(p.norm_final + c + 4);
    for (size_t i = (size_t)blockIdx.x * 512 + tid; i < n8; i += 4 * stride) {
        u32x4 w[4]; f32x4 s0[4], s1[4], s2[4], s3[4];
#pragma unroll
        for (int k = 0; k < 4; ++k) { const size_t ii = i + k * stride; if (ii < n8) { w[k] = *(const u32x4*)(xb + ii * 8); const f32x4* s = (const f32x4*)(ssq + (ii >> 7) * 16); s0[k] = s[0]; s1[k] = s[1]; s2[k] = s[2]; s3[k] = s[3]; } }
#pragma unroll
        for (int k = 0; k < 4; ++k) { const size_t ii = i + k * stride; if (ii < n8) { const f32x4 t = (s0[k] + s1[k]) + (s2[k] + s3[k]);
            const float rs = __builtin_amdgcn_rsqf(((t[0] + t[1]) + (t[2] + t[3])) * (1.0f / 1024.0f) + EPS);
            ((f32x4*)out)[2 * ii] = pg8::unpk_lo(w[k]) * rs * g0; ((f32x4*)out)[2 * ii + 1] = pg8::unpk_hi(w[k]) * rs * g1; } }
    }
}

#define LAS __attribute__((address_space(3)))
#define XB_TMO      128
#define XB_XCNT(j)  (256  + 64 * (j))
#define XB_XSUB(j)  (1280 + 64 * (j))
#define XB_XGEN(j)  (2304 + 64 * (j))
#define XB_TOP      3328
#define XB_TOPGEN   3392
#define XCD_BAR_WORDS 3456
#define XB_SPIN_CAP (1u << 18)

__device__ __forceinline__ unsigned xb_ld(unsigned* p)              { return __hip_atomic_load(p, __ATOMIC_RELAXED, __HIP_MEMORY_SCOPE_AGENT); }
__device__ __forceinline__ unsigned xb_add(unsigned* p, unsigned v) { return __hip_atomic_fetch_add(p, v, __ATOMIC_RELAXED, __HIP_MEMORY_SCOPE_AGENT); }
__device__ __forceinline__ unsigned xb_xcc_id() { return (unsigned)__builtin_amdgcn_s_getreg((3 << 11) | 20) & 0xFu; }
#define XB_SPIN(cond, bar) do { unsigned _sp = 0; while (cond) { __builtin_amdgcn_s_sleep(1); \
    if ((++_sp & 255u) == 0u) { if (xb_ld(&(bar)[XB_TMO])) break; if (_sp > XB_SPIN_CAP) { atomicAdd(&(bar)[XB_TMO], 1u); break; } } } } while (0)

struct XcdBarrier {
    unsigned* bar; unsigned x;
    volatile LAS unsigned* st;
};

__device__ __forceinline__ XcdBarrier xcd_barrier_post(unsigned* bar, volatile LAS unsigned* st) {
    XcdBarrier b; b.bar = bar; b.x = xb_xcc_id(); b.st = st;
    if (threadIdx.x == 0) (void)xb_add(&bar[XB_XCNT(b.x)], 1u);
    return b;
}
__device__ __forceinline__ void xcd_barrier_complete(unsigned* bar, unsigned x, unsigned& nloc, unsigned& nx) {
    const unsigned G = gridDim.x * gridDim.y * gridDim.z;
    unsigned sum, cnt, mine, sp = 0u;
    for (;;) {
        sum = 0u; cnt = 0u; mine = 0u;
#pragma unroll
        for (unsigned j = 0; j < 16; ++j) { const unsigned c = xb_ld(&bar[XB_XCNT(j)]); sum += c; cnt += (c > 0u) ? 1u : 0u; mine = (j == x) ? c : mine; }
        if (sum == G) break;
        __builtin_amdgcn_s_sleep(1);
        if ((++sp & 255u) == 0u) { if (xb_ld(&bar[XB_TMO])) break; if (sp > XB_SPIN_CAP) { atomicAdd(&bar[XB_TMO], 1u); break; } }
    }
    nloc = mine > 0u ? mine : 1u; nx = cnt > 0u ? cnt : 1u;
}

__device__ __forceinline__ void xcd_barrier(const XcdBarrier& b) {
    asm volatile("s_waitcnt vmcnt(0)" ::: "memory");
    __syncthreads();
    if (threadIdx.x == 0) {
        unsigned* bar = b.bar;
        __builtin_amdgcn_s_waitcnt(0);
        unsigned nloc = b.st[0], nx = b.st[1];
        if (nloc == 0u) { xcd_barrier_complete(bar, b.x, nloc, nx); b.st[0] = nloc; b.st[1] = nx; }
        const unsigned old = xb_add(&bar[XB_XSUB(b.x)], 1u);
        const unsigned gen = old / nloc;
        if (old + 1u == (gen + 1u) * nloc) {
            __builtin_amdgcn_fence(__ATOMIC_RELEASE, "agent");
            asm volatile("s_waitcnt vmcnt(0)" ::: "memory");
            const unsigned og = xb_add(&bar[XB_TOP], 1u);
            const unsigned tg = og / nx;
            if (og + 1u == (tg + 1u) * nx) xb_add(&bar[XB_TOPGEN], 1u);
            else XB_SPIN(xb_ld(&bar[XB_TOPGEN]) == tg, bar);
            __builtin_amdgcn_fence(__ATOMIC_ACQUIRE, "agent");
            xb_add(&bar[XB_XGEN(b.x)], 1u);
            asm volatile("s_waitcnt vmcnt(0)" ::: "memory");
        } else {
            XB_SPIN(xb_ld(&bar[XB_XGEN(b.x)]) == gen, bar);
            __builtin_amdgcn_fence(__ATOMIC_ACQUIRE, "agent");
            asm volatile("s_waitcnt vmcnt(0)" ::: "memory");
        }
    }
    __syncthreads();
}

__global__ void __launch_bounds__(512, 2) mk_fwd(Params p) {
    extern __shared__ __attribute__((aligned(16))) unsigned char lds[];
    unsigned char* ws0 = p.ws;
    PG8_LAS unsigned char* ring = (PG8_LAS unsigned char*)lds;
#if MK_MULTI
#define GRID_SYNC() do { } while (0)
#else
    cg::grid_group grid = cg::this_grid();
    volatile LAS unsigned* bst = (volatile LAS unsigned*)((LAS unsigned char*)lds + pg8::STAGE_BYTES);
    if (threadIdx.x < 2) bst[threadIdx.x] = 0u;
    __syncthreads();
    XcdBarrier xbar = xcd_barrier_post((unsigned*)(ws0 + WS_CTL), bst);
#define GRID_SYNC() do { if (p.ph_hi > 100000) grid.sync(); else xcd_barrier(xbar); } while (0)
#endif
    for (int ph = p.ph_lo; ph < p.ph_hi; ++ph) {
        unsigned char* ws = ws0; int G = gridDim.x, c = blockIdx.x; asm volatile("" : "+s"(ws), "+s"(G), "+s"(c));
        float* ssq_mix = (float*)(ws + WS_SSQM); float* ssq_ffn = (float*)(ws + WS_SSQF); float* lns = (float*)(ws + WS_LNS);
        bf16_t* XB = (bf16_t*)(ws + WS_XB); bf16_t* AB = (bf16_t*)(ws + WS_AB); bf16_t* GV = (bf16_t*)(ws + WS_GV); bf16_t* CH = (bf16_t*)(ws + WS_CH);
        bf16_t* T12 = GV; bf16_t* MMb = AB; bf16_t* Hb = AB;
        int cl = -1, cf = 0;
        if (ph == 0) { cl = 0; }
        else if (ph == NPHASE - 1) { if (PHASE_MASK & 2) final_norm_phase(p); }
        else {
            const int l = (ph - 1) / 7, s = (ph - 1) % 7;
            for (int rep_ = 0; rep_ < (((PROBE_DUP >> s) & 1) ? 2 : 1); ++rep_) {
            const unsigned char* lw = ws + WS_W + (size_t)l * LW_BYTES;
            if (s == 0) { if (PHASE_MASK & 4) {
                pg8::Gemm g{XB, (const bf16_t*)(lw + LW_WIN), MT, 5120, DM, DM, 1 << 30, 0}; pg8::StaticOrder S; S.init(MT, 5120, G, c);
                pg8::EpiA E{AB, GV, CH, ssq_mix, lns};
                pg8::gemm_phase<pg8::EpiA, pg8::StaticOrder>(ring, g, S, E); }
            } else if (s == 1) {
                if (PHASE_MASK & 8) gate_conv_phase(p, l, lds);
            } else if (s == 2) { if (PHASE_MASK & 16) {
                pg8::Gemm g{AB, (const bf16_t*)(lw + LW_WPAB), MT, 2048, DM, 2048, 4, 1024}; pg8::StaticOrder S; S.init(MT, 2048, G, c);
                pg8::EpiC E{T12};
                pg8::gemm_phase<pg8::EpiC, pg8::StaticOrder>(ring, g, S, E); }
            } else if (s == 3) { if (PHASE_MASK & 32) {
                pg8::Gemm g{XB, (const bf16_t*)(lw + LW_WIN) + (size_t)5120 * DM, MT, 2048, DM, DM, 1 << 30, 0}; pg8::StaticOrder S; S.init(MT, 2048, G, c);
                pg8::EpiD E{T12, MMb, ssq_mix};
                pg8::gemm_phase<pg8::EpiD, pg8::StaticOrder>(ring, g, S, E); }
            } else if (s == 4) { if (PHASE_MASK & 64) {
                pg8::Gemm g{MMb, (const bf16_t*)(lw + LW_WO), MT, DM, DM, DM, 1 << 30, 0}; pg8::StaticOrder S; S.init(MT, DM, G, c);
                pg8::EpiRes E{XB, ssq_ffn};
                pg8::gemm_phase<pg8::EpiRes, pg8::StaticOrder>(ring, g, S, E); }
            } else if (s == 5) { if (PHASE_MASK & 128) {
                pg8::Gemm g{XB, (const bf16_t*)(lw + LW_WGU), MT, 2 * DFF, DM, DM, 1 << 30, 0}; pg8::StaticOrder S; S.init(MT, 2 * DFF, G, c);
                pg8::EpiF E{Hb, ssq_ffn};
                pg8::gemm_phase<pg8::EpiF, pg8::StaticOrder>(ring, g, S, E); }
            } else { if (PHASE_MASK & 256) {
                pg8::Gemm g{Hb, (const bf16_t*)(lw + LW_WD), MT, DM, DFF, DFF, 1 << 30, 0}; pg8::StaticOrder S; S.init(MT, DM, G, c);
                pg8::EpiRes E{XB, ssq_mix};
                pg8::gemm_phase<pg8::EpiRes, pg8::StaticOrder>(ring, g, S, E);
                if (l + 1 < NL) { cl = l + 1; cf = S.ntot - S.nwg; } }
            }
            }
        }
        if (cl >= 0) p0_prologue(p, (float*)lds, cl, cf, ph == 0);
        if (ph + 1 < p.ph_hi) { GRID_SYNC(); }
    }
}

extern "C" void kernel_launch(void* const* d_in, const int* in_sizes, int n_in, void* d_out, int out_size, void* d_ws, size_t ws_size, hipStream_t stream) {
    static int grid = 0;
    if (grid == 0) {
        if (n_in != 18 || in_sizes[0] != MP * DM || (size_t)out_size != OUT_TOTAL || ws_size < WS_END) {
            fprintf(stderr, "kernel_launch: unexpected shapes: n_in %d in0 %d out %d ws %zu (need %zu)\n", n_in, n_in > 0 ? in_sizes[0] : -1, out_size, ws_size, (size_t)WS_END); grid = -1; return; }
        int dev = 0, cus = 0, per_cu = 0;
        (void)hipGetDevice(&dev); (void)hipDeviceGetAttribute(&cus, hipDeviceAttributeMultiprocessorCount, dev);
        if (hipFuncSetAttribute((const void*)mk_fwd, hipFuncAttributeMaxDynamicSharedMemorySize, LDS_BYTES) != hipSuccess) { fprintf(stderr, "kernel_launch: hipFuncSetAttribute failed\n"); grid = -1; return; }
        if (hipOccupancyMaxActiveBlocksPerMultiprocessor(&per_cu, (const void*)mk_fwd, 512, LDS_BYTES) != hipSuccess || per_cu < 1) { fprintf(stderr, "kernel_launch: occupancy query says %d\n", per_cu); per_cu = 1; }
        (void)hipGetLastError();
        grid = cus * 1;
        fprintf(stderr, "kernel_launch: cus %d per_cu %d grid %d\n", cus, per_cu, grid);
    }
    if (grid < 0) return;
    if (hipMemsetAsync((char*)d_ws + WS_CTL, 0, CTL_BYTES, stream) != hipSuccess) { fprintf(stderr, "kernel_launch: memset failed\n"); return; }
    Params p{};
    const float** pp = (const float**)&p;
    for (int i = 0; i < 18; ++i) pp[i] = (const float*)d_in[i];
    p.out = (float*)d_out; p.ws = (unsigned char*)d_ws;
#if MK_MULTI
    for (int ph = 0; ph < NPHASE; ++ph) { p.ph_lo = ph; p.ph_hi = ph + 1; hipLaunchKernelGGL(mk_fwd, dim3(grid), dim3(512), LDS_BYTES, stream, p); }
#else
    p.ph_lo = 0; p.ph_hi = NPHASE;
    void* args[] = {&p};
    hipError_t e = hipLaunchCooperativeKernel((const void*)mk_fwd, dim3(grid), dim3(512), args, LDS_BYTES, stream);
    if (e != hipSuccess) fprintf(stderr, "kernel_launch: cooperative launch failed: %s (grid %d)\n", hipGetErrorString(e), grid);
#endif
}
```

```cpp
#include <hip/hip_runtime.h>
#include <hip/hip_cooperative_groups.h>
#include <cstdio>
#include <cstdint>
namespace cg = cooperative_groups;

#ifndef PHASE_MASK
#define PHASE_MASK 511
#endif
#ifndef PROBE_DUP
#define PROBE_DUP 0
#endif
#ifndef MK_MULTI
#define MK_MULTI 0
#endif

constexpr int MP = 65536, MS = 1024, MT = MP + MS, DM = 1024, NL = 4, DFF = 2816, NIN = 7168;
constexpr float EPS = 1e-6f;
constexpr size_t OUT_YS = (size_t)MP * DM, OUT_NCP = OUT_YS + (size_t)MS * DM, OUT_NCS = OUT_NCP + (size_t)NL * 32 * 2 * DM, OUT_V = OUT_NCS + (size_t)NL * 32 * 2 * DM;
constexpr size_t OUT_TOTAL = OUT_V + (size_t)NL * 32 * 32 * DM;

constexpr size_t MiB = (size_t)1 << 20;
constexpr size_t WS_SSQM = 0, WS_SSQF = 5 * MiB, WS_LNS = 10 * MiB;
constexpr size_t WS_CTL = 20 * MiB, CTL_BYTES = 16384;
constexpr size_t WS_W = 24 * MiB;
constexpr size_t LW_WIN = 0, LW_WPAB = LW_WIN + (size_t)NIN * DM * 2, LW_WO = LW_WPAB + (size_t)2048 * DM * 2, LW_WGU = LW_WO + (size_t)DM * DM * 2,
                 LW_WD = LW_WGU + (size_t)2 * DFF * DM * 2, LW_WSP = LW_WD + (size_t)DM * DFF * 2, LW_WSS = LW_WSP + (size_t)8 * 128 * 128 * 2, LW_BYTES = LW_WSS + (size_t)8 * 128 * 128 * 2;
constexpr size_t WS_XB = 176 * MiB;
constexpr size_t WS_AB = 306 * MiB;
constexpr size_t WS_GV = 566 * MiB;
constexpr size_t WS_CH = 696 * MiB;
constexpr size_t WS_END = 826 * MiB;
static_assert(WS_W + NL * LW_BYTES <= WS_XB, "weights overflow");

namespace pg8 {
#define PG8_LAS __attribute__((address_space(3)))
typedef unsigned short bf16_t;
typedef short bf16x8 __attribute__((ext_vector_type(8)));
typedef float f32x4 __attribute__((ext_vector_type(4)));
typedef float f32x2 __attribute__((ext_vector_type(2)));
typedef unsigned u32x4 __attribute__((ext_vector_type(4)));
typedef unsigned u32x2 __attribute__((ext_vector_type(2)));
constexpr int BM = 256, BK = 64, HALF = 128, HTB = HALF * BK * 2, STAGE_BYTES = 8 * HTB, NXCD = 8, WGM = 8;

__host__ __device__ __forceinline__ int lds_byte(int r, int c) { const int st = (r >> 4) * 2 + (c >> 5), rr = r & 15, cc = c & 31, ob = rr * 64 + cc * 2; return st * 1024 + (ob ^ (((ob >> 9) & 1) << 5)); }
__host__ __device__ __forceinline__ void stage_rc(int b, int& R, int& C) { const int st = b / 1024, sb = b % 1024, swz = sb ^ (((sb >> 9) & 1) << 5); R = (st >> 1) * 16 + swz / 64; C = (st & 1) * 32 + (swz % 64) / 2; }
__host__ __device__ __forceinline__ int perm32(int rho) { const int n = rho >> 4, i = rho & 15; return 8 * (i >> 2) + 4 * n + (i & 3); }

struct Unit { int pm, pn, half, rbase; };
struct Gemm { const bf16_t* A; const bf16_t* Bt; int M, N, K, lda, asplit_pn, asplit_off; };

struct StaticOrder {
    int nM, nN, nwg, G, c, ntot;
    __host__ __device__ void init(int M, int N, int G_, int c_) { nM = MP / BM; nN = N / BM; nwg = nM * nN; G = G_; c = c_; ntot = nwg + 2 * ((M / BM) - nM) * nN; }
    __host__ __device__ bool next(int i, Unit& u) const {
        const long L = (long)i * G + c; if (L >= ntot) return false;
        if (L >= nwg) { const int h = (int)L - nwg, hp = h / nN; u.pn = h - hp * nN; u.pm = nM + (hp >> 1); u.half = 1; u.rbase = u.pm * BM + (hp & 1) * HALF; return true; }
        int wgid = (int)L; { const int q = nwg / NXCD, r = nwg % NXCD, xcd = wgid % NXCD, off = wgid / NXCD; wgid = (xcd < r ? xcd * (q + 1) : r * (q + 1) + (xcd - r) * q) + off; }
        const int nig = WGM * nN, gid = wgid / nig, fm = gid * WGM, gsz = (nM - fm) < WGM ? (nM - fm) : WGM;
        u.pm = fm + ((wgid % nig) % gsz); u.pn = (wgid % nig) / gsz; u.half = 0; u.rbase = u.pm * BM; return true;
    }
    __device__ __forceinline__ void a_ready(const Unit&) const {}
    __device__ __forceinline__ void done(const Unit&) const {}
};

__host__ __device__ __forceinline__ size_t mt_off(int row, int col, int ncols) { return ((size_t)((row >> 4) * (ncols >> 5) + (col >> 5)) << 9) + (size_t)(((row & 15) << 5) + (col & 31)); }
__device__ __forceinline__ unsigned cvt_pk_bf16(float lo, float hi) { unsigned r; asm volatile("v_cvt_pk_bf16_f32 %0, %1, %2" : "=v"(r) : "v"(lo), "v"(hi)); return r; }
__device__ __forceinline__ float bf_lo(unsigned w) { return __uint_as_float(w << 16); }
__device__ __forceinline__ float bf_hi(unsigned w) { return __uint_as_float(w & 0xffff0000u); }
__device__ __forceinline__ f32x2 gelu_pk(f32x2 v) {
    const f32x2 av = __builtin_elementwise_abs(v), d = av * 0.2316418882f + 1.0f;
    f32x2 t; t.x = __builtin_amdgcn_rcpf(d.x); t.y = __builtin_amdgcn_rcpf(d.y);
    f32x2 q = t * 0.5307027145f + (-0.7265760135f); q = q * t + 0.7107068705f; q = q * t + (-0.142248368f); q = q * t + 0.127414796f; q = q * t;
    const f32x2 s = (v * v) * (-0.72134752044f);
    f32x2 e; e.x = __builtin_amdgcn_exp2f(s.x); e.y = __builtin_amdgcn_exp2f(s.y);
    const f32x2 m = v * (q * e), r = v - m;
    f32x2 o; o.x = v.x < 0.f ? m.x : r.x; o.y = v.y < 0.f ? m.y : r.y; return o;
}
__device__ __forceinline__ f32x4 gelu4(f32x4 v) { const f32x2 a = gelu_pk((f32x2){v[0], v[1]}), b = gelu_pk((f32x2){v[2], v[3]}); return (f32x4){a.x, a.y, b.x, b.y}; }
__device__ __forceinline__ float sigmoidf_(float x) { return __builtin_amdgcn_rcpf(1.0f + __builtin_amdgcn_exp2f(x * -1.44269504f)); }
__device__ __forceinline__ f32x4 sigmoid4(f32x4 v) { return (f32x4){sigmoidf_(v[0]), sigmoidf_(v[1]), sigmoidf_(v[2]), sigmoidf_(v[3])}; }
__device__ __forceinline__ u32x4 pack8(f32x4 v0, f32x4 v1) { u32x4 w; w.x = cvt_pk_bf16(v0[0], v0[1]); w.y = cvt_pk_bf16(v0[2], v0[3]); w.z = cvt_pk_bf16(v1[0], v1[1]); w.w = cvt_pk_bf16(v1[2], v1[3]); return w; }
__device__ __forceinline__ float rstd_of(const float* slots, int row) { const f32x4* s = (const f32x4*)(slots + (size_t)row * 16); const f32x4 t = (s[0] + s[1]) + (s[2] + s[3]);
    return __builtin_amdgcn_rsqf(((t[0] + t[1]) + (t[2] + t[3])) * (1.0f / 1024.0f) + EPS); }

__device__ __forceinline__ void wave_rstd(const float* slots, int rowbase, int lane, int fr, float (&rs)[2][4]) {
    float val[2];
    const f32x4* sa = (const f32x4*)(slots + (size_t)(rowbase + lane) * 16); const f32x4* sb = (const f32x4*)(slots + (size_t)(rowbase + HALF + lane) * 16);
    const f32x4 a0 = sa[0], a1 = sa[1], a2 = sa[2], a3 = sa[3], b0 = sb[0], b1 = sb[1], b2 = sb[2], b3 = sb[3];
    __builtin_amdgcn_sched_barrier(0);
    { const f32x4 t = (a0 + a1) + (a2 + a3); val[0] = __builtin_amdgcn_rsqf(((t[0] + t[1]) + (t[2] + t[3])) * (1.0f / 1024.0f) + EPS); }
    { const f32x4 t = (b0 + b1) + (b2 + b3); val[1] = __builtin_amdgcn_rsqf(((t[0] + t[1]) + (t[2] + t[3])) * (1.0f / 1024.0f) + EPS); }
#pragma unroll
    for (int ai = 0; ai < 2; ++ai)
#pragma unroll
        for (int m = 0; m < 4; ++m) rs[ai][m] = __shfl(val[ai], m * 16 + fr);
}
__device__ __forceinline__ f32x4 unpk_lo(u32x4 w) { return (f32x4){bf_lo(w[0]), bf_hi(w[0]), bf_lo(w[1]), bf_hi(w[1])}; }
__device__ __forceinline__ f32x4 unpk_hi(u32x4 w) { return (f32x4){bf_lo(w[2]), bf_hi(w[2]), bf_lo(w[3]), bf_hi(w[3])}; }

struct EpiA {
    static constexpr bool PERM = true, AFTER_DRAIN = false; static constexpr int NVM = 16;

    bf16_t* AB; bf16_t* GV; bf16_t* CH; const float* ssq; float* lns;
    __device__ __forceinline__ void operator()(const f32x4 (&acc)[2][2][4][2], const Unit& u, int wr, int wc, int fr, int fq) const {
        const int row0 = u.rbase + wr * 64 + fr, cw = wc * 32 + 8 * fq, pn = u.pn;
        float rsv[2][4]; wave_rstd(ssq, u.rbase + wr * 64, fr + 16 * fq, fr, rsv);
        if (pn < 4) {
#pragma unroll
            for (int ai = 0; ai < 2; ++ai)
#pragma unroll
                for (int m = 0; m < 4; ++m) { if (ai == 1 && u.half) continue; const int row = row0 + ai * HALF + m * 16; const float rs = rsv[ai][m]; bf16_t* rowp = AB + mt_off(row, pn * 256 + cw, 2048);
#pragma unroll
                    for (int bj = 0; bj < 2; ++bj) *(u32x4*)(rowp + bj * 4 * 512) = pack8(gelu4(acc[ai][bj][m][0] * rs), gelu4(acc[ai][bj][m][1] * rs)); }
        } else if (pn < 8) {
#pragma unroll
            for (int ai = 0; ai < 2; ++ai)
#pragma unroll
                for (int m = 0; m < 4; ++m) { if (ai == 1 && u.half) continue; const int row = row0 + ai * HALF + m * 16; const float rs = rsv[ai][m]; bf16_t* rowp = GV + (size_t)row * 1024 + (pn - 4) * 256 + cw;
                    float s = 0.f, q = 0.f;
#pragma unroll
                    for (int bj = 0; bj < 2; ++bj) { const u32x4 w = pack8(gelu4(acc[ai][bj][m][0] * rs), gelu4(acc[ai][bj][m][1] * rs)); *(u32x4*)(rowp + bj * HALF) = w;
#pragma unroll
                        for (int e = 0; e < 4; ++e) { const float a = bf_lo(w[e]), b = bf_hi(w[e]); s += a + b; q += a * a + b * b; } }
                    s += __shfl_xor(s, 16); s += __shfl_xor(s, 32); q += __shfl_xor(q, 16); q += __shfl_xor(q, 32);
                    if (fq == 0) *(f32x2*)(lns + ((size_t)row * 16 + (pn - 4) * 4 + wc) * 2) = (f32x2){s, q}; }
        } else if (pn < 12) {
#pragma unroll
            for (int ai = 0; ai < 2; ++ai)
#pragma unroll
                for (int m = 0; m < 4; ++m) { if (ai == 1 && u.half) continue; const int row = row0 + ai * HALF + m * 16; const float rs = rsv[ai][m]; bf16_t* rowp = AB + mt_off(row, 1024 + (pn - 8) * 256 + cw, 2048);
#pragma unroll
                    for (int bj = 0; bj < 2; ++bj) *(u32x4*)(rowp + bj * 4 * 512) = pack8(acc[ai][bj][m][0] * rs, acc[ai][bj][m][1] * rs); }
        } else {
#pragma unroll
            for (int ai = 0; ai < 2; ++ai)
#pragma unroll
                for (int m = 0; m < 4; ++m) { if (ai == 1 && u.half) continue; const int row = row0 + ai * HALF + m * 16; const float rs = rsv[ai][m]; const float rs2 = rs * rs;
                    *(u32x4*)(CH + (size_t)row * 1024 + (pn - 12) * 128 + cw) = pack8(acc[ai][0][m][0] * acc[ai][1][m][0] * rs2, acc[ai][0][m][1] * acc[ai][1][m][1] * rs2); }
        }
    }
};
struct EpiC {
    static constexpr bool PERM = true, AFTER_DRAIN = false; static constexpr int NVM = 16;

    bf16_t* T;
    __device__ __forceinline__ void operator()(const f32x4 (&acc)[2][2][4][2], const Unit& u, int wr, int wc, int fr, int fq) const {
        const int row0 = u.rbase + wr * 64 + fr, cw = u.pn * 256 + wc * 32 + 8 * fq;
#pragma unroll
        for (int ai = 0; ai < 2; ++ai)
#pragma unroll
            for (int m = 0; m < 4; ++m) { if (ai == 1 && u.half) continue; bf16_t* rowp = T + (size_t)(row0 + ai * HALF + m * 16) * 2048 + cw;
#pragma unroll
                for (int bj = 0; bj < 2; ++bj) *(u32x4*)(rowp + bj * HALF) = pack8(acc[ai][bj][m][0], acc[ai][bj][m][1]); }
    }
};
struct EpiD {
    static constexpr bool PERM = true, AFTER_DRAIN = false; static constexpr int NVM = 24;

    const bf16_t* T; bf16_t* MM; const float* ssq;
    __device__ __forceinline__ void operator()(const f32x4 (&acc)[2][2][4][2], const Unit& u, int wr, int wc, int fr, int fq) const {
        const int row0 = u.rbase + wr * 64 + fr, cw = u.pn * 128 + wc * 32 + 8 * fq;
        u32x4 tt[4][2];
#pragma unroll
        for (int m = 0; m < 4; ++m) { const bf16_t* tp = T + (size_t)(row0 + m * 16) * 2048 + cw; tt[m][0] = *(const u32x4*)tp; tt[m][1] = *(const u32x4*)(tp + 1024); }
        float rsv[2][4]; wave_rstd(ssq, u.rbase + wr * 64, fr + 16 * fq, fr, rsv);
#pragma unroll
        for (int ai = 0; ai < 2; ++ai) {
            if (ai == 1 && u.half) break;
            if (ai == 1) {
#pragma unroll
                for (int m = 0; m < 4; ++m) { const bf16_t* tp = T + (size_t)(row0 + HALF + m * 16) * 2048 + cw; tt[m][0] = *(const u32x4*)tp; tt[m][1] = *(const u32x4*)(tp + 1024); } }
#pragma unroll
            for (int m = 0; m < 4; ++m) { const int row = row0 + ai * HALF + m * 16; const float rs = rsv[ai][m];
                const u32x4 t1 = tt[m][0], t2 = tt[m][1];
                const f32x4 a0 = sigmoid4(acc[ai][0][m][0] * rs), a1 = sigmoid4(acc[ai][0][m][1] * rs), b0 = sigmoid4(acc[ai][1][m][0] * rs), b1 = sigmoid4(acc[ai][1][m][1] * rs);
                const f32x4 p0 = {bf_lo(t1[0]), bf_hi(t1[0]), bf_lo(t1[1]), bf_hi(t1[1])}, p1 = {bf_lo(t1[2]), bf_hi(t1[2]), bf_lo(t1[3]), bf_hi(t1[3])};
                const f32x4 q0 = {bf_lo(t2[0]), bf_hi(t2[0]), bf_lo(t2[1]), bf_hi(t2[1])}, q1 = {bf_lo(t2[2]), bf_hi(t2[2]), bf_lo(t2[3]), bf_hi(t2[3])};
                *(u32x4*)(MM + mt_off(row, cw, 1024)) = pack8(a0 * p0 + b0 * q0, a1 * p1 + b1 * q1); }
            asm volatile("" ::: "memory");
        }
    }
};
struct EpiRes {
    static constexpr bool PERM = true, AFTER_DRAIN = false; static constexpr int NVM = 24;

    bf16_t* xb; float* ssq;
    __device__ __forceinline__ void operator()(const f32x4 (&acc)[2][2][4][2], const Unit& u, int wr, int wc, int fr, int fq) const {
        const int row0 = u.rbase + wr * 64 + fr, cw = u.pn * BM + wc * 32 + 8 * fq;
#pragma unroll
        for (int ai = 0; ai < 2; ++ai) {
            if (ai == 1 && u.half) break;
            u32x4 xo[4][2];
#pragma unroll
            for (int m = 0; m < 4; ++m)
#pragma unroll
                for (int bj = 0; bj < 2; ++bj) xo[m][bj] = *(const u32x4*)(xb + mt_off(row0 + ai * HALF + m * 16, cw + bj * HALF, DM));
#pragma unroll
            for (int m = 0; m < 4; ++m) { const int row = row0 + ai * HALF + m * 16; float q = 0.f;
#pragma unroll
                for (int bj = 0; bj < 2; ++bj) { const u32x4 w = pack8(acc[ai][bj][m][0] + unpk_lo(xo[m][bj]), acc[ai][bj][m][1] + unpk_hi(xo[m][bj]));
                    *(u32x4*)(xb + mt_off(row, cw + bj * HALF, DM)) = w;
#pragma unroll
                    for (int e = 0; e < 4; ++e) { const float a = bf_lo(w[e]), b = bf_hi(w[e]); q += a * a + b * b; } }
                q += __shfl_xor(q, 16); q += __shfl_xor(q, 32);
                if (fq == 0) ssq[(size_t)row * 16 + u.pn * 4 + wc] = q; }
            asm volatile("" ::: "memory");
        }
    }
};
struct EpiF {
    static constexpr bool PERM = true, AFTER_DRAIN = false; static constexpr int NVM = 16;

    bf16_t* H; const float* ssq;
    __device__ __forceinline__ void operator()(const f32x4 (&acc)[2][2][4][2], const Unit& u, int wr, int wc, int fr, int fq) const {
        const int row0 = u.rbase + wr * 64 + fr, cw = u.pn * 128 + wc * 32 + 8 * fq;
        float rsv[2][4]; wave_rstd(ssq, u.rbase + wr * 64, fr + 16 * fq, fr, rsv);
#pragma unroll
        for (int ai = 0; ai < 2; ++ai)
#pragma unroll
            for (int m = 0; m < 4; ++m) { if (ai == 1 && u.half) continue; const int row = row0 + ai * HALF + m * 16; const float rs = rsv[ai][m];
                const f32x4 g0 = acc[ai][0][m][0] * rs, g1 = acc[ai][0][m][1] * rs, u0 = acc[ai][1][m][0] * rs, u1 = acc[ai][1][m][1] * rs;
                *(u32x4*)(H + mt_off(row, cw, DFF)) = pack8(g0 * sigmoid4(g0) * u0, g1 * sigmoid4(g1) * u1); }
    }
};

#ifndef PG8_SP2
#define PG8_SP2 true
#endif
#ifndef PG8_ALIGN
#define PG8_ALIGN true
#endif
template <class Epi, class Sched, bool SP2 = PG8_SP2, bool ALIGN_EPI = PG8_ALIGN>
__device__ __forceinline__ void gemm_phase(PG8_LAS unsigned char* lds, const Gemm g, const Sched& S, const Epi& E) {
    int tid = threadIdx.x; asm volatile("" : "+v"(tid));
    const int wid = __builtin_amdgcn_readfirstlane(tid >> 6), lane = tid & 63, wr = wid >> 2, wc = wid & 3, fr = lane & 15, fq = lane >> 4;
    const int K = g.K, nt = K / BK, lda = g.lda;
    unsigned voffA[2], voffB[2];
#pragma unroll
    for (int i = 0; i < 2; ++i) { int R, C; stage_rc(tid * 16 + i * 8192, R, C); const int Rb = Epi::PERM ? ((R & ~31) + perm32(R & 31)) : R;
        (void)Rb; static_assert(Epi::PERM, "the weight copies are stored with the 32-row permutation baked in");
        voffA[i] = (unsigned)mt_off(R, C, lda) * 2u; voffB[i] = (unsigned)mt_off(R, C, K) * 2u; }
    const size_t kstep = (size_t)2048;
    const size_t hstepA = (size_t)HALF * lda * 2, hstepB = (size_t)HALF * K * 2;
    const size_t tstepA = 2 * hstepA, tstepB = 2 * hstepB;
    const unsigned ldsw = (unsigned)wid * 1024u;
    const int aoff = lds_byte(wr * 64 + fr, fq * 8), boff = lds_byte(wc * 32 + fr, fq * 8);
#define PG8_SA(b, h) (((b) * 2 + (h)) * HTB)
#define PG8_SB(b, h) ((4 + (b) * 2 + (h)) * HTB)
#define PG8_STAGE(bufoff, gbase, voff) do { _Pragma("unroll") for (int _i = 0; _i < 2; ++_i) \
        __builtin_amdgcn_global_load_lds((const unsigned*)((const char*)(gbase) + (voff)[_i]), (PG8_LAS unsigned*)(lds + (bufoff) + ldsw + _i * 8192), 16, 0, 0); } while (0)
#define PG8_LDA(dst, b, h) do { _Pragma("unroll") for (int m = 0; m < 4; ++m) _Pragma("unroll") for (int k = 0; k < 2; ++k) dst[m][k] = *(const PG8_LAS bf16x8*)(lds + PG8_SA(b, h) + aoff + m * 2048 + k * 1024); } while (0)
#define PG8_LDB(dst, b, h) do { _Pragma("unroll") for (int n = 0; n < 2; ++n) _Pragma("unroll") for (int k = 0; k < 2; ++k) dst[n][k] = *(const PG8_LAS bf16x8*)(lds + PG8_SB(b, h) + boff + n * 2048 + k * 1024); } while (0)
#define PG8_MMA(ai, bj, At, Bt) do { __builtin_amdgcn_s_setprio(1); _Pragma("unroll") for (int m = 0; m < 4; ++m) _Pragma("unroll") for (int n = 0; n < 2; ++n) _Pragma("unroll") for (int k = 0; k < 2; ++k) \
        acc[ai][bj][m][n] = __builtin_amdgcn_mfma_f32_16x16x32_bf16(Bt[n][k], At[m][k], acc[ai][bj][m][n], 0, 0, 0); __builtin_amdgcn_s_setprio(0); } while (0)
#define PG8_WAIT_V(n) asm volatile("s_waitcnt vmcnt(" #n ")" ::: "memory")
#define PG8_WAIT_L(n) asm volatile("s_waitcnt lgkmcnt(" #n ")" ::: "memory")
#define PG8_WAIT_V8X do { if constexpr (Epi::NVM >= 24) asm volatile("s_cmp_eq_u32 %0, 0\n\ts_cbranch_scc1 1f\n\ts_waitcnt vmcnt(8)\n1:\n\ts_waitcnt vmcnt(32)" :: "s"(t) : "scc", "memory"); \
        else asm volatile("s_cmp_eq_u32 %0, 0\n\ts_cbranch_scc1 1f\n\ts_waitcnt vmcnt(8)\n1:\n\ts_waitcnt vmcnt(24)" :: "s"(t) : "scc", "memory"); } while (0)
#define PG8_BAR __builtin_amdgcn_s_barrier()
#define PG8_SCHED __builtin_amdgcn_sched_barrier(0)
#define PG8_APTR(u) ((const char*)g.A + (size_t)((u).rbase) * lda * 2 + (((u).pn >= g.asplit_pn) ? (size_t)g.asplit_off * 32 : (size_t)0))
    Unit cur, nxt; int ui = 0;
    if (!S.next(0, cur)) return;
    f32x4 acc[2][2][4][2];
#pragma unroll
    for (int a = 0; a < 2; ++a)
#pragma unroll
        for (int b = 0; b < 2; ++b)
#pragma unroll
            for (int m = 0; m < 4; ++m)
#pragma unroll
                for (int n = 0; n < 2; ++n) acc[a][b][m][n] = (f32x4){0.f, 0.f, 0.f, 0.f};
    bf16x8 At[4][2], B0[2][2], B1[2][2];
    const char* cA = PG8_APTR(cur); const char* cB = (const char*)g.Bt + (size_t)cur.pn * tstepB;
    S.a_ready(cur);
    if constexpr (SP2) {
        PG8_STAGE(PG8_SB(0, 0), cB, voffB); PG8_STAGE(PG8_SB(0, 1), cB + hstepB, voffB); PG8_STAGE(PG8_SA(0, 0), cA, voffA); PG8_STAGE(PG8_SA(0, 1), cA + hstepA, voffA);
        if (wr == 1) PG8_BAR;
        PG8_WAIT_V(2); PG8_BAR;
        PG8_STAGE(PG8_SB(1, 0), cB + kstep, voffB); PG8_STAGE(PG8_SA(1, 0), cA + kstep, voffA); PG8_STAGE(PG8_SB(1, 1), cB + hstepB + kstep, voffB);
        PG8_WAIT_V(0); PG8_BAR;
    } else {
    PG8_STAGE(PG8_SB(0, 0), cB, voffB); PG8_STAGE(PG8_SA(0, 0), cA, voffA); PG8_STAGE(PG8_SB(0, 1), cB + hstepB, voffB); PG8_STAGE(PG8_SA(0, 1), cA + hstepA, voffA);
    if (wr == 1) PG8_BAR;
    PG8_WAIT_V(4); PG8_BAR;
    PG8_STAGE(PG8_SB(1, 0), cB + kstep, voffB); PG8_STAGE(PG8_SA(1, 0), cA + kstep, voffA); PG8_STAGE(PG8_SB(1, 1), cB + hstepB + kstep, voffB);
    PG8_WAIT_V(6); PG8_BAR;
    }
    for (;;) {
        const bool has_next = S.next(ui + 1, nxt);
        const char* nA = has_next ? PG8_APTR(nxt) : cA; const char* nB = has_next ? (const char*)g.Bt + (size_t)nxt.pn * tstepB : cB;
        const bool hlf = cur.half != 0;
        for (int t = 0; t < nt; t += 2) {
            const bool last = (t == nt - 2);
            const char* a1 = cA + (size_t)(t + 1) * kstep;
            const char* a2 = last ? nA : cA + (size_t)(t + 2) * kstep; const char* b2 = last ? nB : cB + (size_t)(t + 2) * kstep;
            const char* a3 = a2 + kstep; const char* b3 = b2 + kstep;
            if (last && has_next) S.a_ready(nxt);
            if constexpr (SP2) {
            PG8_LDB(B0, 0, 0); PG8_LDB(B1, 0, 1); PG8_SCHED; PG8_LDA(At, 0, 0); PG8_STAGE(PG8_SA(1, 1), a1 + hstepA, voffA);
            PG8_WAIT_V8X; PG8_WAIT_L(0); PG8_BAR; PG8_MMA(0, 0, At, B0); PG8_MMA(0, 1, At, B1); PG8_BAR; PG8_SCHED;
            if (!hlf) { PG8_LDA(At, 0, 1); } PG8_STAGE(PG8_SB(0, 0), b2, voffB); PG8_STAGE(PG8_SB(0, 1), b2 + hstepB, voffB); PG8_STAGE(PG8_SA(0, 0), a2, voffA);
            PG8_WAIT_V8X; PG8_WAIT_L(0); PG8_BAR; if (!hlf) { PG8_MMA(1, 0, At, B0); PG8_MMA(1, 1, At, B1); } PG8_BAR; PG8_SCHED;
            PG8_LDB(B0, 1, 0); PG8_LDB(B1, 1, 1); PG8_SCHED; PG8_LDA(At, 1, 0); PG8_STAGE(PG8_SA(0, 1), a2 + hstepA, voffA);
            PG8_WAIT_V(8); PG8_WAIT_L(0); PG8_BAR; PG8_MMA(0, 0, At, B0); PG8_MMA(0, 1, At, B1); PG8_BAR; PG8_SCHED;
            if (!hlf) { PG8_LDA(At, 1, 1); } PG8_STAGE(PG8_SB(1, 0), b3, voffB); PG8_STAGE(PG8_SB(1, 1), b3 + hstepB, voffB); PG8_STAGE(PG8_SA(1, 0), a3, voffA);
            PG8_WAIT_V(8); PG8_WAIT_L(0); PG8_BAR; if (!hlf) { PG8_MMA(1, 0, At, B0); PG8_MMA(1, 1, At, B1); } PG8_BAR; PG8_SCHED;
            } else {
            PG8_LDB(B0, 0, 0); PG8_SCHED; PG8_LDA(At, 0, 0); PG8_STAGE(PG8_SA(1, 1), a1 + hstepA, voffA);
            PG8_WAIT_L(8); PG8_BAR; PG8_WAIT_L(0); PG8_MMA(0, 0, At, B0); PG8_BAR; PG8_SCHED;
            PG8_LDB(B1, 0, 1); PG8_STAGE(PG8_SB(0, 0), b2, voffB);
            PG8_BAR; PG8_WAIT_L(0); PG8_MMA(0, 1, At, B1); PG8_BAR;
            PG8_LDA(At, 0, 1); PG8_STAGE(PG8_SA(0, 0), a2, voffA);
            PG8_BAR; PG8_WAIT_L(0); PG8_MMA(1, 0, At, B0); PG8_BAR; PG8_SCHED;
            PG8_STAGE(PG8_SB(0, 1), b2 + hstepB, voffB);
            PG8_WAIT_V(6); PG8_BAR; PG8_MMA(1, 1, At, B1); PG8_BAR;
            PG8_LDB(B0, 1, 0); PG8_SCHED; PG8_LDA(At, 1, 0); PG8_STAGE(PG8_SA(0, 1), a2 + hstepA, voffA);
            PG8_WAIT_L(8); PG8_BAR; PG8_WAIT_L(0); PG8_MMA(0, 0, At, B0); PG8_BAR; PG8_SCHED;
            PG8_LDB(B1, 1, 1); PG8_STAGE(PG8_SB(1, 0), b3, voffB);
            PG8_BAR; PG8_WAIT_L(0); PG8_MMA(0, 1, At, B1); PG8_BAR;
            PG8_LDA(At, 1, 1); PG8_STAGE(PG8_SA(1, 0), a3, voffA);
            PG8_BAR; PG8_WAIT_L(0); PG8_MMA(1, 0, At, B0); PG8_BAR; PG8_SCHED;
            PG8_STAGE(PG8_SB(1, 1), b3 + hstepB, voffB);
            PG8_WAIT_V(6); PG8_BAR; PG8_MMA(1, 1, At, B1); PG8_BAR;
            }
        }
        if constexpr (ALIGN_EPI) { if (wr == 0) PG8_BAR; }
        E(acc, cur, wr, wc, fr, fq); S.done(cur);
        if (!has_next) break;
#pragma unroll
        for (int a = 0; a < 2; ++a)
#pragma unroll
            for (int b = 0; b < 2; ++b)
#pragma unroll
                for (int m = 0; m < 4; ++m)
#pragma unroll
                    for (int n = 0; n < 2; ++n) acc[a][b][m][n] = (f32x4){0.f, 0.f, 0.f, 0.f};
        cur = nxt; cA = nA; cB = nB; ++ui;
        if constexpr (ALIGN_EPI) { if (wr == 1) PG8_BAR; }
    }
    PG8_WAIT_V(0);
    if constexpr (!ALIGN_EPI) { if (wr == 0) PG8_BAR; }
    PG8_BAR;
#undef PG8_APTR
#undef PG8_SA
#undef PG8_SB
#undef PG8_STAGE
#undef PG8_LDA
#undef PG8_LDB
#undef PG8_MMA
#undef PG8_WAIT_V
#undef PG8_WAIT_L
#undef PG8_WAIT_V8X
#undef PG8_BAR
#undef PG8_SCHED
}
}

using pg8::bf16_t; using pg8::f32x4; using pg8::u32x4; using pg8::u32x2; using pg8::bf16x8;
using pg8::cvt_pk_bf16; using pg8::bf_lo; using pg8::bf_hi;

struct Params {
    const float* x_prompt; const float* x_sample; const float* state_conv; const float* norm_mix; const float* w_in; const float* ln_g; const float* ln_b;
    const float* w_s; const float* b_s; const float* conv_w; const float* w_pa; const float* w_pb; const float* w_o; const float* norm_ffn;
    const float* w_gate; const float* w_up; const float* w_down; const float* norm_final;
    float* out; unsigned char* ws; int ph_lo, ph_hi;
};
constexpr int LDS_BYTES = pg8::STAGE_BYTES + 256;
constexpr int NPHASE = 2 + 7 * NL;

__device__ __forceinline__ void transpose_tile(const float* __restrict__ src, int ld, int k0, int col0, const float* __restrict__ scale, bf16_t* __restrict__ dstbase, int n0, int K, float* t, int tid) {
    const int r = tid >> 4, c4 = tid & 15;
#pragma unroll
    for (int pass = 0; pass < 2; ++pass) { const int k = r + 32 * pass; const f32x4 v = *(const f32x4*)(src + (size_t)(k0 + k) * ld + col0 + 4 * c4); const float s = scale ? scale[k0 + k] : 1.0f;
        t[k * 65 + 4 * c4 + 0] = v[0] * s; t[k * 65 + 4 * c4 + 1] = v[1] * s; t[k * 65 + 4 * c4 + 2] = v[2] * s; t[k * 65 + 4 * c4 + 3] = v[3] * s; }
    __syncthreads();
    const int n = tid >> 3, kc = tid & 7; u32x4 w;
    w.x = cvt_pk_bf16(t[(8 * kc + 0) * 65 + n], t[(8 * kc + 1) * 65 + n]); w.y = cvt_pk_bf16(t[(8 * kc + 2) * 65 + n], t[(8 * kc + 3) * 65 + n]);
    w.z = cvt_pk_bf16(t[(8 * kc + 4) * 65 + n], t[(8 * kc + 5) * 65 + n]); w.w = cvt_pk_bf16(t[(8 * kc + 6) * 65 + n], t[(8 * kc + 7) * 65 + n]);
    const int nl = n0 + n, c5 = nl & 31, rho = 16 * ((c5 >> 2) & 1) + (((c5 >> 3) << 2) | (c5 & 3)), P = (nl & ~31) + rho;
    *(u32x4*)(dstbase + pg8::mt_off(P, k0 + 8 * kc, K)) = w;
    __syncthreads();
}
constexpr int IT_WIN = (NIN / 64) * 16, IT_WPAB = 32 * 16, IT_WO = 16 * 16, IT_WGU = (2 * DFF / 64) * 16, IT_WD = 16 * (DFF / 64), IT_LAYER = IT_WIN + IT_WPAB + IT_WO + IT_WGU + IT_WD;

__device__ __forceinline__ void p0_prologue(const Params& p, float* ldsf, int layer, int first, bool misc) {
    unsigned char* ws = p.ws;
    float* ssqm = (float*)(ws + WS_SSQM);
    int tid = threadIdx.x; asm volatile("" : "+v"(tid));
    const int G = gridDim.x, b = blockIdx.x;
    for (int it = b - first; it >= 0 && it < IT_LAYER; it += G - first) {
        const int l = layer; int r = it; unsigned char* lw = ws + WS_W + (size_t)l * LW_BYTES;
        if (r < IT_WIN) { const int ntile = r >> 4, kt = r & 15, n0 = ntile * 64; int col;
            if (n0 < 3072) col = n0; else if (n0 < 5120) { const int t = n0 - 3072; col = ((t & 128) ? 4096 : 3072) + (t >> 8) * 128 + (t & 127); } else { const int t = n0 - 5120; col = ((t & 128) ? 6144 : 5120) + (t >> 8) * 128 + (t & 127); }
            transpose_tile(p.w_in + (size_t)l * DM * NIN, NIN, kt * 64, col, p.norm_mix + l * DM, (bf16_t*)(lw + LW_WIN), n0, DM, ldsf, tid); continue; }
        r -= IT_WIN;
        if (r < IT_WPAB) { const int ntile = r >> 4, kt = r & 15, n0 = ntile * 64;
            const float* src = (n0 < 1024) ? p.w_pa + (size_t)l * DM * DM : p.w_pb + (size_t)l * DM * DM;
            transpose_tile(src, DM, kt * 64, n0 & 1023, nullptr, (bf16_t*)(lw + LW_WPAB), n0, DM, ldsf, tid); continue; }
        r -= IT_WPAB;
        if (r < IT_WO) { const int ntile = r >> 4, kt = r & 15, n0 = ntile * 64;
            transpose_tile(p.w_o + (size_t)l * DM * DM, DM, kt * 64, n0, nullptr, (bf16_t*)(lw + LW_WO), n0, DM, ldsf, tid); continue; }
        r -= IT_WO;
        if (r < IT_WGU) { const int ntile = r >> 4, kt = r & 15, n0 = ntile * 64;
            const float* src = ((n0 & 128) ? p.w_up : p.w_gate) + (size_t)l * DM * DFF; const int col = (n0 >> 8) * 128 + (n0 & 127);
            transpose_tile(src, DFF, kt * 64, col, p.norm_ffn + l * DM, (bf16_t*)(lw + LW_WGU), n0, DM, ldsf, tid); continue; }
        r -= IT_WGU;
        { const int ntile = r / (DFF / 64), kt = r % (DFF / 64), n0 = ntile * 64;
            transpose_tile(p.w_down + (size_t)l * DFF * DM, DM, kt * 64, n0, nullptr, (bf16_t*)(lw + LW_WD), n0, DFF, ldsf, tid); }
    }
    if (!misc) return;
    for (int i = b * 512 + tid; i < NL * 8 * 128 * 128; i += G * 512) {
        const int l = i >> 17, rem = i & 131071, ii = (rem >> 7) & 127, jj = rem & 127;
        const float* wsrc = p.w_s + (size_t)(i - rem);
        const int grp = rem >> 14;
        unsigned char* lw = ws + WS_W + (size_t)l * LW_BYTES;
        const float vp = (jj <= ii) ? p.w_s[i] : 0.f;
        const float vs = ((ii >> 5) == (jj >> 5) && (jj & 31) <= (ii & 31)) ? wsrc[grp * 16384 + (ii & 31) * 128 + (jj & 31)] : 0.f;
        ((bf16_t*)(lw + LW_WSP))[rem] = (bf16_t)(cvt_pk_bf16(vp, 0.f) & 0xffffu);
        ((bf16_t*)(lw + LW_WSS))[rem] = (bf16_t)(cvt_pk_bf16(vs, 0.f) & 0xffffu);
    }
    { const int wave = tid >> 6, lane = tid & 63; bf16_t* xb = (bf16_t*)(ws + WS_XB);
      for (int row = b * 8 + wave; row < MT; row += 2 * G * 8) {
          const int row2 = row + G * 8; const bool has2 = row2 < MT;
          const float* xr = (row < MP) ? p.x_prompt + (size_t)row * DM : p.x_sample + (size_t)(row - MP) * DM;
          const float* xr2 = has2 ? ((row2 < MP) ? p.x_prompt + (size_t)row2 * DM : p.x_sample + (size_t)(row2 - MP) * DM) : xr;
          f32x4 v[4], v2[4];
#pragma unroll
          for (int j = 0; j < 4; ++j) { v[j] = *(const f32x4*)(xr + 4 * (lane + 64 * j)); v2[j] = *(const f32x4*)(xr2 + 4 * (lane + 64 * j)); }
          float q = 0.f, q2 = 0.f;
#pragma unroll
          for (int j = 0; j < 4; ++j) { q += (v[j][0] * v[j][0] + v[j][1] * v[j][1]) + (v[j][2] * v[j][2] + v[j][3] * v[j][3]); q2 += (v2[j][0] * v2[j][0] + v2[j][1] * v2[j][1]) + (v2[j][2] * v2[j][2] + v2[j][3] * v2[j][3]);
              u32x2 w; w.x = cvt_pk_bf16(v[j][0], v[j][1]); w.y = cvt_pk_bf16(v[j][2], v[j][3]); *(u32x2*)(xb + pg8::mt_off(row, 4 * (lane + 64 * j), DM)) = w;
              if (has2) { u32x2 w2; w2.x = cvt_pk_bf16(v2[j][0], v2[j][1]); w2.y = cvt_pk_bf16(v2[j][2], v2[j][3]); *(u32x2*)(xb + pg8::mt_off(row2, 4 * (lane + 64 * j), DM)) = w2; } }
#pragma unroll
          for (int o = 32; o >= 1; o >>= 1) { q += __shfl_xor(q, o); q2 += __shfl_xor(q2, o); }
          if (lane < 4) { ((f32x4*)(ssqm + (size_t)row * 16))[lane] = (f32x4){lane == 0 ? q : 0.f, 0.f, 0.f, 0.f};
              if (has2) ((f32x4*)(ssqm + (size_t)row2 * 16))[lane] = (f32x4){lane == 0 ? q2 : 0.f, 0.f, 0.f, 0.f}; }
      } }
}

constexpr int VT_PITCH = 136;
__device__ __forceinline__ void gate_conv_phase(const Params& p, int l, unsigned char* lds) {
    unsigned char* ws = p.ws;
    const float* lns = (const float*)(ws + WS_LNS);
    bf16_t* AB = (bf16_t*)(ws + WS_AB); const bf16_t* GV = (const bf16_t*)(ws + WS_GV); const bf16_t* CH = (const bf16_t*)(ws + WS_CH);
    const unsigned char* lw = ws + WS_W + (size_t)l * LW_BYTES;
    bf16_t* vT = (bf16_t*)lds;
    float* mr = (float*)(lds + 128 * VT_PITCH * 2);
    int tid = threadIdx.x; asm volatile("" : "+v"(tid));
    const int lane = tid & 63, w = tid >> 6, fr = lane & 15, fq = lane >> 4;
    const int jg = tid >> 5, cq = tid & 31;
    const int ci = tid & 15;
    const int nks = (w >> 1) + 1;
    const int total = (MT / 128) * 8;
    int item = blockIdx.x; if (item >= total) return;
    const int g = item & 7, c0 = g * 128, irow = 16 * w + fr;
    const bf16_t* WsP = (const bf16_t*)(lw + LW_WSP) + g * 16384 + irow * 128 + 8 * fq;
    bf16x8 wf[4];
#pragma unroll
    for (int ks = 0; ks < 4; ++ks) wf[ks] = *(const bf16x8*)(WsP + 32 * ks);
    float bs = p.b_s[(l * 8 + g) * 128 + irow];
    const float* cwp = p.conv_w + (size_t)l * 3 * DM + c0 + 8 * ci;
    bool was_smp = false;
    f32x4 sl0, sl1; u32x2 gv[8]; u32x4 uu[4];
#define GC_LOAD(it) do { const int r0_ = ((it) >> 3) * 128; \
        const f32x4* sl_ = (const f32x4*)(lns + (size_t)(r0_ + (tid >> 2)) * 32 + (tid & 3) * 8); sl0 = sl_[0]; sl1 = sl_[1]; \
        _Pragma("unroll") for (int jj = 0; jj < 8; ++jj) gv[jj] = *(const u32x2*)(GV + (size_t)(r0_ + 8 * jg + jj) * DM + c0 + 4 * cq); } while (0)
#define GC_LOADU(it) do { const int r0_ = ((it) >> 3) * 128; \
        _Pragma("unroll") for (int pp = 0; pp < 4; ++pp) uu[pp] = *(const u32x4*)(AB + pg8::mt_off(r0_ + irow, c0 + 8 * fq, 2048) + 512 * pp); } while (0)
    GC_LOAD(item); GC_LOADU(item);
    for (;;) {
        const int ct = item >> 3, row0 = ct * 128; const bool smp = ct >= MP / 128;
        if (smp && !was_smp) {
            const bf16_t* WsS = (const bf16_t*)(lw + LW_WSS) + g * 16384 + irow * 128 + 8 * fq;
#pragma unroll
            for (int ks = 0; ks < 4; ++ks) wf[ks] = *(const bf16x8*)(WsS + 32 * ks);
            bs = p.b_s[(l * 8 + g) * 128 + (irow & 31)]; was_smp = true; }
        bf16_t* rowp = AB + pg8::mt_off(row0 + irow, c0 + 8 * fq, 2048);
        const f32x4 lg = *(const f32x4*)(p.ln_g + l * DM + c0 + 4 * cq), lb = *(const f32x4*)(p.ln_b + l * DM + c0 + 4 * cq);
        { float sm = (sl0[0] + sl0[2]) + (sl1[0] + sl1[2]), sq = (sl0[1] + sl0[3]) + (sl1[1] + sl1[3]);
          sm += __shfl_xor(sm, 1); sq += __shfl_xor(sq, 1); sm += __shfl_xor(sm, 2); sq += __shfl_xor(sq, 2);
          if ((tid & 3) == 0) { const float mean = sm * (1.0f / 1024.0f), var = sq * (1.0f / 1024.0f) - mean * mean; mr[2 * (tid >> 2)] = mean; mr[2 * (tid >> 2) + 1] = __builtin_amdgcn_rsqf(fmaxf(var, 0.f) + EPS); } }
        __syncthreads();
        { float v[8][4];
#pragma unroll
          for (int jj = 0; jj < 8; ++jj) { const float mean = mr[2 * (8 * jg + jj)], rstd = mr[2 * (8 * jg + jj) + 1];
              v[jj][0] = (bf_lo(gv[jj].x) - mean) * rstd * lg[0] + lb[0]; v[jj][1] = (bf_hi(gv[jj].x) - mean) * rstd * lg[1] + lb[1];
              v[jj][2] = (bf_lo(gv[jj].y) - mean) * rstd * lg[2] + lb[2]; v[jj][3] = (bf_hi(gv[jj].y) - mean) * rstd * lg[3] + lb[3];
              if (smp) *(f32x4*)(p.out + OUT_V + ((size_t)l * MS + (row0 + 8 * jg + jj - MP)) * DM + c0 + 4 * cq) = (f32x4){v[jj][0], v[jj][1], v[jj][2], v[jj][3]}; }
#pragma unroll
          for (int e = 0; e < 4; ++e) { u32x4 wv; wv.x = cvt_pk_bf16(v[0][e], v[1][e]); wv.y = cvt_pk_bf16(v[2][e], v[3][e]); wv.z = cvt_pk_bf16(v[4][e], v[5][e]); wv.w = cvt_pk_bf16(v[6][e], v[7][e]);
              *(u32x4*)(vT + (4 * cq + e) * VT_PITCH + 8 * jg) = wv; } }
        u32x4 ch0[4], ch1[4], ch2[4], bg[4];
#pragma unroll
        for (int vv = 0; vv < 4; ++vv) { const int i = (tid >> 4) + 32 * vv, row = row0 + i, c = c0 + 8 * ci; const int pos = smp ? ((row - MP) & 31) : (row & 2047);
            const u32x4 z4 = {0u, 0u, 0u, 0u};
            ch0[vv] = *(const u32x4*)(CH + (size_t)row * DM + c);
            ch1[vv] = (pos >= 1) ? *(const u32x4*)(CH + (size_t)(row - 1) * DM + c) : z4;
            ch2[vv] = (pos >= 2) ? *(const u32x4*)(CH + (size_t)(row - 2) * DM + c) : z4;
            bg[vv] = *(const u32x4*)(AB + pg8::mt_off(row, 1024 + c, 2048)); }
        const int nitem = item + (int)gridDim.x; const bool has_next = nitem < total;
        if (has_next) GC_LOAD(nitem);
        __syncthreads();
        { f32x4 acc[8];
#pragma unroll
          for (int dt = 0; dt < 8; ++dt) acc[dt] = (f32x4){0.f, 0.f, 0.f, 0.f};
#pragma unroll
          for (int ks = 0; ks < 4; ++ks) if (ks < nks) {
#pragma unroll
              for (int dt = 0; dt < 8; ++dt) { const int d = 32 * (dt >> 1) + 8 * (fr >> 2) + 4 * (dt & 1) + (fr & 3);
                  const bf16x8 vf = *(const bf16x8*)(vT + d * VT_PITCH + 32 * ks + 8 * fq);
                  acc[dt] = __builtin_amdgcn_mfma_f32_16x16x32_bf16(vf, wf[ks], acc[dt], 0, 0, 0); } }
#pragma unroll
          for (int pp = 0; pp < 4; ++pp) { const f32x4 s0 = acc[2 * pp] + bs, s1 = acc[2 * pp + 1] + bs;
              const f32x4 u0 = {bf_lo(uu[pp][0]), bf_hi(uu[pp][0]), bf_lo(uu[pp][1]), bf_hi(uu[pp][1])}, u1 = {bf_lo(uu[pp][2]), bf_hi(uu[pp][2]), bf_lo(uu[pp][3]), bf_hi(uu[pp][3])};
              *(u32x4*)(rowp + 512 * pp) = pg8::pack8(u0 * s0, u1 * s1); } }
        if (has_next) GC_LOADU(nitem);
        const f32x4 w0a = *(const f32x4*)(cwp), w0b = *(const f32x4*)(cwp + 4), w1a = *(const f32x4*)(cwp + DM), w1b = *(const f32x4*)(cwp + DM + 4), w2a = *(const f32x4*)(cwp + 2 * DM), w2b = *(const f32x4*)(cwp + 2 * DM + 4);
#pragma unroll
        for (int vv = 0; vv < 4; ++vv) { const int i = (tid >> 4) + 32 * vv, row = row0 + i, c = c0 + 8 * ci; const int pos = smp ? ((row - MP) & 31) : (row & 2047);
            float f0[8], f1[8], f2[8], o[8];
#pragma unroll
            for (int e = 0; e < 4; ++e) { f0[2 * e] = bf_lo(ch0[vv][e]); f0[2 * e + 1] = bf_hi(ch0[vv][e]); f1[2 * e] = bf_lo(ch1[vv][e]); f1[2 * e + 1] = bf_hi(ch1[vv][e]); f2[2 * e] = bf_lo(ch2[vv][e]); f2[2 * e + 1] = bf_hi(ch2[vv][e]); }
            if (smp && pos < 2) { const int sq = (row - MP) >> 5; const float* stp = p.state_conv + ((size_t)(l * 32 + sq) * 2) * DM + c;
                if (pos == 0) { const f32x4 a = *(const f32x4*)(stp + DM), bq = *(const f32x4*)(stp + DM + 4); f1[0] = a[0]; f1[1] = a[1]; f1[2] = a[2]; f1[3] = a[3]; f1[4] = bq[0]; f1[5] = bq[1]; f1[6] = bq[2]; f1[7] = bq[3]; }
                { const float* s2 = stp + (pos == 0 ? 0 : DM); const f32x4 a = *(const f32x4*)(s2), bq = *(const f32x4*)(s2 + 4); f2[0] = a[0]; f2[1] = a[1]; f2[2] = a[2]; f2[3] = a[3]; f2[4] = bq[0]; f2[5] = bq[1]; f2[6] = bq[2]; f2[7] = bq[3]; } }
#pragma unroll
            for (int e = 0; e < 4; ++e) { o[e] = w0a[e] * f2[e] + w1a[e] * f1[e] + w2a[e] * f0[e]; o[4 + e] = w0b[e] * f2[4 + e] + w1b[e] * f1[4 + e] + w2b[e] * f0[4 + e]; }
            u32x4 ov;
#pragma unroll
            for (int e = 0; e < 4; ++e) ov[e] = cvt_pk_bf16(o[2 * e] * bf_lo(bg[vv][e]), o[2 * e + 1] * bf_hi(bg[vv][e]));
            *(u32x4*)(AB + pg8::mt_off(row, 1024 + c, 2048)) = ov;
            const int lastpos = smp ? 31 : 2047;
            if (pos >= lastpos - 1) { float* op = smp ? p.out + OUT_NCS + (((size_t)l * 32 + ((row - MP) >> 5)) * 2 + (pos - (lastpos - 1))) * DM + c
                                                      : p.out + OUT_NCP + (((size_t)l * 32 + (row >> 11)) * 2 + (pos - (lastpos - 1))) * DM + c;
                *(f32x4*)op = (f32x4){f0[0], f0[1], f0[2], f0[3]}; *(f32x4*)(op + 4) = (f32x4){f0[4], f0[5], f0[6], f0[7]}; } }
        __syncthreads();
        if (!has_next) break;
        item = nitem;
    }
#undef GC_LOAD
#undef GC_LOADU
}

__device__ __forceinline__ void final_norm_phase(const Params& p) {
    const float* __restrict__ ssq = (const float*)(p.ws + WS_SSQM); const bf16_t* __restrict__ xb = (const bf16_t*)(p.ws + WS_XB); float* __restrict__ out = p.out;
    const size_t n8 = (size_t)MT * DM / 8;
    int tid = threadIdx.x; asm volatile("" : "+v"(tid));
    const size_t stride = (size_t)gridDim.x * 512;
    const int c = (tid & 127) * 8;
    const f32x4 g0 = *(const f32x4*)(p.norm_final + c), g1 = *(const f32x4*)(p.norm_final + c + 4);
    for (size_t i = (size_t)blockIdx.x * 512 + tid; i < n8; i += 4 * stride) {
        u32x4 w[4]; f32x4 s0[4], s1[4], s2[4], s3[4];
#pragma unroll
        for (int k = 0; k < 4; ++k) { const size_t ii = i + k * stride; if (ii < n8) { w[k] = *(const u32x4*)(xb + pg8::mt_off((int)(ii >> 7), c, DM)); const f32x4* s = (const f32x4*)(ssq + (ii >> 7) * 16); s0[k] = s[0]; s1[k] = s[1]; s2[k] = s[2]; s3[k] = s[3]; } }
#pragma unroll
        for (int k = 0; k < 4; ++k) { const size_t ii = i + k * stride; if (ii < n8) { const f32x4 t = (s0[k] + s1[k]) + (s2[k] + s3[k]);
            const float rs = __builtin_amdgcn_rsqf(((t[0] + t[1]) + (t[2] + t[3])) * (1.0f / 1024.0f) + EPS);
            ((f32x4*)out)[2 * ii] = pg8::unpk_lo(w[k]) * rs * g0; ((f32x4*)out)[2 * ii + 1] = pg8::unpk_hi(w[k]) * rs * g1; } }
    }
}

#define LAS __attribute__((address_space(3)))
#define XB_TMO      128
#define XB_XCNT(j)  (256  + 64 * (j))
#define XB_XSUB(j)  (1280 + 64 * (j))
#define XB_XGEN(j)  (2304 + 64 * (j))
#define XB_TOP      3328
#define XB_TOPGEN   3392
#define XCD_BAR_WORDS 3456
#define XB_SPIN_CAP (1u << 18)

__device__ __forceinline__ unsigned xb_ld(unsigned* p)              { return __hip_atomic_load(p, __ATOMIC_RELAXED, __HIP_MEMORY_SCOPE_AGENT); }
__device__ __forceinline__ unsigned xb_add(unsigned* p, unsigned v) { return __hip_atomic_fetch_add(p, v, __ATOMIC_RELAXED, __HIP_MEMORY_SCOPE_AGENT); }
__device__ __forceinline__ unsigned xb_xcc_id() { return (unsigned)__builtin_amdgcn_s_getreg((3 << 11) | 20) & 0xFu; }
#define XB_SPIN(cond, bar) do { unsigned _sp = 0; while (cond) { __builtin_amdgcn_s_sleep(1); \
    if ((++_sp & 255u) == 0u) { if (xb_ld(&(bar)[XB_TMO])) break; if (_sp > XB_SPIN_CAP) { atomicAdd(&(bar)[XB_TMO], 1u); break; } } } } while (0)

struct XcdBarrier {
    unsigned* bar; unsigned x;
    volatile LAS unsigned* st;
};

__device__ __forceinline__ XcdBarrier xcd_barrier_post(unsigned* bar, volatile LAS unsigned* st) {
    XcdBarrier b; b.bar = bar; b.x = xb_xcc_id(); b.st = st;
    if (threadIdx.x == 0) (void)xb_add(&bar[XB_XCNT(b.x)], 1u);
    return b;
}
__device__ __forceinline__ void xcd_barrier_complete(unsigned* bar, unsigned x, unsigned& nloc, unsigned& nx) {
    const unsigned G = gridDim.x * gridDim.y * gridDim.z;
    unsigned sum, cnt, mine, sp = 0u;
    for (;;) {
        sum = 0u; cnt = 0u; mine = 0u;
#pragma unroll
        for (unsigned j = 0; j < 16; ++j) { const unsigned c = xb_ld(&bar[XB_XCNT(j)]); sum += c; cnt += (c > 0u) ? 1u : 0u; mine = (j == x) ? c : mine; }
        if (sum == G) break;
        __builtin_amdgcn_s_sleep(1);
        if ((++sp & 255u) == 0u) { if (xb_ld(&bar[XB_TMO])) break; if (sp > XB_SPIN_CAP) { atomicAdd(&bar[XB_TMO], 1u); break; } }
    }
    nloc = mine > 0u ? mine : 1u; nx = cnt > 0u ? cnt : 1u;
}

__device__ __forceinline__ void xcd_barrier(const XcdBarrier& b) {
    asm volatile("s_waitcnt vmcnt(0)" ::: "memory");
    __syncthreads();
    if (threadIdx.x == 0) {
        unsigned* bar = b.bar;
        __builtin_amdgcn_s_waitcnt(0);
        unsigned nloc = b.st[0], nx = b.st[1];
        if (nloc == 0u) { xcd_barrier_complete(bar, b.x, nloc, nx); b.st[0] = nloc; b.st[1] = nx; }
        const unsigned old = xb_add(&bar[XB_XSUB(b.x)], 1u);
        const unsigned gen = old / nloc;
        if (old + 1u == (gen + 1u) * nloc) {
            __builtin_amdgcn_fence(__ATOMIC_RELEASE, "agent");
            asm volatile("s_waitcnt vmcnt(0)" ::: "memory");
            const unsigned og = xb_add(&bar[XB_TOP], 1u);
            const unsigned tg = og / nx;
            if (og + 1u == (tg + 1u) * nx) xb_add(&bar[XB_TOPGEN], 1u);
            else XB_SPIN(xb_ld(&bar[XB_TOPGEN]) == tg, bar);
            __builtin_amdgcn_fence(__ATOMIC_ACQUIRE, "agent");
            xb_add(&bar[XB_XGEN(b.x)], 1u);
            asm volatile("s_waitcnt vmcnt(0)" ::: "memory");
        } else {
            XB_SPIN(xb_ld(&bar[XB_XGEN(b.x)]) == gen, bar);
            __builtin_amdgcn_fence(__ATOMIC_ACQUIRE, "agent");
            asm volatile("s_waitcnt vmcnt(0)" ::: "memory");
        }
    }
    __syncthreads();
}

__global__ void __launch_bounds__(512, 2) mk_fwd(Params p) {
    extern __shared__ __attribute__((aligned(16))) unsigned char lds[];
    unsigned char* ws0 = p.ws;
    PG8_LAS unsigned char* ring = (PG8_LAS unsigned char*)lds;
#if MK_MULTI
#define GRID_SYNC() do { } while (0)
#else
    cg::grid_group grid = cg::this_grid();
    volatile LAS unsigned* bst = (volatile LAS unsigned*)((LAS unsigned char*)lds + pg8::STAGE_BYTES);
    if (threadIdx.x < 2) bst[threadIdx.x] = 0u;
    __syncthreads();
    XcdBarrier xbar = xcd_barrier_post((unsigned*)(ws0 + WS_CTL), bst);
#define GRID_SYNC() do { if (p.ph_hi > 100000) grid.sync(); else xcd_barrier(xbar); } while (0)
#endif
    for (int ph = p.ph_lo; ph < p.ph_hi; ++ph) {
        unsigned char* ws = ws0; int G = gridDim.x, c = blockIdx.x; asm volatile("" : "+s"(ws), "+s"(G), "+s"(c));
        float* ssq_mix = (float*)(ws + WS_SSQM); float* ssq_ffn = (float*)(ws + WS_SSQF); float* lns = (float*)(ws + WS_LNS);
        bf16_t* XB = (bf16_t*)(ws + WS_XB); bf16_t* AB = (bf16_t*)(ws + WS_AB); bf16_t* GV = (bf16_t*)(ws + WS_GV); bf16_t* CH = (bf16_t*)(ws + WS_CH);
        bf16_t* T12 = GV; bf16_t* MMb = AB; bf16_t* Hb = AB;
        int cl = -1, cf = 0;
        if (ph == 0) { cl = 0; }
        else if (ph == NPHASE - 1) { if (PHASE_MASK & 2) final_norm_phase(p); }
        else {
            const int l = (ph - 1) / 7, s = (ph - 1) % 7;
            for (int rep_ = 0; rep_ < (((PROBE_DUP >> s) & 1) ? 2 : 1); ++rep_) {
            const unsigned char* lw = ws + WS_W + (size_t)l * LW_BYTES;
            if (s == 0) { if (PHASE_MASK & 4) {
                pg8::Gemm g{XB, (const bf16_t*)(lw + LW_WIN), MT, 5120, DM, DM, 1 << 30, 0}; pg8::StaticOrder S; S.init(MT, 5120, G, c);
                pg8::EpiA E{AB, GV, CH, ssq_mix, lns};
                pg8::gemm_phase<pg8::EpiA, pg8::StaticOrder>(ring, g, S, E); }
            } else if (s == 1) {
                if (PHASE_MASK & 8) gate_conv_phase(p, l, lds);
            } else if (s == 2) { if (PHASE_MASK & 16) {
                pg8::Gemm g{AB, (const bf16_t*)(lw + LW_WPAB), MT, 2048, DM, 2048, 4, 1024}; pg8::StaticOrder S; S.init(MT, 2048, G, c);
                pg8::EpiC E{T12};
                pg8::gemm_phase<pg8::EpiC, pg8::StaticOrder>(ring, g, S, E); }
            } else if (s == 3) { if (PHASE_MASK & 32) {
                pg8::Gemm g{XB, (const bf16_t*)(lw + LW_WIN) + (size_t)5120 * DM, MT, 2048, DM, DM, 1 << 30, 0}; pg8::StaticOrder S; S.init(MT, 2048, G, c);
                pg8::EpiD E{T12, MMb, ssq_mix};
                pg8::gemm_phase<pg8::EpiD, pg8::StaticOrder>(ring, g, S, E); }
            } else if (s == 4) { if (PHASE_MASK & 64) {
                pg8::Gemm g{MMb, (const bf16_t*)(lw + LW_WO), MT, DM, DM, DM, 1 << 30, 0}; pg8::StaticOrder S; S.init(MT, DM, G, c);
                pg8::EpiRes E{XB, ssq_ffn};
                pg8::gemm_phase<pg8::EpiRes, pg8::StaticOrder>(ring, g, S, E); }
            } else if (s == 5) { if (PHASE_MASK & 128) {
                pg8::Gemm g{XB, (const bf16_t*)(lw + LW_WGU), MT, 2 * DFF, DM, DM, 1 << 30, 0}; pg8::StaticOrder S; S.init(MT, 2 * DFF, G, c);
                pg8::EpiF E{Hb, ssq_ffn};
                pg8::gemm_phase<pg8::EpiF, pg8::StaticOrder>(ring, g, S, E); }
            } else { if (PHASE_MASK & 256) {
                pg8::Gemm g{Hb, (const bf16_t*)(lw + LW_WD), MT, DM, DFF, DFF, 1 << 30, 0}; pg8::StaticOrder S; S.init(MT, DM, G, c);
                pg8::EpiRes E{XB, ssq_mix};
                pg8::gemm_phase<pg8::EpiRes, pg8::StaticOrder>(ring, g, S, E);
                if (l + 1 < NL) { cl = l + 1; cf = S.ntot - S.nwg; } }
            }
            }
        }
        if (cl >= 0) p0_prologue(p, (float*)lds, cl, cf, ph == 0);
        if (ph + 1 < p.ph_hi) { GRID_SYNC(); }
    }
}

extern "C" void kernel_launch(void* const* d_in, const int* in_sizes, int n_in, void* d_out, int out_size, void* d_ws, size_t ws_size, hipStream_t stream) {
    static int grid = 0;
    if (grid == 0) {
        if (n_in != 18 || in_sizes[0] != MP * DM || (size_t)out_size != OUT_TOTAL || ws_size < WS_END) {
            fprintf(stderr, "kernel_launch: unexpected shapes: n_in %d in0 %d out %d ws %zu (need %zu)\n", n_in, n_in > 0 ? in_sizes[0] : -1, out_size, ws_size, (size_t)WS_END); grid = -1; return; }
        int dev = 0, cus = 0, per_cu = 0;
        (void)hipGetDevice(&dev); (void)hipDeviceGetAttribute(&cus, hipDeviceAttributeMultiprocessorCount, dev);
        if (hipFuncSetAttribute((const void*)mk_fwd, hipFuncAttributeMaxDynamicSharedMemorySize, LDS_BYTES) != hipSuccess) { fprintf(stderr, "kernel_launch: hipFuncSetAttribute failed\n"); grid = -1; return; }
        if (hipOccupancyMaxActiveBlocksPerMultiprocessor(&per_cu, (const void*)mk_fwd, 512, LDS_BYTES) != hipSuccess || per_cu < 1) { fprintf(stderr, "kernel_launch: occupancy query says %d\n", per_cu); per_cu = 1; }
        (void)hipGetLastError();
        grid = cus * 1;
        fprintf(stderr, "kernel_launch: cus %d per_cu %d grid %d\n", cus, per_cu, grid);
    }
    if (grid < 0) return;
    if (hipMemsetAsync((char*)d_ws + WS_CTL, 0, CTL_BYTES, stream) != hipSuccess) { fprintf(stderr, "kernel_launch: memset failed\n"); return; }
    Params p{};
    const float** pp = (const float**)&p;
    for (int i = 0; i < 18; ++i) pp[i] = (const float*)d_in[i];
    p.out = (float*)d_out; p.ws = (unsigned char*)d_ws;
#if MK_MULTI
    for (int ph = 0; ph < NPHASE; ++ph) { p.ph_lo = ph; p.ph_hi = ph + 1; hipLaunchKernelGGL(mk_fwd, dim3(grid), dim3(512), LDS_BYTES, stream, p); }
#else
    p.ph_lo = 0; p.ph_hi = NPHASE;
    void* args[] = {&p};
    hipError_t e = hipLaunchCooperativeKernel((const void*)mk_fwd, dim3(grid), dim3(512), args, LDS_BYTES, stream);
    if (e != hipSuccess) fprintf(stderr, "kernel_launch: cooperative launch failed: %s (grid %d)\n", hipGetErrorString(e), grid);
#endif
}
```

```cpp
#include <hip/hip_runtime.h>
#include <hip/hip_cooperative_groups.h>
#include <cstdio>
#include <cstdint>
namespace cg = cooperative_groups;

#ifndef PHASE_MASK
#define PHASE_MASK 511
#endif
#ifndef PROBE_DUP
#define PROBE_DUP 0
#endif
#ifndef MK_MULTI
#define MK_MULTI 0
#endif

constexpr int MP = 65536, MS = 1024, MT = MP + MS, DM = 1024, NL = 4, DFF = 2816, NIN = 7168;
constexpr float EPS = 1e-6f;
constexpr size_t OUT_YS = (size_t)MP * DM, OUT_NCP = OUT_YS + (size_t)MS * DM, OUT_NCS = OUT_NCP + (size_t)NL * 32 * 2 * DM, OUT_V = OUT_NCS + (size_t)NL * 32 * 2 * DM;
constexpr size_t OUT_TOTAL = OUT_V + (size_t)NL * 32 * 32 * DM;

constexpr size_t MiB = (size_t)1 << 20;
constexpr size_t WS_SSQM = 0, WS_SSQF = 5 * MiB, WS_LNS = 10 * MiB;
constexpr size_t WS_CTL = 20 * MiB, CTL_BYTES = 16384;
constexpr size_t WS_W = 24 * MiB;
constexpr size_t LW_WIN = 0, LW_WPAB = LW_WIN + (size_t)NIN * DM * 2, LW_WO = LW_WPAB + (size_t)2048 * DM * 2, LW_WGU = LW_WO + (size_t)DM * DM * 2,
                 LW_WD = LW_WGU + (size_t)2 * DFF * DM * 2, LW_WSP = LW_WD + (size_t)DM * DFF * 2, LW_WSS = LW_WSP + (size_t)8 * 128 * 128 * 2, LW_BYTES = LW_WSS + (size_t)8 * 128 * 128 * 2;
constexpr size_t WS_XB = 176 * MiB;
constexpr size_t WS_AB = 306 * MiB;
constexpr size_t WS_GV = 566 * MiB;
constexpr size_t WS_CH = 696 * MiB;
constexpr size_t WS_END = 826 * MiB;
static_assert(WS_W + NL * LW_BYTES <= WS_XB, "weights overflow");

namespace pg8 {
#define PG8_LAS __attribute__((address_space(3)))
typedef unsigned short bf16_t;
typedef short bf16x8 __attribute__((ext_vector_type(8)));
typedef float f32x4 __attribute__((ext_vector_type(4)));
typedef float f32x2 __attribute__((ext_vector_type(2)));
typedef unsigned u32x4 __attribute__((ext_vector_type(4)));
typedef unsigned u32x2 __attribute__((ext_vector_type(2)));
constexpr int BM = 256, BK = 64, HALF = 128, HTB = HALF * BK * 2, STAGE_BYTES = 8 * HTB, NXCD = 8, WGM = 8;

__host__ __device__ __forceinline__ int lds_byte(int r, int c) { const int st = (r >> 4) * 2 + (c >> 5), rr = r & 15, cc = c & 31, ob = rr * 64 + cc * 2; return st * 1024 + (ob ^ (((ob >> 9) & 1) << 5)); }
__host__ __device__ __forceinline__ void stage_rc(int b, int& R, int& C) { const int st = b / 1024, sb = b % 1024, swz = sb ^ (((sb >> 9) & 1) << 5); R = (st >> 1) * 16 + swz / 64; C = (st & 1) * 32 + (swz % 64) / 2; }
__host__ __device__ __forceinline__ int perm32(int rho) { const int n = rho >> 4, i = rho & 15; return 8 * (i >> 2) + 4 * n + (i & 3); }

struct Unit { int pm, pn, half, rbase; };
struct Gemm { const bf16_t* A; const bf16_t* Bt; int M, N, K, lda, asplit_pn, asplit_off; };

struct StaticOrder {
    int nM, nN, nwg, G, c, ntot;
    __host__ __device__ void init(int M, int N, int G_, int c_) { nM = MP / BM; nN = N / BM; nwg = nM * nN; G = G_; c = c_; ntot = nwg + 2 * ((M / BM) - nM) * nN; }
    __host__ __device__ bool next(int i, Unit& u) const {
        const long L = (long)i * G + c; if (L >= ntot) return false;
        if (L >= nwg) { const int h = (int)L - nwg, hp = h / nN; u.pn = h - hp * nN; u.pm = nM + (hp >> 1); u.half = 1; u.rbase = u.pm * BM + (hp & 1) * HALF; return true; }
        int wgid = (int)L; { const int q = nwg / NXCD, r = nwg % NXCD, xcd = wgid % NXCD, off = wgid / NXCD; wgid = (xcd < r ? xcd * (q + 1) : r * (q + 1) + (xcd - r) * q) + off; }
        const int nig = WGM * nN, gid = wgid / nig, fm = gid * WGM, gsz = (nM - fm) < WGM ? (nM - fm) : WGM;
        u.pm = fm + ((wgid % nig) % gsz); u.pn = (wgid % nig) / gsz; u.half = 0; u.rbase = u.pm * BM; return true;
    }
    __device__ __forceinline__ void a_ready(const Unit&) const {}
    __device__ __forceinline__ void done(const Unit&) const {}
};

__host__ __device__ __forceinline__ size_t mt_off(int row, int col, int ncols) { return ((size_t)((row >> 4) * (ncols >> 5) + (col >> 5)) << 9) + (size_t)(((row & 15) << 5) + (col & 31)); }
__device__ __forceinline__ unsigned cvt_pk_bf16(float lo, float hi) { unsigned r; asm volatile("v_cvt_pk_bf16_f32 %0, %1, %2" : "=v"(r) : "v"(lo), "v"(hi)); return r; }
__device__ __forceinline__ float bf_lo(unsigned w) { return __uint_as_float(w << 16); }
__device__ __forceinline__ float bf_hi(unsigned w) { return __uint_as_float(w & 0xffff0000u); }
__device__ __forceinline__ f32x2 gelu_pk(f32x2 v) {
    const f32x2 av = __builtin_elementwise_abs(v), d = av * 0.2316418882f + 1.0f;
    f32x2 t; t.x = __builtin_amdgcn_rcpf(d.x); t.y = __builtin_amdgcn_rcpf(d.y);
    f32x2 q = t * 0.5307027145f + (-0.7265760135f); q = q * t + 0.7107068705f; q = q * t + (-0.142248368f); q = q * t + 0.127414796f; q = q * t;
    const f32x2 s = (v * v) * (-0.72134752044f);
    f32x2 e; e.x = __builtin_amdgcn_exp2f(s.x); e.y = __builtin_amdgcn_exp2f(s.y);
    const f32x2 m = v * (q * e), r = v - m;
    f32x2 o; o.x = v.x < 0.f ? m.x : r.x; o.y = v.y < 0.f ? m.y : r.y; return o;
}
__device__ __forceinline__ f32x4 gelu4(f32x4 v) { const f32x2 a = gelu_pk((f32x2){v[0], v[1]}), b = gelu_pk((f32x2){v[2], v[3]}); return (f32x4){a.x, a.y, b.x, b.y}; }
__device__ __forceinline__ float sigmoidf_(float x) { return __builtin_amdgcn_rcpf(1.0f + __builtin_amdgcn_exp2f(x * -1.44269504f)); }
__device__ __forceinline__ f32x4 sigmoid4(f32x4 v) { return (f32x4){sigmoidf_(v[0]), sigmoidf_(v[1]), sigmoidf_(v[2]), sigmoidf_(v[3])}; }
__device__ __forceinline__ u32x4 pack8(f32x4 v0, f32x4 v1) { u32x4 w; w.x = cvt_pk_bf16(v0[0], v0[1]); w.y = cvt_pk_bf16(v0[2], v0[3]); w.z = cvt_pk_bf16(v1[0], v1[1]); w.w = cvt_pk_bf16(v1[2], v1[3]); return w; }
__device__ __forceinline__ float rstd_of(const float* slots, int row) { const f32x4* s = (const f32x4*)(slots + (size_t)row * 16); const f32x4 t = (s[0] + s[1]) + (s[2] + s[3]);
    return __builtin_amdgcn_rsqf(((t[0] + t[1]) + (t[2] + t[3])) * (1.0f / 1024.0f) + EPS); }

__device__ __forceinline__ void wave_rstd(const float* slots, int rowbase, int lane, int fr, float (&rs)[2][4]) {
    float val[2];
    const f32x4* sa = (const f32x4*)(slots + (size_t)(rowbase + lane) * 16); const f32x4* sb = (const f32x4*)(slots + (size_t)(rowbase + HALF + lane) * 16);
    const f32x4 a0 = sa[0], a1 = sa[1], a2 = sa[2], a3 = sa[3], b0 = sb[0], b1 = sb[1], b2 = sb[2], b3 = sb[3];
    __builtin_amdgcn_sched_barrier(0);
    { const f32x4 t = (a0 + a1) + (a2 + a3); val[0] = __builtin_amdgcn_rsqf(((t[0] + t[1]) + (t[2] + t[3])) * (1.0f / 1024.0f) + EPS); }
    { const f32x4 t = (b0 + b1) + (b2 + b3); val[1] = __builtin_amdgcn_rsqf(((t[0] + t[1]) + (t[2] + t[3])) * (1.0f / 1024.0f) + EPS); }
#pragma unroll
    for (int ai = 0; ai < 2; ++ai)
#pragma unroll
        for (int m = 0; m < 4; ++m) rs[ai][m] = __shfl(val[ai], m * 16 + fr);
}
__device__ __forceinline__ f32x4 unpk_lo(u32x4 w) { return (f32x4){bf_lo(w[0]), bf_hi(w[0]), bf_lo(w[1]), bf_hi(w[1])}; }
__device__ __forceinline__ f32x4 unpk_hi(u32x4 w) { return (f32x4){bf_lo(w[2]), bf_hi(w[2]), bf_lo(w[3]), bf_hi(w[3])}; }

struct EpiA {
    static constexpr bool PERM = true, AFTER_DRAIN = false; static constexpr int NVM = 16;

    bf16_t* AB; bf16_t* GV; bf16_t* CH; const float* ssq; float* lns;
    __device__ __forceinline__ void operator()(const f32x4 (&acc)[2][2][4][2], const Unit& u, int wr, int wc, int fr, int fq) const {
        const int row0 = u.rbase + wr * 64 + fr, cw = wc * 32 + 8 * fq, pn = u.pn;
        float rsv[2][4]; wave_rstd(ssq, u.rbase + wr * 64, fr + 16 * fq, fr, rsv);
        if (pn < 4) {
#pragma unroll
            for (int ai = 0; ai < 2; ++ai)
#pragma unroll
                for (int m = 0; m < 4; ++m) { if (ai == 1 && u.half) continue; const int row = row0 + ai * HALF + m * 16; const float rs = rsv[ai][m]; bf16_t* rowp = AB + mt_off(row, pn * 256 + cw, 2048);
#pragma unroll
                    for (int bj = 0; bj < 2; ++bj) *(u32x4*)(rowp + bj * 4 * 512) = pack8(gelu4(acc[ai][bj][m][0] * rs), gelu4(acc[ai][bj][m][1] * rs)); }
        } else if (pn < 8) {
#pragma unroll
            for (int ai = 0; ai < 2; ++ai)
#pragma unroll
                for (int m = 0; m < 4; ++m) { if (ai == 1 && u.half) continue; const int row = row0 + ai * HALF + m * 16; const float rs = rsv[ai][m]; bf16_t* rowp = GV + (size_t)row * 1024 + (pn - 4) * 256 + cw;
                    float s = 0.f, q = 0.f;
#pragma unroll
                    for (int bj = 0; bj < 2; ++bj) { const u32x4 w = pack8(gelu4(acc[ai][bj][m][0] * rs), gelu4(acc[ai][bj][m][1] * rs)); *(u32x4*)(rowp + bj * HALF) = w;
#pragma unroll
                        for (int e = 0; e < 4; ++e) { const float a = bf_lo(w[e]), b = bf_hi(w[e]); s += a + b; q += a * a + b * b; } }
                    s += __shfl_xor(s, 16); s += __shfl_xor(s, 32); q += __shfl_xor(q, 16); q += __shfl_xor(q, 32);
                    if (fq == 0) *(f32x2*)(lns + ((size_t)row * 16 + (pn - 4) * 4 + wc) * 2) = (f32x2){s, q}; }
        } else if (pn < 12) {
#pragma unroll
            for (int ai = 0; ai < 2; ++ai)
#pragma unroll
                for (int m = 0; m < 4; ++m) { if (ai == 1 && u.half) continue; const int row = row0 + ai * HALF + m * 16; const float rs = rsv[ai][m]; bf16_t* rowp = AB + mt_off(row, 1024 + (pn - 8) * 256 + cw, 2048);
#pragma unroll
                    for (int bj = 0; bj < 2; ++bj) *(u32x4*)(rowp + bj * 4 * 512) = pack8(acc[ai][bj][m][0] * rs, acc[ai][bj][m][1] * rs); }
        } else {
#pragma unroll
            for (int ai = 0; ai < 2; ++ai)
#pragma unroll
                for (int m = 0; m < 4; ++m) { if (ai == 1 && u.half) continue; const int row = row0 + ai * HALF + m * 16; const float rs = rsv[ai][m]; const float rs2 = rs * rs;
                    *(u32x4*)(CH + (size_t)row * 1024 + (pn - 12) * 128 + cw) = pack8(acc[ai][0][m][0] * acc[ai][1][m][0] * rs2, acc[ai][0][m][1] * acc[ai][1][m][1] * rs2); }
        }
    }
};
struct EpiC {
    static constexpr bool PERM = true, AFTER_DRAIN = false; static constexpr int NVM = 16;

    bf16_t* T;
    __device__ __forceinline__ void operator()(const f32x4 (&acc)[2][2][4][2], const Unit& u, int wr, int wc, int fr, int fq) const {
        const int row0 = u.rbase + wr * 64 + fr, cw = u.pn * 256 + wc * 32 + 8 * fq;
#pragma unroll
        for (int ai = 0; ai < 2; ++ai)
#pragma unroll
            for (int m = 0; m < 4; ++m) { if (ai == 1 && u.half) continue; bf16_t* rowp = T + mt_off(row0 + ai * HALF + m * 16, cw, 2048);
#pragma unroll
                for (int bj = 0; bj < 2; ++bj) *(u32x4*)(rowp + bj * 4 * 512) = pack8(acc[ai][bj][m][0], acc[ai][bj][m][1]); }
    }
};
struct EpiD {
    static constexpr bool PERM = true, AFTER_DRAIN = false; static constexpr int NVM = 24;

    const bf16_t* T; bf16_t* MM; const float* ssq;
    __device__ __forceinline__ void operator()(const f32x4 (&acc)[2][2][4][2], const Unit& u, int wr, int wc, int fr, int fq) const {
        const int row0 = u.rbase + wr * 64 + fr, cw = u.pn * 128 + wc * 32 + 8 * fq;
        u32x4 tt[4][2];
#pragma unroll
        for (int m = 0; m < 4; ++m) { const bf16_t* tp = T + mt_off(row0 + m * 16, cw, 2048); tt[m][0] = *(const u32x4*)tp; tt[m][1] = *(const u32x4*)(tp + 32 * 512); }
        float rsv[2][4]; wave_rstd(ssq, u.rbase + wr * 64, fr + 16 * fq, fr, rsv);
#pragma unroll
        for (int ai = 0; ai < 2; ++ai) {
            if (ai == 1 && u.half) break;
            if (ai == 1) {
#pragma unroll
                for (int m = 0; m < 4; ++m) { const bf16_t* tp = T + mt_off(row0 + HALF + m * 16, cw, 2048); tt[m][0] = *(const u32x4*)tp; tt[m][1] = *(const u32x4*)(tp + 32 * 512); } }
#pragma unroll
            for (int m = 0; m < 4; ++m) { const int row = row0 + ai * HALF + m * 16; const float rs = rsv[ai][m];
                const u32x4 t1 = tt[m][0], t2 = tt[m][1];
                const f32x4 a0 = sigmoid4(acc[ai][0][m][0] * rs), a1 = sigmoid4(acc[ai][0][m][1] * rs), b0 = sigmoid4(acc[ai][1][m][0] * rs), b1 = sigmoid4(acc[ai][1][m][1] * rs);
                const f32x4 p0 = {bf_lo(t1[0]), bf_hi(t1[0]), bf_lo(t1[1]), bf_hi(t1[1])}, p1 = {bf_lo(t1[2]), bf_hi(t1[2]), bf_lo(t1[3]), bf_hi(t1[3])};
                const f32x4 q0 = {bf_lo(t2[0]), bf_hi(t2[0]), bf_lo(t2[1]), bf_hi(t2[1])}, q1 = {bf_lo(t2[2]), bf_hi(t2[2]), bf_lo(t2[3]), bf_hi(t2[3])};
                *(u32x4*)(MM + mt_off(row, cw, 1024)) = pack8(a0 * p0 + b0 * q0, a1 * p1 + b1 * q1); }
            asm volatile("" ::: "memory");
        }
    }
};
struct EpiRes {
    static constexpr bool PERM = true, AFTER_DRAIN = false; static constexpr int NVM = 24;

    bf16_t* xb; float* ssq;
    __device__ __forceinline__ void operator()(const f32x4 (&acc)[2][2][4][2], const Unit& u, int wr, int wc, int fr, int fq) const {
        const int row0 = u.rbase + wr * 64 + fr, cw = u.pn * BM + wc * 32 + 8 * fq;
#pragma unroll
        for (int ai = 0; ai < 2; ++ai) {
            if (ai == 1 && u.half) break;
            u32x4 xo[4][2];
#pragma unroll
            for (int m = 0; m < 4; ++m)
#pragma unroll
                for (int bj = 0; bj < 2; ++bj) xo[m][bj] = *(const u32x4*)(xb + mt_off(row0 + ai * HALF + m * 16, cw + bj * HALF, DM));
#pragma unroll
            for (int m = 0; m < 4; ++m) { const int row = row0 + ai * HALF + m * 16; float q = 0.f;
#pragma unroll
                for (int bj = 0; bj < 2; ++bj) { const u32x4 w = pack8(acc[ai][bj][m][0] + unpk_lo(xo[m][bj]), acc[ai][bj][m][1] + unpk_hi(xo[m][bj]));
                    *(u32x4*)(xb + mt_off(row, cw + bj * HALF, DM)) = w;
#pragma unroll
                    for (int e = 0; e < 4; ++e) { const float a = bf_lo(w[e]), b = bf_hi(w[e]); q += a * a + b * b; } }
                q += __shfl_xor(q, 16); q += __shfl_xor(q, 32);
                if (fq == 0) ssq[(size_t)row * 16 + u.pn * 4 + wc] = q; }
            asm volatile("" ::: "memory");
        }
    }
};
struct EpiF {
    static constexpr bool PERM = true, AFTER_DRAIN = false; static constexpr int NVM = 16;

    bf16_t* H; const float* ssq;
    __device__ __forceinline__ void operator()(const f32x4 (&acc)[2][2][4][2], const Unit& u, int wr, int wc, int fr, int fq) const {
        const int row0 = u.rbase + wr * 64 + fr, cw = u.pn * 128 + wc * 32 + 8 * fq;
        float rsv[2][4]; wave_rstd(ssq, u.rbase + wr * 64, fr + 16 * fq, fr, rsv);
#pragma unroll
        for (int ai = 0; ai < 2; ++ai)
#pragma unroll
            for (int m = 0; m < 4; ++m) { if (ai == 1 && u.half) continue; const int row = row0 + ai * HALF + m * 16; const float rs = rsv[ai][m];
                const f32x4 g0 = acc[ai][0][m][0] * rs, g1 = acc[ai][0][m][1] * rs, u0 = acc[ai][1][m][0] * rs, u1 = acc[ai][1][m][1] * rs;
                *(u32x4*)(H + mt_off(row, cw, DFF)) = pack8(g0 * sigmoid4(g0) * u0, g1 * sigmoid4(g1) * u1); }
    }
};

#ifndef PG8_SP2
#define PG8_SP2 true
#endif
#ifndef PG8_ALIGN
#define PG8_ALIGN true
#endif
template <class Epi, class Sched, bool SP2 = PG8_SP2, bool ALIGN_EPI = PG8_ALIGN>
__device__ __forceinline__ void gemm_phase(PG8_LAS unsigned char* lds, const Gemm g, const Sched& S, const Epi& E) {
    int tid = threadIdx.x; asm volatile("" : "+v"(tid));
    const int wid = __builtin_amdgcn_readfirstlane(tid >> 6), lane = tid & 63, wr = wid >> 2, wc = wid & 3, fr = lane & 15, fq = lane >> 4;
    const int K = g.K, nt = K / BK, lda = g.lda;
    unsigned voffA[2], voffB[2];
#pragma unroll
    for (int i = 0; i < 2; ++i) { int R, C; stage_rc(tid * 16 + i * 8192, R, C); const int Rb = Epi::PERM ? ((R & ~31) + perm32(R & 31)) : R;
        (void)Rb; static_assert(Epi::PERM, "the weight copies are stored with the 32-row permutation baked in");
        voffA[i] = (unsigned)mt_off(R, C, lda) * 2u; voffB[i] = (unsigned)mt_off(R, C, K) * 2u; }
    const size_t kstep = (size_t)2048;
    const size_t hstepA = (size_t)HALF * lda * 2, hstepB = (size_t)HALF * K * 2;
    const size_t tstepA = 2 * hstepA, tstepB = 2 * hstepB;
    const unsigned ldsw = (unsigned)wid * 1024u;
    const int aoff = lds_byte(wr * 64 + fr, fq * 8), boff = lds_byte(wc * 32 + fr, fq * 8);
#define PG8_SA(b, h) (((b) * 2 + (h)) * HTB)
#define PG8_SB(b, h) ((4 + (b) * 2 + (h)) * HTB)
#define PG8_STAGE(bufoff, gbase, voff) do { _Pragma("unroll") for (int _i = 0; _i < 2; ++_i) \
        __builtin_amdgcn_global_load_lds((const unsigned*)((const char*)(gbase) + (voff)[_i]), (PG8_LAS unsigned*)(lds + (bufoff) + ldsw + _i * 8192), 16, 0, 0); } while (0)
#define PG8_LDA(dst, b, h) do { _Pragma("unroll") for (int m = 0; m < 4; ++m) _Pragma("unroll") for (int k = 0; k < 2; ++k) dst[m][k] = *(const PG8_LAS bf16x8*)(lds + PG8_SA(b, h) + aoff + m * 2048 + k * 1024); } while (0)
#define PG8_LDB(dst, b, h) do { _Pragma("unroll") for (int n = 0; n < 2; ++n) _Pragma("unroll") for (int k = 0; k < 2; ++k) dst[n][k] = *(const PG8_LAS bf16x8*)(lds + PG8_SB(b, h) + boff + n * 2048 + k * 1024); } while (0)
#define PG8_MMA(ai, bj, At, Bt) do { __builtin_amdgcn_s_setprio(1); _Pragma("unroll") for (int m = 0; m < 4; ++m) _Pragma("unroll") for (int n = 0; n < 2; ++n) _Pragma("unroll") for (int k = 0; k < 2; ++k) \
        acc[ai][bj][m][n] = __builtin_amdgcn_mfma_f32_16x16x32_bf16(Bt[n][k], At[m][k], acc[ai][bj][m][n], 0, 0, 0); __builtin_amdgcn_s_setprio(0); } while (0)
#define PG8_WAIT_V(n) asm volatile("s_waitcnt vmcnt(" #n ")" ::: "memory")
#define PG8_WAIT_L(n) asm volatile("s_waitcnt lgkmcnt(" #n ")" ::: "memory")
#define PG8_WAIT_V8X do { if constexpr (Epi::NVM >= 24) asm volatile("s_cmp_eq_u32 %0, 0\n\ts_cbranch_scc1 1f\n\ts_waitcnt vmcnt(8)\n1:\n\ts_waitcnt vmcnt(32)" :: "s"(t) : "scc", "memory"); \
        else asm volatile("s_cmp_eq_u32 %0, 0\n\ts_cbranch_scc1 1f\n\ts_waitcnt vmcnt(8)\n1:\n\ts_waitcnt vmcnt(24)" :: "s"(t) : "scc", "memory"); } while (0)
#define PG8_BAR __builtin_amdgcn_s_barrier()
#define PG8_SCHED __builtin_amdgcn_sched_barrier(0)
#define PG8_APTR(u) ((const char*)g.A + (size_t)((u).rbase) * lda * 2 + (((u).pn >= g.asplit_pn) ? (size_t)g.asplit_off * 32 : (size_t)0))
    Unit cur, nxt; int ui = 0;
    if (!S.next(0, cur)) return;
    f32x4 acc[2][2][4][2];
#pragma unroll
    for (int a = 0; a < 2; ++a)
#pragma unroll
        for (int b = 0; b < 2; ++b)
#pragma unroll
            for (int m = 0; m < 4; ++m)
#pragma unroll
                for (int n = 0; n < 2; ++n) acc[a][b][m][n] = (f32x4){0.f, 0.f, 0.f, 0.f};
    bf16x8 At[4][2], B0[2][2], B1[2][2];
    const char* cA = PG8_APTR(cur); const char* cB = (const char*)g.Bt + (size_t)cur.pn * tstepB;
    S.a_ready(cur);
    if constexpr (SP2) {
        PG8_STAGE(PG8_SB(0, 0), cB, voffB); PG8_STAGE(PG8_SB(0, 1), cB + hstepB, voffB); PG8_STAGE(PG8_SA(0, 0), cA, voffA); PG8_STAGE(PG8_SA(0, 1), cA + hstepA, voffA);
        if (wr == 1) PG8_BAR;
        PG8_WAIT_V(2); PG8_BAR;
        PG8_STAGE(PG8_SB(1, 0), cB + kstep, voffB); PG8_STAGE(PG8_SA(1, 0), cA + kstep, voffA); PG8_STAGE(PG8_SB(1, 1), cB + hstepB + kstep, voffB);
        PG8_WAIT_V(0); PG8_BAR;
    } else {
    PG8_STAGE(PG8_SB(0, 0), cB, voffB); PG8_STAGE(PG8_SA(0, 0), cA, voffA); PG8_STAGE(PG8_SB(0, 1), cB + hstepB, voffB); PG8_STAGE(PG8_SA(0, 1), cA + hstepA, voffA);
    if (wr == 1) PG8_BAR;
    PG8_WAIT_V(4); PG8_BAR;
    PG8_STAGE(PG8_SB(1, 0), cB + kstep, voffB); PG8_STAGE(PG8_SA(1, 0), cA + kstep, voffA); PG8_STAGE(PG8_SB(1, 1), cB + hstepB + kstep, voffB);
    PG8_WAIT_V(6); PG8_BAR;
    }
    for (;;) {
        const bool has_next = S.next(ui + 1, nxt);
        const char* nA = has_next ? PG8_APTR(nxt) : cA; const char* nB = has_next ? (const char*)g.Bt + (size_t)nxt.pn * tstepB : cB;
        const bool hlf = cur.half != 0;
        for (int t = 0; t < nt; t += 2) {
            const bool last = (t == nt - 2);
            const char* a1 = cA + (size_t)(t + 1) * kstep;
            const char* a2 = last ? nA : cA + (size_t)(t + 2) * kstep; const char* b2 = last ? nB : cB + (size_t)(t + 2) * kstep;
            const char* a3 = a2 + kstep; const char* b3 = b2 + kstep;
            if (last && has_next) S.a_ready(nxt);
            if constexpr (SP2) {
            PG8_LDB(B0, 0, 0); PG8_LDB(B1, 0, 1); PG8_SCHED; PG8_LDA(At, 0, 0); PG8_STAGE(PG8_SA(1, 1), a1 + hstepA, voffA);
            PG8_WAIT_V8X; PG8_WAIT_L(0); PG8_BAR; PG8_MMA(0, 0, At, B0); PG8_MMA(0, 1, At, B1); PG8_BAR; PG8_SCHED;
            if (!hlf) { PG8_LDA(At, 0, 1); } PG8_STAGE(PG8_SB(0, 0), b2, voffB); PG8_STAGE(PG8_SB(0, 1), b2 + hstepB, voffB); PG8_STAGE(PG8_SA(0, 0), a2, voffA);
            PG8_WAIT_V8X; PG8_WAIT_L(0); PG8_BAR; if (!hlf) { PG8_MMA(1, 0, At, B0); PG8_MMA(1, 1, At, B1); } PG8_BAR; PG8_SCHED;
            PG8_LDB(B0, 1, 0); PG8_LDB(B1, 1, 1); PG8_SCHED; PG8_LDA(At, 1, 0); PG8_STAGE(PG8_SA(0, 1), a2 + hstepA, voffA);
            PG8_WAIT_V(8); PG8_WAIT_L(0); PG8_BAR; PG8_MMA(0, 0, At, B0); PG8_MMA(0, 1, At, B1); PG8_BAR; PG8_SCHED;
            if (!hlf) { PG8_LDA(At, 1, 1); } PG8_STAGE(PG8_SB(1, 0), b3, voffB); PG8_STAGE(PG8_SB(1, 1), b3 + hstepB, voffB); PG8_STAGE(PG8_SA(1, 0), a3, voffA);
            PG8_WAIT_V(8); PG8_WAIT_L(0); PG8_BAR; if (!hlf) { PG8_MMA(1, 0, At, B0); PG8_MMA(1, 1, At, B1); } PG8_BAR; PG8_SCHED;
            } else {
            PG8_LDB(B0, 0, 0); PG8_SCHED; PG8_LDA(At, 0, 0); PG8_STAGE(PG8_SA(1, 1), a1 + hstepA, voffA);
            PG8_WAIT_L(8); PG8_BAR; PG8_WAIT_L(0); PG8_MMA(0, 0, At, B0); PG8_BAR; PG8_SCHED;
            PG8_LDB(B1, 0, 1); PG8_STAGE(PG8_SB(0, 0), b2, voffB);
            PG8_BAR; PG8_WAIT_L(0); PG8_MMA(0, 1, At, B1); PG8_BAR;
            PG8_LDA(At, 0, 1); PG8_STAGE(PG8_SA(0, 0), a2, voffA);
            PG8_BAR; PG8_WAIT_L(0); PG8_MMA(1, 0, At, B0); PG8_BAR; PG8_SCHED;
            PG8_STAGE(PG8_SB(0, 1), b2 + hstepB, voffB);
            PG8_WAIT_V(6); PG8_BAR; PG8_MMA(1, 1, At, B1); PG8_BAR;
            PG8_LDB(B0, 1, 0); PG8_SCHED; PG8_LDA(At, 1, 0); PG8_STAGE(PG8_SA(0, 1), a2 + hstepA, voffA);
            PG8_WAIT_L(8); PG8_BAR; PG8_WAIT_L(0); PG8_MMA(0, 0, At, B0); PG8_BAR; PG8_SCHED;
            PG8_LDB(B1, 1, 1); PG8_STAGE(PG8_SB(1, 0), b3, voffB);
            PG8_BAR; PG8_WAIT_L(0); PG8_MMA(0, 1, At, B1); PG8_BAR;
            PG8_LDA(At, 1, 1); PG8_STAGE(PG8_SA(1, 0), a3, voffA);
            PG8_BAR; PG8_WAIT_L(0); PG8_MMA(1, 0, At, B0); PG8_BAR; PG8_SCHED;
            PG8_STAGE(PG8_SB(1, 1), b3 + hstepB, voffB);
            PG8_WAIT_V(6); PG8_BAR; PG8_MMA(1, 1, At, B1); PG8_BAR;
            }
        }
        if constexpr (ALIGN_EPI) { if (wr == 0) PG8_BAR; }
        E(acc, cur, wr, wc, fr, fq); S.done(cur);
        if (!has_next) break;
#pragma unroll
        for (int a = 0; a < 2; ++a)
#pragma unroll
            for (int b = 0; b < 2; ++b)
#pragma unroll
                for (int m = 0; m < 4; ++m)
#pragma unroll
                    for (int n = 0; n < 2; ++n) acc[a][b][m][n] = (f32x4){0.f, 0.f, 0.f, 0.f};
        cur = nxt; cA = nA; cB = nB; ++ui;
        if constexpr (ALIGN_EPI) { if (wr == 1) PG8_BAR; }
    }
    PG8_WAIT_V(0);
    if constexpr (!ALIGN_EPI) { if (wr == 0) PG8_BAR; }
    PG8_BAR;
#undef PG8_APTR
#undef PG8_SA
#undef PG8_SB
#undef PG8_STAGE
#undef PG8_LDA
#undef PG8_LDB
#undef PG8_MMA
#undef PG8_WAIT_V
#undef PG8_WAIT_L
#undef PG8_WAIT_V8X
#undef PG8_BAR
#undef PG8_SCHED
}
}

using pg8::bf16_t; using pg8::f32x4; using pg8::u32x4; using pg8::u32x2; using pg8::bf16x8;
using pg8::cvt_pk_bf16; using pg8::bf_lo; using pg8::bf_hi;

struct Params {
    const float* x_prompt; const float* x_sample; const float* state_conv; const float* norm_mix; const float* w_in; const float* ln_g; const float* ln_b;
    const float* w_s; const float* b_s; const float* conv_w; const float* w_pa; const float* w_pb; const float* w_o; const float* norm_ffn;
    const float* w_gate; const float* w_up; const float* w_down; const float* norm_final;
    float* out; unsigned char* ws; int ph_lo, ph_hi;
};
constexpr int LDS_BYTES = pg8::STAGE_BYTES + 256;
constexpr int NPHASE = 2 + 7 * NL;

__device__ __forceinline__ void transpose_tile(const float* __restrict__ src, int ld, int k0, int col0, const float* __restrict__ scale, bf16_t* __restrict__ dstbase, int n0, int K, float* t, int tid) {
    const int r = tid >> 4, c4 = tid & 15;
#pragma unroll
    for (int pass = 0; pass < 2; ++pass) { const int k = r + 32 * pass; const f32x4 v = *(const f32x4*)(src + (size_t)(k0 + k) * ld + col0 + 4 * c4); const float s = scale ? scale[k0 + k] : 1.0f;
        t[k * 65 + 4 * c4 + 0] = v[0] * s; t[k * 65 + 4 * c4 + 1] = v[1] * s; t[k * 65 + 4 * c4 + 2] = v[2] * s; t[k * 65 + 4 * c4 + 3] = v[3] * s; }
    __syncthreads();
    const int n = tid >> 3, kc = tid & 7; u32x4 w;
    w.x = cvt_pk_bf16(t[(8 * kc + 0) * 65 + n], t[(8 * kc + 1) * 65 + n]); w.y = cvt_pk_bf16(t[(8 * kc + 2) * 65 + n], t[(8 * kc + 3) * 65 + n]);
    w.z = cvt_pk_bf16(t[(8 * kc + 4) * 65 + n], t[(8 * kc + 5) * 65 + n]); w.w = cvt_pk_bf16(t[(8 * kc + 6) * 65 + n], t[(8 * kc + 7) * 65 + n]);
    const int nl = n0 + n, c5 = nl & 31, rho = 16 * ((c5 >> 2) & 1) + (((c5 >> 3) << 2) | (c5 & 3)), P = (nl & ~31) + rho;
    *(u32x4*)(dstbase + pg8::mt_off(P, k0 + 8 * kc, K)) = w;
    __syncthreads();
}
constexpr int IT_WIN = (NIN / 64) * 16, IT_WPAB = 32 * 16, IT_WO = 16 * 16, IT_WGU = (2 * DFF / 64) * 16, IT_WD = 16 * (DFF / 64), IT_LAYER = IT_WIN + IT_WPAB + IT_WO + IT_WGU + IT_WD;

__device__ __forceinline__ void p0_prologue(const Params& p, float* ldsf, int layer, int first, bool misc) {
    unsigned char* ws = p.ws;
    float* ssqm = (float*)(ws + WS_SSQM);
    int tid = threadIdx.x; asm volatile("" : "+v"(tid));
    const int G = gridDim.x, b = blockIdx.x;
    for (int it = b - first; it >= 0 && it < IT_LAYER; it += G - first) {
        const int l = layer; int r = it; unsigned char* lw = ws + WS_W + (size_t)l * LW_BYTES;
        if (r < IT_WIN) { const int ntile = r >> 4, kt = r & 15, n0 = ntile * 64; int col;
            if (n0 < 3072) col = n0; else if (n0 < 5120) { const int t = n0 - 3072; col = ((t & 128) ? 4096 : 3072) + (t >> 8) * 128 + (t & 127); } else { const int t = n0 - 5120; col = ((t & 128) ? 6144 : 5120) + (t >> 8) * 128 + (t & 127); }
            transpose_tile(p.w_in + (size_t)l * DM * NIN, NIN, kt * 64, col, p.norm_mix + l * DM, (bf16_t*)(lw + LW_WIN), n0, DM, ldsf, tid); continue; }
        r -= IT_WIN;
        if (r < IT_WPAB) { const int ntile = r >> 4, kt = r & 15, n0 = ntile * 64;
            const float* src = (n0 < 1024) ? p.w_pa + (size_t)l * DM * DM : p.w_pb + (size_t)l * DM * DM;
            transpose_tile(src, DM, kt * 64, n0 & 1023, nullptr, (bf16_t*)(lw + LW_WPAB), n0, DM, ldsf, tid); continue; }
        r -= IT_WPAB;
        if (r < IT_WO) { const int ntile = r >> 4, kt = r & 15, n0 = ntile * 64;
            transpose_tile(p.w_o + (size_t)l * DM * DM, DM, kt * 64, n0, nullptr, (bf16_t*)(lw + LW_WO), n0, DM, ldsf, tid); continue; }
        r -= IT_WO;
        if (r < IT_WGU) { const int ntile = r >> 4, kt = r & 15, n0 = ntile * 64;
            const float* src = ((n0 & 128) ? p.w_up : p.w_gate) + (size_t)l * DM * DFF; const int col = (n0 >> 8) * 128 + (n0 & 127);
            transpose_tile(src, DFF, kt * 64, col, p.norm_ffn + l * DM, (bf16_t*)(lw + LW_WGU), n0, DM, ldsf, tid); continue; }
        r -= IT_WGU;
        { const int ntile = r / (DFF / 64), kt = r % (DFF / 64), n0 = ntile * 64;
            transpose_tile(p.w_down + (size_t)l * DFF * DM, DM, kt * 64, n0, nullptr, (bf16_t*)(lw + LW_WD), n0, DFF, ldsf, tid); }
    }
    if (!misc) return;
    for (int i = b * 512 + tid; i < NL * 8 * 128 * 128; i += G * 512) {
        const int l = i >> 17, rem = i & 131071, ii = (rem >> 7) & 127, jj = rem & 127;
        const float* wsrc = p.w_s + (size_t)(i - rem);
        const int grp = rem >> 14;
        unsigned char* lw = ws + WS_W + (size_t)l * LW_BYTES;
        const float vp = (jj <= ii) ? p.w_s[i] : 0.f;
        const float vs = ((ii >> 5) == (jj >> 5) && (jj & 31) <= (ii & 31)) ? wsrc[grp * 16384 + (ii & 31) * 128 + (jj & 31)] : 0.f;
        ((bf16_t*)(lw + LW_WSP))[rem] = (bf16_t)(cvt_pk_bf16(vp, 0.f) & 0xffffu);
        ((bf16_t*)(lw + LW_WSS))[rem] = (bf16_t)(cvt_pk_bf16(vs, 0.f) & 0xffffu);
    }
    { const int wave = tid >> 6, lane = tid & 63; bf16_t* xb = (bf16_t*)(ws + WS_XB);
      for (int row = b * 8 + wave; row < MT; row += 2 * G * 8) {
          const int row2 = row + G * 8; const bool has2 = row2 < MT;
          const float* xr = (row < MP) ? p.x_prompt + (size_t)row * DM : p.x_sample + (size_t)(row - MP) * DM;
          const float* xr2 = has2 ? ((row2 < MP) ? p.x_prompt + (size_t)row2 * DM : p.x_sample + (size_t)(row2 - MP) * DM) : xr;
          f32x4 v[4], v2[4];
#pragma unroll
          for (int j = 0; j < 4; ++j) { v[j] = *(const f32x4*)(xr + 4 * (lane + 64 * j)); v2[j] = *(const f32x4*)(xr2 + 4 * (lane + 64 * j)); }
          float q = 0.f, q2 = 0.f;
#pragma unroll
          for (int j = 0; j < 4; ++j) { q += (v[j][0] * v[j][0] + v[j][1] * v[j][1]) + (v[j][2] * v[j][2] + v[j][3] * v[j][3]); q2 += (v2[j][0] * v2[j][0] + v2[j][1] * v2[j][1]) + (v2[j][2] * v2[j][2] + v2[j][3] * v2[j][3]);
              u32x2 w; w.x = cvt_pk_bf16(v[j][0], v[j][1]); w.y = cvt_pk_bf16(v[j][2], v[j][3]); *(u32x2*)(xb + pg8::mt_off(row, 4 * (lane + 64 * j), DM)) = w;
              if (has2) { u32x2 w2; w2.x = cvt_pk_bf16(v2[j][0], v2[j][1]); w2.y = cvt_pk_bf16(v2[j][2], v2[j][3]); *(u32x2*)(xb + pg8::mt_off(row2, 4 * (lane + 64 * j), DM)) = w2; } }
#pragma unroll
          for (int o = 32; o >= 1; o >>= 1) { q += __shfl_xor(q, o); q2 += __shfl_xor(q2, o); }
          if (lane < 4) { ((f32x4*)(ssqm + (size_t)row * 16))[lane] = (f32x4){lane == 0 ? q : 0.f, 0.f, 0.f, 0.f};
              if (has2) ((f32x4*)(ssqm + (size_t)row2 * 16))[lane] = (f32x4){lane == 0 ? q2 : 0.f, 0.f, 0.f, 0.f}; }
      } }
}

constexpr int VT_PITCH = 136;
__device__ __forceinline__ void gate_conv_phase(const Params& p, int l, unsigned char* lds) {
    unsigned char* ws = p.ws;
    const float* lns = (const float*)(ws + WS_LNS);
    bf16_t* AB = (bf16_t*)(ws + WS_AB); const bf16_t* GV = (const bf16_t*)(ws + WS_GV); const bf16_t* CH = (const bf16_t*)(ws + WS_CH);
    const unsigned char* lw = ws + WS_W + (size_t)l * LW_BYTES;
    bf16_t* vT = (bf16_t*)lds;
    float* mr = (float*)(lds + 128 * VT_PITCH * 2);
    int tid = threadIdx.x; asm volatile("" : "+v"(tid));
    const int lane = tid & 63, w = tid >> 6, fr = lane & 15, fq = lane >> 4;
    const int jg = tid >> 5, cq = tid & 31;
    const int ci = tid & 15;
    const int nks = (w >> 1) + 1;
    const int total = (MT / 128) * 8;
    int item = blockIdx.x; if (item >= total) return;
    const int g = item & 7, c0 = g * 128, irow = 16 * w + fr;
    const bf16_t* WsP = (const bf16_t*)(lw + LW_WSP) + g * 16384 + irow * 128 + 8 * fq;
    bf16x8 wf[4];
#pragma unroll
    for (int ks = 0; ks < 4; ++ks) wf[ks] = *(const bf16x8*)(WsP + 32 * ks);
    float bs = p.b_s[(l * 8 + g) * 128 + irow];
    const float* cwp = p.conv_w + (size_t)l * 3 * DM + c0 + 8 * ci;
    bool was_smp = false;
    f32x4 sl0, sl1; u32x2 gv[8]; u32x4 uu[4];
#define GC_LOAD(it) do { const int r0_ = ((it) >> 3) * 128; \
        const f32x4* sl_ = (const f32x4*)(lns + (size_t)(r0_ + (tid >> 2)) * 32 + (tid & 3) * 8); sl0 = sl_[0]; sl1 = sl_[1]; \
        _Pragma("unroll") for (int jj = 0; jj < 8; ++jj) gv[jj] = *(const u32x2*)(GV + (size_t)(r0_ + 8 * jg + jj) * DM + c0 + 4 * cq); } while (0)
#define GC_LOADU(it) do { const int r0_ = ((it) >> 3) * 128; \
        _Pragma("unroll") for (int pp = 0; pp < 4; ++pp) uu[pp] = *(const u32x4*)(AB + pg8::mt_off(r0_ + irow, c0 + 8 * fq, 2048) + 512 * pp); } while (0)
    GC_LOAD(item); GC_LOADU(item);
    for (;;) {
        const int ct = item >> 3, row0 = ct * 128; const bool smp = ct >= MP / 128;
        if (smp && !was_smp) {
            const bf16_t* WsS = (const bf16_t*)(lw + LW_WSS) + g * 16384 + irow * 128 + 8 * fq;
#pragma unroll
            for (int ks = 0; ks < 4; ++ks) wf[ks] = *(const bf16x8*)(WsS + 32 * ks);
            bs = p.b_s[(l * 8 + g) * 128 + (irow & 31)]; was_smp = true; }
        bf16_t* rowp = AB + pg8::mt_off(row0 + irow, c0 + 8 * fq, 2048);
        const f32x4 lg = *(const f32x4*)(p.ln_g + l * DM + c0 + 4 * cq), lb = *(const f32x4*)(p.ln_b + l * DM + c0 + 4 * cq);
        { float sm = (sl0[0] + sl0[2]) + (sl1[0] + sl1[2]), sq = (sl0[1] + sl0[3]) + (sl1[1] + sl1[3]);
          sm += __shfl_xor(sm, 1); sq += __shfl_xor(sq, 1); sm += __shfl_xor(sm, 2); sq += __shfl_xor(sq, 2);
          if ((tid & 3) == 0) { const float mean = sm * (1.0f / 1024.0f), var = sq * (1.0f / 1024.0f) - mean * mean; mr[2 * (tid >> 2)] = mean; mr[2 * (tid >> 2) + 1] = __builtin_amdgcn_rsqf(fmaxf(var, 0.f) + EPS); } }
        __syncthreads();
        { float v[8][4];
#pragma unroll
          for (int jj = 0; jj < 8; ++jj) { const float mean = mr[2 * (8 * jg + jj)], rstd = mr[2 * (8 * jg + jj) + 1];
              v[jj][0] = (bf_lo(gv[jj].x) - mean) * rstd * lg[0] + lb[0]; v[jj][1] = (bf_hi(gv[jj].x) - mean) * rstd * lg[1] + lb[1];
              v[jj][2] = (bf_lo(gv[jj].y) - mean) * rstd * lg[2] + lb[2]; v[jj][3] = (bf_hi(gv[jj].y) - mean) * rstd * lg[3] + lb[3];
              if (smp) *(f32x4*)(p.out + OUT_V + ((size_t)l * MS + (row0 + 8 * jg + jj - MP)) * DM + c0 + 4 * cq) = (f32x4){v[jj][0], v[jj][1], v[jj][2], v[jj][3]}; }
#pragma unroll
          for (int e = 0; e < 4; ++e) { u32x4 wv; wv.x = cvt_pk_bf16(v[0][e], v[1][e]); wv.y = cvt_pk_bf16(v[2][e], v[3][e]); wv.z = cvt_pk_bf16(v[4][e], v[5][e]); wv.w = cvt_pk_bf16(v[6][e], v[7][e]);
              *(u32x4*)(vT + (4 * cq + e) * VT_PITCH + 8 * jg) = wv; } }
        u32x4 ch0[4], ch1[4], ch2[4], bg[4];
#pragma unroll
        for (int vv = 0; vv < 4; ++vv) { const int i = (tid >> 4) + 32 * vv, row = row0 + i, c = c0 + 8 * ci; const int pos = smp ? ((row - MP) & 31) : (row & 2047);
            const u32x4 z4 = {0u, 0u, 0u, 0u};
            ch0[vv] = *(const u32x4*)(CH + (size_t)row * DM + c);
            ch1[vv] = (pos >= 1) ? *(const u32x4*)(CH + (size_t)(row - 1) * DM + c) : z4;
            ch2[vv] = (pos >= 2) ? *(const u32x4*)(CH + (size_t)(row - 2) * DM + c) : z4;
            bg[vv] = *(const u32x4*)(AB + pg8::mt_off(row, 1024 + c, 2048)); }
        const int nitem = item + (int)gridDim.x; const bool has_next = nitem < total;
        if (has_next) GC_LOAD(nitem);
        __syncthreads();
        { f32x4 acc[8];
#pragma unroll
          for (int dt = 0; dt < 8; ++dt) acc[dt] = (f32x4){0.f, 0.f, 0.f, 0.f};
#pragma unroll
          for (int ks = 0; ks < 4; ++ks) if (ks < nks) {
#pragma unroll
              for (int dt = 0; dt < 8; ++dt) { const int d = 32 * (dt >> 1) + 8 * (fr >> 2) + 4 * (dt & 1) + (fr & 3);
                  const bf16x8 vf = *(const bf16x8*)(vT + d * VT_PITCH + 32 * ks + 8 * fq);
                  acc[dt] = __builtin_amdgcn_mfma_f32_16x16x32_bf16(vf, wf[ks], acc[dt], 0, 0, 0); } }
#pragma unroll
          for (int pp = 0; pp < 4; ++pp) { const f32x4 s0 = acc[2 * pp] + bs, s1 = acc[2 * pp + 1] + bs;
              const f32x4 u0 = {bf_lo(uu[pp][0]), bf_hi(uu[pp][0]), bf_lo(uu[pp][1]), bf_hi(uu[pp][1])}, u1 = {bf_lo(uu[pp][2]), bf_hi(uu[pp][2]), bf_lo(uu[pp][3]), bf_hi(uu[pp][3])};
              *(u32x4*)(rowp + 512 * pp) = pg8::pack8(u0 * s0, u1 * s1); } }
        if (has_next) GC_LOADU(nitem);
        const f32x4 w0a = *(const f32x4*)(cwp), w0b = *(const f32x4*)(cwp + 4), w1a = *(const f32x4*)(cwp + DM), w1b = *(const f32x4*)(cwp + DM + 4), w2a = *(const f32x4*)(cwp + 2 * DM), w2b = *(const f32x4*)(cwp + 2 * DM + 4);
#pragma unroll
        for (int vv = 0; vv < 4; ++vv) { const int i = (tid >> 4) + 32 * vv, row = row0 + i, c = c0 + 8 * ci; const int pos = smp ? ((row - MP) & 31) : (row & 2047);
            float f0[8], f1[8], f2[8], o[8];
#pragma unroll
            for (int e = 0; e < 4; ++e) { f0[2 * e] = bf_lo(ch0[vv][e]); f0[2 * e + 1] = bf_hi(ch0[vv][e]); f1[2 * e] = bf_lo(ch1[vv][e]); f1[2 * e + 1] = bf_hi(ch1[vv][e]); f2[2 * e] = bf_lo(ch2[vv][e]); f2[2 * e + 1] = bf_hi(ch2[vv][e]); }
            if (smp && pos < 2) { const int sq = (row - MP) >> 5; const float* stp = p.state_conv + ((size_t)(l * 32 + sq) * 2) * DM + c;
                if (pos == 0) { const f32x4 a = *(const f32x4*)(stp + DM), bq = *(const f32x4*)(stp + DM + 4); f1[0] = a[0]; f1[1] = a[1]; f1[2] = a[2]; f1[3] = a[3]; f1[4] = bq[0]; f1[5] = bq[1]; f1[6] = bq[2]; f1[7] = bq[3]; }
                { const float* s2 = stp + (pos == 0 ? 0 : DM); const f32x4 a = *(const f32x4*)(s2), bq = *(const f32x4*)(s2 + 4); f2[0] = a[0]; f2[1] = a[1]; f2[2] = a[2]; f2[3] = a[3]; f2[4] = bq[0]; f2[5] = bq[1]; f2[6] = bq[2]; f2[7] = bq[3]; } }
#pragma unroll
            for (int e = 0; e < 4; ++e) { o[e] = w0a[e] * f2[e] + w1a[e] * f1[e] + w2a[e] * f0[e]; o[4 + e] = w0b[e] * f2[4 + e] + w1b[e] * f1[4 + e] + w2b[e] * f0[4 + e]; }
            u32x4 ov;
#pragma unroll
            for (int e = 0; e < 4; ++e) ov[e] = cvt_pk_bf16(o[2 * e] * bf_lo(bg[vv][e]), o[2 * e + 1] * bf_hi(bg[vv][e]));
            *(u32x4*)(AB + pg8::mt_off(row, 1024 + c, 2048)) = ov;
            const int lastpos = smp ? 31 : 2047;
            if (pos >= lastpos - 1) { float* op = smp ? p.out + OUT_NCS + (((size_t)l * 32 + ((row - MP) >> 5)) * 2 + (pos - (lastpos - 1))) * DM + c
                                                      : p.out + OUT_NCP + (((size_t)l * 32 + (row >> 11)) * 2 + (pos - (lastpos - 1))) * DM + c;
                *(f32x4*)op = (f32x4){f0[0], f0[1], f0[2], f0[3]}; *(f32x4*)(op + 4) = (f32x4){f0[4], f0[5], f0[6], f0[7]}; } }
        __syncthreads();
        if (!has_next) break;
        item = nitem;
    }
#undef GC_LOAD
#undef GC_LOADU
}

__device__ __forceinline__ void final_norm_phase(const Params& p) {
    const float* __restrict__ ssq = (const float*)(p.ws + WS_SSQM); const bf16_t* __restrict__ xb = (const bf16_t*)(p.ws + WS_XB); float* __restrict__ out = p.out;
    const size_t n8 = (size_t)MT * DM / 8;
    int tid = threadIdx.x; asm volatile("" : "+v"(tid));
    const size_t stride = (size_t)gridDim.x * 512;
    const int c = (tid & 127) * 8;
    const f32x4 g0 = *(const f32x4*)(p.norm_final + c), g1 = *(const f32x4*)(p.norm_final + c + 4);
    for (size_t i = (size_t)blockIdx.x * 512 + tid; i < n8; i += 4 * stride) {
        u32x4 w[4]; f32x4 s0[4], s1[4], s2[4], s3[4];
#pragma unroll
        for (int k = 0; k < 4; ++k) { const size_t ii = i + k * stride; if (ii < n8) { w[k] = *(const u32x4*)(xb + pg8::mt_off((int)(ii >> 7), c, DM)); const f32x4* s = (const f32x4*)(ssq + (ii >> 7) * 16); s0[k] = s[0]; s1[k] = s[1]; s2[k] = s[2]; s3[k] = s[3]; } }
#pragma unroll
        for (int k = 0; k < 4; ++k) { const size_t ii = i + k * stride; if (ii < n8) { const f32x4 t = (s0[k] + s1[k]) + (s2[k] + s3[k]);
            const float rs = __builtin_amdgcn_rsqf(((t[0] + t[1]) + (t[2] + t[3])) * (1.0f / 1024.0f) + EPS);
            ((f32x4*)out)[2 * ii] = pg8::unpk_lo(w[k]) * rs * g0; ((f32x4*)out)[2 * ii + 1] = pg8::unpk_hi(w[k]) * rs * g1; } }
    }
}

#define LAS __attribute__((address_space(3)))
#define XB_TMO      128
#define XB_XCNT(j)  (256  + 64 * (j))
#define XB_XSUB(j)  (1280 + 64 * (j))
#define XB_XGEN(j)  (2304 + 64 * (j))
#define XB_TOP      3328
#define XB_TOPGEN   3392
#define XCD_BAR_WORDS 3456
#define XB_SPIN_CAP (1u << 18)

__device__ __forceinline__ unsigned xb_ld(unsigned* p)              { return __hip_atomic_load(p, __ATOMIC_RELAXED, __HIP_MEMORY_SCOPE_AGENT); }
__device__ __forceinline__ unsigned xb_add(unsigned* p, unsigned v) { return __hip_atomic_fetch_add(p, v, __ATOMIC_RELAXED, __HIP_MEMORY_SCOPE_AGENT); }
__device__ __forceinline__ unsigned xb_xcc_id() { return (unsigned)__builtin_amdgcn_s_getreg((3 << 11) | 20) & 0xFu; }
#define XB_SPIN(cond, bar) do { unsigned _sp = 0; while (cond) { __builtin_amdgcn_s_sleep(1); \
    if ((++_sp & 255u) == 0u) { if (xb_ld(&(bar)[XB_TMO])) break; if (_sp > XB_SPIN_CAP) { atomicAdd(&(bar)[XB_TMO], 1u); break; } } } } while (0)

struct XcdBarrier {
    unsigned* bar; unsigned x;
    volatile LAS unsigned* st;
};

__device__ __forceinline__ XcdBarrier xcd_barrier_post(unsigned* bar, volatile LAS unsigned* st) {
    XcdBarrier b; b.bar = bar; b.x = xb_xcc_id(); b.st = st;
    if (threadIdx.x == 0) (void)xb_add(&bar[XB_XCNT(b.x)], 1u);
    return b;
}
__device__ __forceinline__ void xcd_barrier_complete(unsigned* bar, unsigned x, unsigned& nloc, unsigned& nx) {
    const unsigned G = gridDim.x * gridDim.y * gridDim.z;
    unsigned sum, cnt, mine, sp = 0u;
    for (;;) {
        sum = 0u; cnt = 0u; mine = 0u;
#pragma unroll
        for (unsigned j = 0; j < 16; ++j) { const unsigned c = xb_ld(&bar[XB_XCNT(j)]); sum += c; cnt += (c > 0u) ? 1u : 0u; mine = (j == x) ? c : mine; }
        if (sum == G) break;
        __builtin_amdgcn_s_sleep(1);
        if ((++sp & 255u) == 0u) { if (xb_ld(&bar[XB_TMO])) break; if (sp > XB_SPIN_CAP) { atomicAdd(&bar[XB_TMO], 1u); break; } }
    }
    nloc = mine > 0u ? mine : 1u; nx = cnt > 0u ? cnt : 1u;
}

__device__ __forceinline__ void xcd_barrier(const XcdBarrier& b) {
    asm volatile("s_waitcnt vmcnt(0)" ::: "memory");
    __syncthreads();
    if (threadIdx.x == 0) {
        unsigned* bar = b.bar;
        __builtin_amdgcn_s_waitcnt(0);
        unsigned nloc = b.st[0], nx = b.st[1];
        if (nloc == 0u) { xcd_barrier_complete(bar, b.x, nloc, nx); b.st[0] = nloc; b.st[1] = nx; }
        const unsigned old = xb_add(&bar[XB_XSUB(b.x)], 1u);
        const unsigned gen = old / nloc;
        if (old + 1u == (gen + 1u) * nloc) {
            __builtin_amdgcn_fence(__ATOMIC_RELEASE, "agent");
            asm volatile("s_waitcnt vmcnt(0)" ::: "memory");
            const unsigned og = xb_add(&bar[XB_TOP], 1u);
            const unsigned tg = og / nx;
            if (og + 1u == (tg + 1u) * nx) xb_add(&bar[XB_TOPGEN], 1u);
            else XB_SPIN(xb_ld(&bar[XB_TOPGEN]) == tg, bar);
            __builtin_amdgcn_fence(__ATOMIC_ACQUIRE, "agent");
            xb_add(&bar[XB_XGEN(b.x)], 1u);
            asm volatile("s_waitcnt vmcnt(0)" ::: "memory");
        } else {
            XB_SPIN(xb_ld(&bar[XB_XGEN(b.x)]) == gen, bar);
            __builtin_amdgcn_fence(__ATOMIC_ACQUIRE, "agent");
            asm volatile("s_waitcnt vmcnt(0)" ::: "memory");
        }
    }
    __syncthreads();
}

__global__ void __launch_bounds__(512, 2) mk_fwd(Params p) {
    extern __shared__ __attribute__((aligned(16))) unsigned char lds[];
    unsigned char* ws0 = p.ws;
    PG8_LAS unsigned char* ring = (PG8_LAS unsigned char*)lds;
#if MK_MULTI
#define GRID_SYNC() do { } while (0)
#else
    cg::grid_group grid = cg::this_grid();
    volatile LAS unsigned* bst = (volatile LAS unsigned*)((LAS unsigned char*)lds + pg8::STAGE_BYTES);
    if (threadIdx.x < 2) bst[threadIdx.x] = 0u;
    __syncthreads();
    XcdBarrier xbar = xcd_barrier_post((unsigned*)(ws0 + WS_CTL), bst);
#define GRID_SYNC() do { if (p.ph_hi > 100000) grid.sync(); else xcd_barrier(xbar); } while (0)
#endif
    for (int ph = p.ph_lo; ph < p.ph_hi; ++ph) {
        unsigned char* ws = ws0; int G = gridDim.x, c = blockIdx.x; asm volatile("" : "+s"(ws), "+s"(G), "+s"(c));
        float* ssq_mix = (float*)(ws + WS_SSQM); float* ssq_ffn = (float*)(ws + WS_SSQF); float* lns = (float*)(ws + WS_LNS);
        bf16_t* XB = (bf16_t*)(ws + WS_XB); bf16_t* AB = (bf16_t*)(ws + WS_AB); bf16_t* GV = (bf16_t*)(ws + WS_GV); bf16_t* CH = (bf16_t*)(ws + WS_CH);
        bf16_t* T12 = GV; bf16_t* MMb = AB; bf16_t* Hb = AB;
        int cl = -1, cf = 0;
        if (ph == 0) { cl = 0; }
        else if (ph == NPHASE - 1) { if (PHASE_MASK & 2) final_norm_phase(p); }
        else {
            const int l = (ph - 1) / 7, s = (ph - 1) % 7;
            for (int rep_ = 0; rep_ < (((PROBE_DUP >> s) & 1) ? 2 : 1); ++rep_) {
            const unsigned char* lw = ws + WS_W + (size_t)l * LW_BYTES;
            if (s == 0) { if (PHASE_MASK & 4) {
                pg8::Gemm g{XB, (const bf16_t*)(lw + LW_WIN), MT, 5120, DM, DM, 1 << 30, 0}; pg8::StaticOrder S; S.init(MT, 5120, G, c);
                pg8::EpiA E{AB, GV, CH, ssq_mix, lns};
                pg8::gemm_phase<pg8::EpiA, pg8::StaticOrder>(ring, g, S, E); }
            } else if (s == 1) {
                if (PHASE_MASK & 8) gate_conv_phase(p, l, lds);
            } else if (s == 2) { if (PHASE_MASK & 16) {
                pg8::Gemm g{AB, (const bf16_t*)(lw + LW_WPAB), MT, 2048, DM, 2048, 4, 1024}; pg8::StaticOrder S; S.init(MT, 2048, G, c);
                pg8::EpiC E{T12};
                pg8::gemm_phase<pg8::EpiC, pg8::StaticOrder>(ring, g, S, E); }
            } else if (s == 3) { if (PHASE_MASK & 32) {
                pg8::Gemm g{XB, (const bf16_t*)(lw + LW_WIN) + (size_t)5120 * DM, MT, 2048, DM, DM, 1 << 30, 0}; pg8::StaticOrder S; S.init(MT, 2048, G, c);
                pg8::EpiD E{T12, MMb, ssq_mix};
                pg8::gemm_phase<pg8::EpiD, pg8::StaticOrder>(ring, g, S, E); }
            } else if (s == 4) { if (PHASE_MASK & 64) {
                pg8::Gemm g{MMb, (const bf16_t*)(lw + LW_WO), MT, DM, DM, DM, 1 << 30, 0}; pg8::StaticOrder S; S.init(MT, DM, G, c);
                pg8::EpiRes E{XB, ssq_ffn};
                pg8::gemm_phase<pg8::EpiRes, pg8::StaticOrder>(ring, g, S, E); }
            } else if (s == 5) { if (PHASE_MASK & 128) {
                pg8::Gemm g{XB, (const bf16_t*)(lw + LW_WGU), MT, 2 * DFF, DM, DM, 1 << 30, 0}; pg8::StaticOrder S; S.init(MT, 2 * DFF, G, c);
                pg8::EpiF E{Hb, ssq_ffn};
                pg8::gemm_phase<pg8::EpiF, pg8::StaticOrder>(ring, g, S, E); }
            } else { if (PHASE_MASK & 256) {
                pg8::Gemm g{Hb, (const bf16_t*)(lw + LW_WD), MT, DM, DFF, DFF, 1 << 30, 0}; pg8::StaticOrder S; S.init(MT, DM, G, c);
                pg8::EpiRes E{XB, ssq_mix};
                pg8::gemm_phase<pg8::EpiRes, pg8::StaticOrder>(ring, g, S, E);
                if (l + 1 < NL) { cl = l + 1; cf = S.ntot - S.nwg; } }
            }
            }
        }
        if (cl >= 0) p0_prologue(p, (float*)lds, cl, cf, ph == 0);
        if (ph + 1 < p.ph_hi) { GRID_SYNC(); }
    }
}

extern "C" void kernel_launch(void* const* d_in, const int* in_sizes, int n_in, void* d_out, int out_size, void* d_ws, size_t ws_size, hipStream_t stream) {
    static int grid = 0;
    if (grid == 0) {
        if (n_in != 18 || in_sizes[0] != MP * DM || (size_t)out_size != OUT_TOTAL || ws_size < WS_END) {
            fprintf(stderr, "kernel_launch: unexpected shapes: n_in %d in0 %d out %d ws %zu (need %zu)\n", n_in, n_in > 0 ? in_sizes[0] : -1, out_size, ws_size, (size_t)WS_END); grid = -1; return; }
        int dev = 0, cus = 0, per_cu = 0;
        (void)hipGetDevice(&dev); (void)hipDeviceGetAttribute(&cus, hipDeviceAttributeMultiprocessorCount, dev);
        if (hipFuncSetAttribute((const void*)mk_fwd, hipFuncAttributeMaxDynamicSharedMemorySize, LDS_BYTES) != hipSuccess) { fprintf(stderr, "kernel_launch: hipFuncSetAttribute failed\n"); grid = -1; return; }
        if (hipOccupancyMaxActiveBlocksPerMultiprocessor(&per_cu, (const void*)mk_fwd, 512, LDS_BYTES) != hipSuccess || per_cu < 1) { fprintf(stderr, "kernel_launch: occupancy query says %d\n", per_cu); per_cu = 1; }
        (void)hipGetLastError();
        grid = cus * 1;
        fprintf(stderr, "kernel_launch: cus %d per_cu %d grid %d\n", cus, per_cu, grid);
    }
    if (grid < 0) return;
    if (hipMemsetAsync((char*)d_ws + WS_CTL, 0, CTL_BYTES, stream) != hipSuccess) { fprintf(stderr, "kernel_launch: memset failed\n"); return; }
    Params p{};
    const float** pp = (const float**)&p;
    for (int i = 0; i < 18; ++i) pp[i] = (const float*)d_in[i];
    p.out = (float*)d_out; p.ws = (unsigned char*)d_ws;
#if MK_MULTI
    for (int ph = 0; ph < NPHASE; ++ph) { p.ph_lo = ph; p.ph_hi = ph + 1; hipLaunchKernelGGL(mk_fwd, dim3(grid), dim3(512), LDS_BYTES, stream, p); }
#else
    p.ph_lo = 0; p.ph_hi = NPHASE;
    void* args[] = {&p};
    hipError_t e = hipLaunchCooperativeKernel((const void*)mk_fwd, dim3(grid), dim3(512), args, LDS_BYTES, stream);
    if (e != hipSuccess) fprintf(stderr, "kernel_launch: cooperative launch failed: %s (grid %d)\n", hipGetErrorString(e), grid);
#endif
}
```

```cpp
#include <hip/hip_runtime.h>
#include <hip/hip_cooperative_groups.h>
#include <cstdio>
#include <cstdint>
namespace cg = cooperative_groups;

#ifndef PHASE_MASK
#define PHASE_MASK 511
#endif
#ifndef PROBE_DUP
#define PROBE_DUP 0
#endif
#ifndef MK_MULTI
#define MK_MULTI 0
#endif

constexpr int MP = 65536, MS = 1024, MT = MP + MS, DM = 1024, NL = 4, DFF = 2816, NIN = 7168;
constexpr float EPS = 1e-6f;
constexpr size_t OUT_YS = (size_t)MP * DM, OUT_NCP = OUT_YS + (size_t)MS * DM, OUT_NCS = OUT_NCP + (size_t)NL * 32 * 2 * DM, OUT_V = OUT_NCS + (size_t)NL * 32 * 2 * DM;
constexpr size_t OUT_TOTAL = OUT_V + (size_t)NL * 32 * 32 * DM;

constexpr size_t MiB = (size_t)1 << 20;
constexpr size_t WS_SSQM = 0, WS_SSQF = 5 * MiB, WS_LNS = 10 * MiB;
constexpr size_t WS_CTL = 20 * MiB, CTL_BYTES = 16384;
constexpr size_t WS_W = 24 * MiB;
constexpr size_t LW_WIN = 0, LW_WPAB = LW_WIN + (size_t)NIN * DM * 2, LW_WO = LW_WPAB + (size_t)2048 * DM * 2, LW_WGU = LW_WO + (size_t)DM * DM * 2,
                 LW_WD = LW_WGU + (size_t)2 * DFF * DM * 2, LW_WSP = LW_WD + (size_t)DM * DFF * 2, LW_WSS = LW_WSP + (size_t)8 * 128 * 128 * 2, LW_BYTES = LW_WSS + (size_t)8 * 128 * 128 * 2;
constexpr size_t WS_XB = 176 * MiB;
constexpr size_t WS_AB = 306 * MiB;
constexpr size_t WS_GV = 566 * MiB;
constexpr size_t WS_CH = 696 * MiB;
constexpr size_t WS_END = 826 * MiB;
static_assert(WS_W + NL * LW_BYTES <= WS_XB, "weights overflow");

namespace pg8 {
#define PG8_LAS __attribute__((address_space(3)))
typedef unsigned short bf16_t;
typedef short bf16x8 __attribute__((ext_vector_type(8)));
typedef float f32x4 __attribute__((ext_vector_type(4)));
typedef float f32x2 __attribute__((ext_vector_type(2)));
typedef unsigned u32x4 __attribute__((ext_vector_type(4)));
typedef unsigned u32x2 __attribute__((ext_vector_type(2)));
constexpr int BM = 256, BK = 64, HALF = 128, HTB = HALF * BK * 2, STAGE_BYTES = 8 * HTB, NXCD = 8, WGM = 8;

__host__ __device__ __forceinline__ int lds_byte(int r, int c) { const int st = (r >> 4) * 2 + (c >> 5), rr = r & 15, cc = c & 31, ob = rr * 64 + cc * 2; return st * 1024 + (ob ^ (((ob >> 9) & 1) << 5)); }
__host__ __device__ __forceinline__ void stage_rc(int b, int& R, int& C) { const int st = b / 1024, sb = b % 1024, swz = sb ^ (((sb >> 9) & 1) << 5); R = (st >> 1) * 16 + swz / 64; C = (st & 1) * 32 + (swz % 64) / 2; }
__host__ __device__ __forceinline__ int perm32(int rho) { const int n = rho >> 4, i = rho & 15; return 8 * (i >> 2) + 4 * n + (i & 3); }

struct Unit { int pm, pn, half, rbase; };
struct Gemm { const bf16_t* A; const bf16_t* Bt; int M, N, K, lda, asplit_pn, asplit_off; };

struct StaticOrder {
    int nM, nN, nwg, G, c, ntot;
    __host__ __device__ void init(int M, int N, int G_, int c_) { nM = MP / BM; nN = N / BM; nwg = nM * nN; G = G_; c = c_; ntot = nwg + 2 * ((M / BM) - nM) * nN; }
    __host__ __device__ bool next(int i, Unit& u) const {
        const long L = (long)i * G + c; if (L >= ntot) return false;
        if (L >= nwg) { const int h = (int)L - nwg, hp = h / nN; u.pn = h - hp * nN; u.pm = nM + (hp >> 1); u.half = 1; u.rbase = u.pm * BM + (hp & 1) * HALF; return true; }
        int wgid = (int)L; { const int q = nwg / NXCD, r = nwg % NXCD, xcd = wgid % NXCD, off = wgid / NXCD; wgid = (xcd < r ? xcd * (q + 1) : r * (q + 1) + (xcd - r) * q) + off; }
        const int nig = WGM * nN, gid = wgid / nig, fm = gid * WGM, gsz = (nM - fm) < WGM ? (nM - fm) : WGM;
        u.pm = fm + ((wgid % nig) % gsz); u.pn = (wgid % nig) / gsz; u.half = 0; u.rbase = u.pm * BM; return true;
    }
    __device__ __forceinline__ void a_ready(const Unit&) const {}
    __device__ __forceinline__ void done(const Unit&) const {}
};

__host__ __device__ __forceinline__ size_t mt_off(int row, int col, int ncols) { return ((size_t)((row >> 4) * (ncols >> 5) + (col >> 5)) << 9) + (size_t)(((row & 15) << 5) + (col & 31)); }
__device__ __forceinline__ unsigned cvt_pk_bf16(float lo, float hi) { unsigned r; asm volatile("v_cvt_pk_bf16_f32 %0, %1, %2" : "=v"(r) : "v"(lo), "v"(hi)); return r; }
__device__ __forceinline__ float bf_lo(unsigned w) { return __uint_as_float(w << 16); }
__device__ __forceinline__ float bf_hi(unsigned w) { return __uint_as_float(w & 0xffff0000u); }
__device__ __forceinline__ f32x2 gelu_pk(f32x2 v) {
    const f32x2 av = __builtin_elementwise_abs(v), d = av * 0.2316418882f + 1.0f;
    f32x2 t; t.x = __builtin_amdgcn_rcpf(d.x); t.y = __builtin_amdgcn_rcpf(d.y);
    f32x2 q = t * 0.5307027145f + (-0.7265760135f); q = q * t + 0.7107068705f; q = q * t + (-0.142248368f); q = q * t + 0.127414796f; q = q * t;
    const f32x2 s = (v * v) * (-0.72134752044f);
    f32x2 e; e.x = __builtin_amdgcn_exp2f(s.x); e.y = __builtin_amdgcn_exp2f(s.y);
    const f32x2 m = v * (q * e), r = v - m;
    f32x2 o; o.x = v.x < 0.f ? m.x : r.x; o.y = v.y < 0.f ? m.y : r.y; return o;
}
__device__ __forceinline__ f32x4 gelu4(f32x4 v) { const f32x2 a = gelu_pk((f32x2){v[0], v[1]}), b = gelu_pk((f32x2){v[2], v[3]}); return (f32x4){a.x, a.y, b.x, b.y}; }
__device__ __forceinline__ float sigmoidf_(float x) { return __builtin_amdgcn_rcpf(1.0f + __builtin_amdgcn_exp2f(x * -1.44269504f)); }
__device__ __forceinline__ f32x4 sigmoid4(f32x4 v) { return (f32x4){sigmoidf_(v[0]), sigmoidf_(v[1]), sigmoidf_(v[2]), sigmoidf_(v[3])}; }
__device__ __forceinline__ u32x4 pack8(f32x4 v0, f32x4 v1) { u32x4 w; w.x = cvt_pk_bf16(v0[0], v0[1]); w.y = cvt_pk_bf16(v0[2], v0[3]); w.z = cvt_pk_bf16(v1[0], v1[1]); w.w = cvt_pk_bf16(v1[2], v1[3]); return w; }
__device__ __forceinline__ float rstd_of(const float* slots, int row) { const f32x4* s = (const f32x4*)(slots + (size_t)row * 16); const f32x4 t = (s[0] + s[1]) + (s[2] + s[3]);
    return __builtin_amdgcn_rsqf(((t[0] + t[1]) + (t[2] + t[3])) * (1.0f / 1024.0f) + EPS); }

__device__ __forceinline__ void wave_rstd(const float* slots, int rowbase, int lane, int fr, float (&rs)[2][4]) {
    float val[2];
    const f32x4* sa = (const f32x4*)(slots + (size_t)(rowbase + lane) * 16); const f32x4* sb = (const f32x4*)(slots + (size_t)(rowbase + HALF + lane) * 16);
    const f32x4 a0 = sa[0], a1 = sa[1], a2 = sa[2], a3 = sa[3], b0 = sb[0], b1 = sb[1], b2 = sb[2], b3 = sb[3];
    __builtin_amdgcn_sched_barrier(0);
    { const f32x4 t = (a0 + a1) + (a2 + a3); val[0] = __builtin_amdgcn_rsqf(((t[0] + t[1]) + (t[2] + t[3])) * (1.0f / 1024.0f) + EPS); }
    { const f32x4 t = (b0 + b1) + (b2 + b3); val[1] = __builtin_amdgcn_rsqf(((t[0] + t[1]) + (t[2] + t[3])) * (1.0f / 1024.0f) + EPS); }
#pragma unroll
    for (int ai = 0; ai < 2; ++ai)
#pragma unroll
        for (int m = 0; m < 4; ++m) rs[ai][m] = __shfl(val[ai], m * 16 + fr);
}
__device__ __forceinline__ f32x4 unpk_lo(u32x4 w) { return (f32x4){bf_lo(w[0]), bf_hi(w[0]), bf_lo(w[1]), bf_hi(w[1])}; }
__device__ __forceinline__ f32x4 unpk_hi(u32x4 w) { return (f32x4){bf_lo(w[2]), bf_hi(w[2]), bf_lo(w[3]), bf_hi(w[3])}; }

struct EpiA {
    static constexpr bool PERM = true, AFTER_DRAIN = false; static constexpr int NVM = 16;

    bf16_t* AB; bf16_t* GV; bf16_t* CH; const float* ssq; float* lns;
    __device__ __forceinline__ void operator()(const f32x4 (&acc)[2][2][4][2], const Unit& u, int wr, int wc, int fr, int fq) const {
        const int row0 = u.rbase + wr * 64 + fr, cw = wc * 32 + 8 * fq, pn = u.pn;
        float rsv[2][4]; wave_rstd(ssq, u.rbase + wr * 64, fr + 16 * fq, fr, rsv);
        if (pn < 4) {
#pragma unroll
            for (int ai = 0; ai < 2; ++ai)
#pragma unroll
                for (int m = 0; m < 4; ++m) { if (ai == 1 && u.half) continue; const int row = row0 + ai * HALF + m * 16; const float rs = rsv[ai][m]; bf16_t* rowp = AB + mt_off(row, pn * 256 + cw, 2048);
#pragma unroll
                    for (int bj = 0; bj < 2; ++bj) *(u32x4*)(rowp + bj * 4 * 512) = pack8(gelu4(acc[ai][bj][m][0] * rs), gelu4(acc[ai][bj][m][1] * rs)); }
        } else if (pn < 8) {
#pragma unroll
            for (int ai = 0; ai < 2; ++ai)
#pragma unroll
                for (int m = 0; m < 4; ++m) { if (ai == 1 && u.half) continue; const int row = row0 + ai * HALF + m * 16; const float rs = rsv[ai][m]; bf16_t* rowp = GV + mt_off(row, (pn - 4) * 256 + cw, 1024);
                    float s = 0.f, q = 0.f;
#pragma unroll
                    for (int bj = 0; bj < 2; ++bj) { const u32x4 w = pack8(gelu4(acc[ai][bj][m][0] * rs), gelu4(acc[ai][bj][m][1] * rs)); *(u32x4*)(rowp + bj * 4 * 512) = w;
#pragma unroll
                        for (int e = 0; e < 4; ++e) { const float a = bf_lo(w[e]), b = bf_hi(w[e]); s += a + b; q += a * a + b * b; } }
                    s += __shfl_xor(s, 16); s += __shfl_xor(s, 32); q += __shfl_xor(q, 16); q += __shfl_xor(q, 32);
                    if (fq == 0) *(f32x2*)(lns + ((size_t)row * 16 + (pn - 4) * 4 + wc) * 2) = (f32x2){s, q}; }
        } else if (pn < 12) {
#pragma unroll
            for (int ai = 0; ai < 2; ++ai)
#pragma unroll
                for (int m = 0; m < 4; ++m) { if (ai == 1 && u.half) continue; const int row = row0 + ai * HALF + m * 16; const float rs = rsv[ai][m]; bf16_t* rowp = AB + mt_off(row, 1024 + (pn - 8) * 256 + cw, 2048);
#pragma unroll
                    for (int bj = 0; bj < 2; ++bj) *(u32x4*)(rowp + bj * 4 * 512) = pack8(acc[ai][bj][m][0] * rs, acc[ai][bj][m][1] * rs); }
        } else {
#pragma unroll
            for (int ai = 0; ai < 2; ++ai)
#pragma unroll
                for (int m = 0; m < 4; ++m) { if (ai == 1 && u.half) continue; const int row = row0 + ai * HALF + m * 16; const float rs = rsv[ai][m]; const float rs2 = rs * rs;
                    *(u32x4*)(CH + mt_off(row, (pn - 12) * 128 + cw, 1024)) = pack8(acc[ai][0][m][0] * acc[ai][1][m][0] * rs2, acc[ai][0][m][1] * acc[ai][1][m][1] * rs2); }
        }
    }
};
struct EpiC {
    static constexpr bool PERM = true, AFTER_DRAIN = false; static constexpr int NVM = 16;

    bf16_t* T;
    __device__ __forceinline__ void operator()(const f32x4 (&acc)[2][2][4][2], const Unit& u, int wr, int wc, int fr, int fq) const {
        const int row0 = u.rbase + wr * 64 + fr, cw = u.pn * 256 + wc * 32 + 8 * fq;
#pragma unroll
        for (int ai = 0; ai < 2; ++ai)
#pragma unroll
            for (int m = 0; m < 4; ++m) { if (ai == 1 && u.half) continue; bf16_t* rowp = T + mt_off(row0 + ai * HALF + m * 16, cw, 2048);
#pragma unroll
                for (int bj = 0; bj < 2; ++bj) *(u32x4*)(rowp + bj * 4 * 512) = pack8(acc[ai][bj][m][0], acc[ai][bj][m][1]); }
    }
};
struct EpiD {
    static constexpr bool PERM = true, AFTER_DRAIN = false; static constexpr int NVM = 24;

    const bf16_t* T; bf16_t* MM; const float* ssq;
    __device__ __forceinline__ void operator()(const f32x4 (&acc)[2][2][4][2], const Unit& u, int wr, int wc, int fr, int fq) const {
        const int row0 = u.rbase + wr * 64 + fr, cw = u.pn * 128 + wc * 32 + 8 * fq;
        u32x4 tt[4][2];
#pragma unroll
        for (int m = 0; m < 4; ++m) { const bf16_t* tp = T + mt_off(row0 + m * 16, cw, 2048); tt[m][0] = *(const u32x4*)tp; tt[m][1] = *(const u32x4*)(tp + 32 * 512); }
        float rsv[2][4]; wave_rstd(ssq, u.rbase + wr * 64, fr + 16 * fq, fr, rsv);
#pragma unroll
        for (int ai = 0; ai < 2; ++ai) {
            if (ai == 1 && u.half) break;
            if (ai == 1) {
#pragma unroll
                for (int m = 0; m < 4; ++m) { const bf16_t* tp = T + mt_off(row0 + HALF + m * 16, cw, 2048); tt[m][0] = *(const u32x4*)tp; tt[m][1] = *(const u32x4*)(tp + 32 * 512); } }
#pragma unroll
            for (int m = 0; m < 4; ++m) { const int row = row0 + ai * HALF + m * 16; const float rs = rsv[ai][m];
                const u32x4 t1 = tt[m][0], t2 = tt[m][1];
                const f32x4 a0 = sigmoid4(acc[ai][0][m][0] * rs), a1 = sigmoid4(acc[ai][0][m][1] * rs), b0 = sigmoid4(acc[ai][1][m][0] * rs), b1 = sigmoid4(acc[ai][1][m][1] * rs);
                const f32x4 p0 = {bf_lo(t1[0]), bf_hi(t1[0]), bf_lo(t1[1]), bf_hi(t1[1])}, p1 = {bf_lo(t1[2]), bf_hi(t1[2]), bf_lo(t1[3]), bf_hi(t1[3])};
                const f32x4 q0 = {bf_lo(t2[0]), bf_hi(t2[0]), bf_lo(t2[1]), bf_hi(t2[1])}, q1 = {bf_lo(t2[2]), bf_hi(t2[2]), bf_lo(t2[3]), bf_hi(t2[3])};
                *(u32x4*)(MM + mt_off(row, cw, 1024)) = pack8(a0 * p0 + b0 * q0, a1 * p1 + b1 * q1); }
            asm volatile("" ::: "memory");
        }
    }
};
struct EpiRes {
    static constexpr bool PERM = true, AFTER_DRAIN = false; static constexpr int NVM = 24;

    bf16_t* xb; float* ssq;
    __device__ __forceinline__ void operator()(const f32x4 (&acc)[2][2][4][2], const Unit& u, int wr, int wc, int fr, int fq) const {
        const int row0 = u.rbase + wr * 64 + fr, cw = u.pn * BM + wc * 32 + 8 * fq;
#pragma unroll
        for (int ai = 0; ai < 2; ++ai) {
            if (ai == 1 && u.half) break;
            u32x4 xo[4][2];
#pragma unroll
            for (int m = 0; m < 4; ++m)
#pragma unroll
                for (int bj = 0; bj < 2; ++bj) xo[m][bj] = *(const u32x4*)(xb + mt_off(row0 + ai * HALF + m * 16, cw + bj * HALF, DM));
#pragma unroll
            for (int m = 0; m < 4; ++m) { const int row = row0 + ai * HALF + m * 16; float q = 0.f;
#pragma unroll
                for (int bj = 0; bj < 2; ++bj) { const u32x4 w = pack8(acc[ai][bj][m][0] + unpk_lo(xo[m][bj]), acc[ai][bj][m][1] + unpk_hi(xo[m][bj]));
                    *(u32x4*)(xb + mt_off(row, cw + bj * HALF, DM)) = w;
#pragma unroll
                    for (int e = 0; e < 4; ++e) { const float a = bf_lo(w[e]), b = bf_hi(w[e]); q += a * a + b * b; } }
                q += __shfl_xor(q, 16); q += __shfl_xor(q, 32);
                if (fq == 0) ssq[(size_t)row * 16 + u.pn * 4 + wc] = q; }
            asm volatile("" ::: "memory");
        }
    }
};
struct EpiF {
    static constexpr bool PERM = true, AFTER_DRAIN = false; static constexpr int NVM = 16;

    bf16_t* H; const float* ssq;
    __device__ __forceinline__ void operator()(const f32x4 (&acc)[2][2][4][2], const Unit& u, int wr, int wc, int fr, int fq) const {
        const int row0 = u.rbase + wr * 64 + fr, cw = u.pn * 128 + wc * 32 + 8 * fq;
        float rsv[2][4]; wave_rstd(ssq, u.rbase + wr * 64, fr + 16 * fq, fr, rsv);
#pragma unroll
        for (int ai = 0; ai < 2; ++ai)
#pragma unroll
            for (int m = 0; m < 4; ++m) { if (ai == 1 && u.half) continue; const int row = row0 + ai * HALF + m * 16; const float rs = rsv[ai][m];
                const f32x4 g0 = acc[ai][0][m][0] * rs, g1 = acc[ai][0][m][1] * rs, u0 = acc[ai][1][m][0] * rs, u1 = acc[ai][1][m][1] * rs;
                *(u32x4*)(H + mt_off(row, cw, DFF)) = pack8(g0 * sigmoid4(g0) * u0, g1 * sigmoid4(g1) * u1); }
    }
};

#ifndef PG8_SP2
#define PG8_SP2 true
#endif
#ifndef PG8_ALIGN
#define PG8_ALIGN true
#endif
template <class Epi, class Sched, bool SP2 = PG8_SP2, bool ALIGN_EPI = PG8_ALIGN>
__device__ __forceinline__ void gemm_phase(PG8_LAS unsigned char* lds, const Gemm g, const Sched& S, const Epi& E) {
    int tid = threadIdx.x; asm volatile("" : "+v"(tid));
    const int wid = __builtin_amdgcn_readfirstlane(tid >> 6), lane = tid & 63, wr = wid >> 2, wc = wid & 3, fr = lane & 15, fq = lane >> 4;
    const int K = g.K, nt = K / BK, lda = g.lda;
    unsigned voffA[2], voffB[2];
#pragma unroll
    for (int i = 0; i < 2; ++i) { int R, C; stage_rc(tid * 16 + i * 8192, R, C); const int Rb = Epi::PERM ? ((R & ~31) + perm32(R & 31)) : R;
        (void)Rb; static_assert(Epi::PERM, "the weight copies are stored with the 32-row permutation baked in");
        voffA[i] = (unsigned)mt_off(R, C, lda) * 2u; voffB[i] = (unsigned)mt_off(R, C, K) * 2u; }
    const size_t kstep = (size_t)2048;
    const size_t hstepA = (size_t)HALF * lda * 2, hstepB = (size_t)HALF * K * 2;
    const size_t tstepA = 2 * hstepA, tstepB = 2 * hstepB;
    const unsigned ldsw = (unsigned)wid * 1024u;
    const int aoff = lds_byte(wr * 64 + fr, fq * 8), boff = lds_byte(wc * 32 + fr, fq * 8);
#define PG8_SA(b, h) (((b) * 2 + (h)) * HTB)
#define PG8_SB(b, h) ((4 + (b) * 2 + (h)) * HTB)
#define PG8_STAGE(bufoff, gbase, voff) do { _Pragma("unroll") for (int _i = 0; _i < 2; ++_i) \
        __builtin_amdgcn_global_load_lds((const unsigned*)((const char*)(gbase) + (voff)[_i]), (PG8_LAS unsigned*)(lds + (bufoff) + ldsw + _i * 8192), 16, 0, 0); } while (0)
#define PG8_LDA(dst, b, h) do { _Pragma("unroll") for (int m = 0; m < 4; ++m) _Pragma("unroll") for (int k = 0; k < 2; ++k) dst[m][k] = *(const PG8_LAS bf16x8*)(lds + PG8_SA(b, h) + aoff + m * 2048 + k * 1024); } while (0)
#define PG8_LDB(dst, b, h) do { _Pragma("unroll") for (int n = 0; n < 2; ++n) _Pragma("unroll") for (int k = 0; k < 2; ++k) dst[n][k] = *(const PG8_LAS bf16x8*)(lds + PG8_SB(b, h) + boff + n * 2048 + k * 1024); } while (0)
#define PG8_MMA(ai, bj, At, Bt) do { __builtin_amdgcn_s_setprio(1); _Pragma("unroll") for (int m = 0; m < 4; ++m) _Pragma("unroll") for (int n = 0; n < 2; ++n) _Pragma("unroll") for (int k = 0; k < 2; ++k) \
        acc[ai][bj][m][n] = __builtin_amdgcn_mfma_f32_16x16x32_bf16(Bt[n][k], At[m][k], acc[ai][bj][m][n], 0, 0, 0); __builtin_amdgcn_s_setprio(0); } while (0)
#define PG8_WAIT_V(n) asm volatile("s_waitcnt vmcnt(" #n ")" ::: "memory")
#define PG8_WAIT_L(n) asm volatile("s_waitcnt lgkmcnt(" #n ")" ::: "memory")
#define PG8_WAIT_V8X do { if constexpr (Epi::NVM >= 24) asm volatile("s_cmp_eq_u32 %0, 0\n\ts_cbranch_scc1 1f\n\ts_waitcnt vmcnt(8)\n1:\n\ts_waitcnt vmcnt(32)" :: "s"(t) : "scc", "memory"); \
        else asm volatile("s_cmp_eq_u32 %0, 0\n\ts_cbranch_scc1 1f\n\ts_waitcnt vmcnt(8)\n1:\n\ts_waitcnt vmcnt(24)" :: "s"(t) : "scc", "memory"); } while (0)
#define PG8_BAR __builtin_amdgcn_s_barrier()
#define PG8_SCHED __builtin_amdgcn_sched_barrier(0)
#define PG8_APTR(u) ((const char*)g.A + (size_t)((u).rbase) * lda * 2 + (((u).pn >= g.asplit_pn) ? (size_t)g.asplit_off * 32 : (size_t)0))
    Unit cur, nxt; int ui = 0;
    if (!S.next(0, cur)) return;
    f32x4 acc[2][2][4][2];
#pragma unroll
    for (int a = 0; a < 2; ++a)
#pragma unroll
        for (int b = 0; b < 2; ++b)
#pragma unroll
            for (int m = 0; m < 4; ++m)
#pragma unroll
                for (int n = 0; n < 2; ++n) acc[a][b][m][n] = (f32x4){0.f, 0.f, 0.f, 0.f};
    bf16x8 At[4][2], B0[2][2], B1[2][2];
    const char* cA = PG8_APTR(cur); const char* cB = (const char*)g.Bt + (size_t)cur.pn * tstepB;
    S.a_ready(cur);
    if constexpr (SP2) {
        PG8_STAGE(PG8_SB(0, 0), cB, voffB); PG8_STAGE(PG8_SB(0, 1), cB + hstepB, voffB); PG8_STAGE(PG8_SA(0, 0), cA, voffA); PG8_STAGE(PG8_SA(0, 1), cA + hstepA, voffA);
        if (wr == 1) PG8_BAR;
        PG8_WAIT_V(2); PG8_BAR;
        PG8_STAGE(PG8_SB(1, 0), cB + kstep, voffB); PG8_STAGE(PG8_SA(1, 0), cA + kstep, voffA); PG8_STAGE(PG8_SB(1, 1), cB + hstepB + kstep, voffB);
        PG8_WAIT_V(0); PG8_BAR;
    } else {
    PG8_STAGE(PG8_SB(0, 0), cB, voffB); PG8_STAGE(PG8_SA(0, 0), cA, voffA); PG8_STAGE(PG8_SB(0, 1), cB + hstepB, voffB); PG8_STAGE(PG8_SA(0, 1), cA + hstepA, voffA);
    if (wr == 1) PG8_BAR;
    PG8_WAIT_V(4); PG8_BAR;
    PG8_STAGE(PG8_SB(1, 0), cB + kstep, voffB); PG8_STAGE(PG8_SA(1, 0), cA + kstep, voffA); PG8_STAGE(PG8_SB(1, 1), cB + hstepB + kstep, voffB);
    PG8_WAIT_V(6); PG8_BAR;
    }
    for (;;) {
        const bool has_next = S.next(ui + 1, nxt);
        const char* nA = has_next ? PG8_APTR(nxt) : cA; const char* nB = has_next ? (const char*)g.Bt + (size_t)nxt.pn * tstepB : cB;
        const bool hlf = cur.half != 0;
        for (int t = 0; t < nt; t += 2) {
            const bool last = (t == nt - 2);
            const char* a1 = cA + (size_t)(t + 1) * kstep;
            const char* a2 = last ? nA : cA + (size_t)(t + 2) * kstep; const char* b2 = last ? nB : cB + (size_t)(t + 2) * kstep;
            const char* a3 = a2 + kstep; const char* b3 = b2 + kstep;
            if (last && has_next) S.a_ready(nxt);
            if constexpr (SP2) {
            PG8_LDB(B0, 0, 0); PG8_LDB(B1, 0, 1); PG8_SCHED; PG8_LDA(At, 0, 0); PG8_STAGE(PG8_SA(1, 1), a1 + hstepA, voffA);
            PG8_WAIT_V8X; PG8_WAIT_L(0); PG8_BAR; PG8_MMA(0, 0, At, B0); PG8_MMA(0, 1, At, B1); PG8_BAR; PG8_SCHED;
            if (!hlf) { PG8_LDA(At, 0, 1); } PG8_STAGE(PG8_SB(0, 0), b2, voffB); PG8_STAGE(PG8_SB(0, 1), b2 + hstepB, voffB); PG8_STAGE(PG8_SA(0, 0), a2, voffA);
            PG8_WAIT_V8X; PG8_WAIT_L(0); PG8_BAR; if (!hlf) { PG8_MMA(1, 0, At, B0); PG8_MMA(1, 1, At, B1); } PG8_BAR; PG8_SCHED;
            PG8_LDB(B0, 1, 0); PG8_LDB(B1, 1, 1); PG8_SCHED; PG8_LDA(At, 1, 0); PG8_STAGE(PG8_SA(0, 1), a2 + hstepA, voffA);
            PG8_WAIT_V(8); PG8_WAIT_L(0); PG8_BAR; PG8_MMA(0, 0, At, B0); PG8_MMA(0, 1, At, B1); PG8_BAR; PG8_SCHED;
            if (!hlf) { PG8_LDA(At, 1, 1); } PG8_STAGE(PG8_SB(1, 0), b3, voffB); PG8_STAGE(PG8_SB(1, 1), b3 + hstepB, voffB); PG8_STAGE(PG8_SA(1, 0), a3, voffA);
            PG8_WAIT_V(8); PG8_WAIT_L(0); PG8_BAR; if (!hlf) { PG8_MMA(1, 0, At, B0); PG8_MMA(1, 1, At, B1); } PG8_BAR; PG8_SCHED;
            } else {
            PG8_LDB(B0, 0, 0); PG8_SCHED; PG8_LDA(At, 0, 0); PG8_STAGE(PG8_SA(1, 1), a1 + hstepA, voffA);
            PG8_WAIT_L(8); PG8_BAR; PG8_WAIT_L(0); PG8_MMA(0, 0, At, B0); PG8_BAR; PG8_SCHED;
            PG8_LDB(B1, 0, 1); PG8_STAGE(PG8_SB(0, 0), b2, voffB);
            PG8_BAR; PG8_WAIT_L(0); PG8_MMA(0, 1, At, B1); PG8_BAR;
            PG8_LDA(At, 0, 1); PG8_STAGE(PG8_SA(0, 0), a2, voffA);
            PG8_BAR; PG8_WAIT_L(0); PG8_MMA(1, 0, At, B0); PG8_BAR; PG8_SCHED;
            PG8_STAGE(PG8_SB(0, 1), b2 + hstepB, voffB);
            PG8_WAIT_V(6); PG8_BAR; PG8_MMA(1, 1, At, B1); PG8_BAR;
            PG8_LDB(B0, 1, 0); PG8_SCHED; PG8_LDA(At, 1, 0); PG8_STAGE(PG8_SA(0, 1), a2 + hstepA, voffA);
            PG8_WAIT_L(8); PG8_BAR; PG8_WAIT_L(0); PG8_MMA(0, 0, At, B0); PG8_BAR; PG8_SCHED;
            PG8_LDB(B1, 1, 1); PG8_STAGE(PG8_SB(1, 0), b3, voffB);
            PG8_BAR; PG8_WAIT_L(0); PG8_MMA(0, 1, At, B1); PG8_BAR;
            PG8_LDA(At, 1, 1); PG8_STAGE(PG8_SA(1, 0), a3, voffA);
            PG8_BAR; PG8_WAIT_L(0); PG8_MMA(1, 0, At, B0); PG8_BAR; PG8_SCHED;
            PG8_STAGE(PG8_SB(1, 1), b3 + hstepB, voffB);
            PG8_WAIT_V(6); PG8_BAR; PG8_MMA(1, 1, At, B1); PG8_BAR;
            }
        }
        if constexpr (ALIGN_EPI) { if (wr == 0) PG8_BAR; }
        E(acc, cur, wr, wc, fr, fq); S.done(cur);
        if (!has_next) break;
#pragma unroll
        for (int a = 0; a < 2; ++a)
#pragma unroll
            for (int b = 0; b < 2; ++b)
#pragma unroll
                for (int m = 0; m < 4; ++m)
#pragma unroll
                    for (int n = 0; n < 2; ++n) acc[a][b][m][n] = (f32x4){0.f, 0.f, 0.f, 0.f};
        cur = nxt; cA = nA; cB = nB; ++ui;
        if constexpr (ALIGN_EPI) { if (wr == 1) PG8_BAR; }
    }
    PG8_WAIT_V(0);
    if constexpr (!ALIGN_EPI) { if (wr == 0) PG8_BAR; }
    PG8_BAR;
#undef PG8_APTR
#undef PG8_SA
#undef PG8_SB
#undef PG8_STAGE
#undef PG8_LDA
#undef PG8_LDB
#undef PG8_MMA
#undef PG8_WAIT_V
#undef PG8_WAIT_L
#undef PG8_WAIT_V8X
#undef PG8_BAR
#undef PG8_SCHED
}
}

using pg8::bf16_t; using pg8::f32x4; using pg8::u32x4; using pg8::u32x2; using pg8::bf16x8;
using pg8::cvt_pk_bf16; using pg8::bf_lo; using pg8::bf_hi;

struct Params {
    const float* x_prompt; const float* x_sample; const float* state_conv; const float* norm_mix; const float* w_in; const float* ln_g; const float* ln_b;
    const float* w_s; const float* b_s; const float* conv_w; const float* w_pa; const float* w_pb; const float* w_o; const float* norm_ffn;
    const float* w_gate; const float* w_up; const float* w_down; const float* norm_final;
    float* out; unsigned char* ws; int ph_lo, ph_hi;
};
constexpr int LDS_BYTES = pg8::STAGE_BYTES + 256;
constexpr int NPHASE = 2 + 7 * NL;

__device__ __forceinline__ void transpose_tile(const float* __restrict__ src, int ld, int k0, int col0, const float* __restrict__ scale, bf16_t* __restrict__ dstbase, int n0, int K, float* t, int tid) {
    const int r = tid >> 4, c4 = tid & 15;
#pragma unroll
    for (int pass = 0; pass < 2; ++pass) { const int k = r + 32 * pass; const f32x4 v = *(const f32x4*)(src + (size_t)(k0 + k) * ld + col0 + 4 * c4); const float s = scale ? scale[k0 + k] : 1.0f;
        t[k * 65 + 4 * c4 + 0] = v[0] * s; t[k * 65 + 4 * c4 + 1] = v[1] * s; t[k * 65 + 4 * c4 + 2] = v[2] * s; t[k * 65 + 4 * c4 + 3] = v[3] * s; }
    __syncthreads();
    const int n = tid >> 3, kc = tid & 7; u32x4 w;
    w.x = cvt_pk_bf16(t[(8 * kc + 0) * 65 + n], t[(8 * kc + 1) * 65 + n]); w.y = cvt_pk_bf16(t[(8 * kc + 2) * 65 + n], t[(8 * kc + 3) * 65 + n]);
    w.z = cvt_pk_bf16(t[(8 * kc + 4) * 65 + n], t[(8 * kc + 5) * 65 + n]); w.w = cvt_pk_bf16(t[(8 * kc + 6) * 65 + n], t[(8 * kc + 7) * 65 + n]);
    const int nl = n0 + n, c5 = nl & 31, rho = 16 * ((c5 >> 2) & 1) + (((c5 >> 3) << 2) | (c5 & 3)), P = (nl & ~31) + rho;
    *(u32x4*)(dstbase + pg8::mt_off(P, k0 + 8 * kc, K)) = w;
    __syncthreads();
}
constexpr int IT_WIN = (NIN / 64) * 16, IT_WPAB = 32 * 16, IT_WO = 16 * 16, IT_WGU = (2 * DFF / 64) * 16, IT_WD = 16 * (DFF / 64), IT_LAYER = IT_WIN + IT_WPAB + IT_WO + IT_WGU + IT_WD;

__device__ __forceinline__ void p0_prologue(const Params& p, float* ldsf, int layer, int first, bool misc) {
    unsigned char* ws = p.ws;
    float* ssqm = (float*)(ws + WS_SSQM);
    int tid = threadIdx.x; asm volatile("" : "+v"(tid));
    const int G = gridDim.x, b = blockIdx.x;
    for (int it = b - first; it >= 0 && it < IT_LAYER; it += G - first) {
        const int l = layer; int r = it; unsigned char* lw = ws + WS_W + (size_t)l * LW_BYTES;
        if (r < IT_WIN) { const int ntile = r >> 4, kt = r & 15, n0 = ntile * 64; int col;
            if (n0 < 3072) col = n0; else if (n0 < 5120) { const int t = n0 - 3072; col = ((t & 128) ? 4096 : 3072) + (t >> 8) * 128 + (t & 127); } else { const int t = n0 - 5120; col = ((t & 128) ? 6144 : 5120) + (t >> 8) * 128 + (t & 127); }
            transpose_tile(p.w_in + (size_t)l * DM * NIN, NIN, kt * 64, col, p.norm_mix + l * DM, (bf16_t*)(lw + LW_WIN), n0, DM, ldsf, tid); continue; }
        r -= IT_WIN;
        if (r < IT_WPAB) { const int ntile = r >> 4, kt = r & 15, n0 = ntile * 64;
            const float* src = (n0 < 1024) ? p.w_pa + (size_t)l * DM * DM : p.w_pb + (size_t)l * DM * DM;
            transpose_tile(src, DM, kt * 64, n0 & 1023, nullptr, (bf16_t*)(lw + LW_WPAB), n0, DM, ldsf, tid); continue; }
        r -= IT_WPAB;
        if (r < IT_WO) { const int ntile = r >> 4, kt = r & 15, n0 = ntile * 64;
            transpose_tile(p.w_o + (size_t)l * DM * DM, DM, kt * 64, n0, nullptr, (bf16_t*)(lw + LW_WO), n0, DM, ldsf, tid); continue; }
        r -= IT_WO;
        if (r < IT_WGU) { const int ntile = r >> 4, kt = r & 15, n0 = ntile * 64;
            const float* src = ((n0 & 128) ? p.w_up : p.w_gate) + (size_t)l * DM * DFF; const int col = (n0 >> 8) * 128 + (n0 & 127);
            transpose_tile(src, DFF, kt * 64, col, p.norm_ffn + l * DM, (bf16_t*)(lw + LW_WGU), n0, DM, ldsf, tid); continue; }
        r -= IT_WGU;
        { const int ntile = r / (DFF / 64), kt = r % (DFF / 64), n0 = ntile * 64;
            transpose_tile(p.w_down + (size_t)l * DFF * DM, DM, kt * 64, n0, nullptr, (bf16_t*)(lw + LW_WD), n0, DFF, ldsf, tid); }
    }
    if (!misc) return;
    for (int i = b * 512 + tid; i < NL * 8 * 128 * 128; i += G * 512) {
        const int l = i >> 17, rem = i & 131071, ii = (rem >> 7) & 127, jj = rem & 127;
        const float* wsrc = p.w_s + (size_t)(i - rem);
        const int grp = rem >> 14;
        unsigned char* lw = ws + WS_W + (size_t)l * LW_BYTES;
        const float vp = (jj <= ii) ? p.w_s[i] : 0.f;
        const float vs = ((ii >> 5) == (jj >> 5) && (jj & 31) <= (ii & 31)) ? wsrc[grp * 16384 + (ii & 31) * 128 + (jj & 31)] : 0.f;
        ((bf16_t*)(lw + LW_WSP))[rem] = (bf16_t)(cvt_pk_bf16(vp, 0.f) & 0xffffu);
        ((bf16_t*)(lw + LW_WSS))[rem] = (bf16_t)(cvt_pk_bf16(vs, 0.f) & 0xffffu);
    }
    { const int wave = tid >> 6, lane = tid & 63; bf16_t* xb = (bf16_t*)(ws + WS_XB);
      for (int row = b * 8 + wave; row < MT; row += 2 * G * 8) {
          const int row2 = row + G * 8; const bool has2 = row2 < MT;
          const float* xr = (row < MP) ? p.x_prompt + (size_t)row * DM : p.x_sample + (size_t)(row - MP) * DM;
          const float* xr2 = has2 ? ((row2 < MP) ? p.x_prompt + (size_t)row2 * DM : p.x_sample + (size_t)(row2 - MP) * DM) : xr;
          f32x4 v[4], v2[4];
#pragma unroll
          for (int j = 0; j < 4; ++j) { v[j] = *(const f32x4*)(xr + 4 * (lane + 64 * j)); v2[j] = *(const f32x4*)(xr2 + 4 * (lane + 64 * j)); }
          float q = 0.f, q2 = 0.f;
#pragma unroll
          for (int j = 0; j < 4; ++j) { q += (v[j][0] * v[j][0] + v[j][1] * v[j][1]) + (v[j][2] * v[j][2] + v[j][3] * v[j][3]); q2 += (v2[j][0] * v2[j][0] + v2[j][1] * v2[j][1]) + (v2[j][2] * v2[j][2] + v2[j][3] * v2[j][3]);
              u32x2 w; w.x = cvt_pk_bf16(v[j][0], v[j][1]); w.y = cvt_pk_bf16(v[j][2], v[j][3]); *(u32x2*)(xb + pg8::mt_off(row, 4 * (lane + 64 * j), DM)) = w;
              if (has2) { u32x2 w2; w2.x = cvt_pk_bf16(v2[j][0], v2[j][1]); w2.y = cvt_pk_bf16(v2[j][2], v2[j][3]); *(u32x2*)(xb + pg8::mt_off(row2, 4 * (lane + 64 * j), DM)) = w2; } }
#pragma unroll
          for (int o = 32; o >= 1; o >>= 1) { q += __shfl_xor(q, o); q2 += __shfl_xor(q2, o); }
          if (lane < 4) { ((f32x4*)(ssqm + (size_t)row * 16))[lane] = (f32x4){lane == 0 ? q : 0.f, 0.f, 0.f, 0.f};
              if (has2) ((f32x4*)(ssqm + (size_t)row2 * 16))[lane] = (f32x4){lane == 0 ? q2 : 0.f, 0.f, 0.f, 0.f}; }
      } }
}

constexpr int VT_PITCH = 136;
__device__ __forceinline__ void gate_conv_phase(const Params& p, int l, unsigned char* lds) {
    unsigned char* ws = p.ws;
    const float* lns = (const float*)(ws + WS_LNS);
    bf16_t* AB = (bf16_t*)(ws + WS_AB); const bf16_t* GV = (const bf16_t*)(ws + WS_GV); const bf16_t* CH = (const bf16_t*)(ws + WS_CH);
    const unsigned char* lw = ws + WS_W + (size_t)l * LW_BYTES;
    bf16_t* vT = (bf16_t*)lds;
    float* mr = (float*)(lds + 128 * VT_PITCH * 2);
    int tid = threadIdx.x; asm volatile("" : "+v"(tid));
    const int lane = tid & 63, w = tid >> 6, fr = lane & 15, fq = lane >> 4;
    const int jg = tid >> 5, cq = tid & 31;
    const int col8 = ((tid >> 6) & 3) * 32 + (lane & 3) * 8;
    const int nks = (w >> 1) + 1;
    const int total = (MT / 128) * 8;
    int item = blockIdx.x; if (item >= total) return;
    const int g = item & 7, c0 = g * 128, irow = 16 * w + fr;
    const bf16_t* WsP = (const bf16_t*)(lw + LW_WSP) + g * 16384 + irow * 128 + 8 * fq;
    bf16x8 wf[4];
#pragma unroll
    for (int ks = 0; ks < 4; ++ks) wf[ks] = *(const bf16x8*)(WsP + 32 * ks);
    float bs = p.b_s[(l * 8 + g) * 128 + irow];
    const float* cwp = p.conv_w + (size_t)l * 3 * DM + c0 + col8;
    bool was_smp = false;
    f32x4 sl0, sl1; u32x2 gv[8]; u32x4 uu[4];
#define GC_LOAD(it) do { const int r0_ = ((it) >> 3) * 128; \
        const f32x4* sl_ = (const f32x4*)(lns + (size_t)(r0_ + (tid >> 2)) * 32 + (tid & 3) * 8); sl0 = sl_[0]; sl1 = sl_[1]; \
        _Pragma("unroll") for (int jj = 0; jj < 8; ++jj) gv[jj] = *(const u32x2*)(GV + pg8::mt_off(r0_ + 8 * jg + jj, c0 + 4 * cq, DM)); } while (0)
#define GC_LOADU(it) do { const int r0_ = ((it) >> 3) * 128; \
        _Pragma("unroll") for (int pp = 0; pp < 4; ++pp) uu[pp] = *(const u32x4*)(AB + pg8::mt_off(r0_ + irow, c0 + 8 * fq, 2048) + 512 * pp); } while (0)
    for (;;) {
        const int ct = item >> 3, row0 = ct * 128; const bool smp = ct >= MP / 128;
        GC_LOAD(item); GC_LOADU(item);
        if (smp && !was_smp) {
            const bf16_t* WsS = (const bf16_t*)(lw + LW_WSS) + g * 16384 + irow * 128 + 8 * fq;
#pragma unroll
            for (int ks = 0; ks < 4; ++ks) wf[ks] = *(const bf16x8*)(WsS + 32 * ks);
            bs = p.b_s[(l * 8 + g) * 128 + (irow & 31)]; was_smp = true; }
        bf16_t* rowp = AB + pg8::mt_off(row0 + irow, c0 + 8 * fq, 2048);
        const f32x4 lg = *(const f32x4*)(p.ln_g + l * DM + c0 + 4 * cq), lb = *(const f32x4*)(p.ln_b + l * DM + c0 + 4 * cq);
        { float sm = (sl0[0] + sl0[2]) + (sl1[0] + sl1[2]), sq = (sl0[1] + sl0[3]) + (sl1[1] + sl1[3]);
          sm += __shfl_xor(sm, 1); sq += __shfl_xor(sq, 1); sm += __shfl_xor(sm, 2); sq += __shfl_xor(sq, 2);
          if ((tid & 3) == 0) { const float mean = sm * (1.0f / 1024.0f), var = sq * (1.0f / 1024.0f) - mean * mean; mr[2 * (tid >> 2)] = mean; mr[2 * (tid >> 2) + 1] = __builtin_amdgcn_rsqf(fmaxf(var, 0.f) + EPS); } }
        __syncthreads();
        { float v[8][4];
#pragma unroll
          for (int jj = 0; jj < 8; ++jj) { const float mean = mr[2 * (8 * jg + jj)], rstd = mr[2 * (8 * jg + jj) + 1];
              v[jj][0] = (bf_lo(gv[jj].x) - mean) * rstd * lg[0] + lb[0]; v[jj][1] = (bf_hi(gv[jj].x) - mean) * rstd * lg[1] + lb[1];
              v[jj][2] = (bf_lo(gv[jj].y) - mean) * rstd * lg[2] + lb[2]; v[jj][3] = (bf_hi(gv[jj].y) - mean) * rstd * lg[3] + lb[3];
              if (smp) *(f32x4*)(p.out + OUT_V + ((size_t)l * MS + (row0 + 8 * jg + jj - MP)) * DM + c0 + 4 * cq) = (f32x4){v[jj][0], v[jj][1], v[jj][2], v[jj][3]}; }
#pragma unroll
          for (int e = 0; e < 4; ++e) { u32x4 wv; wv.x = cvt_pk_bf16(v[0][e], v[1][e]); wv.y = cvt_pk_bf16(v[2][e], v[3][e]); wv.z = cvt_pk_bf16(v[4][e], v[5][e]); wv.w = cvt_pk_bf16(v[6][e], v[7][e]);
              *(u32x4*)(vT + (4 * cq + e) * VT_PITCH + 8 * jg) = wv; } }
        u32x4 ch0[4], ch1[4], ch2[4], bg[4];
        const int i0 = ((w >> 2) << 4) + (lane >> 2);
        const bf16_t* chb = CH + pg8::mt_off(row0 + i0, c0 + col8, DM); const bf16_t* bgl = AB + pg8::mt_off(row0 + i0, 1024 + c0 + col8, 2048);
        const int d1 = ((lane >> 2) >= 1) ? 32 : ((DM >> 5) * 512 - 15 * 32), d2 = ((lane >> 2) >= 2) ? 64 : ((DM >> 5) * 512 - 14 * 32);
#pragma unroll
        for (int vv = 0; vv < 4; ++vv) { const int i = (((w >> 2) + 2 * vv) << 4) + (lane >> 2), row = row0 + i, c = c0 + col8; const int pos = smp ? ((row - MP) & 31) : (row & 2047);
            const u32x4 z4 = {0u, 0u, 0u, 0u};
            const bf16_t* chp = chb + (size_t)vv * (2 * (DM >> 5) * 512);
            ch0[vv] = *(const u32x4*)chp;
            ch1[vv] = (pos >= 1) ? *(const u32x4*)(chp - d1) : z4;
            ch2[vv] = (pos >= 2) ? *(const u32x4*)(chp - d2) : z4;
            bg[vv] = *(const u32x4*)(bgl + (size_t)vv * (2 * 64 * 512)); (void)c; }
        const int nitem = item + (int)gridDim.x; const bool has_next = nitem < total;
        __syncthreads();
        { f32x4 acc[8];
#pragma unroll
          for (int dt = 0; dt < 8; ++dt) acc[dt] = (f32x4){0.f, 0.f, 0.f, 0.f};
#pragma unroll
          for (int ks = 0; ks < 4; ++ks) if (ks < nks) {
#pragma unroll
              for (int dt = 0; dt < 8; ++dt) { const int d = 32 * (dt >> 1) + 8 * (fr >> 2) + 4 * (dt & 1) + (fr & 3);
                  const bf16x8 vf = *(const bf16x8*)(vT + d * VT_PITCH + 32 * ks + 8 * fq);
                  acc[dt] = __builtin_amdgcn_mfma_f32_16x16x32_bf16(vf, wf[ks], acc[dt], 0, 0, 0); } }
#pragma unroll
          for (int pp = 0; pp < 4; ++pp) { const f32x4 s0 = acc[2 * pp] + bs, s1 = acc[2 * pp + 1] + bs;
              const f32x4 u0 = {bf_lo(uu[pp][0]), bf_hi(uu[pp][0]), bf_lo(uu[pp][1]), bf_hi(uu[pp][1])}, u1 = {bf_lo(uu[pp][2]), bf_hi(uu[pp][2]), bf_lo(uu[pp][3]), bf_hi(uu[pp][3])};
              *(u32x4*)(rowp + 512 * pp) = pg8::pack8(u0 * s0, u1 * s1); } }
        const f32x4 w0a = *(const f32x4*)(cwp), w0b = *(const f32x4*)(cwp + 4), w1a = *(const f32x4*)(cwp + DM), w1b = *(const f32x4*)(cwp + DM + 4), w2a = *(const f32x4*)(cwp + 2 * DM), w2b = *(const f32x4*)(cwp + 2 * DM + 4);
#pragma unroll
        for (int vv = 0; vv < 4; ++vv) { const int i = (((w >> 2) + 2 * vv) << 4) + (lane >> 2), row = row0 + i, c = c0 + col8; const int pos = smp ? ((row - MP) & 31) : (row & 2047);
            float f0[8], f1[8], f2[8], o[8];
#pragma unroll
            for (int e = 0; e < 4; ++e) { f0[2 * e] = bf_lo(ch0[vv][e]); f0[2 * e + 1] = bf_hi(ch0[vv][e]); f1[2 * e] = bf_lo(ch1[vv][e]); f1[2 * e + 1] = bf_hi(ch1[vv][e]); f2[2 * e] = bf_lo(ch2[vv][e]); f2[2 * e + 1] = bf_hi(ch2[vv][e]); }
            if (smp && pos < 2) { const int sq = (row - MP) >> 5; const float* stp = p.state_conv + ((size_t)(l * 32 + sq) * 2) * DM + c;
                if (pos == 0) { const f32x4 a = *(const f32x4*)(stp + DM), bq = *(const f32x4*)(stp + DM + 4); f1[0] = a[0]; f1[1] = a[1]; f1[2] = a[2]; f1[3] = a[3]; f1[4] = bq[0]; f1[5] = bq[1]; f1[6] = bq[2]; f1[7] = bq[3]; }
                { const float* s2 = stp + (pos == 0 ? 0 : DM); const f32x4 a = *(const f32x4*)(s2), bq = *(const f32x4*)(s2 + 4); f2[0] = a[0]; f2[1] = a[1]; f2[2] = a[2]; f2[3] = a[3]; f2[4] = bq[0]; f2[5] = bq[1]; f2[6] = bq[2]; f2[7] = bq[3]; } }
#pragma unroll
            for (int e = 0; e < 4; ++e) { o[e] = w0a[e] * f2[e] + w1a[e] * f1[e] + w2a[e] * f0[e]; o[4 + e] = w0b[e] * f2[4 + e] + w1b[e] * f1[4 + e] + w2b[e] * f0[4 + e]; }
            u32x4 ov;
#pragma unroll
            for (int e = 0; e < 4; ++e) ov[e] = cvt_pk_bf16(o[2 * e] * bf_lo(bg[vv][e]), o[2 * e + 1] * bf_hi(bg[vv][e]));
            *(u32x4*)(AB + pg8::mt_off(row, 1024 + c, 2048)) = ov;
            const int lastpos = smp ? 31 : 2047;
            if (pos >= lastpos - 1) { float* op = smp ? p.out + OUT_NCS + (((size_t)l * 32 + ((row - MP) >> 5)) * 2 + (pos - (lastpos - 1))) * DM + c
                                                      : p.out + OUT_NCP + (((size_t)l * 32 + (row >> 11)) * 2 + (pos - (lastpos - 1))) * DM + c;
                *(f32x4*)op = (f32x4){f0[0], f0[1], f0[2], f0[3]}; *(f32x4*)(op + 4) = (f32x4){f0[4], f0[5], f0[6], f0[7]}; } }
        __syncthreads();
        if (!has_next) break;
        item = nitem;
    }
#undef GC_LOAD
#undef GC_LOADU
}

__device__ __forceinline__ void final_norm_phase(const Params& p) {
    const float* __restrict__ ssq = (const float*)(p.ws + WS_SSQM); const bf16_t* __restrict__ xb = (const bf16_t*)(p.ws + WS_XB); float* __restrict__ out = p.out;
    const size_t n8 = (size_t)MT * DM / 8;
    int tid = threadIdx.x; asm volatile("" : "+v"(tid));
    const size_t stride = (size_t)gridDim.x * 512;
    const int c = (tid & 127) * 8;
    const f32x4 g0 = *(const f32x4*)(p.norm_final + c), g1 = *(const f32x4*)(p.norm_final + c + 4);
    for (size_t i = (size_t)blockIdx.x * 512 + tid; i < n8; i += 4 * stride) {
        u32x4 w[4]; f32x4 s0[4], s1[4], s2[4], s3[4];
#pragma unroll
        for (int k = 0; k < 4; ++k) { const size_t ii = i + k * stride; if (ii < n8) { w[k] = *(const u32x4*)(xb + pg8::mt_off((int)(ii >> 7), c, DM)); const f32x4* s = (const f32x4*)(ssq + (ii >> 7) * 16); s0[k] = s[0]; s1[k] = s[1]; s2[k] = s[2]; s3[k] = s[3]; } }
#pragma unroll
        for (int k = 0; k < 4; ++k) { const size_t ii = i + k * stride; if (ii < n8) { const f32x4 t = (s0[k] + s1[k]) + (s2[k] + s3[k]);
            const float rs = __builtin_amdgcn_rsqf(((t[0] + t[1]) + (t[2] + t[3])) * (1.0f / 1024.0f) + EPS);
            ((f32x4*)out)[2 * ii] = pg8::unpk_lo(w[k]) * rs * g0; ((f32x4*)out)[2 * ii + 1] = pg8::unpk_hi(w[k]) * rs * g1; } }
    }
}

#define LAS __attribute__((address_space(3)))
#define XB_TMO      128
#define XB_XCNT(j)  (256  + 64 * (j))
#define XB_XSUB(j)  (1280 + 64 * (j))
#define XB_XGEN(j)  (2304 + 64 * (j))
#define XB_TOP      3328
#define XB_TOPGEN   3392
#define XCD_BAR_WORDS 3456
#define XB_SPIN_CAP (1u << 18)

__device__ __forceinline__ unsigned xb_ld(unsigned* p)              { return __hip_atomic_load(p, __ATOMIC_RELAXED, __HIP_MEMORY_SCOPE_AGENT); }
__device__ __forceinline__ unsigned xb_add(unsigned* p, unsigned v) { return __hip_atomic_fetch_add(p, v, __ATOMIC_RELAXED, __HIP_MEMORY_SCOPE_AGENT); }
__device__ __forceinline__ unsigned xb_xcc_id() { return (unsigned)__builtin_amdgcn_s_getreg((3 << 11) | 20) & 0xFu; }
#define XB_SPIN(cond, bar) do { unsigned _sp = 0; while (cond) { __builtin_amdgcn_s_sleep(1); \
    if ((++_sp & 255u) == 0u) { if (xb_ld(&(bar)[XB_TMO])) break; if (_sp > XB_SPIN_CAP) { atomicAdd(&(bar)[XB_TMO], 1u); break; } } } } while (0)

struct XcdBarrier {
    unsigned* bar; unsigned x;
    volatile LAS unsigned* st;
};

__device__ __forceinline__ XcdBarrier xcd_barrier_post(unsigned* bar, volatile LAS unsigned* st) {
    XcdBarrier b; b.bar = bar; b.x = xb_xcc_id(); b.st = st;
    if (threadIdx.x == 0) (void)xb_add(&bar[XB_XCNT(b.x)], 1u);
    return b;
}
__device__ __forceinline__ void xcd_barrier_complete(unsigned* bar, unsigned x, unsigned& nloc, unsigned& nx) {
    const unsigned G = gridDim.x * gridDim.y * gridDim.z;
    unsigned sum, cnt, mine, sp = 0u;
    for (;;) {
        sum = 0u; cnt = 0u; mine = 0u;
#pragma unroll
        for (unsigned j = 0; j < 16; ++j) { const unsigned c = xb_ld(&bar[XB_XCNT(j)]); sum += c; cnt += (c > 0u) ? 1u : 0u; mine = (j == x) ? c : mine; }
        if (sum == G) break;
        __builtin_amdgcn_s_sleep(1);
        if ((++sp & 255u) == 0u) { if (xb_ld(&bar[XB_TMO])) break; if (sp > XB_SPIN_CAP) { atomicAdd(&bar[XB_TMO], 1u); break; } }
    }
    nloc = mine > 0u ? mine : 1u; nx = cnt > 0u ? cnt : 1u;
}

__device__ __forceinline__ void xcd_barrier(const XcdBarrier& b) {
    asm volatile("s_waitcnt vmcnt(0)" ::: "memory");
    __syncthreads();
    if (threadIdx.x == 0) {
        unsigned* bar = b.bar;
        __builtin_amdgcn_s_waitcnt(0);
        unsigned nloc = b.st[0], nx = b.st[1];
        if (nloc == 0u) { xcd_barrier_complete(bar, b.x, nloc, nx); b.st[0] = nloc; b.st[1] = nx; }
        const unsigned old = xb_add(&bar[XB_XSUB(b.x)], 1u);
        const unsigned gen = old / nloc;
        if (old + 1u == (gen + 1u) * nloc) {
            __builtin_amdgcn_fence(__ATOMIC_RELEASE, "agent");
            asm volatile("s_waitcnt vmcnt(0)" ::: "memory");
            const unsigned og = xb_add(&bar[XB_TOP], 1u);
            const unsigned tg = og / nx;
            if (og + 1u == (tg + 1u) * nx) xb_add(&bar[XB_TOPGEN], 1u);
            else XB_SPIN(xb_ld(&bar[XB_TOPGEN]) == tg, bar);
            __builtin_amdgcn_fence(__ATOMIC_ACQUIRE, "agent");
            xb_add(&bar[XB_XGEN(b.x)], 1u);
            asm volatile("s_waitcnt vmcnt(0)" ::: "memory");
        } else {
            XB_SPIN(xb_ld(&bar[XB_XGEN(b.x)]) == gen, bar);
            __builtin_amdgcn_fence(__ATOMIC_ACQUIRE, "agent");
            asm volatile("s_waitcnt vmcnt(0)" ::: "memory");
        }
    }
    __syncthreads();
}

__global__ void __launch_bounds__(512, 2) mk_fwd(Params p) {
    extern __shared__ __attribute__((aligned(16))) unsigned char lds[];
    unsigned char* ws0 = p.ws;
    PG8_LAS unsigned char* ring = (PG8_LAS unsigned char*)lds;
#if MK_MULTI
#define GRID_SYNC() do { } while (0)
#else
    cg::grid_group grid = cg::this_grid();
    volatile LAS unsigned* bst = (volatile LAS unsigned*)((LAS unsigned char*)lds + pg8::STAGE_BYTES);
    if (threadIdx.x < 2) bst[threadIdx.x] = 0u;
    __syncthreads();
    XcdBarrier xbar = xcd_barrier_post((unsigned*)(ws0 + WS_CTL), bst);
#define GRID_SYNC() do { if (p.ph_hi > 100000) grid.sync(); else xcd_barrier(xbar); } while (0)
#endif
    for (int ph = p.ph_lo; ph < p.ph_hi; ++ph) {
        unsigned char* ws = ws0; int G = gridDim.x, c = blockIdx.x; asm volatile("" : "+s"(ws), "+s"(G), "+s"(c));
        float* ssq_mix = (float*)(ws + WS_SSQM); float* ssq_ffn = (float*)(ws + WS_SSQF); float* lns = (float*)(ws + WS_LNS);
        bf16_t* XB = (bf16_t*)(ws + WS_XB); bf16_t* AB = (bf16_t*)(ws + WS_AB); bf16_t* GV = (bf16_t*)(ws + WS_GV); bf16_t* CH = (bf16_t*)(ws + WS_CH);
        bf16_t* T12 = GV; bf16_t* MMb = AB; bf16_t* Hb = AB;
        int cl = -1, cf = 0;
        if (ph == 0) { cl = 0; }
        else if (ph == NPHASE - 1) { if (PHASE_MASK & 2) final_norm_phase(p); }
        else {
            const int l = (ph - 1) / 7, s = (ph - 1) % 7;
            for (int rep_ = 0; rep_ < (((PROBE_DUP >> s) & 1) ? 2 : 1); ++rep_) {
            const unsigned char* lw = ws + WS_W + (size_t)l * LW_BYTES;
            if (s == 0) { if (PHASE_MASK & 4) {
                pg8::Gemm g{XB, (const bf16_t*)(lw + LW_WIN), MT, 5120, DM, DM, 1 << 30, 0}; pg8::StaticOrder S; S.init(MT, 5120, G, c);
                pg8::EpiA E{AB, GV, CH, ssq_mix, lns};
                pg8::gemm_phase<pg8::EpiA, pg8::StaticOrder>(ring, g, S, E); }
            } else if (s == 1) {
                if (PHASE_MASK & 8) gate_conv_phase(p, l, lds);
            } else if (s == 2) { if (PHASE_MASK & 16) {
                pg8::Gemm g{AB, (const bf16_t*)(lw + LW_WPAB), MT, 2048, DM, 2048, 4, 1024}; pg8::StaticOrder S; S.init(MT, 2048, G, c);
                pg8::EpiC E{T12};
                pg8::gemm_phase<pg8::EpiC, pg8::StaticOrder>(ring, g, S, E); }
            } else if (s == 3) { if (PHASE_MASK & 32) {
                pg8::Gemm g{XB, (const bf16_t*)(lw + LW_WIN) + (size_t)5120 * DM, MT, 2048, DM, DM, 1 << 30, 0}; pg8::StaticOrder S; S.init(MT, 2048, G, c);
                pg8::EpiD E{T12, MMb, ssq_mix};
                pg8::gemm_phase<pg8::EpiD, pg8::StaticOrder>(ring, g, S, E); }
            } else if (s == 4) { if (PHASE_MASK & 64) {
                pg8::Gemm g{MMb, (const bf16_t*)(lw + LW_WO), MT, DM, DM, DM, 1 << 30, 0}; pg8::StaticOrder S; S.init(MT, DM, G, c);
                pg8::EpiRes E{XB, ssq_ffn};
                pg8::gemm_phase<pg8::EpiRes, pg8::StaticOrder>(ring, g, S, E); }
            } else if (s == 5) { if (PHASE_MASK & 128) {
                pg8::Gemm g{XB, (const bf16_t*)(lw + LW_WGU), MT, 2 * DFF, DM, DM, 1 << 30, 0}; pg8::StaticOrder S; S.init(MT, 2 * DFF, G, c);
                pg8::EpiF E{Hb, ssq_ffn};
                pg8::gemm_phase<pg8::EpiF, pg8::StaticOrder>(ring, g, S, E); }
            } else { if (PHASE_MASK & 256) {
                pg8::Gemm g{Hb, (const bf16_t*)(lw + LW_WD), MT, DM, DFF, DFF, 1 << 30, 0}; pg8::StaticOrder S; S.init(MT, DM, G, c);
                pg8::EpiRes E{XB, ssq_mix};
                pg8::gemm_phase<pg8::EpiRes, pg8::StaticOrder>(ring, g, S, E);
                if (l + 1 < NL) { cl = l + 1; cf = S.ntot - S.nwg; } }
            }
            }
        }
        if (cl >= 0) p0_prologue(p, (float*)lds, cl, cf, ph == 0);
        if (ph + 1 < p.ph_hi) { GRID_SYNC(); }
    }
}

extern "C" void kernel_launch(void* const* d_in, const int* in_sizes, int n_in, void* d_out, int out_size, void* d_ws, size_t ws_size, hipStream_t stream) {
    static int grid = 0;
    if (grid == 0) {
        if (n_in != 18 || in_sizes[0] != MP * DM || (size_t)out_size != OUT_TOTAL || ws_size < WS_END) {
            fprintf(stderr, "kernel_launch: unexpected shapes: n_in %d in0 %d out %d ws %zu (need %zu)\n", n_in, n_in > 0 ? in_sizes[0] : -1, out_size, ws_size, (size_t)WS_END); grid = -1; return; }
        int dev = 0, cus = 0, per_cu = 0;
        (void)hipGetDevice(&dev); (void)hipDeviceGetAttribute(&cus, hipDeviceAttributeMultiprocessorCount, dev);
        if (hipFuncSetAttribute((const void*)mk_fwd, hipFuncAttributeMaxDynamicSharedMemorySize, LDS_BYTES) != hipSuccess) { fprintf(stderr, "kernel_launch: hipFuncSetAttribute failed\n"); grid = -1; return; }
        if (hipOccupancyMaxActiveBlocksPerMultiprocessor(&per_cu, (const void*)mk_fwd, 512, LDS_BYTES) != hipSuccess || per_cu < 1) { fprintf(stderr, "kernel_launch: occupancy query says %d\n", per_cu); per_cu = 1; }
        (void)hipGetLastError();
        grid = cus * 1;
        fprintf(stderr, "kernel_launch: cus %d per_cu %d grid %d\n", cus, per_cu, grid);
    }
    if (grid < 0) return;
    if (hipMemsetAsync((char*)d_ws + WS_CTL, 0, CTL_BYTES, stream) != hipSuccess) { fprintf(stderr, "kernel_launch: memset failed\n"); return; }
    Params p{};
    const float** pp = (const float**)&p;
    for (int i = 0; i < 18; ++i) pp[i] = (const float*)d_in[i];
    p.out = (float*)d_out; p.ws = (unsigned char*)d_ws;
#if MK_MULTI
    for (int ph = 0; ph < NPHASE; ++ph) { p.ph_lo = ph; p.ph_hi = ph + 1; hipLaunchKernelGGL(mk_fwd, dim3(grid), dim3(512), LDS_BYTES, stream, p); }
#else
    p.ph_lo = 0; p.ph_hi = NPHASE;
    void* args[] = {&p};
    hipError_t e = hipLaunchCooperativeKernel((const void*)mk_fwd, dim3(grid), dim3(512), args, LDS_BYTES, stream);
    if (e != hipSuccess) fprintf(stderr, "kernel_launch: cooperative launch failed: %s (grid %d)\n", hipGetErrorString(e), grid);
#endif
}
```

```cpp
#include <hip/hip_runtime.h>
#include <hip/hip_cooperative_groups.h>
#include <cstdio>
#include <cstdint>
namespace cg = cooperative_groups;

#ifndef PHASE_MASK
#define PHASE_MASK 511
#endif
#ifndef PROBE_DUP
#define PROBE_DUP 0
#endif
#ifndef MK_MULTI
#define MK_MULTI 0
#endif

constexpr int MP = 65536, MS = 1024, MT = MP + MS, DM = 1024, NL = 4, DFF = 2816, NIN = 7168;
constexpr float EPS = 1e-6f;
constexpr size_t OUT_YS = (size_t)MP * DM, OUT_NCP = OUT_YS + (size_t)MS * DM, OUT_NCS = OUT_NCP + (size_t)NL * 32 * 2 * DM, OUT_V = OUT_NCS + (size_t)NL * 32 * 2 * DM;
constexpr size_t OUT_TOTAL = OUT_V + (size_t)NL * 32 * 32 * DM;

constexpr size_t MiB = (size_t)1 << 20;
constexpr size_t WS_SSQM = 0, WS_SSQF = 5 * MiB, WS_LNS = 10 * MiB;
constexpr size_t WS_CTL = 20 * MiB, CTL_BYTES = 16384;
constexpr size_t WS_W = 24 * MiB;
constexpr size_t LW_WIN = 0, LW_WPAB = LW_WIN + (size_t)NIN * DM * 2, LW_WO = LW_WPAB + (size_t)2048 * DM * 2, LW_WGU = LW_WO + (size_t)DM * DM * 2,
                 LW_WD = LW_WGU + (size_t)2 * DFF * DM * 2, LW_WSP = LW_WD + (size_t)DM * DFF * 2, LW_WSS = LW_WSP + (size_t)8 * 128 * 128 * 2, LW_BYTES = LW_WSS + (size_t)8 * 128 * 128 * 2;
constexpr size_t WS_XB = 176 * MiB;
constexpr size_t WS_AB = 306 * MiB;
constexpr size_t WS_GV = 566 * MiB;
constexpr size_t WS_CH = 696 * MiB;
constexpr size_t WS_END = 826 * MiB;
static_assert(WS_W + NL * LW_BYTES <= WS_XB, "weights overflow");

namespace pg8 {
#define PG8_LAS __attribute__((address_space(3)))
typedef unsigned short bf16_t;
typedef short bf16x8 __attribute__((ext_vector_type(8)));
typedef float f32x4 __attribute__((ext_vector_type(4)));
typedef float f32x2 __attribute__((ext_vector_type(2)));
typedef unsigned u32x4 __attribute__((ext_vector_type(4)));
typedef unsigned u32x2 __attribute__((ext_vector_type(2)));
constexpr int BM = 256, BK = 64, HALF = 128, HTB = HALF * BK * 2, STAGE_BYTES = 8 * HTB, NXCD = 8, WGM = 8;

__host__ __device__ __forceinline__ int lds_byte(int r, int c) { const int st = (r >> 4) * 2 + (c >> 5), rr = r & 15, cc = c & 31, ob = rr * 64 + cc * 2; return st * 1024 + (ob ^ (((ob >> 9) & 1) << 5)); }
__host__ __device__ __forceinline__ void stage_rc(int b, int& R, int& C) { const int st = b / 1024, sb = b % 1024, swz = sb ^ (((sb >> 9) & 1) << 5); R = (st >> 1) * 16 + swz / 64; C = (st & 1) * 32 + (swz % 64) / 2; }
__host__ __device__ __forceinline__ int perm32(int rho) { const int n = rho >> 4, i = rho & 15; return 8 * (i >> 2) + 4 * n + (i & 3); }

struct Unit { int pm, pn, half, rbase; };
struct Gemm { const bf16_t* A; const bf16_t* Bt; int M, N, K, lda, asplit_pn, asplit_off; };

struct StaticOrder {
    int nM, nN, nwg, G, c, ntot;
    __host__ __device__ void init(int M, int N, int G_, int c_) { nM = MP / BM; nN = N / BM; nwg = nM * nN; G = G_; c = c_; ntot = nwg + 2 * ((M / BM) - nM) * nN; }
    __host__ __device__ bool next(int i, Unit& u) const {
        const long L = (long)i * G + c; if (L >= ntot) return false;
        if (L >= nwg) { const int h = (int)L - nwg, hp = h / nN; u.pn = h - hp * nN; u.pm = nM + (hp >> 1); u.half = 1; u.rbase = u.pm * BM + (hp & 1) * HALF; return true; }
        int wgid = (int)L; { const int q = nwg / NXCD, r = nwg % NXCD, xcd = wgid % NXCD, off = wgid / NXCD; wgid = (xcd < r ? xcd * (q + 1) : r * (q + 1) + (xcd - r) * q) + off; }
        const int nig = WGM * nN, gid = wgid / nig, fm = gid * WGM, gsz = (nM - fm) < WGM ? (nM - fm) : WGM;
        u.pm = fm + ((wgid % nig) % gsz); u.pn = (wgid % nig) / gsz; u.half = 0; u.rbase = u.pm * BM; return true;
    }
    __device__ __forceinline__ void a_ready(const Unit&) const {}
    __device__ __forceinline__ void done(const Unit&) const {}
};

__host__ __device__ __forceinline__ size_t mt_off(int row, int col, int ncols) { return ((size_t)((row >> 4) * (ncols >> 5) + (col >> 5)) << 9) + (size_t)(((row & 15) << 5) + (col & 31)); }
__device__ __forceinline__ unsigned cvt_pk_bf16(float lo, float hi) { unsigned r; asm volatile("v_cvt_pk_bf16_f32 %0, %1, %2" : "=v"(r) : "v"(lo), "v"(hi)); return r; }
__device__ __forceinline__ float bf_lo(unsigned w) { return __uint_as_float(w << 16); }
__device__ __forceinline__ float bf_hi(unsigned w) { return __uint_as_float(w & 0xffff0000u); }
__device__ __forceinline__ f32x2 gelu_pk(f32x2 v) {
    const f32x2 av = __builtin_elementwise_abs(v), d = av * 0.2316418882f + 1.0f;
    f32x2 t; t.x = __builtin_amdgcn_rcpf(d.x); t.y = __builtin_amdgcn_rcpf(d.y);
    f32x2 q = t * 0.5307027145f + (-0.7265760135f); q = q * t + 0.7107068705f; q = q * t + (-0.142248368f); q = q * t + 0.127414796f; q = q * t;
    const f32x2 s = (v * v) * (-0.72134752044f);
    f32x2 e; e.x = __builtin_amdgcn_exp2f(s.x); e.y = __builtin_amdgcn_exp2f(s.y);
    const f32x2 m = v * (q * e), r = v - m;
    f32x2 o; o.x = v.x < 0.f ? m.x : r.x; o.y = v.y < 0.f ? m.y : r.y; return o;
}
__device__ __forceinline__ f32x4 gelu4(f32x4 v) { const f32x2 a = gelu_pk((f32x2){v[0], v[1]}), b = gelu_pk((f32x2){v[2], v[3]}); return (f32x4){a.x, a.y, b.x, b.y}; }
__device__ __forceinline__ float sigmoidf_(float x) { return __builtin_amdgcn_rcpf(1.0f + __builtin_amdgcn_exp2f(x * -1.44269504f)); }
__device__ __forceinline__ f32x4 sigmoid4(f32x4 v) { return (f32x4){sigmoidf_(v[0]), sigmoidf_(v[1]), sigmoidf_(v[2]), sigmoidf_(v[3])}; }
__device__ __forceinline__ u32x4 pack8(f32x4 v0, f32x4 v1) { u32x4 w; w.x = cvt_pk_bf16(v0[0], v0[1]); w.y = cvt_pk_bf16(v0[2], v0[3]); w.z = cvt_pk_bf16(v1[0], v1[1]); w.w = cvt_pk_bf16(v1[2], v1[3]); return w; }
__device__ __forceinline__ float rstd_of(const float* slots, int row) { const f32x4* s = (const f32x4*)(slots + (size_t)row * 16); const f32x4 t = (s[0] + s[1]) + (s[2] + s[3]);
    return __builtin_amdgcn_rsqf(((t[0] + t[1]) + (t[2] + t[3])) * (1.0f / 1024.0f) + EPS); }

__device__ __forceinline__ void wave_rstd(const float* slots, int rowbase, int lane, int fr, float (&rs)[2][4]) {
    float val[2];
    const f32x4* sa = (const f32x4*)(slots + (size_t)(rowbase + lane) * 16); const f32x4* sb = (const f32x4*)(slots + (size_t)(rowbase + HALF + lane) * 16);
    const f32x4 a0 = sa[0], a1 = sa[1], a2 = sa[2], a3 = sa[3], b0 = sb[0], b1 = sb[1], b2 = sb[2], b3 = sb[3];
    __builtin_amdgcn_sched_barrier(0);
    { const f32x4 t = (a0 + a1) + (a2 + a3); val[0] = __builtin_amdgcn_rsqf(((t[0] + t[1]) + (t[2] + t[3])) * (1.0f / 1024.0f) + EPS); }
    { const f32x4 t = (b0 + b1) + (b2 + b3); val[1] = __builtin_amdgcn_rsqf(((t[0] + t[1]) + (t[2] + t[3])) * (1.0f / 1024.0f) + EPS); }
#pragma unroll
    for (int ai = 0; ai < 2; ++ai)
#pragma unroll
        for (int m = 0; m < 4; ++m) rs[ai][m] = __shfl(val[ai], m * 16 + fr);
}
__device__ __forceinline__ f32x4 unpk_lo(u32x4 w) { return (f32x4){bf_lo(w[0]), bf_hi(w[0]), bf_lo(w[1]), bf_hi(w[1])}; }
__device__ __forceinline__ f32x4 unpk_hi(u32x4 w) { return (f32x4){bf_lo(w[2]), bf_hi(w[2]), bf_lo(w[3]), bf_hi(w[3])}; }

struct EpiA {
    static constexpr bool PERM = true, AFTER_DRAIN = false; static constexpr int NVM = 8; static constexpr bool NEEDS_RS = true;

    bf16_t* AB; bf16_t* GV; bf16_t* CH; const float* ssq; float* lns;
    __device__ __forceinline__ void operator()(const f32x4 (&acc)[2][2][4][2], const Unit& u, int wr, int wc, int fr, int fq, const PG8_LAS float* rt) const {
        const int row0 = u.rbase + wr * 64 + fr, cw = wc * 32 + 8 * fq, pn = u.pn;
        float rsv[2][4];
#pragma unroll
        for (int ai = 0; ai < 2; ++ai)
#pragma unroll
            for (int m = 0; m < 4; ++m) rsv[ai][m] = rt[((u.rbase - u.pm * BM) + wr * 64 + ai * HALF + m * 16 + fr) & 255];
        if (pn < 4) {
#pragma unroll
            for (int ai = 0; ai < 2; ++ai)
#pragma unroll
                for (int m = 0; m < 4; ++m) { if (ai == 1 && u.half) continue; const int row = row0 + ai * HALF + m * 16; const float rs = rsv[ai][m]; bf16_t* rowp = AB + mt_off(row, pn * 256 + cw, 2048);
#pragma unroll
                    for (int bj = 0; bj < 2; ++bj) *(u32x4*)(rowp + bj * 4 * 512) = pack8(gelu4(acc[ai][bj][m][0] * rs), gelu4(acc[ai][bj][m][1] * rs)); }
        } else if (pn < 8) {
#pragma unroll
            for (int ai = 0; ai < 2; ++ai)
#pragma unroll
                for (int m = 0; m < 4; ++m) { if (ai == 1 && u.half) continue; const int row = row0 + ai * HALF + m * 16; const float rs = rsv[ai][m]; bf16_t* rowp = GV + mt_off(row, (pn - 4) * 256 + cw, 1024);
                    float s = 0.f, q = 0.f;
#pragma unroll
                    for (int bj = 0; bj < 2; ++bj) { const u32x4 w = pack8(gelu4(acc[ai][bj][m][0] * rs), gelu4(acc[ai][bj][m][1] * rs)); *(u32x4*)(rowp + bj * 4 * 512) = w;
#pragma unroll
                        for (int e = 0; e < 4; ++e) { const float a = bf_lo(w[e]), b = bf_hi(w[e]); s += a + b; q += a * a + b * b; } }
                    s += __shfl_xor(s, 16); s += __shfl_xor(s, 32); q += __shfl_xor(q, 16); q += __shfl_xor(q, 32);
                    if (fq == 0) *(f32x2*)(lns + ((size_t)row * 16 + (pn - 4) * 4 + wc) * 2) = (f32x2){s, q}; }
        } else if (pn < 12) {
#pragma unroll
            for (int ai = 0; ai < 2; ++ai)
#pragma unroll
                for (int m = 0; m < 4; ++m) { if (ai == 1 && u.half) continue; const int row = row0 + ai * HALF + m * 16; const float rs = rsv[ai][m]; bf16_t* rowp = AB + mt_off(row, 1024 + (pn - 8) * 256 + cw, 2048);
#pragma unroll
                    for (int bj = 0; bj < 2; ++bj) *(u32x4*)(rowp + bj * 4 * 512) = pack8(acc[ai][bj][m][0] * rs, acc[ai][bj][m][1] * rs); }
        } else {
#pragma unroll
            for (int ai = 0; ai < 2; ++ai)
#pragma unroll
                for (int m = 0; m < 4; ++m) { if (ai == 1 && u.half) continue; const int row = row0 + ai * HALF + m * 16; const float rs = rsv[ai][m]; const float rs2 = rs * rs;
                    *(u32x4*)(CH + mt_off(row, (pn - 12) * 128 + cw, 1024)) = pack8(acc[ai][0][m][0] * acc[ai][1][m][0] * rs2, acc[ai][0][m][1] * acc[ai][1][m][1] * rs2); }
        }
    }
};
struct EpiC {
    static constexpr bool PERM = true, AFTER_DRAIN = false; static constexpr int NVM = 16; static constexpr bool NEEDS_RS = false;

    bf16_t* T;
    __device__ __forceinline__ void operator()(const f32x4 (&acc)[2][2][4][2], const Unit& u, int wr, int wc, int fr, int fq, const PG8_LAS float* rt) const {
        const int row0 = u.rbase + wr * 64 + fr, cw = u.pn * 256 + wc * 32 + 8 * fq;
#pragma unroll
        for (int ai = 0; ai < 2; ++ai)
#pragma unroll
            for (int m = 0; m < 4; ++m) { if (ai == 1 && u.half) continue; bf16_t* rowp = T + mt_off(row0 + ai * HALF + m * 16, cw, 2048);
#pragma unroll
                for (int bj = 0; bj < 2; ++bj) *(u32x4*)(rowp + bj * 4 * 512) = pack8(acc[ai][bj][m][0], acc[ai][bj][m][1]); }
    }
};
struct EpiD {
    static constexpr bool PERM = true, AFTER_DRAIN = false; static constexpr int NVM = 24; static constexpr bool NEEDS_RS = true;

    const bf16_t* T; bf16_t* MM; const float* ssq;
    __device__ __forceinline__ void operator()(const f32x4 (&acc)[2][2][4][2], const Unit& u, int wr, int wc, int fr, int fq, const PG8_LAS float* rt) const {
        const int row0 = u.rbase + wr * 64 + fr, cw = u.pn * 128 + wc * 32 + 8 * fq;
        u32x4 tt[4][2];
#pragma unroll
        for (int m = 0; m < 4; ++m) { const bf16_t* tp = T + mt_off(row0 + m * 16, cw, 2048); tt[m][0] = *(const u32x4*)tp; tt[m][1] = *(const u32x4*)(tp + 32 * 512); }
        float rsv[2][4];
#pragma unroll
        for (int ai = 0; ai < 2; ++ai)
#pragma unroll
            for (int m = 0; m < 4; ++m) rsv[ai][m] = rt[((u.rbase - u.pm * BM) + wr * 64 + ai * HALF + m * 16 + fr) & 255];
#pragma unroll
        for (int ai = 0; ai < 2; ++ai) {
            if (ai == 1 && u.half) break;
            if (ai == 1) {
#pragma unroll
                for (int m = 0; m < 4; ++m) { const bf16_t* tp = T + mt_off(row0 + HALF + m * 16, cw, 2048); tt[m][0] = *(const u32x4*)tp; tt[m][1] = *(const u32x4*)(tp + 32 * 512); } }
#pragma unroll
            for (int m = 0; m < 4; ++m) { const int row = row0 + ai * HALF + m * 16; const float rs = rsv[ai][m];
                const u32x4 t1 = tt[m][0], t2 = tt[m][1];
                const f32x4 a0 = sigmoid4(acc[ai][0][m][0] * rs), a1 = sigmoid4(acc[ai][0][m][1] * rs), b0 = sigmoid4(acc[ai][1][m][0] * rs), b1 = sigmoid4(acc[ai][1][m][1] * rs);
                const f32x4 p0 = {bf_lo(t1[0]), bf_hi(t1[0]), bf_lo(t1[1]), bf_hi(t1[1])}, p1 = {bf_lo(t1[2]), bf_hi(t1[2]), bf_lo(t1[3]), bf_hi(t1[3])};
                const f32x4 q0 = {bf_lo(t2[0]), bf_hi(t2[0]), bf_lo(t2[1]), bf_hi(t2[1])}, q1 = {bf_lo(t2[2]), bf_hi(t2[2]), bf_lo(t2[3]), bf_hi(t2[3])};
                *(u32x4*)(MM + mt_off(row, cw, 1024)) = pack8(a0 * p0 + b0 * q0, a1 * p1 + b1 * q1); }
            asm volatile("" ::: "memory");
        }
    }
};
struct EpiRes {
    static constexpr bool PERM = true, AFTER_DRAIN = false; static constexpr int NVM = 24; static constexpr bool NEEDS_RS = false;

    bf16_t* xb; float* ssq;
    __device__ __forceinline__ void operator()(const f32x4 (&acc)[2][2][4][2], const Unit& u, int wr, int wc, int fr, int fq, const PG8_LAS float* rt) const {
        const int row0 = u.rbase + wr * 64 + fr, cw = u.pn * BM + wc * 32 + 8 * fq;
#pragma unroll
        for (int ai = 0; ai < 2; ++ai) {
            if (ai == 1 && u.half) break;
            u32x4 xo[4][2];
#pragma unroll
            for (int m = 0; m < 4; ++m)
#pragma unroll
                for (int bj = 0; bj < 2; ++bj) xo[m][bj] = *(const u32x4*)(xb + mt_off(row0 + ai * HALF + m * 16, cw + bj * HALF, DM));
#pragma unroll
            for (int m = 0; m < 4; ++m) { const int row = row0 + ai * HALF + m * 16; float q = 0.f;
#pragma unroll
                for (int bj = 0; bj < 2; ++bj) { const u32x4 w = pack8(acc[ai][bj][m][0] + unpk_lo(xo[m][bj]), acc[ai][bj][m][1] + unpk_hi(xo[m][bj]));
                    *(u32x4*)(xb + mt_off(row, cw + bj * HALF, DM)) = w;
#pragma unroll
                    for (int e = 0; e < 4; ++e) { const float a = bf_lo(w[e]), b = bf_hi(w[e]); q += a * a + b * b; } }
                q += __shfl_xor(q, 16); q += __shfl_xor(q, 32);
                if (fq == 0) ssq[(size_t)row * 16 + u.pn * 4 + wc] = q; }
            asm volatile("" ::: "memory");
        }
    }
};
struct EpiF {
    static constexpr bool PERM = true, AFTER_DRAIN = false; static constexpr int NVM = 8; static constexpr bool NEEDS_RS = true;

    bf16_t* H; const float* ssq;
    __device__ __forceinline__ void operator()(const f32x4 (&acc)[2][2][4][2], const Unit& u, int wr, int wc, int fr, int fq, const PG8_LAS float* rt) const {
        const int row0 = u.rbase + wr * 64 + fr, cw = u.pn * 128 + wc * 32 + 8 * fq;
        float rsv[2][4];
#pragma unroll
        for (int ai = 0; ai < 2; ++ai)
#pragma unroll
            for (int m = 0; m < 4; ++m) rsv[ai][m] = rt[((u.rbase - u.pm * BM) + wr * 64 + ai * HALF + m * 16 + fr) & 255];
#pragma unroll
        for (int ai = 0; ai < 2; ++ai)
#pragma unroll
            for (int m = 0; m < 4; ++m) { if (ai == 1 && u.half) continue; const int row = row0 + ai * HALF + m * 16; const float rs = rsv[ai][m];
                const f32x4 g0 = acc[ai][0][m][0] * rs, g1 = acc[ai][0][m][1] * rs, u0 = acc[ai][1][m][0] * rs, u1 = acc[ai][1][m][1] * rs;
                *(u32x4*)(H + mt_off(row, cw, DFF)) = pack8(g0 * sigmoid4(g0) * u0, g1 * sigmoid4(g1) * u1); }
    }
};

#ifndef PG8_SP2
#define PG8_SP2 true
#endif
#ifndef PG8_ALIGN
#define PG8_ALIGN true
#endif
template <class Epi, class Sched, bool SP2 = PG8_SP2, bool ALIGN_EPI = PG8_ALIGN>
__device__ __forceinline__ void gemm_phase(PG8_LAS unsigned char* lds, const Gemm g, const Sched& S, const Epi& E, PG8_LAS float* rstab) {
    int tid = threadIdx.x; asm volatile("" : "+v"(tid));
    const int wid = __builtin_amdgcn_readfirstlane(tid >> 6), lane = tid & 63, wr = wid >> 2, wc = wid & 3, fr = lane & 15, fq = lane >> 4;
    const int K = g.K, nt = K / BK, lda = g.lda;
    unsigned voffA[2], voffB[2];
#pragma unroll
    for (int i = 0; i < 2; ++i) { int R, C; stage_rc(tid * 16 + i * 8192, R, C); const int Rb = Epi::PERM ? ((R & ~31) + perm32(R & 31)) : R;
        (void)Rb; static_assert(Epi::PERM, "the weight copies are stored with the 32-row permutation baked in");
        voffA[i] = (unsigned)mt_off(R, C, lda) * 2u; voffB[i] = (unsigned)mt_off(R, C, K) * 2u; }
    const size_t kstep = (size_t)2048;
    const size_t hstepA = (size_t)HALF * lda * 2, hstepB = (size_t)HALF * K * 2;
    const size_t tstepA = 2 * hstepA, tstepB = 2 * hstepB;
    const unsigned ldsw = (unsigned)wid * 1024u;
    const int aoff = lds_byte(wr * 64 + fr, fq * 8), boff = lds_byte(wc * 32 + fr, fq * 8);
#define PG8_SA(b, h) (((b) * 2 + (h)) * HTB)
#define PG8_SB(b, h) ((4 + (b) * 2 + (h)) * HTB)
#define PG8_STAGE(bufoff, gbase, voff) do { _Pragma("unroll") for (int _i = 0; _i < 2; ++_i) \
        __builtin_amdgcn_global_load_lds((const unsigned*)((const char*)(gbase) + (voff)[_i]), (PG8_LAS unsigned*)(lds + (bufoff) + ldsw + _i * 8192), 16, 0, 0); } while (0)
#define PG8_LDA(dst, b, h) do { _Pragma("unroll") for (int m = 0; m < 4; ++m) _Pragma("unroll") for (int k = 0; k < 2; ++k) dst[m][k] = *(const PG8_LAS bf16x8*)(lds + PG8_SA(b, h) + aoff + m * 2048 + k * 1024); } while (0)
#define PG8_LDB(dst, b, h) do { _Pragma("unroll") for (int n = 0; n < 2; ++n) _Pragma("unroll") for (int k = 0; k < 2; ++k) dst[n][k] = *(const PG8_LAS bf16x8*)(lds + PG8_SB(b, h) + boff + n * 2048 + k * 1024); } while (0)
#define PG8_MMA(ai, bj, At, Bt) do { __builtin_amdgcn_s_setprio(1); _Pragma("unroll") for (int m = 0; m < 4; ++m) _Pragma("unroll") for (int n = 0; n < 2; ++n) _Pragma("unroll") for (int k = 0; k < 2; ++k) \
        acc[ai][bj][m][n] = __builtin_amdgcn_mfma_f32_16x16x32_bf16(Bt[n][k], At[m][k], acc[ai][bj][m][n], 0, 0, 0); __builtin_amdgcn_s_setprio(0); } while (0)
#define PG8_WAIT_V(n) asm volatile("s_waitcnt vmcnt(" #n ")" ::: "memory")
#define PG8_WAIT_L(n) asm volatile("s_waitcnt lgkmcnt(" #n ")" ::: "memory")
#define PG8_WAIT_V8X do { if constexpr (Epi::NVM >= 24) asm volatile("s_cmp_eq_u32 %0, 0\n\ts_cbranch_scc1 1f\n\ts_waitcnt vmcnt(8)\n1:\n\ts_waitcnt vmcnt(32)" :: "s"(t) : "scc", "memory"); \
        else if constexpr (Epi::NVM >= 16) asm volatile("s_cmp_eq_u32 %0, 0\n\ts_cbranch_scc1 1f\n\ts_waitcnt vmcnt(8)\n1:\n\ts_waitcnt vmcnt(24)" :: "s"(t) : "scc", "memory"); \
        else asm volatile("s_cmp_eq_u32 %0, 0\n\ts_cbranch_scc1 1f\n\ts_waitcnt vmcnt(8)\n1:\n\ts_waitcnt vmcnt(16)" :: "s"(t) : "scc", "memory"); } while (0)
#define PG8_BAR __builtin_amdgcn_s_barrier()
#define PG8_SCHED __builtin_amdgcn_sched_barrier(0)
#define PG8_APTR(u) ((const char*)g.A + (size_t)((u).rbase) * lda * 2 + (((u).pn >= g.asplit_pn) ? (size_t)g.asplit_off * 32 : (size_t)0))
    Unit cur, nxt; int ui = 0;
    if (!S.next(0, cur)) return;
    int tab_pm = -1, tab_sel = 0;
#define PG8_RSTAB(u) do { if constexpr (Epi::NEEDS_RS) { if ((u).pm != tab_pm) { tab_pm = (u).pm; tab_sel ^= 1; \
        const f32x4* s_ = (const f32x4*)(E.ssq + ((size_t)(u).pm * BM + (tid >> 1)) * 16 + (tid & 1) * 8); const f32x4 t_ = s_[0] + s_[1]; float v_ = (t_[0] + t_[1]) + (t_[2] + t_[3]); \
        v_ += __shfl_xor(v_, 1); if ((tid & 1) == 0) rstab[tab_sel * 256 + (tid >> 1)] = __builtin_amdgcn_rsqf(v_ * (1.0f / 1024.0f) + EPS); } } } while (0)
    PG8_RSTAB(cur);
    f32x4 acc[2][2][4][2];
#pragma unroll
    for (int a = 0; a < 2; ++a)
#pragma unroll
        for (int b = 0; b < 2; ++b)
#pragma unroll
            for (int m = 0; m < 4; ++m)
#pragma unroll
                for (int n = 0; n < 2; ++n) acc[a][b][m][n] = (f32x4){0.f, 0.f, 0.f, 0.f};
    bf16x8 At[4][2], B0[2][2], B1[2][2];
    const char* cA = PG8_APTR(cur); const char* cB = (const char*)g.Bt + (size_t)cur.pn * tstepB;
    S.a_ready(cur);
    if constexpr (SP2) {
        PG8_STAGE(PG8_SB(0, 0), cB, voffB); PG8_STAGE(PG8_SB(0, 1), cB + hstepB, voffB); PG8_STAGE(PG8_SA(0, 0), cA, voffA); PG8_STAGE(PG8_SA(0, 1), cA + hstepA, voffA);
        if (wr == 1) PG8_BAR;
        PG8_WAIT_V(2); PG8_BAR;
        PG8_STAGE(PG8_SB(1, 0), cB + kstep, voffB); PG8_STAGE(PG8_SA(1, 0), cA + kstep, voffA); PG8_STAGE(PG8_SB(1, 1), cB + hstepB + kstep, voffB);
        PG8_WAIT_V(0); PG8_BAR;
    } else {
    PG8_STAGE(PG8_SB(0, 0), cB, voffB); PG8_STAGE(PG8_SA(0, 0), cA, voffA); PG8_STAGE(PG8_SB(0, 1), cB + hstepB, voffB); PG8_STAGE(PG8_SA(0, 1), cA + hstepA, voffA);
    if (wr == 1) PG8_BAR;
    PG8_WAIT_V(4); PG8_BAR;
    PG8_STAGE(PG8_SB(1, 0), cB + kstep, voffB); PG8_STAGE(PG8_SA(1, 0), cA + kstep, voffA); PG8_STAGE(PG8_SB(1, 1), cB + hstepB + kstep, voffB);
    PG8_WAIT_V(6); PG8_BAR;
    }
    for (;;) {
        const bool has_next = S.next(ui + 1, nxt);
        const char* nA = has_next ? PG8_APTR(nxt) : cA; const char* nB = has_next ? (const char*)g.Bt + (size_t)nxt.pn * tstepB : cB;
        const bool hlf = cur.half != 0;
        for (int t = 0; t < nt; t += 2) {
            const bool last = (t == nt - 2);
            const char* a1 = cA + (size_t)(t + 1) * kstep;
            const char* a2 = last ? nA : cA + (size_t)(t + 2) * kstep; const char* b2 = last ? nB : cB + (size_t)(t + 2) * kstep;
            const char* a3 = a2 + kstep; const char* b3 = b2 + kstep;
            if (last && has_next) S.a_ready(nxt);
            if constexpr (SP2) {
            PG8_LDB(B0, 0, 0); PG8_LDB(B1, 0, 1); PG8_SCHED; PG8_LDA(At, 0, 0); PG8_STAGE(PG8_SA(1, 1), a1 + hstepA, voffA);
            PG8_WAIT_V8X; PG8_WAIT_L(0); PG8_BAR; PG8_MMA(0, 0, At, B0); PG8_MMA(0, 1, At, B1); PG8_BAR; PG8_SCHED;
            if (!hlf) { PG8_LDA(At, 0, 1); } PG8_STAGE(PG8_SB(0, 0), b2, voffB); PG8_STAGE(PG8_SB(0, 1), b2 + hstepB, voffB); PG8_STAGE(PG8_SA(0, 0), a2, voffA);
            PG8_WAIT_V8X; PG8_WAIT_L(0); PG8_BAR; if (!hlf) { PG8_MMA(1, 0, At, B0); PG8_MMA(1, 1, At, B1); } PG8_BAR; PG8_SCHED;
            PG8_LDB(B0, 1, 0); PG8_LDB(B1, 1, 1); PG8_SCHED; PG8_LDA(At, 1, 0); PG8_STAGE(PG8_SA(0, 1), a2 + hstepA, voffA);
            PG8_WAIT_V(8); PG8_WAIT_L(0); PG8_BAR; PG8_MMA(0, 0, At, B0); PG8_MMA(0, 1, At, B1); PG8_BAR; PG8_SCHED;
            if (!hlf) { PG8_LDA(At, 1, 1); } PG8_STAGE(PG8_SB(1, 0), b3, voffB); PG8_STAGE(PG8_SB(1, 1), b3 + hstepB, voffB); PG8_STAGE(PG8_SA(1, 0), a3, voffA);
            PG8_WAIT_V(8); PG8_WAIT_L(0); PG8_BAR; if (!hlf) { PG8_MMA(1, 0, At, B0); PG8_MMA(1, 1, At, B1); } PG8_BAR; PG8_SCHED;
            } else {
            PG8_LDB(B0, 0, 0); PG8_SCHED; PG8_LDA(At, 0, 0); PG8_STAGE(PG8_SA(1, 1), a1 + hstepA, voffA);
            PG8_WAIT_L(8); PG8_BAR; PG8_WAIT_L(0); PG8_MMA(0, 0, At, B0); PG8_BAR; PG8_SCHED;
            PG8_LDB(B1, 0, 1); PG8_STAGE(PG8_SB(0, 0), b2, voffB);
            PG8_BAR; PG8_WAIT_L(0); PG8_MMA(0, 1, At, B1); PG8_BAR;
            PG8_LDA(At, 0, 1); PG8_STAGE(PG8_SA(0, 0), a2, voffA);
            PG8_BAR; PG8_WAIT_L(0); PG8_MMA(1, 0, At, B0); PG8_BAR; PG8_SCHED;
            PG8_STAGE(PG8_SB(0, 1), b2 + hstepB, voffB);
            PG8_WAIT_V(6); PG8_BAR; PG8_MMA(1, 1, At, B1); PG8_BAR;
            PG8_LDB(B0, 1, 0); PG8_SCHED; PG8_LDA(At, 1, 0); PG8_STAGE(PG8_SA(0, 1), a2 + hstepA, voffA);
            PG8_WAIT_L(8); PG8_BAR; PG8_WAIT_L(0); PG8_MMA(0, 0, At, B0); PG8_BAR; PG8_SCHED;
            PG8_LDB(B1, 1, 1); PG8_STAGE(PG8_SB(1, 0), b3, voffB);
            PG8_BAR; PG8_WAIT_L(0); PG8_MMA(0, 1, At, B1); PG8_BAR;
            PG8_LDA(At, 1, 1); PG8_STAGE(PG8_SA(1, 0), a3, voffA);
            PG8_BAR; PG8_WAIT_L(0); PG8_MMA(1, 0, At, B0); PG8_BAR; PG8_SCHED;
            PG8_STAGE(PG8_SB(1, 1), b3 + hstepB, voffB);
            PG8_WAIT_V(6); PG8_BAR; PG8_MMA(1, 1, At, B1); PG8_BAR;
            }
        }
        if constexpr (ALIGN_EPI) { if (wr == 0) PG8_BAR; }
        E(acc, cur, wr, wc, fr, fq, rstab + tab_sel * 256); S.done(cur);
        if (!has_next) break;
#pragma unroll
        for (int a = 0; a < 2; ++a)
#pragma unroll
            for (int b = 0; b < 2; ++b)
#pragma unroll
                for (int m = 0; m < 4; ++m)
#pragma unroll
                    for (int n = 0; n < 2; ++n) acc[a][b][m][n] = (f32x4){0.f, 0.f, 0.f, 0.f};
        cur = nxt; cA = nA; cB = nB; ++ui;
        PG8_RSTAB(cur);
        if constexpr (ALIGN_EPI) { if (wr == 1) PG8_BAR; }
    }
    PG8_WAIT_V(0);
    if constexpr (!ALIGN_EPI) { if (wr == 0) PG8_BAR; }
    PG8_BAR;
#undef PG8_APTR
#undef PG8_RSTAB
#undef PG8_SA
#undef PG8_SB
#undef PG8_STAGE
#undef PG8_LDA
#undef PG8_LDB
#undef PG8_MMA
#undef PG8_WAIT_V
#undef PG8_WAIT_L
#undef PG8_WAIT_V8X
#undef PG8_BAR
#undef PG8_SCHED
}
}

using pg8::bf16_t; using pg8::f32x4; using pg8::u32x4; using pg8::u32x2; using pg8::bf16x8;
using pg8::cvt_pk_bf16; using pg8::bf_lo; using pg8::bf_hi;

struct Params {
    const float* x_prompt; const float* x_sample; const float* state_conv; const float* norm_mix; const float* w_in; const float* ln_g; const float* ln_b;
    const float* w_s; const float* b_s; const float* conv_w; const float* w_pa; const float* w_pb; const float* w_o; const float* norm_ffn;
    const float* w_gate; const float* w_up; const float* w_down; const float* norm_final;
    float* out; unsigned char* ws; int ph_lo, ph_hi;
};
constexpr int LDS_BYTES = pg8::STAGE_BYTES + 256 + 2048;
constexpr int NPHASE = 2 + 7 * NL;

__device__ __forceinline__ void transpose_tile(const float* __restrict__ src, int ld, int k0, int col0, const float* __restrict__ scale, bf16_t* __restrict__ dstbase, int n0, int K, float* t, int tid) {
    const int r = tid >> 4, c4 = tid & 15;
#pragma unroll
    for (int pass = 0; pass < 2; ++pass) { const int k = r + 32 * pass; const f32x4 v = *(const f32x4*)(src + (size_t)(k0 + k) * ld + col0 + 4 * c4); const float s = scale ? scale[k0 + k] : 1.0f;
        t[k * 65 + 4 * c4 + 0] = v[0] * s; t[k * 65 + 4 * c4 + 1] = v[1] * s; t[k * 65 + 4 * c4 + 2] = v[2] * s; t[k * 65 + 4 * c4 + 3] = v[3] * s; }
    __syncthreads();
    const int n = tid >> 3, kc = tid & 7; u32x4 w;
    w.x = cvt_pk_bf16(t[(8 * kc + 0) * 65 + n], t[(8 * kc + 1) * 65 + n]); w.y = cvt_pk_bf16(t[(8 * kc + 2) * 65 + n], t[(8 * kc + 3) * 65 + n]);
    w.z = cvt_pk_bf16(t[(8 * kc + 4) * 65 + n], t[(8 * kc + 5) * 65 + n]); w.w = cvt_pk_bf16(t[(8 * kc + 6) * 65 + n], t[(8 * kc + 7) * 65 + n]);
    const int nl = n0 + n, c5 = nl & 31, rho = 16 * ((c5 >> 2) & 1) + (((c5 >> 3) << 2) | (c5 & 3)), P = (nl & ~31) + rho;
    *(u32x4*)(dstbase + pg8::mt_off(P, k0 + 8 * kc, K)) = w;
    __syncthreads();
}
constexpr int IT_WIN = (NIN / 64) * 16, IT_WPAB = 32 * 16, IT_WO = 16 * 16, IT_WGU = (2 * DFF / 64) * 16, IT_WD = 16 * (DFF / 64), IT_LAYER = IT_WIN + IT_WPAB + IT_WO + IT_WGU + IT_WD;

__device__ __forceinline__ void p0_prologue(const Params& p, float* ldsf, int layer, int first, bool misc) {
    unsigned char* ws = p.ws;
    float* ssqm = (float*)(ws + WS_SSQM);
    int tid = threadIdx.x; asm volatile("" : "+v"(tid));
    const int G = gridDim.x, b = blockIdx.x;
    for (int it = b - first; it >= 0 && it < IT_LAYER; it += G - first) {
        const int l = layer; int r = it; unsigned char* lw = ws + WS_W + (size_t)l * LW_BYTES;
        if (r < IT_WIN) { const int ntile = r >> 4, kt = r & 15, n0 = ntile * 64; int col;
            if (n0 < 3072) col = n0; else if (n0 < 5120) { const int t = n0 - 3072; col = ((t & 128) ? 4096 : 3072) + (t >> 8) * 128 + (t & 127); } else { const int t = n0 - 5120; col = ((t & 128) ? 6144 : 5120) + (t >> 8) * 128 + (t & 127); }
            transpose_tile(p.w_in + (size_t)l * DM * NIN, NIN, kt * 64, col, p.norm_mix + l * DM, (bf16_t*)(lw + LW_WIN), n0, DM, ldsf, tid); continue; }
        r -= IT_WIN;
        if (r < IT_WPAB) { const int ntile = r >> 4, kt = r & 15, n0 = ntile * 64;
            const float* src = (n0 < 1024) ? p.w_pa + (size_t)l * DM * DM : p.w_pb + (size_t)l * DM * DM;
            transpose_tile(src, DM, kt * 64, n0 & 1023, nullptr, (bf16_t*)(lw + LW_WPAB), n0, DM, ldsf, tid); continue; }
        r -= IT_WPAB;
        if (r < IT_WO) { const int ntile = r >> 4, kt = r & 15, n0 = ntile * 64;
            transpose_tile(p.w_o + (size_t)l * DM * DM, DM, kt * 64, n0, nullptr, (bf16_t*)(lw + LW_WO), n0, DM, ldsf, tid); continue; }
        r -= IT_WO;
        if (r < IT_WGU) { const int ntile = r >> 4, kt = r & 15, n0 = ntile * 64;
            const float* src = ((n0 & 128) ? p.w_up : p.w_gate) + (size_t)l * DM * DFF; const int col = (n0 >> 8) * 128 + (n0 & 127);
            transpose_tile(src, DFF, kt * 64, col, p.norm_ffn + l * DM, (bf16_t*)(lw + LW_WGU), n0, DM, ldsf, tid); continue; }
        r -= IT_WGU;
        { const int ntile = r / (DFF / 64), kt = r % (DFF / 64), n0 = ntile * 64;
            transpose_tile(p.w_down + (size_t)l * DFF * DM, DM, kt * 64, n0, nullptr, (bf16_t*)(lw + LW_WD), n0, DFF, ldsf, tid); }
    }
    if (!misc) return;
    for (int i = b * 512 + tid; i < NL * 8 * 128 * 128; i += G * 512) {
        const int l = i >> 17, rem = i & 131071, ii = (rem >> 7) & 127, jj = rem & 127;
        const float* wsrc = p.w_s + (size_t)(i - rem);
        const int grp = rem >> 14;
        unsigned char* lw = ws + WS_W + (size_t)l * LW_BYTES;
        const float vp = (jj <= ii) ? p.w_s[i] : 0.f;
        const float vs = ((ii >> 5) == (jj >> 5) && (jj & 31) <= (ii & 31)) ? wsrc[grp * 16384 + (ii & 31) * 128 + (jj & 31)] : 0.f;
        ((bf16_t*)(lw + LW_WSP))[rem] = (bf16_t)(cvt_pk_bf16(vp, 0.f) & 0xffffu);
        ((bf16_t*)(lw + LW_WSS))[rem] = (bf16_t)(cvt_pk_bf16(vs, 0.f) & 0xffffu);
    }
    { const int wave = tid >> 6, lane = tid & 63; bf16_t* xb = (bf16_t*)(ws + WS_XB);
      for (int row = b * 8 + wave; row < MT; row += 2 * G * 8) {
          const int row2 = row + G * 8; const bool has2 = row2 < MT;
          const float* xr = (row < MP) ? p.x_prompt + (size_t)row * DM : p.x_sample + (size_t)(row - MP) * DM;
          const float* xr2 = has2 ? ((row2 < MP) ? p.x_prompt + (size_t)row2 * DM : p.x_sample + (size_t)(row2 - MP) * DM) : xr;
          f32x4 v[4], v2[4];
#pragma unroll
          for (int j = 0; j < 4; ++j) { v[j] = *(const f32x4*)(xr + 4 * (lane + 64 * j)); v2[j] = *(const f32x4*)(xr2 + 4 * (lane + 64 * j)); }
          float q = 0.f, q2 = 0.f;
#pragma unroll
          for (int j = 0; j < 4; ++j) { q += (v[j][0] * v[j][0] + v[j][1] * v[j][1]) + (v[j][2] * v[j][2] + v[j][3] * v[j][3]); q2 += (v2[j][0] * v2[j][0] + v2[j][1] * v2[j][1]) + (v2[j][2] * v2[j][2] + v2[j][3] * v2[j][3]);
              u32x2 w; w.x = cvt_pk_bf16(v[j][0], v[j][1]); w.y = cvt_pk_bf16(v[j][2], v[j][3]); *(u32x2*)(xb + pg8::mt_off(row, 4 * (lane + 64 * j), DM)) = w;
              if (has2) { u32x2 w2; w2.x = cvt_pk_bf16(v2[j][0], v2[j][1]); w2.y = cvt_pk_bf16(v2[j][2], v2[j][3]); *(u32x2*)(xb + pg8::mt_off(row2, 4 * (lane + 64 * j), DM)) = w2; } }
#pragma unroll
          for (int o = 32; o >= 1; o >>= 1) { q += __shfl_xor(q, o); q2 += __shfl_xor(q2, o); }
          if (lane < 4) { ((f32x4*)(ssqm + (size_t)row * 16))[lane] = (f32x4){lane == 0 ? q : 0.f, 0.f, 0.f, 0.f};
              if (has2) ((f32x4*)(ssqm + (size_t)row2 * 16))[lane] = (f32x4){lane == 0 ? q2 : 0.f, 0.f, 0.f, 0.f}; }
      } }
}

constexpr int VT_PITCH = 136;
__device__ __forceinline__ void gate_conv_phase(const Params& p, int l, unsigned char* lds) {
    unsigned char* ws = p.ws;
    const float* lns = (const float*)(ws + WS_LNS);
    bf16_t* AB = (bf16_t*)(ws + WS_AB); const bf16_t* GV = (const bf16_t*)(ws + WS_GV); const bf16_t* CH = (const bf16_t*)(ws + WS_CH);
    const unsigned char* lw = ws + WS_W + (size_t)l * LW_BYTES;
    bf16_t* vT = (bf16_t*)lds;
    float* mr = (float*)(lds + 128 * VT_PITCH * 2);
    int tid = threadIdx.x; asm volatile("" : "+v"(tid));
    const int lane = tid & 63, w = tid >> 6, fr = lane & 15, fq = lane >> 4;
    const int jg = tid >> 5, cq = tid & 31;
    const int col8 = ((tid >> 6) & 3) * 32 + (lane & 3) * 8;
    const int nks = (w >> 1) + 1;
    const int total = (MT / 128) * 8;
    int item = blockIdx.x; if (item >= total) return;
    const int g = item & 7, c0 = g * 128, irow = 16 * w + fr;
    const bf16_t* WsP = (const bf16_t*)(lw + LW_WSP) + g * 16384 + irow * 128 + 8 * fq;
    bf16x8 wf[4];
#pragma unroll
    for (int ks = 0; ks < 4; ++ks) wf[ks] = *(const bf16x8*)(WsP + 32 * ks);
    float bs = p.b_s[(l * 8 + g) * 128 + irow];
    const float* cwp = p.conv_w + (size_t)l * 3 * DM + c0 + col8;
    bool was_smp = false;
    f32x4 sl0, sl1; u32x2 gv[8]; u32x4 uu[4];
#define GC_LOAD(it) do { const int r0_ = ((it) >> 3) * 128; \
        const f32x4* sl_ = (const f32x4*)(lns + (size_t)(r0_ + (tid >> 2)) * 32 + (tid & 3) * 8); sl0 = sl_[0]; sl1 = sl_[1]; \
        _Pragma("unroll") for (int jj = 0; jj < 8; ++jj) gv[jj] = *(const u32x2*)(GV + pg8::mt_off(r0_ + 8 * jg + jj, c0 + 4 * cq, DM)); } while (0)
#define GC_LOADU(it) do { const int r0_ = ((it) >> 3) * 128; \
        _Pragma("unroll") for (int pp = 0; pp < 4; ++pp) uu[pp] = *(const u32x4*)(AB + pg8::mt_off(r0_ + irow, c0 + 8 * fq, 2048) + 512 * pp); } while (0)
    for (;;) {
        const int ct = item >> 3, row0 = ct * 128; const bool smp = ct >= MP / 128;
        GC_LOAD(item); GC_LOADU(item);
        if (smp && !was_smp) {
            const bf16_t* WsS = (const bf16_t*)(lw + LW_WSS) + g * 16384 + irow * 128 + 8 * fq;
#pragma unroll
            for (int ks = 0; ks < 4; ++ks) wf[ks] = *(const bf16x8*)(WsS + 32 * ks);
            bs = p.b_s[(l * 8 + g) * 128 + (irow & 31)]; was_smp = true; }
        bf16_t* rowp = AB + pg8::mt_off(row0 + irow, c0 + 8 * fq, 2048);
        const f32x4 lg = *(const f32x4*)(p.ln_g + l * DM + c0 + 4 * cq), lb = *(const f32x4*)(p.ln_b + l * DM + c0 + 4 * cq);
        { float sm = (sl0[0] + sl0[2]) + (sl1[0] + sl1[2]), sq = (sl0[1] + sl0[3]) + (sl1[1] + sl1[3]);
          sm += __shfl_xor(sm, 1); sq += __shfl_xor(sq, 1); sm += __shfl_xor(sm, 2); sq += __shfl_xor(sq, 2);
          if ((tid & 3) == 0) { const float mean = sm * (1.0f / 1024.0f), var = sq * (1.0f / 1024.0f) - mean * mean; mr[2 * (tid >> 2)] = mean; mr[2 * (tid >> 2) + 1] = __builtin_amdgcn_rsqf(fmaxf(var, 0.f) + EPS); } }
        __syncthreads();
        { float v[8][4];
#pragma unroll
          for (int jj = 0; jj < 8; ++jj) { const float mean = mr[2 * (8 * jg + jj)], rstd = mr[2 * (8 * jg + jj) + 1];
              v[jj][0] = (bf_lo(gv[jj].x) - mean) * rstd * lg[0] + lb[0]; v[jj][1] = (bf_hi(gv[jj].x) - mean) * rstd * lg[1] + lb[1];
              v[jj][2] = (bf_lo(gv[jj].y) - mean) * rstd * lg[2] + lb[2]; v[jj][3] = (bf_hi(gv[jj].y) - mean) * rstd * lg[3] + lb[3];
              if (smp) *(f32x4*)(p.out + OUT_V + ((size_t)l * MS + (row0 + 8 * jg + jj - MP)) * DM + c0 + 4 * cq) = (f32x4){v[jj][0], v[jj][1], v[jj][2], v[jj][3]}; }
#pragma unroll
          for (int e = 0; e < 4; ++e) { u32x4 wv; wv.x = cvt_pk_bf16(v[0][e], v[1][e]); wv.y = cvt_pk_bf16(v[2][e], v[3][e]); wv.z = cvt_pk_bf16(v[4][e], v[5][e]); wv.w = cvt_pk_bf16(v[6][e], v[7][e]);
              *(u32x4*)(vT + (4 * cq + e) * VT_PITCH + 8 * jg) = wv; } }
        u32x4 ch0[4], ch1[4], ch2[4], bg[4];
        const int i0 = ((w >> 2) << 4) + (lane >> 2);
        const bf16_t* chb = CH + pg8::mt_off(row0 + i0, c0 + col8, DM); const bf16_t* bgl = AB + pg8::mt_off(row0 + i0, 1024 + c0 + col8, 2048);
        const int d1 = ((lane >> 2) >= 1) ? 32 : ((DM >> 5) * 512 - 15 * 32), d2 = ((lane >> 2) >= 2) ? 64 : ((DM >> 5) * 512 - 14 * 32);
#pragma unroll
        for (int vv = 0; vv < 4; ++vv) { const int i = (((w >> 2) + 2 * vv) << 4) + (lane >> 2), row = row0 + i, c = c0 + col8; const int pos = smp ? ((row - MP) & 31) : (row & 2047);
            const u32x4 z4 = {0u, 0u, 0u, 0u};
            const bf16_t* chp = chb + (size_t)vv * (2 * (DM >> 5) * 512);
            ch0[vv] = *(const u32x4*)chp;
            ch1[vv] = (pos >= 1) ? *(const u32x4*)(chp - d1) : z4;
            ch2[vv] = (pos >= 2) ? *(const u32x4*)(chp - d2) : z4;
            bg[vv] = *(const u32x4*)(bgl + (size_t)vv * (2 * 64 * 512)); (void)c; }
        const int nitem = item + (int)gridDim.x; const bool has_next = nitem < total;
        __syncthreads();
        { f32x4 acc[8];
#pragma unroll
          for (int dt = 0; dt < 8; ++dt) acc[dt] = (f32x4){0.f, 0.f, 0.f, 0.f};
#pragma unroll
          for (int ks = 0; ks < 4; ++ks) if (ks < nks) {
#pragma unroll
              for (int dt = 0; dt < 8; ++dt) { const int d = 32 * (dt >> 1) + 8 * (fr >> 2) + 4 * (dt & 1) + (fr & 3);
                  const bf16x8 vf = *(const bf16x8*)(vT + d * VT_PITCH + 32 * ks + 8 * fq);
                  acc[dt] = __builtin_amdgcn_mfma_f32_16x16x32_bf16(vf, wf[ks], acc[dt], 0, 0, 0); } }
#pragma unroll
          for (int pp = 0; pp < 4; ++pp) { const f32x4 s0 = acc[2 * pp] + bs, s1 = acc[2 * pp + 1] + bs;
              const f32x4 u0 = {bf_lo(uu[pp][0]), bf_hi(uu[pp][0]), bf_lo(uu[pp][1]), bf_hi(uu[pp][1])}, u1 = {bf_lo(uu[pp][2]), bf_hi(uu[pp][2]), bf_lo(uu[pp][3]), bf_hi(uu[pp][3])};
              *(u32x4*)(rowp + 512 * pp) = pg8::pack8(u0 * s0, u1 * s1); } }
        const f32x4 w0a = *(const f32x4*)(cwp), w0b = *(const f32x4*)(cwp + 4), w1a = *(const f32x4*)(cwp + DM), w1b = *(const f32x4*)(cwp + DM + 4), w2a = *(const f32x4*)(cwp + 2 * DM), w2b = *(const f32x4*)(cwp + 2 * DM + 4);
#pragma unroll
        for (int vv = 0; vv < 4; ++vv) { const int i = (((w >> 2) + 2 * vv) << 4) + (lane >> 2), row = row0 + i, c = c0 + col8; const int pos = smp ? ((row - MP) & 31) : (row & 2047);
            float f0[8], f1[8], f2[8], o[8];
#pragma unroll
            for (int e = 0; e < 4; ++e) { f0[2 * e] = bf_lo(ch0[vv][e]); f0[2 * e + 1] = bf_hi(ch0[vv][e]); f1[2 * e] = bf_lo(ch1[vv][e]); f1[2 * e + 1] = bf_hi(ch1[vv][e]); f2[2 * e] = bf_lo(ch2[vv][e]); f2[2 * e + 1] = bf_hi(ch2[vv][e]); }
            if (smp && pos < 2) { const int sq = (row - MP) >> 5; const float* stp = p.state_conv + ((size_t)(l * 32 + sq) * 2) * DM + c;
                if (pos == 0) { const f32x4 a = *(const f32x4*)(stp + DM), bq = *(const f32x4*)(stp + DM + 4); f1[0] = a[0]; f1[1] = a[1]; f1[2] = a[2]; f1[3] = a[3]; f1[4] = bq[0]; f1[5] = bq[1]; f1[6] = bq[2]; f1[7] = bq[3]; }
                { const float* s2 = stp + (pos == 0 ? 0 : DM); const f32x4 a = *(const f32x4*)(s2), bq = *(const f32x4*)(s2 + 4); f2[0] = a[0]; f2[1] = a[1]; f2[2] = a[2]; f2[3] = a[3]; f2[4] = bq[0]; f2[5] = bq[1]; f2[6] = bq[2]; f2[7] = bq[3]; } }
#pragma unroll
            for (int e = 0; e < 4; ++e) { o[e] = w0a[e] * f2[e] + w1a[e] * f1[e] + w2a[e] * f0[e]; o[4 + e] = w0b[e] * f2[4 + e] + w1b[e] * f1[4 + e] + w2b[e] * f0[4 + e]; }
            u32x4 ov;
#pragma unroll
            for (int e = 0; e < 4; ++e) ov[e] = cvt_pk_bf16(o[2 * e] * bf_lo(bg[vv][e]), o[2 * e + 1] * bf_hi(bg[vv][e]));
            *(u32x4*)(AB + pg8::mt_off(row, 1024 + c, 2048)) = ov;
            const int lastpos = smp ? 31 : 2047;
            if (pos >= lastpos - 1) { float* op = smp ? p.out + OUT_NCS + (((size_t)l * 32 + ((row - MP) >> 5)) * 2 + (pos - (lastpos - 1))) * DM + c
                                                      : p.out + OUT_NCP + (((size_t)l * 32 + (row >> 11)) * 2 + (pos - (lastpos - 1))) * DM + c;
                *(f32x4*)op = (f32x4){f0[0], f0[1], f0[2], f0[3]}; *(f32x4*)(op + 4) = (f32x4){f0[4], f0[5], f0[6], f0[7]}; } }
        __syncthreads();
        if (!has_next) break;
        item = nitem;
    }
#undef GC_LOAD
#undef GC_LOADU
}

__device__ __forceinline__ void final_norm_phase(const Params& p) {
    const float* __restrict__ ssq = (const float*)(p.ws + WS_SSQM); const bf16_t* __restrict__ xb = (const bf16_t*)(p.ws + WS_XB); float* __restrict__ out = p.out;
    const size_t n8 = (size_t)MT * DM / 8;
    int tid = threadIdx.x; asm volatile("" : "+v"(tid));
    const size_t stride = (size_t)gridDim.x * 512;
    const int c = (tid & 127) * 8;
    const f32x4 g0 = *(const f32x4*)(p.norm_final + c), g1 = *(const f32x4*)(p.norm_final + c + 4);
    for (size_t i = (size_t)blockIdx.x * 512 + tid; i < n8; i += 4 * stride) {
        u32x4 w[4]; f32x4 s0[4], s1[4], s2[4], s3[4];
#pragma unroll
        for (int k = 0; k < 4; ++k) { const size_t ii = i + k * stride; if (ii < n8) { w[k] = *(const u32x4*)(xb + pg8::mt_off((int)(ii >> 7), c, DM)); const f32x4* s = (const f32x4*)(ssq + (ii >> 7) * 16); s0[k] = s[0]; s1[k] = s[1]; s2[k] = s[2]; s3[k] = s[3]; } }
#pragma unroll
        for (int k = 0; k < 4; ++k) { const size_t ii = i + k * stride; if (ii < n8) { const f32x4 t = (s0[k] + s1[k]) + (s2[k] + s3[k]);
            const float rs = __builtin_amdgcn_rsqf(((t[0] + t[1]) + (t[2] + t[3])) * (1.0f / 1024.0f) + EPS);
            ((f32x4*)out)[2 * ii] = pg8::unpk_lo(w[k]) * rs * g0; ((f32x4*)out)[2 * ii + 1] = pg8::unpk_hi(w[k]) * rs * g1; } }
    }
}

#define LAS __attribute__((address_space(3)))
#define XB_TMO      128
#define XB_XCNT(j)  (256  + 64 * (j))
#define XB_XSUB(j)  (1280 + 64 * (j))
#define XB_XGEN(j)  (2304 + 64 * (j))
#define XB_TOP      3328
#define XB_TOPGEN   3392
#define XCD_BAR_WORDS 3456
#define XB_SPIN_CAP (1u << 18)

__device__ __forceinline__ unsigned xb_ld(unsigned* p)              { return __hip_atomic_load(p, __ATOMIC_RELAXED, __HIP_MEMORY_SCOPE_AGENT); }
__device__ __forceinline__ unsigned xb_add(unsigned* p, unsigned v) { return __hip_atomic_fetch_add(p, v, __ATOMIC_RELAXED, __HIP_MEMORY_SCOPE_AGENT); }
__device__ __forceinline__ unsigned xb_xcc_id() { return (unsigned)__builtin_amdgcn_s_getreg((3 << 11) | 20) & 0xFu; }
#define XB_SPIN(cond, bar) do { unsigned _sp = 0; while (cond) { __builtin_amdgcn_s_sleep(1); \
    if ((++_sp & 255u) == 0u) { if (xb_ld(&(bar)[XB_TMO])) break; if (_sp > XB_SPIN_CAP) { atomicAdd(&(bar)[XB_TMO], 1u); break; } } } } while (0)

struct XcdBarrier {
    unsigned* bar; unsigned x;
    volatile LAS unsigned* st;
};

__device__ __forceinline__ XcdBarrier xcd_barrier_post(unsigned* bar, volatile LAS unsigned* st) {
    XcdBarrier b; b.bar = bar; b.x = xb_xcc_id(); b.st = st;
    if (threadIdx.x == 0) (void)xb_add(&bar[XB_XCNT(b.x)], 1u);
    return b;
}
__device__ __forceinline__ void xcd_barrier_complete(unsigned* bar, unsigned x, unsigned& nloc, unsigned& nx) {
    const unsigned G = gridDim.x * gridDim.y * gridDim.z;
    unsigned sum, cnt, mine, sp = 0u;
    for (;;) {
        sum = 0u; cnt = 0u; mine = 0u;
#pragma unroll
        for (unsigned j = 0; j < 16; ++j) { const unsigned c = xb_ld(&bar[XB_XCNT(j)]); sum += c; cnt += (c > 0u) ? 1u : 0u; mine = (j == x) ? c : mine; }
        if (sum == G) break;
        __builtin_amdgcn_s_sleep(1);
        if ((++sp & 255u) == 0u) { if (xb_ld(&bar[XB_TMO])) break; if (sp > XB_SPIN_CAP) { atomicAdd(&bar[XB_TMO], 1u); break; } }
    }
    nloc = mine > 0u ? mine : 1u; nx = cnt > 0u ? cnt : 1u;
}

__device__ __forceinline__ void xcd_barrier(const XcdBarrier& b) {
    asm volatile("s_waitcnt vmcnt(0)" ::: "memory");
    __syncthreads();
    if (threadIdx.x == 0) {
        unsigned* bar = b.bar;
        __builtin_amdgcn_s_waitcnt(0);
        unsigned nloc = b.st[0], nx = b.st[1];
        if (nloc == 0u) { xcd_barrier_complete(bar, b.x, nloc, nx); b.st[0] = nloc; b.st[1] = nx; }
        const unsigned old = xb_add(&bar[XB_XSUB(b.x)], 1u);
        const unsigned gen = old / nloc;
        if (old + 1u == (gen + 1u) * nloc) {
            __builtin_amdgcn_fence(__ATOMIC_RELEASE, "agent");
            asm volatile("s_waitcnt vmcnt(0)" ::: "memory");
            const unsigned og = xb_add(&bar[XB_TOP], 1u);
            const unsigned tg = og / nx;
            if (og + 1u == (tg + 1u) * nx) xb_add(&bar[XB_TOPGEN], 1u);
            else XB_SPIN(xb_ld(&bar[XB_TOPGEN]) == tg, bar);
            __builtin_amdgcn_fence(__ATOMIC_ACQUIRE, "agent");
            xb_add(&bar[XB_XGEN(b.x)], 1u);
            asm volatile("s_waitcnt vmcnt(0)" ::: "memory");
        } else {
            XB_SPIN(xb_ld(&bar[XB_XGEN(b.x)]) == gen, bar);
            __builtin_amdgcn_fence(__ATOMIC_ACQUIRE, "agent");
            asm volatile("s_waitcnt vmcnt(0)" ::: "memory");
        }
    }
    __syncthreads();
}

__global__ void __launch_bounds__(512, 2) mk_fwd(Params p) {
    extern __shared__ __attribute__((aligned(16))) unsigned char lds[];
    unsigned char* ws0 = p.ws;
    PG8_LAS unsigned char* ring = (PG8_LAS unsigned char*)lds;
#if MK_MULTI
#define GRID_SYNC() do { } while (0)
#else
    cg::grid_group grid = cg::this_grid();
    volatile LAS unsigned* bst = (volatile LAS unsigned*)((LAS unsigned char*)lds + pg8::STAGE_BYTES);
    if (threadIdx.x < 2) bst[threadIdx.x] = 0u;
    __syncthreads();
    XcdBarrier xbar = xcd_barrier_post((unsigned*)(ws0 + WS_CTL), bst);
#define GRID_SYNC() do { if (p.ph_hi > 100000) grid.sync(); else xcd_barrier(xbar); } while (0)
#endif
    for (int ph = p.ph_lo; ph < p.ph_hi; ++ph) {
        unsigned char* ws = ws0; int G = gridDim.x, c = blockIdx.x; asm volatile("" : "+s"(ws), "+s"(G), "+s"(c));
        float* ssq_mix = (float*)(ws + WS_SSQM); float* ssq_ffn = (float*)(ws + WS_SSQF); float* lns = (float*)(ws + WS_LNS);
        bf16_t* XB = (bf16_t*)(ws + WS_XB); bf16_t* AB = (bf16_t*)(ws + WS_AB); bf16_t* GV = (bf16_t*)(ws + WS_GV); bf16_t* CH = (bf16_t*)(ws + WS_CH);
        bf16_t* T12 = GV; bf16_t* MMb = AB; bf16_t* Hb = AB;
        int cl = -1, cf = 0;
        if (ph == 0) { cl = 0; }
        else if (ph == NPHASE - 1) { if (PHASE_MASK & 2) final_norm_phase(p); }
        else {
            const int l = (ph - 1) / 7, s = (ph - 1) % 7;
            for (int rep_ = 0; rep_ < (((PROBE_DUP >> s) & 1) ? 2 : 1); ++rep_) {
            const unsigned char* lw = ws + WS_W + (size_t)l * LW_BYTES;
            if (s == 0) { if (PHASE_MASK & 4) {
                pg8::Gemm g{XB, (const bf16_t*)(lw + LW_WIN), MT, 5120, DM, DM, 1 << 30, 0}; pg8::StaticOrder S; S.init(MT, 5120, G, c);
                pg8::EpiA E{AB, GV, CH, ssq_mix, lns};
                pg8::gemm_phase<pg8::EpiA, pg8::StaticOrder>(ring, g, S, E, (PG8_LAS float*)(ring + pg8::STAGE_BYTES + 256)); }
            } else if (s == 1) {
                if (PHASE_MASK & 8) gate_conv_phase(p, l, lds);
            } else if (s == 2) { if (PHASE_MASK & 16) {
                pg8::Gemm g{AB, (const bf16_t*)(lw + LW_WPAB), MT, 2048, DM, 2048, 4, 1024}; pg8::StaticOrder S; S.init(MT, 2048, G, c);
                pg8::EpiC E{T12};
                pg8::gemm_phase<pg8::EpiC, pg8::StaticOrder>(ring, g, S, E, (PG8_LAS float*)(ring + pg8::STAGE_BYTES + 256)); }
            } else if (s == 3) { if (PHASE_MASK & 32) {
                pg8::Gemm g{XB, (const bf16_t*)(lw + LW_WIN) + (size_t)5120 * DM, MT, 2048, DM, DM, 1 << 30, 0}; pg8::StaticOrder S; S.init(MT, 2048, G, c);
                pg8::EpiD E{T12, MMb, ssq_mix};
                pg8::gemm_phase<pg8::EpiD, pg8::StaticOrder>(ring, g, S, E, (PG8_LAS float*)(ring + pg8::STAGE_BYTES + 256)); }
            } else if (s == 4) { if (PHASE_MASK & 64) {
                pg8::Gemm g{MMb, (const bf16_t*)(lw + LW_WO), MT, DM, DM, DM, 1 << 30, 0}; pg8::StaticOrder S; S.init(MT, DM, G, c);
                pg8::EpiRes E{XB, ssq_ffn};
                pg8::gemm_phase<pg8::EpiRes, pg8::StaticOrder>(ring, g, S, E, (PG8_LAS float*)(ring + pg8::STAGE_BYTES + 256)); }
            } else if (s == 5) { if (PHASE_MASK & 128) {
                pg8::Gemm g{XB, (const bf16_t*)(lw + LW_WGU), MT, 2 * DFF, DM, DM, 1 << 30, 0}; pg8::StaticOrder S; S.init(MT, 2 * DFF, G, c);
                pg8::EpiF E{Hb, ssq_ffn};
                pg8::gemm_phase<pg8::EpiF, pg8::StaticOrder>(ring, g, S, E, (PG8_LAS float*)(ring + pg8::STAGE_BYTES + 256)); }
            } else { if (PHASE_MASK & 256) {
                pg8::Gemm g{Hb, (const bf16_t*)(lw + LW_WD), MT, DM, DFF, DFF, 1 << 30, 0}; pg8::StaticOrder S; S.init(MT, DM, G, c);
                pg8::EpiRes E{XB, ssq_mix};
                pg8::gemm_phase<pg8::EpiRes, pg8::StaticOrder>(ring, g, S, E, (PG8_LAS float*)(ring + pg8::STAGE_BYTES + 256));
                if (l + 1 < NL) { cl = l + 1; cf = S.ntot - S.nwg; } }
            }
            }
        }
        if (cl >= 0) p0_prologue(p, (float*)lds, cl, cf, ph == 0);
        if (ph + 1 < p.ph_hi) { GRID_SYNC(); }
    }
}

extern "C" void kernel_launch(void* const* d_in, const int* in_sizes, int n_in, void* d_out, int out_size, void* d_ws, size_t ws_size, hipStream_t stream) {
    static int grid = 0;
    if (grid == 0) {
        if (n_in != 18 || in_sizes[0] != MP * DM || (size_t)out_size != OUT_TOTAL || ws_size < WS_END) {
            fprintf(stderr, "kernel_launch: unexpected shapes: n_in %d in0 %d out %d ws %zu (need %zu)\n", n_in, n_in > 0 ? in_sizes[0] : -1, out_size, ws_size, (size_t)WS_END); grid = -1; return; }
        int dev = 0, cus = 0, per_cu = 0;
        (void)hipGetDevice(&dev); (void)hipDeviceGetAttribute(&cus, hipDeviceAttributeMultiprocessorCount, dev);
        if (hipFuncSetAttribute((const void*)mk_fwd, hipFuncAttributeMaxDynamicSharedMemorySize, LDS_BYTES) != hipSuccess) { fprintf(stderr, "kernel_launch: hipFuncSetAttribute failed\n"); grid = -1; return; }
        if (hipOccupancyMaxActiveBlocksPerMultiprocessor(&per_cu, (const void*)mk_fwd, 512, LDS_BYTES) != hipSuccess || per_cu < 1) { fprintf(stderr, "kernel_launch: occupancy query says %d\n", per_cu); per_cu = 1; }
        (void)hipGetLastError();
        grid = cus * 1;
        fprintf(stderr, "kernel_launch: cus %d per_cu %d grid %d\n", cus, per_cu, grid);
    }
    if (grid < 0) return;
    if (hipMemsetAsync((char*)d_ws + WS_CTL, 0, CTL_BYTES, stream) != hipSuccess) { fprintf(stderr, "kernel_launch: memset failed\n"); return; }
    Params p{};
    const float** pp = (const float**)&p;
    for (int i = 0; i < 18; ++i) pp[i] = (const float*)d_in[i];
    p.out = (float*)d_out; p.ws = (unsigned char*)d_ws;
#if MK_MULTI
    for (int ph = 0; ph < NPHASE; ++ph) { p.ph_lo = ph; p.ph_hi = ph + 1; hipLaunchKernelGGL(mk_fwd, dim3(grid), dim3(512), LDS_BYTES, stream, p); }
#else
    p.ph_lo = 0; p.ph_hi = NPHASE;
    void* args[] = {&p};
    hipError_t e = hipLaunchCooperativeKernel((const void*)mk_fwd, dim3(grid), dim3(512), args, LDS_BYTES, stream);
    if (e != hipSuccess) fprintf(stderr, "kernel_launch: cooperative launch failed: %s (grid %d)\n", hipGetErrorString(e), grid);
#endif
}
```
